# Optimizing an MI355X kernel written in HIP

```python
import math
import jax, jax.numpy as jnp
from jax import lax
import numpy as np

D_MODEL = 1024
BATCH = 2
SEQ = 8192
DEPTH = 2

N_META = 16
D_MIX = D_MODEL
EPS = 1e-6
N_ATTN_HEADS = 8
ATTN_HEAD_DIM = 64
D_ATTN = N_ATTN_HEADS * ATTN_HEAD_DIM
Q_RANK = 256
KV_RANK = 128
N_IDX_HEADS = 4
IDX_DIM = 64
TOPK_MAX = 256
Q_BLOCK = 128
N_REL_BUCKETS = 32
REL_MAX_DIST = 128
N_GDN_HEADS = 4
GDN_HEAD_DIM = 128
D_GDN = N_GDN_HEADS * GDN_HEAD_DIM
CONV_WIDTH = 4
CHUNK = 64
IN_PROJ_SPLITS = (Q_RANK, KV_RANK, IDX_DIM, N_IDX_HEADS, D_ATTN, D_GDN, D_GDN, D_GDN, D_GDN, N_GDN_HEADS, N_GDN_HEADS)
D_IN_PROJ = Q_RANK + KV_RANK + IDX_DIM + N_IDX_HEADS + D_ATTN + 4 * D_GDN + 2 * N_GDN_HEADS

kernel_name = "hybrid_dsa_gdn_parallel_heads"


def _split_last(a, sizes):
    outs, start = [], 0
    for s in sizes:
        outs.append(a[..., start:start + s])
        start += s
    return outs


def _rms_norm(x, gain):
    xf = x.astype(jnp.float32)
    y = xf * lax.rsqrt(jnp.mean(xf * xf, axis=-1, keepdims=True) + EPS)
    return (y * gain.astype(jnp.float32)).astype(x.dtype)


def _l2_norm(x):
    return x * lax.rsqrt(jnp.sum(x * x, axis=-1, keepdims=True) + EPS)


def _pad_seq(a, before, after):
    widths = [(0, 0)] * a.ndim
    widths[1] = (before, after)
    return jnp.pad(a, widths)


def _t5_bucket(dist):
    n = jnp.maximum(dist, 0)
    max_exact = N_REL_BUCKETS // 2
    nf = jnp.maximum(n, 1).astype(jnp.float32)
    large = max_exact + (jnp.log(nf / max_exact) / math.log(REL_MAX_DIST / max_exact)
                         * (N_REL_BUCKETS - max_exact)).astype(jnp.int32)
    large = jnp.minimum(large, N_REL_BUCKETS - 1)
    return jnp.where(n < max_exact, n, large)


def _dsa_mixer(c_q, c_kv, k_idx, w_idx, g_cq, g_ckv, w_uq, w_ukv, w_q_idx, g_qn, g_kn, rel_table, topk):
    B, T, _ = c_q.shape
    cq = _rms_norm(c_q, g_cq)
    ckv = _rms_norm(c_kv, g_ckv)
    q = _rms_norm((cq @ w_uq).reshape(B, T, N_ATTN_HEADS, ATTN_HEAD_DIM), g_qn)
    k_lin, v = _split_last(ckv @ w_ukv, (D_ATTN, D_ATTN))
    k = _rms_norm(k_lin.reshape(B, T, N_ATTN_HEADS, ATTN_HEAD_DIM), g_kn)
    v = v.reshape(B, T, N_ATTN_HEADS, ATTN_HEAD_DIM)
    q_idx = (cq @ w_q_idx).reshape(B, T, N_IDX_HEADS, IDX_DIM)
    w_idx = w_idx * (N_IDX_HEADS ** -0.5)

    n_blk = -(-T // Q_BLOCK)
    Tp = n_blk * Q_BLOCK
    pad = Tp - T
    q_p, qi_p, wi_p = _pad_seq(q, 0, pad), _pad_seq(q_idx, 0, pad), _pad_seq(w_idx, 0, pad)
    k_p, v_p, ki_p = _pad_seq(k, 0, pad), _pad_seq(v, 0, pad), _pad_seq(k_idx, 0, pad)
    key_pos = jnp.arange(Tp, dtype=jnp.int32)
    scale = ATTN_HEAD_DIM ** -0.5

    def to_blocks(a):
        return jnp.moveaxis(a.reshape((B, n_blk, Q_BLOCK) + a.shape[2:]), 1, 0)

    def one_block(args):
        qb, qib, wb, t0 = args
        q_pos = t0 + jnp.arange(Q_BLOCK, dtype=jnp.int32)
        causal = key_pos[None, :] <= q_pos[:, None]
        idx_logits = jnp.einsum('bqhd,bsd->bqhs', qib, ki_p) * (IDX_DIM ** -0.5)
        idx_score = jnp.einsum('bqh,bqhs->bqs', wb, jax.nn.relu(idx_logits)).astype(jnp.float32)
        idx_score = jnp.where(causal[None], idx_score, -jnp.inf)
        _, sel = lax.top_k(idx_score, topk)
        valid = sel <= q_pos[None, :, None]
        kg = jax.vmap(lambda a, i: a[i])(k_p, sel)
        vg = jax.vmap(lambda a, i: a[i])(v_p, sel)
        bias = rel_table[_t5_bucket(q_pos[None, :, None] - sel)]
        logits = (jnp.einsum('bqhd,bqkhd->bqhk', qb, kg).astype(jnp.float32) * scale
                  + jnp.moveaxis(bias, -1, 2).astype(jnp.float32))
        logits = jnp.where(valid[:, :, None, :], logits, -jnp.inf)
        p = jax.nn.softmax(logits, axis=-1).astype(vg.dtype)
        return jnp.einsum('bqhk,bqkhd->bqhd', p, vg)

    t0s = jnp.arange(n_blk, dtype=jnp.int32) * Q_BLOCK
    out = lax.map(one_block, (to_blocks(q_p), to_blocks(qi_p), to_blocks(wi_p), t0s))
    return jnp.moveaxis(out, 0, 1).reshape(B, Tp, D_ATTN)[:, :T]


def _gdn_mixer(q, k, v, z, b, a, conv_w, a_log, dt_bias, g_out, n_front):
    B, T, _ = q.shape
    f32 = jnp.float32
    H, d = N_GDN_HEADS, GDN_HEAD_DIM
    qkv = jnp.concatenate([q, k, v], axis=-1).astype(f32)
    qkv = lax.conv_general_dilated(qkv, conv_w.astype(f32)[:, None, :], window_strides=(1,),
                                   padding=[(CONV_WIDTH - 1, 0)], dimension_numbers=('NWC', 'WIO', 'NWC'),
                                   feature_group_count=3 * D_GDN)
    qkv = jax.nn.silu(qkv)
    qc, kc, vc = _split_last(qkv, (D_GDN, D_GDN, D_GDN))
    qc = _l2_norm(qc.reshape(B, T, H, d)) * (d ** -0.5)
    kc = _l2_norm(kc.reshape(B, T, H, d))
    vc = vc.reshape(B, T, H, d)
    beta = jax.nn.sigmoid(b.astype(f32))
    g = -jnp.exp(a_log.astype(f32)) * jax.nn.softplus(a.astype(f32) + dt_bias.astype(f32))

    qc, kc, vc, beta, g = (_pad_seq(t, n_front, 0) for t in (qc, kc, vc, beta, g))
    Tc = T + n_front
    N = Tc // CHUNK

    def chunks4(t):
        return t.reshape(B, N, CHUNK, H, d).transpose(0, 3, 1, 2, 4)

    def chunks3(t):
        return t.reshape(B, N, CHUNK, H).transpose(0, 3, 1, 2)

    qc, kc, vc = chunks4(qc), chunks4(kc), chunks4(vc)
    beta, g = chunks3(beta), chunks3(g)
    decay = jnp.cumsum(g, axis=-1)
    tri = jnp.tril(jnp.ones((CHUNK, CHUNK), dtype=bool))
    strict = jnp.tril(jnp.ones((CHUNK, CHUNK), dtype=bool), -1)
    gamma = jnp.exp(jnp.where(tri, decay[..., :, None] - decay[..., None, :], -jnp.inf))
    kb = kc * beta[..., None]
    amat = jnp.eye(CHUNK, dtype=f32) + jnp.where(strict, jnp.einsum('bhncd,bhnsd->bhncs', kb, kc) * gamma, 0.0)
    u = lax.linalg.triangular_solve(amat, vc * beta[..., None], left_side=True, lower=True, unit_diagonal=True)
    w = lax.linalg.triangular_solve(amat, kb * jnp.exp(decay)[..., None], left_side=True, lower=True,
                                    unit_diagonal=True)
    aqk = jnp.where(tri, jnp.einsum('bhncd,bhnsd->bhncs', qc, kc) * gamma, 0.0)
    q_dec = qc * jnp.exp(decay)[..., None]
    k_dec = kc * jnp.exp(decay[..., -1:] - decay)[..., None]
    chunk_decay = jnp.exp(decay[..., -1])

    def step(S, xs):
        u_i, w_i, qd_i, kd_i, aqk_i, cd_i = xs
        v_new = u_i - jnp.einsum('bhcd,bhde->bhce', w_i, S)
        o = jnp.einsum('bhcd,bhde->bhce', qd_i, S) + jnp.einsum('bhcs,bhse->bhce', aqk_i, v_new)
        S = S * cd_i[..., None, None] + jnp.einsum('bhcd,bhce->bhde', kd_i, v_new)
        return S, o

    xs = tuple(jnp.moveaxis(t, 2, 0) for t in (u, w, q_dec, k_dec, aqk, chunk_decay))
    S0 = jnp.zeros((B, H, d, d), f32)
    _, o = lax.scan(step, S0, xs)
    o = o.transpose(1, 0, 3, 2, 4).reshape(B, Tc, H, d)[:, n_front:]
    o = _rms_norm(o, g_out) * jax.nn.silu(z.astype(f32).reshape(B, T, H, d))
    return o.reshape(B, T, D_GDN)


def _hybrid_layer(h, norm_gain, w_in, cq_norm_gain, ckv_norm_gain, w_uq, w_ukv, w_q_idx, q_norm_gain,
                  k_norm_gain, conv_w, a_log, dt_bias, gdn_norm_gain, w_out, rel_table, topk):
    hn = _rms_norm(h, norm_gain)
    proj = hn @ w_in
    (c_q, c_kv, k_idx, w_idx, z_attn, q_g, k_g, v_g, z_g, b_g, a_g) = _split_last(proj, IN_PROJ_SPLITS)
    o_attn = _dsa_mixer(c_q, c_kv, k_idx, w_idx, cq_norm_gain, ckv_norm_gain, w_uq, w_ukv, w_q_idx,
                        q_norm_gain, k_norm_gain, rel_table, topk) * jax.nn.silu(z_attn)
    o_gdn = _gdn_mixer(q_g, k_g, v_g, z_g, b_g, a_g, conv_w, a_log, dt_bias, gdn_norm_gain,
                       (-N_META) % CHUNK).astype(h.dtype)
    y = jnp.concatenate([o_attn.astype(h.dtype), o_gdn], axis=-1) @ w_out
    return h + y


def setup_inputs(seed: int = 0) -> dict:
    key = jax.random.key(seed)
    ks = jax.random.split(key, 20)
    nrm = jax.random.normal
    x = nrm(ks[0], (BATCH, SEQ, D_MODEL), jnp.float32)
    meta_tokens = nrm(ks[1], (N_META, D_MODEL), jnp.float32)
    rel_bias_table = 0.5 * nrm(ks[2], (N_REL_BUCKETS, N_ATTN_HEADS), jnp.float32)
    norm_gain = 1.0 + 0.02 * nrm(ks[3], (DEPTH, D_MODEL), jnp.float32)
    w_in = nrm(ks[4], (DEPTH, D_MODEL, D_IN_PROJ), jnp.float32) * D_MODEL ** -0.5
    cq_norm_gain = 1.0 + 0.02 * nrm(ks[5], (DEPTH, Q_RANK), jnp.float32)
    ckv_norm_gain = 1.0 + 0.02 * nrm(ks[6], (DEPTH, KV_RANK), jnp.float32)
    w_uq = nrm(ks[7], (DEPTH, Q_RANK, D_ATTN), jnp.float32) * Q_RANK ** -0.5
    w_ukv = nrm(ks[8], (DEPTH, KV_RANK, 2 * D_ATTN), jnp.float32) * KV_RANK ** -0.5
    w_q_idx = nrm(ks[9], (DEPTH, Q_RANK, N_IDX_HEADS * IDX_DIM), jnp.float32) * Q_RANK ** -0.5
    q_norm_gain = 1.0 + 0.02 * nrm(ks[10], (DEPTH, ATTN_HEAD_DIM), jnp.float32)
    k_norm_gain = 1.0 + 0.02 * nrm(ks[11], (DEPTH, ATTN_HEAD_DIM), jnp.float32)
    conv_w = nrm(ks[12], (DEPTH, CONV_WIDTH, 3 * D_GDN), jnp.float32) * CONV_WIDTH ** -0.5
    a_log = jnp.log(jax.random.uniform(ks[13], (DEPTH, N_GDN_HEADS), jnp.float32, minval=1.0, maxval=16.0))
    dt = jnp.exp(jax.random.uniform(ks[14], (DEPTH, N_GDN_HEADS), jnp.float32,
                                    minval=math.log(1e-3), maxval=math.log(1e-1)))
    dt_bias = dt + jnp.log(-jnp.expm1(-dt))
    gdn_norm_gain = 1.0 + 0.02 * nrm(ks[15], (DEPTH, GDN_HEAD_DIM), jnp.float32)
    w_out = nrm(ks[16], (DEPTH, D_MIX, D_MODEL), jnp.float32) * D_MIX ** -0.5
    return {"x": x, "meta_tokens": meta_tokens, "rel_bias_table": rel_bias_table, "norm_gain": norm_gain,
            "w_in": w_in, "cq_norm_gain": cq_norm_gain, "ckv_norm_gain": ckv_norm_gain, "w_uq": w_uq,
            "w_ukv": w_ukv, "w_q_idx": w_q_idx, "q_norm_gain": q_norm_gain, "k_norm_gain": k_norm_gain,
            "conv_w": conv_w, "a_log": a_log, "dt_bias": dt_bias, "gdn_norm_gain": gdn_norm_gain,
            "w_out": w_out}


def reference(x, meta_tokens, rel_bias_table, norm_gain, w_in, cq_norm_gain, ckv_norm_gain, w_uq, w_ukv,
              w_q_idx, q_norm_gain, k_norm_gain, conv_w, a_log, dt_bias, gdn_norm_gain, w_out):
    B, S, _ = x.shape
    topk = min(TOPK_MAX, S // 4)
    meta = jnp.broadcast_to(meta_tokens[None].astype(x.dtype), (B, N_META, D_MODEL))
    h = jnp.concatenate([meta, x], axis=1)
    for l in range(DEPTH):
        h = _hybrid_layer(h, norm_gain[l], w_in[l], cq_norm_gain[l], ckv_norm_gain[l], w_uq[l], w_ukv[l],
                          w_q_idx[l], q_norm_gain[l], k_norm_gain[l], conv_w[l], a_log[l], dt_bias[l],
                          gdn_norm_gain[l], w_out[l], rel_bias_table, topk)
    return h[:, N_META:]
```

```cpp
#include <hip/hip_runtime.h>
#include <hip/hip_cooperative_groups.h>
#include <stdio.h>
#include <stdint.h>
namespace cg = cooperative_groups;

#ifndef N_LAUNCH_MODE
#define N_LAUNCH_MODE 1
#endif

typedef _Float16 h16;
typedef h16 h16x8 __attribute__((ext_vector_type(8)));
typedef h16 h16x4 __attribute__((ext_vector_type(4)));
typedef float f32x4 __attribute__((ext_vector_type(4)));
typedef float f32x16 __attribute__((ext_vector_type(16)));
typedef unsigned long long u64;

#define MFMA32(a, b, c) __builtin_amdgcn_mfma_f32_32x32x16_f16(a, b, c, 0, 0, 0)
#define MFMA16(a, b, c) __builtin_amdgcn_mfma_f32_16x16x32_f16(a, b, c, 0, 0, 0)
#define WAVE_FENCE() do { __builtin_amdgcn_fence(__ATOMIC_SEQ_CST, "wavefront"); __builtin_amdgcn_wave_barrier(); } while (0)

constexpr int T_ = 8208;
constexpr int NT = 16416;
constexpr int NTP = 16512;
constexpr int NRB = 129;
constexpr int NCH = 129;
constexpr int NGI = 8 * NCH;
constexpr int NKT = 257;
constexpr float EPS = 1e-6f;
constexpr int NTHREADS = 256;
constexpr int LDS_BYTES = 122880;
constexpr int NPHASE = 11;

constexpr size_t OFF_CTL = 0;
constexpr size_t OFF_W1T = 4096;
constexpr size_t OFF_WOT = OFF_W1T + (size_t)2 * 3072 * 1024 * 2;
constexpr size_t OFF_WQ2T = OFF_WOT + (size_t)2 * 1024 * 1024 * 2;
constexpr size_t OFF_WUKT = OFF_WQ2T + (size_t)2 * 768 * 256 * 2;
constexpr size_t OFF_WKABS = OFF_WUKT + (size_t)2 * 512 * 128 * 2;
constexpr size_t OFF_WUVT = OFF_WKABS + (size_t)2 * 8 * 128 * 64 * 2;
constexpr size_t OFF_SMALL = OFF_WUVT + (size_t)2 * 8 * 64 * 128 * 2;
constexpr size_t OFF_SZA = OFF_SMALL + (size_t)NTP * 16 * 4;
constexpr size_t OFF_SZG = OFF_SZA + (size_t)NTP * 512 * 2;
constexpr size_t OFF_PROJG = OFF_SZG + (size_t)NTP * 512 * 2;
constexpr size_t OFF_PROJA = OFF_PROJG + (size_t)NTP * 1536 * 2;
constexpr size_t OFF_QIDX = OFF_PROJA + (size_t)NTP * 512 * 2;
constexpr size_t OFF_QN = OFF_QIDX + (size_t)NTP * 256 * 2;
constexpr size_t OFF_QK = OFF_QN + (size_t)NTP * 512 * 2;
constexpr size_t OFF_KVROW = OFF_QK + (size_t)NTP * 1024 * 2;
constexpr size_t OFF_KFRAG = OFF_KVROW + (size_t)NTP * 136 * 2;
constexpr size_t OFF_U = OFF_KFRAG + (size_t)2 * NKT * 2048 * 2;
constexpr size_t OFF_WM = OFF_U + (size_t)NGI * 8192 * 2;
constexpr size_t OFF_QD = OFF_WM + (size_t)NGI * 8192 * 2;
constexpr size_t OFF_KDT = OFF_QD + (size_t)NGI * 8192 * 2;
constexpr size_t OFF_AQK = OFF_KDT + (size_t)NGI * 8192 * 2;
constexpr size_t OFF_CDEC = OFF_AQK + (size_t)NGI * 4096 * 2;
constexpr size_t OFF_METAH = OFF_CDEC + 8192;
constexpr size_t WS_END = OFF_METAH + (size_t)2 * 16 * 1024 * 4;
constexpr size_t OFF_CTX = OFF_PROJG;
constexpr size_t OFF_OMIX = OFF_PROJG + (size_t)NTP * 1024 * 2;

struct Params {
    const float* x; const float* meta; const float* rel; const float* norm_gain; const float* w_in;
    const float* g_cq; const float* g_ckv; const float* w_uq; const float* w_ukv; const float* w_qidx;
    const float* g_qn; const float* g_kn; const float* conv_w; const float* a_log; const float* dt_bias;
    const float* g_out; const float* w_out;
    float* out; unsigned char* ws;
    int ph_lo, ph_hi;
};

__constant__ unsigned char c_bucket[128] = {
    0, 1, 2, 3, 4, 5, 6, 7, 8, 9, 10, 11, 12, 13, 14, 15, 16, 16, 16, 17, 17, 18, 18, 18, 19, 19, 19, 20, 20, 20, 20, 21,
    21, 21, 21, 22, 22, 22, 22, 22, 23, 23, 23, 23, 23, 23, 24, 24, 24, 24, 24, 24, 25, 25, 25, 25, 25, 25, 25, 26, 26, 26, 26, 26,
    26, 26, 26, 27, 27, 27, 27, 27, 27, 27, 27, 27, 27, 28, 28, 28, 28, 28, 28, 28, 28, 28, 28, 29, 29, 29, 29, 29, 29, 29, 29, 29,
    29, 29, 29, 30, 30, 30, 30, 30, 30, 30, 30, 30, 30, 30, 30, 30, 30, 31, 31, 31, 31, 31, 31, 31, 31, 31, 31, 31, 31, 31, 31, 31};

__device__ __forceinline__ float silu_f(float x) { return x / (1.f + __expf(-x)); }
__device__ __forceinline__ int lanes_below(u64 m) { return __builtin_amdgcn_mbcnt_hi((unsigned)(m >> 32), __builtin_amdgcn_mbcnt_lo((unsigned)m, 0)); }
__device__ __forceinline__ unsigned ordkey(float f) { unsigned u = __float_as_uint(f); return (u & 0x80000000u) ? ~u : (u | 0x80000000u); }
__device__ __forceinline__ float ordinv(unsigned k) { unsigned u = (k & 0x80000000u) ? (k & 0x7fffffffu) : ~k; return __uint_as_float(u); }
__device__ __forceinline__ int opaque_tid() { int t = threadIdx.x; asm volatile("" : "+v"(t)); return t; }
__device__ __forceinline__ void lds_barrier() { asm volatile("s_waitcnt lgkmcnt(0)\n\ts_barrier" ::: "memory"); }

constexpr int GS = 72;

struct AF16 {
    const h16* p; int ld;
    __device__ __forceinline__ void init(int) {}
    __device__ __forceinline__ h16x8 load(int i, int row, int k) { return *(const h16x8*)(p + (size_t)row * ld + k); }
};

struct AH32 {
    const float* meta; const float* xs; int meta_bstride;
    const float* rp[4]; float ss[4];
    __device__ __forceinline__ const float* rowptr(int row) const {
        row = row < NT ? row : NT - 1;
        int b = row >= T_ ? 1 : 0; int t = row - b * T_;
        return t < 16 ? meta + (size_t)b * meta_bstride + (size_t)t * 1024 : xs + ((size_t)b * 8192 + (t - 16)) * 1024;
    }
    __device__ __forceinline__ h16x8 load(int i, int, int k) {
        const float4 v0 = *(const float4*)(rp[i] + k), v1 = *(const float4*)(rp[i] + k + 4);
        ss[i] += v0.x * v0.x + v0.y * v0.y + v0.z * v0.z + v0.w * v0.w + v1.x * v1.x + v1.y * v1.y + v1.z * v1.z + v1.w * v1.w;
        h16x8 r; r[0] = (h16)v0.x; r[1] = (h16)v0.y; r[2] = (h16)v0.z; r[3] = (h16)v0.w; r[4] = (h16)v1.x; r[5] = (h16)v1.y; r[6] = (h16)v1.z; r[7] = (h16)v1.w;
        return r;
    }
};

template <int BN, class AL, class EP>
__device__ __forceinline__ void gemm_tile(AL& al, int arow0, const h16* __restrict__ Bt, int ldb, int K, EP& ep, h16* smem) {
    const int tid = opaque_tid(), lane = tid & 63, w = tid >> 6, wm = w >> 1, wn = w & 1;
    constexpr int NTL = BN / 64;
    constexpr int NBG = BN / 32;
    constexpr int BUF = (128 + BN) * GS;
    f32x16 acc[2][NTL];
#pragma unroll
    for (int i = 0; i < 2; ++i)
#pragma unroll
        for (int j = 0; j < NTL; ++j)
#pragma unroll
            for (int r = 0; r < 16; ++r) acc[i][j][r] = 0.f;
    h16x8 ra[4], rb[NBG];
    const int nk = K >> 6;
#pragma unroll
    for (int i = 0; i < 4; ++i) { int g = tid + 256 * i; ra[i] = al.load(i, arow0 + (g >> 3), (g & 7) * 8); }
#pragma unroll
    for (int i = 0; i < NBG; ++i) { int g = tid + 256 * i; rb[i] = *(const h16x8*)(Bt + (size_t)(g >> 3) * ldb + (g & 7) * 8); }
    __syncthreads();
#pragma unroll
    for (int i = 0; i < 4; ++i) { int g = tid + 256 * i; *(h16x8*)(smem + (g >> 3) * GS + (g & 7) * 8) = ra[i]; }
#pragma unroll
    for (int i = 0; i < NBG; ++i) { int g = tid + 256 * i; *(h16x8*)(smem + 128 * GS + (g >> 3) * GS + (g & 7) * 8) = rb[i]; }
    __syncthreads();
    for (int kt = 0; kt < nk; ++kt) {
        const int cur = kt & 1;
        const h16* sA = smem + cur * BUF;
        const h16* sB = sA + 128 * GS;
        if (kt + 1 < nk) {
            const int k0 = (kt + 1) << 6;
#pragma unroll
            for (int i = 0; i < 4; ++i) { int g = tid + 256 * i; ra[i] = al.load(i, arow0 + (g >> 3), k0 + (g & 7) * 8); }
#pragma unroll
            for (int i = 0; i < NBG; ++i) { int g = tid + 256 * i; rb[i] = *(const h16x8*)(Bt + (size_t)(g >> 3) * ldb + k0 + (g & 7) * 8); }
        }
#pragma unroll
        for (int ks = 0; ks < 4; ++ks) {
            h16x8 af[2], bf[NTL];
#pragma unroll
            for (int mt = 0; mt < 2; ++mt) af[mt] = *(const h16x8*)(sA + (64 * wm + 32 * mt + (lane & 31)) * GS + 16 * ks + 8 * (lane >> 5));
#pragma unroll
            for (int nt = 0; nt < NTL; ++nt) bf[nt] = *(const h16x8*)(sB + ((BN / 2) * wn + 32 * nt + (lane & 31)) * GS + 16 * ks + 8 * (lane >> 5));
#pragma unroll
            for (int mt = 0; mt < 2; ++mt)
#pragma unroll
                for (int nt = 0; nt < NTL; ++nt) acc[mt][nt] = MFMA32(af[mt], bf[nt], acc[mt][nt]);
        }
        if (kt + 1 < nk) {
            h16* dA = smem + (cur ^ 1) * BUF;
            h16* dB = dA + 128 * GS;
#pragma unroll
            for (int i = 0; i < 4; ++i) { int g = tid + 256 * i; *(h16x8*)(dA + (g >> 3) * GS + (g & 7) * 8) = ra[i]; }
#pragma unroll
            for (int i = 0; i < NBG; ++i) { int g = tid + 256 * i; *(h16x8*)(dB + (g >> 3) * GS + (g & 7) * 8) = rb[i]; }
        }
        __syncthreads();
    }
    ep.pre(al);
    float* ft = (float*)smem;
#pragma unroll
    for (int mt = 0; mt < 2; ++mt)
#pragma unroll
        for (int nt = 0; nt < NTL; ++nt)
#pragma unroll
            for (int r = 0; r < 16; ++r) {
                const int rl = 64 * wm + 32 * mt + (r & 3) + 8 * (r >> 2) + 4 * (lane >> 5);
                const int cl = (BN / 2) * wn + 32 * nt + (lane & 31);
                ft[rl * (BN + 1) + cl] = acc[mt][nt][r];
            }
    __syncthreads();
    if (EP::kSweep) {
#pragma unroll 4
        for (int idx = tid; idx < 128 * BN; idx += NTHREADS) { const int rl = idx / BN, cl = idx % BN; ep(rl, cl, ft[rl * (BN + 1) + cl]); }
    }
}

struct EpiInProj {
    static constexpr bool kSweep = true;
    int row0, n0; const float* rstd; h16* projA; float* small; h16* sza; h16* szg; h16* projG;
    template <class AL_> __device__ __forceinline__ void pre(AL_&) {}
    __device__ __forceinline__ void operator()(int rl, int cl, float v) const {
        const int row = row0 + rl; const float y = v * rstd[rl]; const int c = n0 + cl;
        if (c < 512) { if (c < 448) projA[(size_t)row * 512 + c] = (h16)y; else if (c < 460) small[(size_t)row * 16 + (c - 448)] = y; }
        else if (c < 1024) sza[(size_t)row * 512 + (c - 512)] = (h16)silu_f(y);
        else if (c < 2560) projG[(size_t)row * 1536 + (c - 1024)] = (h16)y;
        else szg[(size_t)row * 512 + (c - 2560)] = (h16)silu_f(y);
    }
};
struct EpiIn2 : EpiInProj {
    float* rstd_w; int tid;
    __device__ __forceinline__ void pre(AH32& al) {
#pragma unroll
        for (int i = 0; i < 4; ++i) {
            float s = al.ss[i];
            s += __shfl_xor(s, 1); s += __shfl_xor(s, 2); s += __shfl_xor(s, 4);
            if ((tid & 7) == 0) rstd_w[(tid + 256 * i) >> 3] = rsqrtf(s * (1.f / 1024.f) + EPS);
        }
        __syncthreads();
    }
};
struct EpiTileF32 {
    static constexpr bool kSweep = false;
    template <class AL_> __device__ __forceinline__ void pre(AL_&) {}
    __device__ __forceinline__ void operator()(int, int, float) const {}
};
struct EpiStoreH {
    static constexpr bool kSweep = true;
    h16* dst; int ld; int row0; const float* rs;
    template <class AL_> __device__ __forceinline__ void pre(AL_&) {}
    __device__ __forceinline__ void operator()(int rl, int cl, float v) const { dst[(size_t)(row0 + rl) * ld + cl] = (h16)(rs ? v * rs[rl] : v); }
};
struct EpiGate {
    static constexpr bool kSweep = true;
    h16* dst; const h16* gate; int row0; int c0;
    template <class AL_> __device__ __forceinline__ void pre(AL_&) {}
    __device__ __forceinline__ void operator()(int rl, int cl, float v) const {
        const size_t row = row0 + rl;
        dst[row * 1024 + c0 + cl] = (h16)(v * (float)gate[row * 512 + c0 + cl]);
    }
};
struct EpiResid {
    static constexpr bool kSweep = true;
    int layer; int row0; int n0; const float* meta; const float* x; float* metah; float* out;
    template <class AL_> __device__ __forceinline__ void pre(AL_&) {}
    __device__ __forceinline__ void operator()(int rl, int cl, float v) const {
        const int row = row0 + rl; if (row >= NT) return;
        const int b = row >= T_ ? 1 : 0; const int t = row - b * T_; const int c = n0 + cl;
        if (layer == 0) {
            if (t < 16) metah[((size_t)b * 16 + t) * 1024 + c] = meta[(size_t)t * 1024 + c] + v;
            else { const size_t o = ((size_t)b * 8192 + (t - 16)) * 1024 + c; out[o] = x[o] + v; }
        } else {
            if (t >= 16) { const size_t o = ((size_t)b * 8192 + (t - 16)) * 1024 + c; out[o] = out[o] + v; }
        }
    }
};

__device__ __forceinline__ int in_src_col(int n) {
    if (n < 452) return n;
    if (n < 456) return 3012 + (n - 452);
    if (n < 460) return 3016 + (n - 456);
    if (n < 512) return -1;
    if (n < 1024) return 452 + (n - 512);
    if (n < 2560) return 964 + (n - 1024);
    return 2500 + (n - 2560);
}
__device__ __forceinline__ float prep_get(const Params& P, int l, int job, int h, int n, int k) {
    switch (job) {
        case 0: { const int s = in_src_col(n); if (s < 0) return 0.f; return P.norm_gain[l * 1024 + k] * P.w_in[((size_t)l * 1024 + k) * 3020 + s]; }
        case 1: return P.w_out[((size_t)l * 1024 + k) * 1024 + n];
        case 2: return P.g_cq[l * 256 + k] * (n < 512 ? P.w_uq[((size_t)l * 256 + k) * 512 + n] : P.w_qidx[((size_t)l * 256 + k) * 256 + (n - 512)]);
        case 3: return P.w_ukv[((size_t)l * 128 + k) * 1024 + n];
        case 4: return P.w_ukv[((size_t)l * 128 + n) * 1024 + h * 64 + k] * P.g_kn[l * 64 + k] * 0.125f;
        default: return P.w_ukv[((size_t)l * 128 + k) * 1024 + 512 + h * 64 + n];
    }
}
__device__ void phase_prep(const Params& P, unsigned char* lds) {
    float* tile = (float*)lds;
    const int tid = opaque_tid();
    for (int it = blockIdx.x; it < 2240; it += gridDim.x) {
        const int l = it / 1120; int r = it % 1120;
        int job, h = 0, N, K, tn, tk; h16* dst;
        if (r < 768) { job = 0; N = 3072; K = 1024; tn = r / 16; tk = r % 16; dst = (h16*)(P.ws + OFF_W1T) + (size_t)l * 3072 * 1024; }
        else if ((r -= 768) < 256) { job = 1; N = 1024; K = 1024; tn = r / 16; tk = r % 16; dst = (h16*)(P.ws + OFF_WOT) + (size_t)l * 1024 * 1024; }
        else if ((r -= 256) < 48) { job = 2; N = 768; K = 256; tn = r / 4; tk = r % 4; dst = (h16*)(P.ws + OFF_WQ2T) + (size_t)l * 768 * 256; }
        else if ((r -= 48) < 16) { job = 3; N = 512; K = 128; tn = r / 2; tk = r % 2; dst = (h16*)(P.ws + OFF_WUKT) + (size_t)l * 512 * 128; }
        else if ((r -= 16) < 16) { job = 4; N = 128; K = 64; h = r / 2; tn = r % 2; tk = 0; dst = (h16*)(P.ws + OFF_WKABS) + ((size_t)l * 8 + h) * 128 * 64; }
        else { r -= 16; job = 5; N = 64; K = 128; h = r / 2; tn = 0; tk = r % 2; dst = (h16*)(P.ws + OFF_WUVT) + ((size_t)l * 8 + h) * 64 * 128; }
        (void)N;
        const int n0 = tn * 64, k0 = tk * 64;
        __syncthreads();
#pragma unroll 4
        for (int q = 0; q < 16; ++q) { const int kk = q * 4 + (tid >> 6), nn = tid & 63; tile[kk * 65 + nn] = prep_get(P, l, job, h, n0 + nn, k0 + kk); }
        __syncthreads();
#pragma unroll 4
        for (int q = 0; q < 16; ++q) { const int nn = q * 4 + (tid >> 6), kk = tid & 63; dst[(size_t)(n0 + nn) * K + k0 + kk] = (h16)tile[kk * 65 + nn]; }
    }
}

__device__ void phase_inproj(const Params& P, int l, unsigned char* lds) {
    h16* smem = (h16*)lds;
    float* rstd = (float*)(lds + 73728);
    const int tid = opaque_tid();
    const h16* W = (const h16*)(P.ws + OFF_W1T) + (size_t)l * 3072 * 1024;
    for (int it = blockIdx.x; it < NRB * 24; it += gridDim.x) {
        const int rb = it / 24, tn = it % 24;
        AH32 al;
        if (l == 0) { al.meta = P.meta; al.xs = P.x; al.meta_bstride = 0; }
        else { al.meta = (const float*)(P.ws + OFF_METAH); al.xs = P.out; al.meta_bstride = 16 * 1024; }
#pragma unroll
        for (int i = 0; i < 4; ++i) { al.rp[i] = al.rowptr(rb * 128 + ((tid + 256 * i) >> 3)); al.ss[i] = 0.f; }
        EpiIn2 ep;
        ep.row0 = rb * 128; ep.n0 = tn * 128; ep.rstd = rstd;
        ep.projA = (h16*)(P.ws + OFF_PROJA); ep.small = (float*)(P.ws + OFF_SMALL); ep.sza = (h16*)(P.ws + OFF_SZA); ep.szg = (h16*)(P.ws + OFF_SZG); ep.projG = (h16*)(P.ws + OFF_PROJG);
        ep.rstd_w = rstd; ep.tid = tid;
        gemm_tile<128>(al, rb * 128, W + (size_t)tn * 128 * 1024, 1024, 1024, ep, smem);
    }
}

__device__ void p2a_item(const Params& P, int l, int rb, int j, unsigned char* lds) {
    h16* smem = (h16*)lds;
    float* ft = (float*)lds;
    float* rstdq = (float*)(lds + 73728);
    const int tid = opaque_tid(); const int row0 = rb * 128;
    const h16* projA = (const h16*)(P.ws + OFF_PROJA);
    __syncthreads();
    {
        const int row = row0 + (tid >> 1), hf = tid & 1; float s = 0.f;
#pragma unroll 4
        for (int q = 0; q < 16; ++q) { const h16x8 v = *(const h16x8*)(projA + (size_t)row * 512 + hf * 128 + q * 8);
#pragma unroll
            for (int e = 0; e < 8; ++e) { const float f = (float)v[e]; s += f * f; } }
        s += __shfl_xor(s, 1);
        if (hf == 0) rstdq[tid >> 1] = rsqrtf(s * (1.f / 256.f) + EPS);
    }
    __syncthreads();
    const h16* Wq2 = (const h16*)(P.ws + OFF_WQ2T) + (size_t)l * 768 * 256;
    AF16 al{projA, 512};
    if (j >= 4) {
        EpiStoreH ep{(h16*)(P.ws + OFF_QIDX) + (j - 4) * 128, 256, row0, rstdq};
        gemm_tile<128>(al, row0, Wq2 + (size_t)j * 128 * 256, 256, 256, ep, smem);
        return;
    }
    EpiTileF32 ep;
    gemm_tile<128>(al, row0, Wq2 + (size_t)j * 128 * 256, 256, 256, ep, smem);
    __syncthreads();
    h16* qn = (h16*)(P.ws + OFF_QN);
    {
        const int rl = tid >> 1, hh = tid & 1; float s = 0.f;
        const float rq = rstdq[rl];
        for (int d = 0; d < 64; ++d) { const float f = ft[rl * 129 + hh * 64 + d] * rq; s += f * f; }
        const float rs = rsqrtf(s * (1.f / 64.f) + EPS) * rq;
        h16* dst = qn + (size_t)(row0 + rl) * 512 + (2 * j + hh) * 64;
        const float* gq = P.g_qn + l * 64;
        for (int d = 0; d < 64; d += 8) { h16x8 o;
#pragma unroll
            for (int e = 0; e < 8; ++e) o[e] = (h16)(ft[rl * 129 + hh * 64 + d + e] * rs * gq[d + e]);
            *(h16x8*)(dst + d) = o; }
    }
    __threadfence_block();
    __syncthreads();
    for (int hh = 0; hh < 2; ++hh) {
        const int head = 2 * j + hh;
        AF16 al2{qn + head * 64, 512};
        EpiStoreH ep2{(h16*)(P.ws + OFF_QK) + head * 128, 1024, row0, nullptr};
        gemm_tile<128>(al2, row0, (const h16*)(P.ws + OFF_WKABS) + ((size_t)l * 8 + head) * 128 * 64, 64, 64, ep2, smem);
    }
}

__device__ void p2b_item(const Params& P, int l, int rb, unsigned char* lds) {
    h16* smem = (h16*)lds;
    float* ft = (float*)lds;
    const int tid = opaque_tid(); const int row0 = rb * 128;
    const h16* projA = (const h16*)(P.ws + OFF_PROJA);
    h16* kvrow = (h16*)(P.ws + OFF_KVROW);
    __syncthreads();
    {
        const int row = row0 + (tid >> 1), hf = tid & 1; float s = 0.f; h16x8 v[8];
#pragma unroll
        for (int q = 0; q < 8; ++q) { v[q] = *(const h16x8*)(projA + (size_t)row * 512 + 256 + hf * 64 + q * 8);
#pragma unroll
            for (int e = 0; e < 8; ++e) { const float f = (float)v[q][e]; s += f * f; } }
        s += __shfl_xor(s, 1);
        const float rs = rsqrtf(s * (1.f / 128.f) + EPS);
        const float* g = P.g_ckv + l * 128 + hf * 64;
#pragma unroll
        for (int q = 0; q < 8; ++q) { h16x8 o;
#pragma unroll
            for (int e = 0; e < 8; ++e) o[e] = (h16)((float)v[q][e] * rs * g[q * 8 + e]);
            *(h16x8*)(kvrow + (size_t)row * 136 + hf * 64 + q * 8) = o; }
    }
    {
        h16* kfrag = (h16*)(P.ws + OFF_KFRAG);
#pragma unroll
        for (int q = 0; q < 4; ++q) {
            const int g = tid + 256 * q; const int row = row0 + (g >> 3), g8 = g & 7;
            if (row < NT) {
                const int b = row >= T_ ? 1 : 0; const int t = row - b * T_;
                const h16x8 v = *(const h16x8*)(projA + (size_t)row * 512 + 384 + g8 * 8);
                const int tile = t >> 5, ks = g8 >> 1, hh = g8 & 1;
                *(h16x8*)(kfrag + ((size_t)(b * NKT + tile) * 4 + ks) * 512 + (hh * 32 + (t & 31)) * 8) = v;
            }
        }
    }
    __threadfence_block();
    __syncthreads();
    const h16* Wuk = (const h16*)(P.ws + OFF_WUKT) + (size_t)l * 512 * 128;
    for (int tn = 0; tn < 4; ++tn) {
        AF16 al{kvrow, 136};
        EpiTileF32 ep;
        gemm_tile<128>(al, row0, Wuk + (size_t)tn * 128 * 128, 128, 128, ep, smem);
        __syncthreads();
        const int rl = tid >> 1, hh = tid & 1; float s = 0.f;
        for (int d = 0; d < 64; ++d) { const float f = ft[rl * 129 + hh * 64 + d]; s += f * f; }
        kvrow[(size_t)(row0 + rl) * 136 + 128 + 2 * tn + hh] = (h16)rsqrtf(s * (1.f / 64.f) + EPS);
        __syncthreads();
    }
}

__device__ void p2c_item(const Params& P, int l, int item, unsigned char* lds) {
    h16* qh = (h16*)lds;
    h16* kh = (h16*)(lds + 17408);
    float* kf = (float*)(lds + 34816);
    float* vf = (float*)(lds + 67584);
    float* Lm = (float*)(lds + 100352);
    float* beta = (float*)(lds + 116736);
    float* dec = beta + 64;
    float* edec = dec + 64;
    const int tid = opaque_tid(), lane = tid & 63, w = tid >> 6;
    const int chain = item / NCH, n = item % NCH, b = chain >> 2, h = chain & 3;
    const h16* projG = (const h16*)(P.ws + OFF_PROJG);
    const float* small = (const float*)(P.ws + OFF_SMALL);
    const float* cw = P.conv_w + (size_t)l * 4 * 1536;
    __syncthreads();
#ifndef P2C
#define P2C 15
#endif
    if (P2C & 1) {
        const int i = tid >> 2, part = tid & 3;
        const int t = 64 * n + i - 48; const bool valid = t >= 0;
        const size_t row = (size_t)b * T_ + (valid ? t : 0);
        float vals[32];
#pragma unroll
        for (int m = 0; m < 3; ++m) {
            const int cbase = m * 512 + h * 128 + part * 32;
#pragma unroll
            for (int c = 0; c < 32; ++c) vals[c] = 0.f;
#pragma unroll
            for (int jj = 0; jj < 4; ++jj) {
                const int tt = t - 3 + jj;
                if (valid && tt >= 0) {
                    const h16* rp = projG + ((size_t)b * T_ + tt) * 1536 + cbase;
                    const float* wp = cw + jj * 1536 + cbase;
#pragma unroll
                    for (int c8 = 0; c8 < 4; ++c8) { const h16x8 v = *(const h16x8*)(rp + c8 * 8);
#pragma unroll
                        for (int e = 0; e < 8; ++e) vals[c8 * 8 + e] += wp[c8 * 8 + e] * (float)v[e]; }
                }
            }
            float ss = 0.f;
#pragma unroll
            for (int c = 0; c < 32; ++c) { vals[c] = silu_f(vals[c]); ss += vals[c] * vals[c]; }
            if (m < 2) {
                ss += __shfl_xor(ss, 1); ss += __shfl_xor(ss, 2);
                const float rs = valid ? rsqrtf(ss + EPS) : 0.f;
                h16* dsth = (m == 0 ? qh : kh) + i * 136 + part * 32;
#pragma unroll
                for (int c8 = 0; c8 < 4; ++c8) { h16x8 o;
#pragma unroll
                    for (int e = 0; e < 8; ++e) o[e] = (h16)(vals[c8 * 8 + e] * rs);
                    *(h16x8*)(dsth + c8 * 8) = o; }
                if (m == 1) {
#pragma unroll
                    for (int c = 0; c < 32; ++c) kf[i * 128 + part * 32 + c] = vals[c] * rs;
                }
            } else {
#pragma unroll
                for (int c = 0; c < 32; ++c) vf[i * 128 + part * 32 + c] = valid ? vals[c] : 0.f;
            }
            __builtin_amdgcn_sched_barrier(0);
        }
        if (part == 0) {
            float bt = 0.f, g = 0.f;
            if (valid) {
                const float bl = small[row * 16 + 4 + h], al = small[row * 16 + 8 + h];
                bt = 1.f / (1.f + expf(-bl));
                const float xx = al + P.dt_bias[l * 4 + h];
                const float sp = xx > 20.f ? xx : log1pf(expf(xx));
                g = -expf(P.a_log[l * 4 + h]) * sp;
            }
            beta[i] = bt; dec[i] = g;
        }
    }
    __syncthreads();
    if (w == 0) {
        float v = dec[lane];
#pragma unroll
        for (int d = 1; d < 64; d <<= 1) { const float o = __shfl_up(v, d); if (lane >= d) v += o; }
        dec[lane] = v; edec[lane] = expf(v);
    }
    __syncthreads();
    if (P2C & 2) {
        const int gq = lane >> 4, c16 = lane & 15;
        h16* aqk = (h16*)(P.ws + OFF_AQK) + (size_t)item * 4096;
        h16x8 ak[4], aq[4];
#pragma unroll
        for (int ks = 0; ks < 4; ++ks) { ak[ks] = *(const h16x8*)(kh + (16 * w + c16) * 136 + 32 * ks + 8 * gq); aq[ks] = *(const h16x8*)(qh + (16 * w + c16) * 136 + 32 * ks + 8 * gq); }
#pragma unroll
        for (int nt = 0; nt < 4; ++nt) {
            f32x4 kk = {0.f, 0.f, 0.f, 0.f}, qk = {0.f, 0.f, 0.f, 0.f};
#pragma unroll
            for (int ks = 0; ks < 4; ++ks) { const h16x8 bb = *(const h16x8*)(kh + (16 * nt + c16) * 136 + 32 * ks + 8 * gq); kk = MFMA16(ak[ks], bb, kk); qk = MFMA16(aq[ks], bb, qk); }
            const int jc = 16 * nt + c16; const float dj = dec[jc];
#pragma unroll
            for (int r = 0; r < 4; ++r) {
                const int ir = 16 * w + 4 * gq + r; const float gm = expf(dec[ir] - dj);
                Lm[ir * 64 + jc] = ir > jc ? beta[ir] * kk[r] * gm : 0.f;
                aqk[ir * 64 + jc] = (h16)(ir >= jc ? qk[r] * gm : 0.f);
            }
        }
    }
    __syncthreads();
    if (P2C & 8) {
        h16* qd = (h16*)(P.ws + OFF_QD) + (size_t)item * 8192;
        const int i = tid >> 2, part = tid & 3; const float ed = edec[i];
#pragma unroll
        for (int c8 = 0; c8 < 4; ++c8) { const h16x8 v = *(const h16x8*)(qh + i * 136 + part * 32 + c8 * 8); h16x8 o;
#pragma unroll
            for (int e = 0; e < 8; ++e) o[e] = (h16)((float)v[e] * ed);
            *(h16x8*)(qd + i * 128 + part * 32 + c8 * 8) = o; }
        h16* kdt = (h16*)(P.ws + OFF_KDT) + (size_t)item * 8192;
        const int d = tid & 127, ih = tid >> 7; const float dl = dec[63];
#pragma unroll
        for (int i8 = 0; i8 < 4; ++i8) { h16x8 o;
#pragma unroll
            for (int e = 0; e < 8; ++e) { const int ii = ih * 32 + i8 * 8 + e; o[e] = (h16)(kf[ii * 128 + d] * expf(dl - dec[ii])); }
            *(h16x8*)(kdt + d * 64 + ih * 32 + i8 * 8) = o; }
        if (tid == 0) ((float*)(P.ws + OFF_CDEC))[item] = expf(dl);
    }
    __syncthreads();
    if (P2C & 4) {
        const int c = tid; const bool isu = c < 128; float* col = isu ? (vf + c) : (kf + (c - 128));
#pragma unroll 1
        for (int bi = 0; bi < 8; ++bi) {
            float sv[8];
#pragma unroll
            for (int r = 0; r < 8; ++r) { const int i = 8 * bi + r; float v = col[i * 128] * beta[i]; if (!isu) v *= edec[i]; sv[r] = v; }
#pragma unroll 1
            for (int j4 = 0; j4 < 2 * bi; ++j4) {
                const float x0 = col[(4 * j4 + 0) * 128], x1 = col[(4 * j4 + 1) * 128], x2 = col[(4 * j4 + 2) * 128], x3 = col[(4 * j4 + 3) * 128];
#pragma unroll
                for (int r = 0; r < 8; ++r) { const float4 lv = *(const float4*)(Lm + (8 * bi + r) * 64 + 4 * j4); sv[r] -= lv.x * x0; sv[r] -= lv.y * x1; sv[r] -= lv.z * x2; sv[r] -= lv.w * x3; }
            }
#pragma unroll
            for (int r = 1; r < 8; ++r) {
                const float4 la = *(const float4*)(Lm + (8 * bi + r) * 64 + 8 * bi), lb = *(const float4*)(Lm + (8 * bi + r) * 64 + 8 * bi + 4);
                const float lv[8] = {la.x, la.y, la.z, la.w, lb.x, lb.y, lb.z, lb.w};
#pragma unroll
                for (int q = 0; q < r; ++q) sv[r] -= lv[q] * sv[q];
            }
#pragma unroll
            for (int r = 0; r < 8; ++r) col[(8 * bi + r) * 128] = sv[r];
        }
        h16* dst = (h16*)(P.ws + (isu ? OFF_U : OFF_WM)) + (size_t)item * 8192 + (isu ? c : c - 128);
#pragma unroll 8
        for (int i = 0; i < 64; ++i) dst[i * 128] = (h16)col[i * 128];
    }
}

__device__ void phase2(const Params& P, int l, unsigned char* lds) {
    for (int it = blockIdx.x; it < 774 + 129 + NGI; it += gridDim.x) {
#ifndef P2SUB
#define P2SUB 7
#endif
        if (it < 774) { if (P2SUB & 1) p2a_item(P, l, it / 6, it % 6, lds); }
        else if (it < 903) { if (P2SUB & 2) p2b_item(P, l, it - 774, lds); }
        else { if (P2SUB & 4) p2c_item(P, l, it - 903, lds); }
    }
}

__device__ void gdn_scan(const Params& P, int sw, unsigned char* lds) {
    h16* St = (h16*)lds;
    h16* Vt = (h16*)(lds + 4352);
    const int tid = opaque_tid(), lane = tid & 63, w = tid >> 6, gq = lane >> 4, c16 = lane & 15;
    const int chain = sw >> 3, e0 = (sw & 7) * 16, b = chain >> 2, h = chain & 3;
    const h16* Ub = (const h16*)(P.ws + OFF_U); const h16* Wb = (const h16*)(P.ws + OFF_WM);
    const h16* Qb = (const h16*)(P.ws + OFF_QD); const h16* Kb = (const h16*)(P.ws + OFF_KDT);
    const h16* Ab = (const h16*)(P.ws + OFF_AQK); const float* cdec = (const float*)(P.ws + OFF_CDEC);
    h16* og = (h16*)(P.ws + OFF_QN);
    __syncthreads();
    for (int i = tid; i < 16 * 136; i += NTHREADS) St[i] = (h16)0.f;
    f32x4 S[2] = {{0.f, 0.f, 0.f, 0.f}, {0.f, 0.f, 0.f, 0.f}};
    __syncthreads();
    h16x8 wf[4], qf[4], af[2], kf_[2][2]; h16 uv[4]; float cd;
#define SCAN_LOAD(n_) do { const size_t itm = (size_t)chain * NCH + (n_); \
        _Pragma("unroll") for (int ks = 0; ks < 4; ++ks) { wf[ks] = *(const h16x8*)(Wb + itm * 8192 + (16 * w + c16) * 128 + 32 * ks + 8 * gq); qf[ks] = *(const h16x8*)(Qb + itm * 8192 + (16 * w + c16) * 128 + 32 * ks + 8 * gq); } \
        _Pragma("unroll") for (int ks = 0; ks < 2; ++ks) { af[ks] = *(const h16x8*)(Ab + itm * 4096 + (16 * w + c16) * 64 + 32 * ks + 8 * gq); \
            _Pragma("unroll") for (int m2 = 0; m2 < 2; ++m2) kf_[m2][ks] = *(const h16x8*)(Kb + itm * 8192 + (16 * (2 * w + m2) + c16) * 64 + 32 * ks + 8 * gq); } \
        _Pragma("unroll") for (int r = 0; r < 4; ++r) uv[r] = Ub[itm * 8192 + (16 * w + 4 * gq + r) * 128 + e0 + c16]; \
        cd = cdec[itm]; } while (0)
    SCAN_LOAD(0);
    for (int n = 0; n < NCH; ++n) {
        h16x8 cwf[4], cqf[4], caf[2], ckf[2][2]; float cu[4]; const float ccd = cd;
#pragma unroll
        for (int ks = 0; ks < 4; ++ks) { cwf[ks] = wf[ks]; cqf[ks] = qf[ks]; }
#pragma unroll
        for (int ks = 0; ks < 2; ++ks) { caf[ks] = af[ks]; ckf[0][ks] = kf_[0][ks]; ckf[1][ks] = kf_[1][ks]; }
#pragma unroll
        for (int r = 0; r < 4; ++r) cu[r] = (float)uv[r];
        if (n + 1 < NCH) SCAN_LOAD(n + 1);
        f32x4 Pm = {0.f, 0.f, 0.f, 0.f}, O = {0.f, 0.f, 0.f, 0.f};
#pragma unroll
        for (int ks = 0; ks < 4; ++ks) { const h16x8 bs = *(const h16x8*)(St + c16 * 136 + 32 * ks + 8 * gq); Pm = MFMA16(cwf[ks], bs, Pm); O = MFMA16(cqf[ks], bs, O); }
        h16x4 vn;
#pragma unroll
        for (int r = 0; r < 4; ++r) vn[r] = (h16)(cu[r] - Pm[r]);
        *(h16x4*)(Vt + c16 * 72 + 16 * w + 4 * gq) = vn;
        lds_barrier();
#pragma unroll
        for (int m2 = 0; m2 < 2; ++m2)
#pragma unroll
            for (int r = 0; r < 4; ++r) S[m2][r] *= ccd;
#pragma unroll
        for (int ks = 0; ks < 2; ++ks) { const h16x8 bv = *(const h16x8*)(Vt + c16 * 72 + 32 * ks + 8 * gq); O = MFMA16(caf[ks], bv, O); S[0] = MFMA16(ckf[0][ks], bv, S[0]); S[1] = MFMA16(ckf[1][ks], bv, S[1]); }
#pragma unroll
        for (int r = 0; r < 4; ++r) { const int t = 64 * n + 16 * w + 4 * gq + r - 48; if (t >= 0) og[((size_t)b * T_ + t) * 512 + h * 128 + e0 + c16] = (h16)(O[r] * 0.08838834764831845f); }
#pragma unroll
        for (int m2 = 0; m2 < 2; ++m2) { h16x4 sv;
#pragma unroll
            for (int r = 0; r < 4; ++r) sv[r] = (h16)S[m2][r];
            *(h16x4*)(St + c16 * 136 + 16 * (2 * w + m2) + 4 * gq) = sv; }
        lds_barrier();
    }
#undef SCAN_LOAD
}

__device__ __forceinline__ float topk_prune(float* sc, unsigned short* ix, unsigned* hist, int c, int lane) {
    unsigned key[8]; unsigned short idx[8]; float val[8];
#pragma unroll
    for (int it = 0; it < 8; ++it) { const int i = lane + 64 * it; const bool v = i < c; const float f = v ? sc[i] : 0.f; val[it] = f; idx[it] = v ? ix[i] : (unsigned short)0; key[it] = v ? ordkey(f) : 0u; }
    unsigned prefix = 0; int need = 256;
#pragma unroll
    for (int r = 0; r < 4; ++r) {
        const int shift = 24 - 8 * r;
        ((uint4*)hist)[lane] = make_uint4(0u, 0u, 0u, 0u);
        WAVE_FENCE();
#pragma unroll
        for (int it = 0; it < 8; ++it) {
            const bool m = (key[it] != 0u) && (r == 0 || ((key[it] ^ prefix) >> ((shift + 8) & 31)) == 0u);
            if (m) atomicAdd(&hist[(key[it] >> shift) & 255u], 1u);
        }
        WAVE_FENCE();
        const uint4 h4 = ((const uint4*)hist)[lane];
        WAVE_FENCE();
        const unsigned loc = h4.x + h4.y + h4.z + h4.w;
        unsigned incl = loc;
#pragma unroll
        for (int d = 1; d < 64; d <<= 1) { const unsigned t = __shfl_down(incl, d); if (lane + d < 64) incl += t; }
        const unsigned c3 = incl - loc, c2 = c3 + h4.w, c1 = c2 + h4.z, c0 = c1 + h4.y;
        const unsigned un = (unsigned)need;
        int dsel = -1; unsigned cab = 0;
        if (c3 < un && un <= c3 + h4.w) { dsel = 3; cab = c3; }
        else if (c2 < un && un <= c2 + h4.z) { dsel = 2; cab = c2; }
        else if (c1 < un && un <= c1 + h4.y) { dsel = 1; cab = c1; }
        else if (c0 < un && un <= c0 + h4.x) { dsel = 0; cab = c0; }
        const u64 fm = __ballot(dsel >= 0);
        const int src = __ffsll((long long)fm) - 1;
        const int digit = __shfl(4 * lane + dsel, src);
        const int cabv = __shfl((int)cab, src);
        need -= cabv; prefix |= (unsigned)digit << shift;
    }
    const unsigned thr = prefix; int out = 0, tb = 0;
#pragma unroll
    for (int it = 0; it < 8; ++it) {
        const bool v = key[it] != 0u; const bool gt = v && key[it] > thr; const bool eq = v && key[it] == thr;
        const u64 meq = __ballot(eq); const int tr = tb + lanes_below(meq); const bool keep = gt || (eq && tr < need);
        const u64 mk = __ballot(keep); const int slot = out + lanes_below(mk);
        if (keep) { sc[slot] = val[it]; ix[slot] = idx[it]; }
        out += __popcll(mk); tb += __popcll(meq);
    }
    WAVE_FENCE();
    return ordinv(thr);
}

__device__ void dsa_item(const Params& P, int item, unsigned char* wl, const float* relb, const unsigned char* blut, int lane) {
    float* sc = (float*)wl;
    unsigned short* ix = (unsigned short*)(wl + 16384);
    unsigned* hist = (unsigned*)(wl + 24576);
    unsigned short* sel = (unsigned short*)(wl + 25600);
    h16* stg = (h16*)wl;
    const h16* qidx = (const h16*)(P.ws + OFF_QIDX);
    const float* small = (const float*)(P.ws + OFF_SMALL);
    const h16* kvrow = (const h16*)(P.ws + OFF_KVROW);
    const h16* qk = (const h16*)(P.ws + OFF_QK);
    h16* ctxb = (h16*)(P.ws + OFF_CTX);
    const int row0 = item * 8; const int b = row0 >= T_ ? 1 : 0; const int t0 = row0 - b * T_;
    const int half = lane >> 5, kl = lane & 31;
    int* nselL = (int*)(wl + 29696);
    WAVE_FENCE();
    {
        h16x8 afr[4];
        { const int qq = kl >> 2, hd = kl & 3; const h16* p = qidx + (size_t)(row0 + qq) * 256 + hd * 64 + 8 * half;
#pragma unroll
          for (int ks = 0; ks < 4; ++ks) afr[ks] = *(const h16x8*)(p + 16 * ks); }
        float wq[4][4]; float th[4]; int cnt[4];
#pragma unroll
        for (int g = 0; g < 4; ++g) { const float* sp = small + (size_t)(row0 + 2 * g + half) * 16;
#pragma unroll
            for (int hh = 0; hh < 4; ++hh) wq[g][hh] = sp[hh];
            th[g] = -INFINITY; cnt[g] = 0; }
        const int ntiles = ((t0 + 7) >> 5) + 1;
        const h16* kfp = (const h16*)(P.ws + OFF_KFRAG) + (size_t)b * NKT * 2048 + lane * 8;
        h16x8 bn[4];
#pragma unroll
        for (int ks = 0; ks < 4; ++ks) bn[ks] = *(const h16x8*)(kfp + ks * 512);
        for (int tile = 0; tile <= ntiles; ++tile) {
            const bool last = tile == ntiles;
            if (!last) {
                h16x8 bc[4];
#pragma unroll
                for (int ks = 0; ks < 4; ++ks) bc[ks] = bn[ks];
                if (tile + 1 < ntiles) {
#pragma unroll
                    for (int ks = 0; ks < 4; ++ks) bn[ks] = *(const h16x8*)(kfp + (size_t)(tile + 1) * 2048 + ks * 512);
                }
                f32x16 acc;
#pragma unroll
                for (int r = 0; r < 16; ++r) acc[r] = 0.f;
#pragma unroll
                for (int ks = 0; ks < 4; ++ks) acc = MFMA32(afr[ks], bc[ks], acc);
                const int key = tile * 32 + kl;
#pragma unroll
                for (int g = 0; g < 4; ++g) {
                    float s = 0.f;
#pragma unroll
                    for (int hh = 0; hh < 4; ++hh) s = fmaf(wq[g][hh], fmaxf(acc[4 * g + hh], 0.f), s);
                    const int tq = t0 + 2 * g + half;
                    const bool pass = (key <= tq) && (s > th[g]);
                    const u64 m = __ballot(pass);
                    if (m != 0ull) {
                        const unsigned lo = (unsigned)m, hi = (unsigned)(m >> 32);
                        const int off = half ? __builtin_amdgcn_mbcnt_hi(hi, 0) : __builtin_amdgcn_mbcnt_lo(lo, 0);
                        const int qq = 2 * g + half;
                        if (pass) { const int slot = cnt[g] + off; sc[qq * 512 + slot] = s; ix[qq * 512 + slot] = (unsigned short)key; }
                        cnt[g] += half ? __popc(hi) : __popc(lo);
                    }
                }
            }
            const int lim = last ? 256 : 480;
            if (__any((cnt[0] > lim) || (cnt[1] > lim) || (cnt[2] > lim) || (cnt[3] > lim))) {
                WAVE_FENCE();
#pragma unroll 1
                for (int qq = 0; qq < 8; ++qq) {
                    const int g = qq >> 1, hs = qq & 1;
                    const int cv = g == 0 ? cnt[0] : (g == 1 ? cnt[1] : (g == 2 ? cnt[2] : cnt[3]));
                    const int c = __shfl(cv, hs * 32);
                    if (c > lim) {
                        const float nt = topk_prune(sc + qq * 512, ix + qq * 512, hist, c, lane);
#pragma unroll
                        for (int gg = 0; gg < 4; ++gg) if (gg == g && half == hs) { cnt[gg] = 256; th[gg] = nt; }
                    }
                }
            }
        }
        WAVE_FENCE();
#pragma unroll 1
        for (int qq = 0; qq < 8; ++qq) {
            const int g = qq >> 1, hs = qq & 1;
            const int cv = g == 0 ? cnt[0] : (g == 1 ? cnt[1] : (g == 2 ? cnt[2] : cnt[3]));
            const int c = __shfl(cv, hs * 32);
            if (lane == 0) nselL[qq] = c;
            for (int i = lane; i < c; i += 64) sel[qq * 256 + i] = ix[qq * 512 + i];
        }
        WAVE_FENCE();
    }
    const int gq = lane >> 4, c16 = lane & 15; const bool hv = c16 < 8;
#pragma unroll 1
    for (int qq = 0; qq < 8; ++qq) {
        const int rowq = row0 + qq, tq = t0 + qq, ns = nselL[qq];
        const unsigned short* selq = sel + qq * 256;
        h16x8 qf[4];
#pragma unroll
        for (int ks = 0; ks < 4; ++ks) {
            if (hv) qf[ks] = *(const h16x8*)(qk + (size_t)rowq * 1024 + c16 * 128 + 32 * ks + 8 * gq);
            else {
#pragma unroll
                for (int e = 0; e < 8; ++e) qf[ks][e] = (h16)0.f;
            }
        }
        float m_run = -INFINITY, l_run = 0.f;
        f32x4 ctx[8];
#pragma unroll
        for (int nt = 0; nt < 8; ++nt) ctx[nt] = (f32x4){0.f, 0.f, 0.f, 0.f};
        const int nch = (ns + 63) >> 6;
        h16x8 pre[17];
#define GATHER(c_) do { _Pragma("unroll") for (int i = 0; i < 17; ++i) { const int pid = lane + 64 * i; const int kk = pid / 17; const int pc = pid - kk * 17; const int kidx = 64 * (c_) + kk; \
            const int s = kidx < ns ? (int)selq[kidx] : 0; pre[i] = *(const h16x8*)(kvrow + ((size_t)b * T_ + s) * 136 + pc * 8); } } while (0)
        GATHER(0);
        for (int c = 0; c < nch; ++c) {
            WAVE_FENCE();
#pragma unroll
            for (int i = 0; i < 17; ++i) *(h16x8*)(stg + (size_t)(lane + 64 * i) * 8) = pre[i];
            WAVE_FENCE();
            if (c + 1 < nch) GATHER(c + 1);
            f32x4 s4[4];
#pragma unroll
            for (int mt = 0; mt < 4; ++mt) { s4[mt] = (f32x4){0.f, 0.f, 0.f, 0.f};
#pragma unroll
                for (int ks = 0; ks < 4; ++ks) { const h16x8 a = *(const h16x8*)(stg + (16 * mt + c16) * 136 + 32 * ks + 8 * gq); s4[mt] = MFMA16(a, qf[ks], s4[mt]); } }
            __builtin_amdgcn_sched_barrier(0);
            float lg[4][4]; float mx = -INFINITY;
#pragma unroll
            for (int mt = 0; mt < 4; ++mt)
#pragma unroll
                for (int r = 0; r < 4; ++r) {
                    const int kk = 16 * mt + 4 * gq + r; const int kidx = 64 * c + kk; const bool valid = hv && (kidx < ns);
                    const int s = (int)selq[kidx]; const float rr = (float)stg[kk * 136 + 128 + (c16 & 7)];
                    int dist = tq - s; dist = dist < 0 ? 0 : dist;
                    const int bk = dist < 128 ? (int)blut[dist] : 31;
                    const float v = valid ? s4[mt][r] * rr + relb[bk * 8 + (c16 & 7)] : -INFINITY;
                    lg[mt][r] = v; mx = fmaxf(mx, v);
                }
            mx = fmaxf(mx, __shfl_xor(mx, 16)); mx = fmaxf(mx, __shfl_xor(mx, 32));
            const float m_new = fmaxf(m_run, mx);
            const float alpha = hv ? __expf(m_run - m_new) : 1.f;
            float rs = 0.f; float pp[4][4];
#pragma unroll
            for (int mt = 0; mt < 4; ++mt)
#pragma unroll
                for (int r = 0; r < 4; ++r) { const float p = (hv && lg[mt][r] > -INFINITY) ? __expf(lg[mt][r] - m_new) : 0.f; pp[mt][r] = p; rs += p; }
            rs += __shfl_xor(rs, 16); rs += __shfl_xor(rs, 32);
            l_run = l_run * alpha + rs; m_run = m_new;
            h16x8 pa[2];
#pragma unroll
            for (int k2 = 0; k2 < 2; ++k2)
#pragma unroll
                for (int j = 0; j < 8; ++j) pa[k2][j] = (h16)pp[2 * k2 + (j >> 2)][j & 3];
            float ar[4];
#pragma unroll
            for (int r = 0; r < 4; ++r) ar[r] = __shfl(alpha, 4 * gq + r);
#pragma unroll
            for (int nt = 0; nt < 8; ++nt) {
#pragma unroll
                for (int r = 0; r < 4; ++r) ctx[nt][r] *= ar[r];
#pragma unroll
                for (int k2 = 0; k2 < 2; ++k2) { h16x8 bf;
#pragma unroll
                    for (int j = 0; j < 8; ++j) { const int kk = 32 * k2 + 16 * (j >> 2) + 4 * gq + (j & 3); bf[j] = stg[kk * 136 + 16 * nt + c16]; }
                    ctx[nt] = MFMA16(pa[k2], bf, ctx[nt]); }
                __builtin_amdgcn_sched_barrier(0);
            }
        }
#undef GATHER
        float li[4];
#pragma unroll
        for (int r = 0; r < 4; ++r) li[r] = 1.f / __shfl(l_run, (4 * gq + r) & 7);
        if (gq < 2) {
#pragma unroll
            for (int nt = 0; nt < 8; ++nt)
#pragma unroll
                for (int r = 0; r < 4; ++r) ctxb[(size_t)rowq * 1024 + (4 * gq + r) * 128 + 16 * nt + c16] = (h16)(ctx[nt][r] * li[r]);
        }
        WAVE_FENCE();
    }
}

__device__ void phase3(const Params& P, int l, unsigned char* lds) {
    const int tid = opaque_tid(), lane = tid & 63, w = tid >> 6;
    float* relb = (float*)(lds + 118912);
    unsigned char* blut = (unsigned char*)(lds + 118912 + 1024);
    __syncthreads();
    relb[tid] = P.rel[tid];
    if (tid < 128) blut[tid] = c_bucket[tid];
    __syncthreads();
    for (int sw = blockIdx.x; sw < 64; sw += gridDim.x) gdn_scan(P, sw, lds);
    __syncthreads();
    unsigned* ctr = (unsigned*)(P.ws + OFF_CTL) + l;
    unsigned char* wl = lds + w * 29728;
    for (;;) {
        int item = 0;
        if (lane == 0) item = (int)atomicAdd(ctr, 1u);
        item = __shfl(item, 0);
        if (item >= NT / 8) break;
        dsa_item(P, NT / 8 - 1 - item, wl, relb, blut, lane);
    }
}

__device__ void phase4(const Params& P, int l, unsigned char* lds) {
    h16* smem = (h16*)lds;
    const int tid = opaque_tid(), lane = tid & 63, w = tid >> 6;
    h16* omix = (h16*)(P.ws + OFF_OMIX);
    for (int it = blockIdx.x; it < NRB * 8 + NRB; it += gridDim.x) {
        if (it < NRB * 8) {
            const int rb = it >> 3, head = it & 7;
            AF16 al{(const h16*)(P.ws + OFF_CTX) + head * 128, 1024};
            EpiGate ep{omix, (const h16*)(P.ws + OFF_SZA), rb * 128, head * 64};
            gemm_tile<64>(al, rb * 128, (const h16*)(P.ws + OFF_WUVT) + ((size_t)l * 8 + head) * 64 * 128, 128, 128, ep, smem);
        } else {
            const int rb = it - NRB * 8;
            const h16* og = (const h16*)(P.ws + OFF_QN); const h16* szg = (const h16*)(P.ws + OFF_SZG);
            const float* go = P.g_out + l * 128;
            for (int pr = w; pr < 512; pr += 4) {
                const int row = rb * 128 + (pr >> 2), hd = pr & 3;
                const size_t o = (size_t)row * 512 + hd * 128 + lane * 2;
                const float a0 = (float)og[o], a1 = (float)og[o + 1];
                float s = a0 * a0 + a1 * a1;
#pragma unroll
                for (int d = 1; d < 64; d <<= 1) s += __shfl_xor(s, d);
                const float rs = rsqrtf(s * (1.f / 128.f) + EPS);
                omix[(size_t)row * 1024 + 512 + hd * 128 + lane * 2] = (h16)(a0 * rs * go[lane * 2] * (float)szg[o]);
                omix[(size_t)row * 1024 + 512 + hd * 128 + lane * 2 + 1] = (h16)(a1 * rs * go[lane * 2 + 1] * (float)szg[o + 1]);
            }
        }
    }
}

__device__ void phase5(const Params& P, int l, unsigned char* lds) {
    h16* smem = (h16*)lds;
    const h16* W = (const h16*)(P.ws + OFF_WOT) + (size_t)l * 1024 * 1024;
    for (int it = blockIdx.x; it < NRB * 8; it += gridDim.x) {
        const int rb = it >> 3, tn = it & 7;
        AF16 al{(const h16*)(P.ws + OFF_OMIX), 1024};
        EpiResid ep{l, rb * 128, tn * 128, P.meta, P.x, (float*)(P.ws + OFF_METAH), P.out};
        gemm_tile<128>(al, rb * 128, W + (size_t)tn * 128 * 1024, 1024, 1024, ep, smem);
    }
}

__global__ void __launch_bounds__(NTHREADS) hybrid_fwd(Params P) {
    extern __shared__ __attribute__((aligned(16))) unsigned char lds[];
    cg::grid_group grid = cg::this_grid();
    for (int ph = P.ph_lo; ph < P.ph_hi; ++ph) {
#ifndef ONLY
#define ONLY -1
#endif
        if (ph == 0) { if (ONLY < 0 || ((ONLY >> 0) & 1)) phase_prep(P, lds); }
        else {
            const int l = (ph - 1) / 5, s = (ph - 1) % 5;
            if (s == 0) { if (ONLY < 0 || ((ONLY >> 1) & 1)) phase_inproj(P, l, lds); }
            else if (s == 1) { if (ONLY < 0 || ((ONLY >> 2) & 1)) phase2(P, l, lds); }
            else if (s == 2) { if (ONLY < 0 || ((ONLY >> 3) & 1)) phase3(P, l, lds); }
            else if (s == 3) { if (ONLY < 0 || ((ONLY >> 4) & 1)) phase4(P, l, lds); }
            else { if (ONLY < 0 || ((ONLY >> 5) & 1)) phase5(P, l, lds); }
        }
        if (ph + 1 < P.ph_hi) grid.sync();
    }
}

extern "C" void kernel_launch(void* const* d_in, const int* in_sizes, int n_in, void* d_out, int out_size, void* d_ws, size_t ws_size, hipStream_t stream) {
    static int grid_blocks = 0;
    if (grid_blocks == 0) {
        if (n_in != 17 || ws_size < WS_END) { fprintf(stderr, "kernel_launch: unexpected inputs (n_in %d, ws %zu < %zu)\n", n_in, ws_size, (size_t)WS_END); grid_blocks = -1; return; }
        int dev = 0, cus = 0, per_cu = 0;
        hipGetDevice(&dev);
        hipDeviceGetAttribute(&cus, hipDeviceAttributeMultiprocessorCount, dev);
        if (hipFuncSetAttribute((const void*)hybrid_fwd, hipFuncAttributeMaxDynamicSharedMemorySize, LDS_BYTES) != hipSuccess) { fprintf(stderr, "kernel_launch: hipFuncSetAttribute failed\n"); grid_blocks = -1; return; }
        hipOccupancyMaxActiveBlocksPerMultiprocessor(&per_cu, (const void*)hybrid_fwd, NTHREADS, LDS_BYTES);
        if (per_cu < 1) { fprintf(stderr, "kernel_launch: occupancy query says 0 blocks per CU\n"); grid_blocks = -1; return; }
        grid_blocks = cus * per_cu;
    }
    if (grid_blocks < 0) return;
    hipMemsetAsync((char*)d_ws + OFF_CTL, 0, 4096, stream);
    Params p{};
    p.x = (const float*)d_in[0]; p.meta = (const float*)d_in[1]; p.rel = (const float*)d_in[2]; p.norm_gain = (const float*)d_in[3];
    p.w_in = (const float*)d_in[4]; p.g_cq = (const float*)d_in[5]; p.g_ckv = (const float*)d_in[6]; p.w_uq = (const float*)d_in[7];
    p.w_ukv = (const float*)d_in[8]; p.w_qidx = (const float*)d_in[9]; p.g_qn = (const float*)d_in[10]; p.g_kn = (const float*)d_in[11];
    p.conv_w = (const float*)d_in[12]; p.a_log = (const float*)d_in[13]; p.dt_bias = (const float*)d_in[14]; p.g_out = (const float*)d_in[15];
    p.w_out = (const float*)d_in[16];
    p.out = (float*)d_out; p.ws = (unsigned char*)d_ws;
#if N_LAUNCH_MODE == 1
    p.ph_lo = 0; p.ph_hi = NPHASE;
    void* args[] = {&p};
    hipError_t e = hipLaunchCooperativeKernel((const void*)hybrid_fwd, dim3(grid_blocks), dim3(NTHREADS), args, LDS_BYTES, stream);
    if (e != hipSuccess) fprintf(stderr, "cooperative launch failed: %s (grid %d)\n", hipGetErrorString(e), grid_blocks);
#else
    for (int ph = 0; ph < NPHASE; ++ph) {
        p.ph_lo = ph; p.ph_hi = ph + 1;
        hipLaunchKernelGGL(hybrid_fwd, dim3(grid_blocks), dim3(NTHREADS), LDS_BYTES, stream, p);
    }
#endif
}
```

```cpp
#include <hip/hip_runtime.h>
#include <hip/hip_cooperative_groups.h>
#include <stdio.h>
#include <stdint.h>
namespace cg = cooperative_groups;

#define PROBE_TOPK2 0
#define PROBE_ATT2 0
#define PROBE_P1X 0
#define PROBE_P2X 0
#define PROBE_SCAN2 0
#define PROBE_P4X 0
#define PROBE_P0X 0
#define PROBE_P5L0X 0
#define PROBE_SYNC 0
#define PROBE_SWEEP 0
#define PROBE_P2C 0
#define PROBE_CHAIN 0
#ifndef N_LAUNCH_MODE
#define N_LAUNCH_MODE 1
#endif

typedef _Float16 h16;
typedef h16 h16x8 __attribute__((ext_vector_type(8)));
typedef h16 h16x4 __attribute__((ext_vector_type(4)));
typedef float f32x4 __attribute__((ext_vector_type(4)));
typedef float f32x16 __attribute__((ext_vector_type(16)));
typedef unsigned long long u64;
typedef __fp16 fp16x4 __attribute__((__vector_size__(4 * sizeof(__fp16))));

#define MFMA32(a, b, c) __builtin_amdgcn_mfma_f32_32x32x16_f16(a, b, c, 0, 0, 0)
#define MFMA16(a, b, c) __builtin_amdgcn_mfma_f32_16x16x32_f16(a, b, c, 0, 0, 0)
#define WAVE_FENCE() do { __builtin_amdgcn_fence(__ATOMIC_SEQ_CST, "wavefront"); __builtin_amdgcn_wave_barrier(); } while (0)

constexpr int T_ = 8208;
constexpr int NT = 16416;
constexpr int NTP = 16512;
constexpr int NRB = 129;
constexpr int NCH = 129;
constexpr int NGI = 8 * NCH;
constexpr int NKT = 257;
constexpr float EPS = 1e-6f;
constexpr int NTHREADS = 256;
constexpr int LDS_BYTES = 163840;
constexpr int NPHASE = 11;

constexpr size_t OFF_CTL = 0;
constexpr size_t OFF_W1T = 32768;
constexpr size_t OFF_WOT = OFF_W1T + (size_t)2 * 3072 * 1024 * 2;
constexpr size_t OFF_WQ2T = OFF_WOT + (size_t)2 * 1024 * 1024 * 2;
constexpr size_t OFF_WUKT = OFF_WQ2T + (size_t)2 * 768 * 256 * 2;
constexpr size_t OFF_WKABS = OFF_WUKT + (size_t)2 * 512 * 128 * 2;
constexpr size_t OFF_WUVT = OFF_WKABS + (size_t)2 * 8 * 128 * 64 * 2;
constexpr size_t OFF_SMALL = OFF_WUVT + (size_t)2 * 8 * 64 * 128 * 2;
constexpr size_t OFF_SZA = OFF_SMALL + (size_t)NTP * 16 * 4;
constexpr size_t OFF_SZG = OFF_SZA + (size_t)NTP * 512 * 2;
constexpr size_t OFF_PROJG = OFF_SZG + (size_t)NTP * 512 * 2;
constexpr size_t OFF_PROJA = OFF_PROJG + (size_t)NTP * 1536 * 2;
constexpr size_t OFF_QIDX = OFF_PROJA + (size_t)NTP * 512 * 2;
constexpr size_t OFF_QN = OFF_QIDX + (size_t)NTP * 256 * 2;
constexpr size_t OFF_QK = OFF_QN + (size_t)NTP * 512 * 2;
constexpr size_t OFF_KVROW = OFF_QK + (size_t)NTP * 1024 * 2;
constexpr size_t OFF_KFRAG = OFF_KVROW + (size_t)NTP * 136 * 2;
constexpr size_t OFF_U = OFF_KFRAG + (size_t)2 * NKT * 2048 * 2;
constexpr size_t OFF_WM = OFF_U + (size_t)NGI * 8192 * 2;
constexpr size_t OFF_QD = OFF_WM + (size_t)NGI * 8192 * 2;
constexpr size_t OFF_KDT = OFF_QD + (size_t)NGI * 8192 * 2;
constexpr size_t OFF_AQK = OFF_KDT + (size_t)NGI * 8192 * 2;
constexpr size_t OFF_CDEC = OFF_AQK + (size_t)NGI * 4096 * 2;
constexpr size_t OFF_METAH = OFF_CDEC + 8192;
constexpr size_t OFF_SUMSQ = OFF_METAH + (size_t)2 * 16 * 1024 * 4;
constexpr size_t WS_END = OFF_SUMSQ + (size_t)2 * NTP * 4;
constexpr size_t OFF_H16 = OFF_QK;
constexpr size_t OFF_CTX = OFF_PROJG;
constexpr size_t OFF_OMIX = OFF_PROJG + (size_t)NTP * 1024 * 2;

struct Params {
    const float* x; const float* meta; const float* rel; const float* norm_gain; const float* w_in;
    const float* g_cq; const float* g_ckv; const float* w_uq; const float* w_ukv; const float* w_qidx;
    const float* g_qn; const float* g_kn; const float* conv_w; const float* a_log; const float* dt_bias;
    const float* g_out; const float* w_out;
    float* out; unsigned char* ws;
    int ph_lo, ph_hi;
};

__constant__ unsigned char c_bucket[128] = {
    0, 1, 2, 3, 4, 5, 6, 7, 8, 9, 10, 11, 12, 13, 14, 15, 16, 16, 16, 17, 17, 18, 18, 18, 19, 19, 19, 20, 20, 20, 20, 21,
    21, 21, 21, 22, 22, 22, 22, 22, 23, 23, 23, 23, 23, 23, 24, 24, 24, 24, 24, 24, 25, 25, 25, 25, 25, 25, 25, 26, 26, 26, 26, 26,
    26, 26, 26, 27, 27, 27, 27, 27, 27, 27, 27, 27, 27, 28, 28, 28, 28, 28, 28, 28, 28, 28, 28, 29, 29, 29, 29, 29, 29, 29, 29, 29,
    29, 29, 29, 30, 30, 30, 30, 30, 30, 30, 30, 30, 30, 30, 30, 30, 30, 31, 31, 31, 31, 31, 31, 31, 31, 31, 31, 31, 31, 31, 31, 31};

__device__ __forceinline__ float silu_f(float x) { return x / (1.f + __expf(-x)); }
__device__ __forceinline__ int lanes_below(u64 m) { return __builtin_amdgcn_mbcnt_hi((unsigned)(m >> 32), __builtin_amdgcn_mbcnt_lo((unsigned)m, 0)); }
__device__ __forceinline__ unsigned ordkey(float f) { unsigned u = __float_as_uint(f); return (u & 0x80000000u) ? ~u : (u | 0x80000000u); }
__device__ __forceinline__ float ordinv(unsigned k) { unsigned u = (k & 0x80000000u) ? (k & 0x7fffffffu) : ~k; return __uint_as_float(u); }
__device__ __forceinline__ int opaque_tid() { int t = threadIdx.x; asm volatile("" : "+v"(t)); return t; }
__device__ __forceinline__ void lds_barrier() { asm volatile("s_waitcnt lgkmcnt(0)\n\ts_barrier" ::: "memory"); }

#define XB_TMO      128
#define XB_XCNT(j)  (256  + 64 * (j))
#define XB_XSUB(j)  (1280 + 64 * (j))
#define XB_XGEN(j)  (2304 + 64 * (j))
#define XB_TOP      3328
#define XB_TOPGEN   3392
#define XCD_BAR_WORDS 3456
#define XB_SPIN_CAP (1u << 22)
#define LAS __attribute__((address_space(3)))
__device__ __forceinline__ unsigned xb_ld(unsigned* p)              { return __hip_atomic_load(p, __ATOMIC_RELAXED, __HIP_MEMORY_SCOPE_AGENT); }
__device__ __forceinline__ unsigned xb_add(unsigned* p, unsigned v) { return __hip_atomic_fetch_add(p, v, __ATOMIC_RELAXED, __HIP_MEMORY_SCOPE_AGENT); }
__device__ __forceinline__ unsigned xb_xcc_id() { return (unsigned)__builtin_amdgcn_s_getreg((3 << 11) | 20) & 0xFu; }
#define XB_SPIN(cond, bar) do { unsigned _sp = 0; while (cond) { __builtin_amdgcn_s_sleep(1); \
    if ((++_sp & 255u) == 0u) { if (xb_ld(&(bar)[XB_TMO])) break; if (_sp > XB_SPIN_CAP) { atomicAdd(&(bar)[XB_TMO], 1u); break; } } } } while (0)
struct XcdBarrier { unsigned* bar; unsigned x; volatile LAS unsigned* st; };
__device__ __forceinline__ XcdBarrier xcd_barrier_post(unsigned* bar, volatile LAS unsigned* st) {
    XcdBarrier b; b.bar = bar; b.x = xb_xcc_id(); b.st = st;
    if (threadIdx.x == 0) (void)xb_add(&bar[XB_XCNT(b.x)], 1u);
    return b;
}
__device__ __forceinline__ void xcd_barrier_complete(unsigned* bar, unsigned x, unsigned& nloc, unsigned& nx) {
    const unsigned G = gridDim.x * gridDim.y * gridDim.z;
    unsigned sum, cnt, mine, sp = 0u;
    for (;;) {
        sum = 0u; cnt = 0u; mine = 0u;
#pragma unroll
        for (unsigned j = 0; j < 16; ++j) { const unsigned c = xb_ld(&bar[XB_XCNT(j)]); sum += c; cnt += (c > 0u) ? 1u : 0u; mine = (j == x) ? c : mine; }
        if (sum == G) break;
        __builtin_amdgcn_s_sleep(1);
        if ((++sp & 255u) == 0u) { if (xb_ld(&bar[XB_TMO])) break; if (sp > XB_SPIN_CAP) { atomicAdd(&bar[XB_TMO], 1u); break; } }
    }
    nloc = mine > 0u ? mine : 1u; nx = cnt > 0u ? cnt : 1u;
}
__device__ __forceinline__ void xcd_barrier(const XcdBarrier& b) {
    asm volatile("s_waitcnt vmcnt(0)" ::: "memory");
    __syncthreads();
    if (threadIdx.x == 0) {
        unsigned* bar = b.bar;
        __builtin_amdgcn_s_waitcnt(0);
        unsigned nloc = b.st[0], nx = b.st[1];
        if (nloc == 0u) { xcd_barrier_complete(bar, b.x, nloc, nx); b.st[0] = nloc; b.st[1] = nx; }
        const unsigned old = xb_add(&bar[XB_XSUB(b.x)], 1u);
        const unsigned gen = old / nloc;
        if (old + 1u == (gen + 1u) * nloc) {
            __builtin_amdgcn_fence(__ATOMIC_RELEASE, "agent");
            asm volatile("s_waitcnt vmcnt(0)" ::: "memory");
            const unsigned og = xb_add(&bar[XB_TOP], 1u);
            const unsigned tg = og / nx;
            if (og + 1u == (tg + 1u) * nx) xb_add(&bar[XB_TOPGEN], 1u);
            else XB_SPIN(xb_ld(&bar[XB_TOPGEN]) == tg, bar);
            __builtin_amdgcn_fence(__ATOMIC_ACQUIRE, "agent");
            xb_add(&bar[XB_XGEN(b.x)], 1u);
            asm volatile("s_waitcnt vmcnt(0)" ::: "memory");
        } else {
            XB_SPIN(xb_ld(&bar[XB_XGEN(b.x)]) == gen, bar);
            __builtin_amdgcn_fence(__ATOMIC_ACQUIRE, "agent");
            asm volatile("s_waitcnt vmcnt(0)" ::: "memory");
        }
    }
    __syncthreads();
}

struct XcdQueue {
    unsigned* ctr; int n_per; int x0; int d; int* slot;
    __device__ __forceinline__ void init(unsigned* c, int np, int* s) { ctr = c; n_per = np; x0 = (int)xb_xcc_id() & 7; d = 0; slot = s; }
    __device__ __forceinline__ bool next(int& xl, int& q) {
        __syncthreads();
        if (threadIdx.x == 0) {
            int res = -1;
            while (d < 8) {
                const int xc = (x0 + d) & 7;
                const unsigned t = __hip_atomic_fetch_add(ctr + xc * 16, 1u, __ATOMIC_RELAXED, __HIP_MEMORY_SCOPE_AGENT);
                if ((int)t < n_per) { res = xc * 65536 + (int)t; break; }
                ++d;
            }
            *slot = res;
        }
        __syncthreads();
        const int r = *slot;
        if (r < 0) return false;
        xl = r >> 16; q = r & 65535;
        return true;
    }
};

constexpr int GS = 72;

struct AF16 {
    const h16* p; int ld;
    __device__ __forceinline__ void init(int) {}
    __device__ __forceinline__ h16x8 load(int i, int row, int k) { return *(const h16x8*)(p + (size_t)row * ld + k); }
};

struct AH32 {
    const float* meta; const float* xs; int meta_bstride;
    const float* rp[4]; float ss[4];
    __device__ __forceinline__ const float* rowptr(int row) const {
        row = row < NT ? row : NT - 1;
        int b = row >= T_ ? 1 : 0; int t = row - b * T_;
        return t < 16 ? meta + (size_t)b * meta_bstride + (size_t)t * 1024 : xs + ((size_t)b * 8192 + (t - 16)) * 1024;
    }
    __device__ __forceinline__ h16x8 load(int i, int, int k) {
        const float4 v0 = *(const float4*)(rp[i] + k), v1 = *(const float4*)(rp[i] + k + 4);
        ss[i] += v0.x * v0.x + v0.y * v0.y + v0.z * v0.z + v0.w * v0.w + v1.x * v1.x + v1.y * v1.y + v1.z * v1.z + v1.w * v1.w;
        h16x8 r; r[0] = (h16)v0.x; r[1] = (h16)v0.y; r[2] = (h16)v0.z; r[3] = (h16)v0.w; r[4] = (h16)v1.x; r[5] = (h16)v1.y; r[6] = (h16)v1.z; r[7] = (h16)v1.w;
        return r;
    }
};

template <int BN, class AL, class EP>
__device__ __forceinline__ void gemm_tile(AL& al, int arow0, const h16* __restrict__ Bt, int ldb, int K, EP& ep, h16* smem) {
    const int tid = opaque_tid(), lane = tid & 63, w = tid >> 6, wm = w >> 1, wn = w & 1;
    constexpr int NTL = BN / 64;
    constexpr int NBG = BN / 32;
    constexpr int BUF = (128 + BN) * GS;
    f32x16 acc[2][NTL];
#pragma unroll
    for (int i = 0; i < 2; ++i)
#pragma unroll
        for (int j = 0; j < NTL; ++j)
#pragma unroll
            for (int r = 0; r < 16; ++r) acc[i][j][r] = 0.f;
    h16x8 ra[4], rb[NBG];
    const int nk = K >> 6;
#pragma unroll
    for (int i = 0; i < 4; ++i) { int g = tid + 256 * i; ra[i] = al.load(i, arow0 + (g >> 3), (g & 7) * 8); }
#pragma unroll
    for (int i = 0; i < NBG; ++i) { int g = tid + 256 * i; rb[i] = *(const h16x8*)(Bt + (size_t)(g >> 3) * ldb + (g & 7) * 8); }
    __syncthreads();
#pragma unroll
    for (int i = 0; i < 4; ++i) { int g = tid + 256 * i; *(h16x8*)(smem + (g >> 3) * GS + (g & 7) * 8) = ra[i]; }
#pragma unroll
    for (int i = 0; i < NBG; ++i) { int g = tid + 256 * i; *(h16x8*)(smem + 128 * GS + (g >> 3) * GS + (g & 7) * 8) = rb[i]; }
    __syncthreads();
    for (int kt = 0; kt < nk; ++kt) {
        const int cur = kt & 1;
        const h16* sA = smem + cur * BUF;
        const h16* sB = sA + 128 * GS;
        if (kt + 1 < nk) {
            const int k0 = (kt + 1) << 6;
#pragma unroll
            for (int i = 0; i < 4; ++i) { int g = tid + 256 * i; ra[i] = al.load(i, arow0 + (g >> 3), k0 + (g & 7) * 8); }
#pragma unroll
            for (int i = 0; i < NBG; ++i) { int g = tid + 256 * i; rb[i] = *(const h16x8*)(Bt + (size_t)(g >> 3) * ldb + k0 + (g & 7) * 8); }
        }
#pragma unroll
        for (int ks = 0; ks < 4; ++ks) {
            h16x8 af[2], bf[NTL];
#pragma unroll
            for (int mt = 0; mt < 2; ++mt) af[mt] = *(const h16x8*)(sA + (64 * wm + 32 * mt + (lane & 31)) * GS + 16 * ks + 8 * (lane >> 5));
#pragma unroll
            for (int nt = 0; nt < NTL; ++nt) bf[nt] = *(const h16x8*)(sB + ((BN / 2) * wn + 32 * nt + (lane & 31)) * GS + 16 * ks + 8 * (lane >> 5));
#pragma unroll
            for (int mt = 0; mt < 2; ++mt)
#pragma unroll
                for (int nt = 0; nt < NTL; ++nt) acc[mt][nt] = MFMA32(af[mt], bf[nt], acc[mt][nt]);
        }
        if (kt + 1 < nk) {
            h16* dA = smem + (cur ^ 1) * BUF;
            h16* dB = dA + 128 * GS;
#pragma unroll
            for (int i = 0; i < 4; ++i) { int g = tid + 256 * i; *(h16x8*)(dA + (g >> 3) * GS + (g & 7) * 8) = ra[i]; }
#pragma unroll
            for (int i = 0; i < NBG; ++i) { int g = tid + 256 * i; *(h16x8*)(dB + (g >> 3) * GS + (g & 7) * 8) = rb[i]; }
        }
        __syncthreads();
    }
    ep.pre(al);
    float* ft = (float*)smem;
#pragma unroll
    for (int mt = 0; mt < 2; ++mt)
#pragma unroll
        for (int nt = 0; nt < NTL; ++nt)
#pragma unroll
            for (int r = 0; r < 16; ++r) {
                const int rl = 64 * wm + 32 * mt + (r & 3) + 8 * (r >> 2) + 4 * (lane >> 5);
                const int cl = (BN / 2) * wn + 32 * nt + (lane & 31);
                ft[rl * (BN + 1) + cl] = acc[mt][nt][r];
            }
    __syncthreads();
    if (EP::kSweep) {
#pragma unroll 4
        for (int idx = tid; idx < 128 * BN; idx += NTHREADS) {
            const int rl = idx / BN, cl = idx % BN;
            float q = ep(rl, cl, ft[rl * (BN + 1) + cl]);
            if (EP::kRowSum) {
#pragma unroll
                for (int d = 1; d < 64; d <<= 1) q += __shfl_xor(q, d);
                if (lane == 0) ep.rowsum(rl, q);
            }
        }
    }
}

constexpr int GS2 = 40;
template <class EP>
__device__ __forceinline__ void gemm_big(const h16* __restrict__ A, int lda, const h16* __restrict__ Bt, int ldb, int K, EP& ep, h16* smem) {
    const int tid = opaque_tid(), lane = tid & 63, w = tid >> 6, wm = w >> 1, wn = w & 1;
    constexpr int BUF = 512 * GS2;
    f32x16 acc[4][4];
    float zero_ = 0.f; asm volatile("" : "+v"(zero_));
#pragma unroll
    for (int i = 0; i < 4; ++i)
#pragma unroll
        for (int j = 0; j < 4; ++j)
#pragma unroll
            for (int r = 0; r < 16; ++r) acc[i][j][r] = zero_;
    h16x8 ra[2][4], rb[2][4];
    const int nk = K >> 5;
    const h16* ap = A + (size_t)(tid >> 2) * lda + (tid & 3) * 8;
    const h16* bp = Bt + (size_t)(tid >> 2) * ldb + (tid & 3) * 8;
    const int soff = (tid >> 2) * GS2 + (tid & 3) * 8;
#pragma unroll
    for (int i = 0; i < 4; ++i) { ra[0][i] = *(const h16x8*)(ap + (size_t)(64 * i) * lda); rb[0][i] = *(const h16x8*)(bp + (size_t)(64 * i) * ldb); }
#pragma unroll
    for (int i = 0; i < 4; ++i) { ra[1][i] = *(const h16x8*)(ap + (size_t)(64 * i) * lda + 32); rb[1][i] = *(const h16x8*)(bp + (size_t)(64 * i) * ldb + 32); }
    __syncthreads();
#pragma unroll
    for (int i = 0; i < 4; ++i) { *(h16x8*)(smem + soff + 64 * i * GS2) = ra[0][i]; *(h16x8*)(smem + 256 * GS2 + soff + 64 * i * GS2) = rb[0][i]; }
    __syncthreads();
#define BIG_STEP(CUR, KT) do { \
        const h16* sA = smem + (CUR) * BUF + (128 * wm + (lane & 31)) * GS2 + 8 * (lane >> 5); \
        const h16* sB = smem + (CUR) * BUF + 256 * GS2 + (128 * wn + (lane & 31)) * GS2 + 8 * (lane >> 5); \
        { int k0 = ((KT) + 2) << 5; k0 = k0 < K ? k0 : K - 32; \
            _Pragma("unroll") for (int i = 0; i < 4; ++i) { ra[CUR][i] = *(const h16x8*)(ap + (size_t)(64 * i) * lda + k0); rb[CUR][i] = *(const h16x8*)(bp + (size_t)(64 * i) * ldb + k0); } } \
        h16x8 af[2][4], bf[2][4]; \
        _Pragma("unroll") for (int ks = 0; ks < 2; ++ks) _Pragma("unroll") for (int t = 0; t < 4; ++t) { af[ks][t] = *(const h16x8*)(sA + 32 * t * GS2 + 16 * ks); bf[ks][t] = *(const h16x8*)(sB + 32 * t * GS2 + 16 * ks); } \
        __builtin_amdgcn_sched_barrier(0); \
        { h16* d = smem + ((CUR) ^ 1) * BUF; \
            _Pragma("unroll") for (int i = 0; i < 4; ++i) { *(h16x8*)(d + soff + 64 * i * GS2) = ra[(CUR) ^ 1][i]; *(h16x8*)(d + 256 * GS2 + soff + 64 * i * GS2) = rb[(CUR) ^ 1][i]; } } \
        __builtin_amdgcn_sched_barrier(0); \
        _Pragma("unroll") for (int ks = 0; ks < 2; ++ks) \
            _Pragma("unroll") for (int mt = 0; mt < 4; ++mt) _Pragma("unroll") for (int nt = 0; nt < 4; ++nt) acc[mt][nt] = MFMA32(af[ks][mt], bf[ks][nt], acc[mt][nt]); \
        __builtin_amdgcn_sched_barrier(0); \
        __syncthreads(); } while (0)
    for (int kt = 0; kt < nk; kt += 2) { BIG_STEP(0, kt); BIG_STEP(1, kt + 1); }
#undef BIG_STEP
    float* st = (float*)smem + w * 1152;
    const int prow = lane >> 1, pc0 = (lane & 1) * 16;
    ep.template prefetch<0>(128 * wm + prow, 128 * wn + pc0);
#pragma unroll
    for (int mt = 0; mt < 4; ++mt) {
        if (mt == 0) ep.template prefetch<1>(128 * wm + 32 + prow, 128 * wn + pc0);
        if (mt == 1) ep.template prefetch<0>(128 * wm + 64 + prow, 128 * wn + pc0);
        if (mt == 2) ep.template prefetch<1>(128 * wm + 96 + prow, 128 * wn + pc0);
        ep.row_begin();
#pragma unroll
        for (int nt = 0; nt < 4; ++nt) {
#pragma unroll
            for (int r = 0; r < 16; ++r) st[((r & 3) + 8 * (r >> 2) + 4 * (lane >> 5)) * 36 + (lane & 31)] = acc[mt][nt][r];
            WAVE_FENCE();
            float v[16];
#pragma unroll
            for (int q = 0; q < 4; ++q) { const float4 t4 = *(const float4*)(st + prow * 36 + pc0 + 4 * q); v[4 * q] = t4.x; v[4 * q + 1] = t4.y; v[4 * q + 2] = t4.z; v[4 * q + 3] = t4.w; }
            WAVE_FENCE();
            if (mt & 1) ep.template store16<1>(nt, 128 * wm + 32 * mt + prow, 128 * wn + 32 * nt + pc0, v);
            else ep.template store16<0>(nt, 128 * wm + 32 * mt + prow, 128 * wn + 32 * nt + pc0, v);
        }
        ep.row_end(128 * wm + 32 * mt + prow, lane);
    }
}

template <class EP>
__device__ __forceinline__ void skinny_tile(const h16* __restrict__ A, int lda, const h16* __restrict__ Bt, int ldb, int K, EP& ep, float* st, int lane) {
    f32x16 acc;
#pragma unroll
    for (int r = 0; r < 16; ++r) acc[r] = 0.f;
    const h16* ap = A + (size_t)(lane & 31) * lda + 8 * (lane >> 5);
    const h16* bp = Bt + (size_t)(lane & 31) * ldb + 8 * (lane >> 5);
    ep.template prefetch<0>(lane >> 1, (lane & 1) * 16);
    for (int k0 = 0; k0 < K; k0 += 128) {
        h16x8 af[8], bf[8];
#pragma unroll
        for (int u = 0; u < 8; ++u) { af[u] = *(const h16x8*)(ap + k0 + 16 * u); bf[u] = *(const h16x8*)(bp + k0 + 16 * u); }
#pragma unroll
        for (int u = 0; u < 8; ++u) acc = MFMA32(af[u], bf[u], acc);
    }
    const int prow = lane >> 1, pc0 = (lane & 1) * 16;
    ep.row_begin();
    WAVE_FENCE();
#pragma unroll
    for (int r = 0; r < 16; ++r) st[((r & 3) + 8 * (r >> 2) + 4 * (lane >> 5)) * 36 + (lane & 31)] = acc[r];
    WAVE_FENCE();
    float v[16];
#pragma unroll
    for (int q = 0; q < 4; ++q) { const float4 t4 = *(const float4*)(st + prow * 36 + pc0 + 4 * q); v[4 * q] = t4.x; v[4 * q + 1] = t4.y; v[4 * q + 2] = t4.z; v[4 * q + 3] = t4.w; }
    WAVE_FENCE();
    ep.template store16<0>(0, prow, pc0, v);
    ep.row_end(prow, lane);
}

struct EpiInProj {
    static constexpr bool kSweep = true; static constexpr bool kRowSum = false;
    int row0, n0; const float* rstd; h16* projA; float* small; h16* sza; h16* szg; h16* projG;
    template <class AL_> __device__ __forceinline__ void pre(AL_&) {}
    __device__ __forceinline__ float operator()(int rl, int cl, float v) const {
        const int row = row0 + rl; const float y = v * rstd[rl]; const int c = n0 + cl;
        if (c < 512) { if (c < 448) projA[(size_t)row * 512 + c] = (h16)y; else if (c < 460) small[(size_t)row * 16 + (c - 448)] = y; }
        else if (c < 1024) sza[(size_t)row * 512 + (c - 512)] = (h16)silu_f(y);
        else if (c < 2560) projG[(size_t)row * 1536 + (c - 1024)] = (h16)y;
        else szg[(size_t)row * 512 + (c - 2560)] = (h16)silu_f(y);
        return 0.f;
    }
    __device__ __forceinline__ void rowsum(int, float) const {}
};
struct EpiIn2 : EpiInProj {
    float* rstd_w; int tid; const float* sumsq;
    template <class AL_> __device__ __forceinline__ void pre(AL_&) {
        if (tid < 128) rstd_w[tid] = rsqrtf(sumsq[row0 + tid] * (1.f / 1024.f) + EPS);
        __syncthreads();
    }
};
struct EpiTileF32 {
    static constexpr bool kSweep = false; static constexpr bool kRowSum = false;
    template <class AL_> __device__ __forceinline__ void pre(AL_&) {}
    __device__ __forceinline__ float operator()(int, int, float) const { return 0.f; }
    __device__ __forceinline__ void rowsum(int, float) const {}
};
struct EpiStoreH {
    static constexpr bool kSweep = true; static constexpr bool kRowSum = false;
    h16* dst; int ld; int row0; const float* rs;
    template <class AL_> __device__ __forceinline__ void pre(AL_&) {}
    __device__ __forceinline__ float operator()(int rl, int cl, float v) const { dst[(size_t)(row0 + rl) * ld + cl] = (h16)(rs ? v * rs[rl] : v); return 0.f; }
    __device__ __forceinline__ void rowsum(int, float) const {}
};
struct EpiGate {
    static constexpr bool kSweep = true; static constexpr bool kRowSum = false;
    h16* dst; const h16* gate; int row0; int c0;
    template <class AL_> __device__ __forceinline__ void pre(AL_&) {}
    __device__ __forceinline__ float operator()(int rl, int cl, float v) const {
        const size_t row = row0 + rl;
        dst[row * 1024 + c0 + cl] = (h16)(v * (float)gate[row * 512 + c0 + cl]);
        return 0.f;
    }
    __device__ __forceinline__ void rowsum(int, float) const {}
};
struct EpiResid {
    static constexpr bool kSweep = true; static constexpr bool kRowSum = true;
    int layer; int row0; int n0; const float* meta; const float* x; float* metah; float* out; h16* h16o; float* sumsq_next;
    template <class AL_> __device__ __forceinline__ void pre(AL_&) {}
    __device__ __forceinline__ float operator()(int rl, int cl, float v) const {
        const int row = row0 + rl; if (row >= NT) return 0.f;
        const int b = row >= T_ ? 1 : 0; const int t = row - b * T_; const int c = n0 + cl;
        if (layer == 0) {
            float hn;
            if (t < 16) { hn = meta[(size_t)t * 1024 + c] + v; metah[((size_t)b * 16 + t) * 1024 + c] = hn; }
            else { const size_t o = ((size_t)b * 8192 + (t - 16)) * 1024 + c; hn = x[o] + v; out[o] = hn; }
            h16o[(size_t)row * 1024 + c] = (h16)hn;
            return hn * hn;
        } else {
            if (t >= 16) { const size_t o = ((size_t)b * 8192 + (t - 16)) * 1024 + c; out[o] = out[o] + v; }
            return 0.f;
        }
    }
    __device__ __forceinline__ void rowsum(int rl, float q) const { if (layer == 0 && row0 + rl < NT) atomicAdd(sumsq_next + row0 + rl, q); }
};

__device__ __forceinline__ void store16h(h16* dst, const float* v) {
    h16x8 a, b;
#pragma unroll
    for (int e = 0; e < 8; ++e) { a[e] = (h16)v[e]; b[e] = (h16)v[8 + e]; }
    *(h16x8*)dst = a; *(h16x8*)(dst + 8) = b;
}
struct EpiInBig {
    int row0, n0; const float* sumsq; h16* projA; float* small; h16* sza; h16* szg; h16* projG;
    float ssq[2];
    __device__ __forceinline__ void row_begin() {}
    __device__ __forceinline__ void row_end(int, int) {}
    template <int B> __device__ __forceinline__ void prefetch(int rl, int) { ssq[B] = sumsq[row0 + rl]; }
    template <int B> __device__ __forceinline__ void store16(int, int rl, int cl, const float* v) const {
        const int row = row0 + rl; const int c = n0 + cl;
        const float rs = rsqrtf(ssq[B] * (1.f / 1024.f) + EPS);
        float y[16];
#pragma unroll
        for (int e = 0; e < 16; ++e) y[e] = v[e] * rs;
        if (c < 512) {
            if (c < 448) store16h(projA + (size_t)row * 512 + c, y);
            else if (c == 448) {
#pragma unroll
                for (int e = 0; e < 12; ++e) small[(size_t)row * 16 + e] = y[e];
            }
        } else if (c < 1024) {
#pragma unroll
            for (int e = 0; e < 16; ++e) y[e] = silu_f(y[e]);
            store16h(sza + (size_t)row * 512 + (c - 512), y);
        } else if (c < 2560) store16h(projG + (size_t)row * 1536 + (c - 1024), y);
        else {
#pragma unroll
            for (int e = 0; e < 16; ++e) y[e] = silu_f(y[e]);
            store16h(szg + (size_t)row * 512 + (c - 2560), y);
        }
    }
};
struct EpiResBig {
    int layer, row0, n0; const float* meta; const float* x; float* metah; float* out; h16* h16o; float* sumsq_next; float ss; int nseg;
    float4 pf[2][4][4];
    __device__ __forceinline__ void row_begin() { ss = 0.f; }
    __device__ __forceinline__ void row_end(int rl, int lane) {
        if (layer == 0) { float q = ss; q += __shfl_xor(q, 1); if ((lane & 1) == 0) atomicAdd(sumsq_next + row0 + rl, q); }
    }
    __device__ __forceinline__ const float* srcp(int row, int c) const {
        const int b = row >= T_ ? 1 : 0; const int t = row - b * T_;
        if (layer == 0) return t < 16 ? meta + (size_t)t * 1024 + c : x + ((size_t)b * 8192 + (t - 16)) * 1024 + c;
        return out + ((size_t)b * 8192 + (t < 16 ? 0 : t - 16)) * 1024 + c;
    }
    template <int B> __device__ __forceinline__ void prefetch(int rl, int cl) {
        const float* src = srcp(row0 + rl, n0 + cl);
#pragma unroll
        for (int nt = 0; nt < 4; ++nt)
            if (nt < nseg) {
#pragma unroll
                for (int q = 0; q < 4; ++q) pf[B][nt][q] = *(const float4*)(src + 32 * nt + 4 * q);
            }
    }
    template <int B> __device__ __forceinline__ void store16(int nt, int rl, int cl, const float* v) {
        const int row = row0 + rl; const int c = n0 + cl;
        const int b = row >= T_ ? 1 : 0; const int t = row - b * T_;
        float* dst;
        if (layer == 0) dst = t < 16 ? metah + ((size_t)b * 16 + t) * 1024 + c : out + ((size_t)b * 8192 + (t - 16)) * 1024 + c;
        else { if (t < 16) return; dst = out + ((size_t)b * 8192 + (t - 16)) * 1024 + c; }
        float hn[16];
#pragma unroll
        for (int q = 0; q < 4; ++q) {
            const float4 hv = pf[B][nt][q];
            float4 o4; o4.x = hv.x + v[4 * q]; o4.y = hv.y + v[4 * q + 1]; o4.z = hv.z + v[4 * q + 2]; o4.w = hv.w + v[4 * q + 3];
            *(float4*)(dst + 4 * q) = o4;
            hn[4 * q] = o4.x; hn[4 * q + 1] = o4.y; hn[4 * q + 2] = o4.z; hn[4 * q + 3] = o4.w;
        }
        if (layer == 0) {
            store16h(h16o + (size_t)row * 1024 + c, hn);
#pragma unroll
            for (int e = 0; e < 16; ++e) ss += hn[e] * hn[e];
        }
    }
};

__device__ __forceinline__ int in_src_col(int n) {
    if (n < 452) return n;
    if (n < 456) return 3012 + (n - 452);
    if (n < 460) return 3016 + (n - 456);
    if (n < 512) return -1;
    if (n < 1024) return 452 + (n - 512);
    if (n < 2560) return 964 + (n - 1024);
    return 2500 + (n - 2560);
}
__device__ __forceinline__ float prep_get(const Params& P, int l, int job, int h, int n, int k) {
    switch (job) {
        case 0: { const int s = in_src_col(n); if (s < 0) return 0.f; return P.norm_gain[l * 1024 + k] * P.w_in[((size_t)l * 1024 + k) * 3020 + s]; }
        case 1: return P.w_out[((size_t)l * 1024 + k) * 1024 + n];
        case 2: return P.g_cq[l * 256 + k] * (n < 512 ? P.w_uq[((size_t)l * 256 + k) * 512 + n] : P.w_qidx[((size_t)l * 256 + k) * 256 + (n - 512)]);
        case 3: return P.g_ckv[l * 128 + k] * P.w_ukv[((size_t)l * 128 + k) * 1024 + n];
        case 4: { const int kk = k >> 4, hf = (k >> 3) & 1, j = k & 7; const int d = 16 * kk + 8 * (j >> 2) + 4 * hf + (j & 3);
                  return P.w_ukv[((size_t)l * 128 + n) * 1024 + h * 64 + d] * P.g_kn[l * 64 + d] * P.g_qn[l * 64 + d] * 0.125f; }
        default: return P.w_ukv[((size_t)l * 128 + k) * 1024 + 512 + h * 64 + n];
    }
}
__device__ __forceinline__ void phase_prep(const Params& P, unsigned char* lds) {
    float* tile = (float*)lds;
    const int tid = opaque_tid();
    {
        h16* h16o = (h16*)(P.ws + OFF_H16); float* sumsq = (float*)(P.ws + OFF_SUMSQ);
        const int lane = tid & 63, w = tid >> 6;
        for (int row = blockIdx.x * 4 + w; row < NT; row += gridDim.x * 4) {
            const int b = row >= T_ ? 1 : 0; const int t = row - b * T_;
            const float* src = t < 16 ? P.meta + (size_t)t * 1024 : P.x + ((size_t)b * 8192 + (t - 16)) * 1024;
            float ss = 0.f;
#pragma unroll
            for (int q = 0; q < 2; ++q) {
                const float4 a = *(const float4*)(src + q * 512 + lane * 8), c4 = *(const float4*)(src + q * 512 + lane * 8 + 4);
                ss += a.x * a.x + a.y * a.y + a.z * a.z + a.w * a.w + c4.x * c4.x + c4.y * c4.y + c4.z * c4.z + c4.w * c4.w;
                h16x8 o; o[0] = (h16)a.x; o[1] = (h16)a.y; o[2] = (h16)a.z; o[3] = (h16)a.w; o[4] = (h16)c4.x; o[5] = (h16)c4.y; o[6] = (h16)c4.z; o[7] = (h16)c4.w;
                *(h16x8*)(h16o + (size_t)row * 1024 + q * 512 + lane * 8) = o;
            }
#pragma unroll
            for (int d = 1; d < 64; d <<= 1) ss += __shfl_xor(ss, d);
            if (lane == 0) sumsq[row] = ss;
        }
    }
    for (int it = blockIdx.x; it < 2240; it += gridDim.x) {
        const int l = it / 1120; int r = it % 1120;
        int job, h = 0, N, K, tn, tk; h16* dst;
        if (r < 768) { job = 0; N = 3072; K = 1024; tn = r / 16; tk = r % 16; dst = (h16*)(P.ws + OFF_W1T) + (size_t)l * 3072 * 1024; }
        else if ((r -= 768) < 256) { job = 1; N = 1024; K = 1024; tn = r / 16; tk = r % 16; dst = (h16*)(P.ws + OFF_WOT) + (size_t)l * 1024 * 1024; }
        else if ((r -= 256) < 48) { job = 2; N = 768; K = 256; tn = r / 4; tk = r % 4; dst = (h16*)(P.ws + OFF_WQ2T) + (size_t)l * 768 * 256; }
        else if ((r -= 48) < 16) { job = 3; N = 512; K = 128; tn = r / 2; tk = r % 2; dst = (h16*)(P.ws + OFF_WUKT) + (size_t)l * 512 * 128; }
        else if ((r -= 16) < 16) { job = 4; N = 128; K = 64; h = r / 2; tn = r % 2; tk = 0; dst = (h16*)(P.ws + OFF_WKABS) + ((size_t)l * 8 + h) * 128 * 64; }
        else { r -= 16; job = 5; N = 64; K = 128; h = r / 2; tn = 0; tk = r % 2; dst = (h16*)(P.ws + OFF_WUVT) + ((size_t)l * 8 + h) * 64 * 128; }
        (void)N;
        const int n0 = tn * 64, k0 = tk * 64;
        __syncthreads();
#pragma unroll 4
        for (int q = 0; q < 16; ++q) { const int kk = q * 4 + (tid >> 6), nn = tid & 63; tile[kk * 65 + nn] = prep_get(P, l, job, h, n0 + nn, k0 + kk); }
        __syncthreads();
#pragma unroll 4
        for (int q = 0; q < 16; ++q) { const int nn = q * 4 + (tid >> 6), kk = tid & 63; dst[(size_t)(n0 + nn) * K + k0 + kk] = (h16)tile[kk * 65 + nn]; }
    }
}

__device__ __forceinline__ void phase_inproj(const Params& P, int l, unsigned char* lds) {
    h16* smem = (h16*)lds;
    float* rstd = (float*)(lds + 73728);
    const int tid = opaque_tid();
    const h16* W = (const h16*)(P.ws + OFF_W1T) + (size_t)l * 3072 * 1024;
    const h16* A = (const h16*)(P.ws + OFF_H16);
    const float* sumsq = (const float*)(P.ws + OFF_SUMSQ) + (size_t)l * NTP;
    XcdQueue xq; xq.init((unsigned*)(P.ws + OFF_CTL) + 4096 + l * 128, 96, (int*)(lds + LDS_BYTES - 32));
    int xl, qi;
    while (xq.next(xl, qi)) {
        const int rb = 8 * xl + (qi & 7), tn = 4 * (qi >> 5) + ((qi >> 3) & 3);
        EpiInBig ep{rb * 256, tn * 256, sumsq, (h16*)(P.ws + OFF_PROJA), (float*)(P.ws + OFF_SMALL), (h16*)(P.ws + OFF_SZA), (h16*)(P.ws + OFF_SZG), (h16*)(P.ws + OFF_PROJG), {0.f, 0.f}};
        gemm_big(A + (size_t)rb * 256 * 1024, 1024, W + (size_t)tn * 256 * 1024, 1024, 1024, ep, smem);
    }
    __syncthreads();
    if ((tid >> 6) == 0) {
        for (int it = blockIdx.x; it < 96; it += gridDim.x) {
            EpiInBig ep{16384, it * 32, sumsq, (h16*)(P.ws + OFF_PROJA), (float*)(P.ws + OFF_SMALL), (h16*)(P.ws + OFF_SZA), (h16*)(P.ws + OFF_SZG), (h16*)(P.ws + OFF_PROJG), {0.f, 0.f}};
            skinny_tile(A + (size_t)16384 * 1024, 1024, W + (size_t)it * 32 * 1024, 1024, 1024, ep, (float*)lds, tid & 63);
        }
    }
    (void)rstd;
}

__device__ __forceinline__ void p2a_item(const Params& P, int l, int rb, int j, unsigned char* lds) {
    h16* smem = (h16*)lds;
    float* ft = (float*)lds;
    float* rstdq = (float*)(lds + 73728);
    const int tid = opaque_tid(); const int row0 = rb * 128;
    const h16* projA = (const h16*)(P.ws + OFF_PROJA);
    __syncthreads();
    {
        const int row = row0 + (tid >> 1), hf = tid & 1; float s = 0.f;
#pragma unroll 4
        for (int q = 0; q < 16; ++q) { const h16x8 v = *(const h16x8*)(projA + (size_t)row * 512 + hf * 128 + q * 8);
#pragma unroll
            for (int e = 0; e < 8; ++e) { const float f = (float)v[e]; s += f * f; } }
        s += __shfl_xor(s, 1);
        if (hf == 0) rstdq[tid >> 1] = rsqrtf(s * (1.f / 256.f) + EPS);
    }
    __syncthreads();
    const h16* Wq2 = (const h16*)(P.ws + OFF_WQ2T) + (size_t)l * 768 * 256;
    AF16 al{projA, 512};
    if (j >= 4) {
        EpiStoreH ep{(h16*)(P.ws + OFF_QIDX) + (j - 4) * 128, 256, row0, rstdq};
        gemm_tile<128>(al, row0, Wq2 + (size_t)j * 128 * 256, 256, 256, ep, smem);
        return;
    }
    EpiTileF32 ep;
    gemm_tile<128>(al, row0, Wq2 + (size_t)j * 128 * 256, 256, 256, ep, smem);
    __syncthreads();
    h16* qn = (h16*)(P.ws + OFF_QN);
    {
        const int rl = tid >> 1, hh = tid & 1; float s = 0.f;
        const float rq = rstdq[rl];
        for (int d = 0; d < 64; ++d) { const float f = ft[rl * 129 + hh * 64 + d] * rq; s += f * f; }
        const float rs = rsqrtf(s * (1.f / 64.f) + EPS) * rq;
        h16* dst = qn + (size_t)(row0 + rl) * 512 + (2 * j + hh) * 64;
        const float* gq = P.g_qn + l * 64;
        for (int d = 0; d < 64; d += 8) { h16x8 o;
#pragma unroll
            for (int e = 0; e < 8; ++e) o[e] = (h16)(ft[rl * 129 + hh * 64 + d + e] * rs * gq[d + e]);
            *(h16x8*)(dst + d) = o; }
    }
    __threadfence_block();
    __syncthreads();
    for (int hh = 0; hh < 2; ++hh) {
        const int head = 2 * j + hh;
        AF16 al2{qn + head * 64, 512};
        EpiStoreH ep2{(h16*)(P.ws + OFF_QK) + head * 128, 1024, row0, nullptr};
        gemm_tile<128>(al2, row0, (const h16*)(P.ws + OFF_WKABS) + ((size_t)l * 8 + head) * 128 * 64, 64, 64, ep2, smem);
    }
}

__device__ __forceinline__ void p2b_item(const Params& P, int l, int rb, unsigned char* lds) {
    h16* smem = (h16*)lds;
    float* ft = (float*)lds;
    const int tid = opaque_tid(); const int row0 = rb * 128;
    const h16* projA = (const h16*)(P.ws + OFF_PROJA);
    h16* kvrow = (h16*)(P.ws + OFF_KVROW);
    __syncthreads();
    {
        const int row = row0 + (tid >> 1), hf = tid & 1; float s = 0.f; h16x8 v[8];
#pragma unroll
        for (int q = 0; q < 8; ++q) { v[q] = *(const h16x8*)(projA + (size_t)row * 512 + 256 + hf * 64 + q * 8);
#pragma unroll
            for (int e = 0; e < 8; ++e) { const float f = (float)v[q][e]; s += f * f; } }
        s += __shfl_xor(s, 1);
        const float rs = rsqrtf(s * (1.f / 128.f) + EPS);
        const float* g = P.g_ckv + l * 128 + hf * 64;
#pragma unroll
        for (int q = 0; q < 8; ++q) { h16x8 o;
#pragma unroll
            for (int e = 0; e < 8; ++e) o[e] = (h16)((float)v[q][e] * rs * g[q * 8 + e]);
            *(h16x8*)(kvrow + (size_t)row * 136 + hf * 64 + q * 8) = o; }
    }
    {
        h16* kfrag = (h16*)(P.ws + OFF_KFRAG);
#pragma unroll
        for (int q = 0; q < 4; ++q) {
            const int g = tid + 256 * q; const int row = row0 + (g >> 3), g8 = g & 7;
            if (row < NT) {
                const int b = row >= T_ ? 1 : 0; const int t = row - b * T_;
                const h16x8 v = *(const h16x8*)(projA + (size_t)row * 512 + 384 + g8 * 8);
                const int tile = t >> 5, ks = g8 >> 1, hh = g8 & 1;
                *(h16x8*)(kfrag + ((size_t)(b * NKT + tile) * 4 + ks) * 512 + (hh * 32 + (t & 31)) * 8) = v;
            }
        }
    }
    __threadfence_block();
    __syncthreads();
    const h16* Wuk = (const h16*)(P.ws + OFF_WUKT) + (size_t)l * 512 * 128;
    for (int tn = 0; tn < 4; ++tn) {
        AF16 al{kvrow, 136};
        EpiTileF32 ep;
        gemm_tile<128>(al, row0, Wuk + (size_t)tn * 128 * 128, 128, 128, ep, smem);
        __syncthreads();
        const int rl = tid >> 1, hh = tid & 1; float s = 0.f;
        for (int d = 0; d < 64; ++d) { const float f = ft[rl * 129 + hh * 64 + d]; s += f * f; }
        kvrow[(size_t)(row0 + rl) * 136 + 128 + 2 * tn + hh] = (h16)rsqrtf(s * (1.f / 64.f) + EPS);
        __syncthreads();
    }
}

__device__ __forceinline__ void p2c_item(const Params& P, int l, int item, unsigned char* lds) {
    h16* qh = (h16*)lds;
    h16* kh = (h16*)(lds + 17408);
    float* kf = (float*)(lds + 34816);
    float* vf = (float*)(lds + 67584);
    float* Lm = (float*)(lds + 100352);
    float* beta = (float*)(lds + 116736);
    float* dec = beta + 64;
    float* edec = dec + 64;
    const int tid = opaque_tid(), lane = tid & 63, w = tid >> 6;
    const int chain = item / NCH, n = item % NCH, b = chain >> 2, h = chain & 3;
    const h16* projG = (const h16*)(P.ws + OFF_PROJG);
    const float* small = (const float*)(P.ws + OFF_SMALL);
    const float* cw = P.conv_w + (size_t)l * 4 * 1536;
    __syncthreads();
#ifndef P2C
#define P2C 15
#endif
    float* cwl = (float*)(lds + 117504);
    for (int e = tid; e < 1536; e += NTHREADS) { const int m = e >> 9, jj = (e >> 7) & 3, c = e & 127; cwl[e] = cw[jj * 1536 + m * 512 + h * 128 + c]; }
    __syncthreads();
    if (P2C & 1) {
        const int i = tid >> 2, part = tid & 3;
        const int t = 64 * n + i - 48; const bool valid = t >= 0;
        const size_t row = (size_t)b * T_ + (valid ? t : 0);
        h16x8 rv[3][4][4];
#define CONV_LOAD(m_) do { _Pragma("unroll") for (int jj = 0; jj < 4; ++jj) { int tt = t - 3 + jj; tt = tt < 0 ? 0 : tt; \
            const h16* rp = projG + ((size_t)b * T_ + tt) * 1536 + (m_) * 512 + h * 128 + part * 32; \
            _Pragma("unroll") for (int c8 = 0; c8 < 4; ++c8) rv[m_][jj][c8] = *(const h16x8*)(rp + c8 * 8); } } while (0)
        CONV_LOAD(0); CONV_LOAD(1);
        float bl = 0.f, al = 0.f;
        if (part == 0) { bl = small[row * 16 + 4 + h]; al = small[row * 16 + 8 + h]; }
        float vals[32];
#pragma unroll
        for (int m = 0; m < 3; ++m) {
            if (m == 1) { CONV_LOAD(2); }
            __builtin_amdgcn_sched_barrier(0);
#pragma unroll
            for (int c = 0; c < 32; ++c) vals[c] = 0.f;
#pragma unroll
            for (int jj = 0; jj < 4; ++jj) {
                const float msk = (valid && (t - 3 + jj) >= 0) ? 1.f : 0.f;
                const float* wp = cwl + (m * 4 + jj) * 128 + part * 32;
#pragma unroll
                for (int c8 = 0; c8 < 4; ++c8) {
                    const float4 w0 = *(const float4*)(wp + c8 * 8), w1 = *(const float4*)(wp + c8 * 8 + 4);
                    const float wv[8] = {w0.x, w0.y, w0.z, w0.w, w1.x, w1.y, w1.z, w1.w};
#pragma unroll
                    for (int e = 0; e < 8; ++e) vals[c8 * 8 + e] += wv[e] * msk * (float)rv[m][jj][c8][e];
                }
            }
            float ss = 0.f;
#pragma unroll
            for (int c = 0; c < 32; ++c) { vals[c] = silu_f(vals[c]); ss += vals[c] * vals[c]; }
            if (m < 2) {
                ss += __shfl_xor(ss, 1); ss += __shfl_xor(ss, 2);
                const float rs = valid ? rsqrtf(ss + EPS) : 0.f;
                h16* dsth = (m == 0 ? qh : kh) + i * 136 + part * 32;
#pragma unroll
                for (int c8 = 0; c8 < 4; ++c8) { h16x8 o;
#pragma unroll
                    for (int e = 0; e < 8; ++e) o[e] = (h16)(vals[c8 * 8 + e] * rs);
                    *(h16x8*)(dsth + c8 * 8) = o; }
                if (m == 1) {
#pragma unroll
                    for (int c4 = 0; c4 < 8; ++c4) *(float4*)(kf + i * 128 + part * 32 + c4 * 4) = make_float4(vals[4 * c4] * rs, vals[4 * c4 + 1] * rs, vals[4 * c4 + 2] * rs, vals[4 * c4 + 3] * rs);
                }
            } else {
#pragma unroll
                for (int c4 = 0; c4 < 8; ++c4) *(float4*)(vf + i * 128 + part * 32 + c4 * 4) = valid ? make_float4(vals[4 * c4], vals[4 * c4 + 1], vals[4 * c4 + 2], vals[4 * c4 + 3]) : make_float4(0.f, 0.f, 0.f, 0.f);
            }
        }
#undef CONV_LOAD
        if (part == 0) {
            float bt = 0.f, g = 0.f;
            if (valid) {
                bt = 1.f / (1.f + __expf(-bl));
                const float xx = al + P.dt_bias[l * 4 + h];
                const float sp = xx > 20.f ? xx : log1pf(__expf(xx));
                g = -__expf(P.a_log[l * 4 + h]) * sp;
            }
            beta[i] = bt; dec[i] = g;
        }
    }
    __syncthreads();
    if (w == 0) {
        float v = dec[lane];
#pragma unroll
        for (int d = 1; d < 64; d <<= 1) { const float o = __shfl_up(v, d); if (lane >= d) v += o; }
        dec[lane] = v; edec[lane] = __expf(v);
    }
    __syncthreads();
    if (P2C & 2) {
        const int gq = lane >> 4, c16 = lane & 15;
        h16* aqk = (h16*)(P.ws + OFF_AQK) + (size_t)item * 4096;
        h16x8 ak[4], aq[4];
#pragma unroll
        for (int ks = 0; ks < 4; ++ks) { ak[ks] = *(const h16x8*)(kh + (16 * w + c16) * 136 + 32 * ks + 8 * gq); aq[ks] = *(const h16x8*)(qh + (16 * w + c16) * 136 + 32 * ks + 8 * gq); }
#pragma unroll
        for (int nt = 0; nt < 4; ++nt) {
            f32x4 kk = {0.f, 0.f, 0.f, 0.f}, qk = {0.f, 0.f, 0.f, 0.f};
#pragma unroll
            for (int ks = 0; ks < 4; ++ks) { const h16x8 bb = *(const h16x8*)(kh + (16 * nt + c16) * 136 + 32 * ks + 8 * gq); kk = MFMA16(ak[ks], bb, kk); qk = MFMA16(aq[ks], bb, qk); }
            const int jc = 16 * nt + c16; const float dj = dec[jc];
#pragma unroll
            for (int r = 0; r < 4; ++r) {
                const int ir = 16 * w + 4 * gq + r; const float gm = __expf(fminf(dec[ir] - dj, 0.f));
                Lm[ir * 64 + jc] = ir > jc ? beta[ir] * kk[r] * gm : 0.f;
                aqk[ir * 64 + jc] = (h16)(ir >= jc ? qk[r] * gm : 0.f);
            }
        }
    }
    __syncthreads();
    if (P2C & 8) {
        h16* qd = (h16*)(P.ws + OFF_QD) + (size_t)item * 8192;
        const int i = tid >> 2, part = tid & 3; const float ed = edec[i];
#pragma unroll
        for (int c8 = 0; c8 < 4; ++c8) { const h16x8 v = *(const h16x8*)(qh + i * 136 + part * 32 + c8 * 8); h16x8 o;
#pragma unroll
            for (int e = 0; e < 8; ++e) o[e] = (h16)((float)v[e] * ed);
            *(h16x8*)(qd + i * 128 + part * 32 + c8 * 8) = o; }
        h16* kdt = (h16*)(P.ws + OFF_KDT) + (size_t)item * 8192;
        const int d = tid & 127, ih = tid >> 7; const float dl = dec[63];
#pragma unroll
        for (int i8 = 0; i8 < 4; ++i8) { h16x8 o;
#pragma unroll
            for (int e = 0; e < 8; ++e) { const int ii = ih * 32 + i8 * 8 + e; o[e] = (h16)(kf[ii * 128 + d] * __expf(dl - dec[ii])); }
            *(h16x8*)(kdt + d * 64 + ih * 32 + i8 * 8) = o; }
        if (tid == 0) ((float*)(P.ws + OFF_CDEC))[item] = __expf(dl);
    }
    __syncthreads();
    if (P2C & 4) {
        const int c = tid; const bool isu = c < 128; float* col = isu ? (vf + c) : (kf + (c - 128));
#pragma unroll 1
        for (int bi = 0; bi < 8; ++bi) {
            float sv[8];
#pragma unroll
            for (int r = 0; r < 8; ++r) { const int i = 8 * bi + r; float v = col[i * 128] * beta[i]; if (!isu) v *= edec[i]; sv[r] = v; }
#pragma unroll 1
            for (int j4 = 0; j4 < 2 * bi; ++j4) {
                const float x0 = col[(4 * j4 + 0) * 128], x1 = col[(4 * j4 + 1) * 128], x2 = col[(4 * j4 + 2) * 128], x3 = col[(4 * j4 + 3) * 128];
#pragma unroll
                for (int r = 0; r < 8; ++r) { const float4 lv = *(const float4*)(Lm + (8 * bi + r) * 64 + 4 * j4); sv[r] -= lv.x * x0; sv[r] -= lv.y * x1; sv[r] -= lv.z * x2; sv[r] -= lv.w * x3; }
            }
#pragma unroll
            for (int r = 1; r < 8; ++r) {
                const float4 la = *(const float4*)(Lm + (8 * bi + r) * 64 + 8 * bi), lb = *(const float4*)(Lm + (8 * bi + r) * 64 + 8 * bi + 4);
                const float lv[8] = {la.x, la.y, la.z, la.w, lb.x, lb.y, lb.z, lb.w};
#pragma unroll
                for (int q = 0; q < r; ++q) sv[r] -= lv[q] * sv[q];
            }
#pragma unroll
            for (int r = 0; r < 8; ++r) col[(8 * bi + r) * 128] = sv[r];
        }
        h16* dst = (h16*)(P.ws + (isu ? OFF_U : OFF_WM)) + (size_t)item * 8192 + (isu ? c : c - 128);
#pragma unroll 8
        for (int i = 0; i < 64; ++i) dst[i * 128] = (h16)col[i * 128];
    }
}

__device__ __forceinline__ float half_sum(float x) {
    const unsigned u = __float_as_uint(x); const auto p = __builtin_amdgcn_permlane32_swap(u, u, false, false);
    return __uint_as_float(p[0]) + __uint_as_float(p[1]);
}
__device__ __forceinline__ void store_tile_T(const f32x16& acc, float scale, float* st, h16* dst_row_lane  , bool ok, int lane) {
#pragma unroll
    for (int r = 0; r < 16; ++r) st[(lane & 31) * 36 + (r & 3) + 8 * (r >> 2) + 4 * (lane >> 5)] = acc[r] * scale;
    WAVE_FENCE();
    float v[16];
#pragma unroll
    for (int q = 0; q < 4; ++q) { const float4 t4 = *(const float4*)(st + (lane >> 1) * 36 + (lane & 1) * 16 + 4 * q); v[4 * q] = t4.x; v[4 * q + 1] = t4.y; v[4 * q + 2] = t4.z; v[4 * q + 3] = t4.w; }
    WAVE_FENCE();
    if (ok) store16h(dst_row_lane, v);
}

__device__ __forceinline__ void chain_item(const Params& P, int l, int item, float* st, int lane) {
    const int r0 = item * 32; const int tok = lane & 31, hf = lane >> 5;
    const int row = r0 + tok; const int rowc = row < NT ? row : NT - 1;
    const h16* projA = (const h16*)(P.ws + OFF_PROJA);
    const h16* Wq2 = (const h16*)(P.ws + OFF_WQ2T) + (size_t)l * 768 * 256;
    const h16* Wka = (const h16*)(P.ws + OFF_WKABS) + (size_t)l * 8 * 128 * 64;
    const h16* Wuk = (const h16*)(P.ws + OFF_WUKT) + (size_t)l * 512 * 128;
    h16* qidx = (h16*)(P.ws + OFF_QIDX); h16* qk = (h16*)(P.ws + OFF_QK); h16* kvrow = (h16*)(P.ws + OFF_KVROW);
    const int srow = r0 + (lane >> 1); const bool sok = srow < NT; const size_t srowc = sok ? srow : NT - 1;
    h16x8 bq[16]; float ss = 0.f;
#pragma unroll
    for (int ks = 0; ks < 16; ++ks) { bq[ks] = *(const h16x8*)(projA + (size_t)rowc * 512 + 16 * ks + 8 * hf);
#pragma unroll
        for (int e = 0; e < 8; ++e) { const float f = (float)bq[ks][e]; ss += f * f; } }
    ss = half_sum(ss);
    const float rstd_q = rsqrtf(ss * (1.f / 256.f) + EPS);
#pragma unroll 1
    for (int h = 0; h < 8; ++h) {
        f32x16 aq[2];
#pragma unroll
        for (int mt = 0; mt < 2; ++mt)
#pragma unroll
            for (int r = 0; r < 16; ++r) aq[mt][r] = 0.f;
        const h16* wp = Wq2 + (size_t)(64 * h + tok) * 256 + 8 * hf;
#pragma unroll
        for (int ks = 0; ks < 16; ++ks) {
            const h16x8 a0 = *(const h16x8*)(wp + 16 * ks), a1 = *(const h16x8*)(wp + 32 * 256 + 16 * ks);
            aq[0] = MFMA32(a0, bq[ks], aq[0]); aq[1] = MFMA32(a1, bq[ks], aq[1]);
        }
        float sq = 0.f;
#pragma unroll
        for (int mt = 0; mt < 2; ++mt)
#pragma unroll
            for (int r = 0; r < 16; ++r) sq += aq[mt][r] * aq[mt][r];
        sq = half_sum(sq) * rstd_q * rstd_q;
        const float rsq = rsqrtf(sq * (1.f / 64.f) + EPS) * rstd_q;
        h16x8 qb[4];
#pragma unroll
        for (int kk = 0; kk < 4; ++kk)
#pragma unroll
            for (int j = 0; j < 8; ++j) qb[kk][j] = (h16)(aq[kk >> 1][8 * (kk & 1) + j] * rsq);
        const h16* kp = Wka + (size_t)h * 128 * 64 + (size_t)tok * 64 + 8 * hf;
#pragma unroll
        for (int ct = 0; ct < 4; ++ct) {
            f32x16 ak;
#pragma unroll
            for (int r = 0; r < 16; ++r) ak[r] = 0.f;
#pragma unroll
            for (int kk = 0; kk < 4; ++kk) { const h16x8 a = *(const h16x8*)(kp + (size_t)(32 * ct) * 64 + 16 * kk); ak = MFMA32(a, qb[kk], ak); }
            store_tile_T(ak, 1.f, st, qk + srowc * 1024 + h * 128 + 32 * ct + 16 * (lane & 1), sok, lane);
        }
    }
#pragma unroll 1
    for (int nt = 0; nt < 8; ++nt) {
        f32x16 ai;
#pragma unroll
        for (int r = 0; r < 16; ++r) ai[r] = 0.f;
        const h16* wp = Wq2 + (size_t)(512 + 32 * nt + tok) * 256 + 8 * hf;
#pragma unroll
        for (int ks = 0; ks < 16; ++ks) { const h16x8 a = *(const h16x8*)(wp + 16 * ks); ai = MFMA32(a, bq[ks], ai); }
#pragma unroll
        for (int r = 0; r < 16; ++r) ai[r] *= rstd_q;
        store_tile_T(ai, 1.f, st, qidx + srowc * 256 + 32 * nt + 16 * (lane & 1), sok, lane);
    }
    h16x8 bk[8]; float sk = 0.f;
#pragma unroll
    for (int ks = 0; ks < 8; ++ks) { bk[ks] = *(const h16x8*)(projA + (size_t)rowc * 512 + 256 + 16 * ks + 8 * hf);
#pragma unroll
        for (int e = 0; e < 8; ++e) { const float f = (float)bk[ks][e]; sk += f * f; } }
    sk = half_sum(sk);
    const float rstd_kv = rsqrtf(sk * (1.f / 128.f) + EPS);
    if (row < NT) {
        const float* g = P.g_ckv + l * 128;
#pragma unroll
        for (int ks = 0; ks < 8; ++ks) { h16x8 o;
#pragma unroll
            for (int e = 0; e < 8; ++e) o[e] = (h16)((float)bk[ks][e] * rstd_kv * g[16 * ks + 8 * hf + e]);
            *(h16x8*)(kvrow + (size_t)row * 136 + 16 * ks + 8 * hf) = o; }
    }
#pragma unroll 1
    for (int h = 0; h < 8; ++h) {
        f32x16 ak[2];
#pragma unroll
        for (int mt = 0; mt < 2; ++mt)
#pragma unroll
            for (int r = 0; r < 16; ++r) ak[mt][r] = 0.f;
        const h16* wp = Wuk + (size_t)(64 * h + tok) * 128 + 8 * hf;
#pragma unroll
        for (int ks = 0; ks < 8; ++ks) {
            const h16x8 a0 = *(const h16x8*)(wp + 16 * ks), a1 = *(const h16x8*)(wp + 32 * 128 + 16 * ks);
            ak[0] = MFMA32(a0, bk[ks], ak[0]); ak[1] = MFMA32(a1, bk[ks], ak[1]);
        }
        float sq = 0.f;
#pragma unroll
        for (int mt = 0; mt < 2; ++mt)
#pragma unroll
            for (int r = 0; r < 16; ++r) sq += ak[mt][r] * ak[mt][r];
        sq = half_sum(sq) * rstd_kv * rstd_kv;
        if (row < NT && hf == 0) kvrow[(size_t)row * 136 + 128 + h] = (h16)rsqrtf(sq * (1.f / 64.f) + EPS);
    }
    if (row < NT) {
        h16* kfrag = (h16*)(P.ws + OFF_KFRAG);
        const int b = row >= T_ ? 1 : 0; const int t = row - b * T_; const int tile = t >> 5;
#pragma unroll
        for (int q = 0; q < 4; ++q) {
            const int g8 = 2 * q + hf;
            const h16x8 v = *(const h16x8*)(projA + (size_t)row * 512 + 384 + g8 * 8);
            *(h16x8*)(kfrag + ((size_t)(b * NKT + tile) * 4 + (g8 >> 1)) * 512 + ((g8 & 1) * 32 + (t & 31)) * 8) = v;
        }
    }
}

__device__ __forceinline__ void p4_item(const Params& P, int l, int item, int lane) {
    const int r0 = item * 32; const int tok = lane & 31, hf = lane >> 5;
    const int row = r0 + tok; const bool ok = row < NT; const size_t rowc = ok ? row : NT - 1;
    const h16* ctx = (const h16*)(P.ws + OFF_CTX); const h16* Wuv = (const h16*)(P.ws + OFF_WUVT) + (size_t)l * 8 * 64 * 128;
    const h16* sza = (const h16*)(P.ws + OFF_SZA); const h16* szg = (const h16*)(P.ws + OFF_SZG); const h16* og = (const h16*)(P.ws + OFF_QN);
    h16* omix = (h16*)(P.ws + OFF_OMIX);
#pragma unroll 1
    for (int h = 0; h < 8; ++h) {
        h16x8 bc[8];
#pragma unroll
        for (int ks = 0; ks < 8; ++ks) bc[ks] = *(const h16x8*)(ctx + rowc * 1024 + h * 128 + 16 * ks + 8 * hf);
        f32x16 ao[2];
#pragma unroll
        for (int mt = 0; mt < 2; ++mt)
#pragma unroll
            for (int r = 0; r < 16; ++r) ao[mt][r] = 0.f;
        const h16* wp = Wuv + (size_t)h * 64 * 128 + (size_t)tok * 128 + 8 * hf;
#pragma unroll
        for (int ks = 0; ks < 8; ++ks) {
            const h16x8 a0 = *(const h16x8*)(wp + 16 * ks), a1 = *(const h16x8*)(wp + 32 * 128 + 16 * ks);
            ao[0] = MFMA32(a0, bc[ks], ao[0]); ao[1] = MFMA32(a1, bc[ks], ao[1]);
        }
        if (ok) {
#pragma unroll
            for (int mt = 0; mt < 2; ++mt)
#pragma unroll
                for (int g = 0; g < 4; ++g) {
                    const int d0 = h * 64 + 32 * mt + 8 * g + 4 * hf;
                    const h16x4 z = *(const h16x4*)(sza + (size_t)row * 512 + d0);
                    h16x4 o;
#pragma unroll
                    for (int e = 0; e < 4; ++e) o[e] = (h16)(ao[mt][4 * g + e] * (float)z[e]);
                    *(h16x4*)(omix + (size_t)row * 1024 + d0) = o;
                }
        }
    }
    const float* go = P.g_out + l * 128;
#pragma unroll 1
    for (int h = 0; h < 4; ++h) {
        h16x8 v[8]; float ss = 0.f;
#pragma unroll
        for (int q = 0; q < 8; ++q) { v[q] = *(const h16x8*)(og + rowc * 512 + h * 128 + 64 * hf + 8 * q);
#pragma unroll
            for (int e = 0; e < 8; ++e) { const float f = (float)v[q][e]; ss += f * f; } }
        ss = half_sum(ss);
        const float rs = rsqrtf(ss * (1.f / 128.f) + EPS);
        if (ok) {
#pragma unroll
            for (int q = 0; q < 8; ++q) { const h16x8 z = *(const h16x8*)(szg + (size_t)row * 512 + h * 128 + 64 * hf + 8 * q); h16x8 o;
#pragma unroll
                for (int e = 0; e < 8; ++e) o[e] = (h16)((float)v[q][e] * rs * go[64 * hf + 8 * q + e] * (float)z[e]);
                *(h16x8*)(omix + (size_t)row * 1024 + 512 + h * 128 + 64 * hf + 8 * q) = o; }
        }
    }
}

__device__ __forceinline__ void phase2(const Params& P, int l, unsigned char* lds) {
    for (int rep_ = 0; rep_ <= PROBE_P2C; ++rep_) for (int it = blockIdx.x; it < NGI; it += gridDim.x) p2c_item(P, l, it, lds);
    __syncthreads();
    const int tid = opaque_tid(), lane = tid & 63, w = tid >> 6;
    float* st = (float*)lds + w * 1152;
    for (int rep_ = 0; rep_ <= PROBE_CHAIN; ++rep_) for (int it = blockIdx.x * 4 + w; it < (NT + 31) / 32; it += gridDim.x * 4) chain_item(P, l, it, st, lane);
}

__device__ __forceinline__ void gdn_scan(const Params& P, int sw, unsigned char* lds) {
    h16* St = (h16*)lds;
    h16* Vt = (h16*)(lds + 4352);
    const int tid = opaque_tid(), lane = tid & 63, w = tid >> 6, gq = lane >> 4, c16 = lane & 15;
    const int chain = sw >> 3, e0 = (sw & 7) * 16, b = chain >> 2, h = chain & 3;
    const h16* Ub = (const h16*)(P.ws + OFF_U); const h16* Wb = (const h16*)(P.ws + OFF_WM);
    const h16* Qb = (const h16*)(P.ws + OFF_QD); const h16* Kb = (const h16*)(P.ws + OFF_KDT);
    const h16* Ab = (const h16*)(P.ws + OFF_AQK); const float* cdec = (const float*)(P.ws + OFF_CDEC);
    h16* og = (h16*)(P.ws + OFF_QN);
    __syncthreads();
    for (int i = tid; i < 16 * 136; i += NTHREADS) St[i] = (h16)0.f;
    f32x4 S[2] = {{0.f, 0.f, 0.f, 0.f}, {0.f, 0.f, 0.f, 0.f}};
    __syncthreads();
    h16x8 wf[4], qf[4], af[2], kf_[2][2]; h16 uv[4]; float cd;
#define SCAN_LOAD(n_) do { const size_t itm = (size_t)chain * NCH + (n_); \
        _Pragma("unroll") for (int ks = 0; ks < 4; ++ks) { wf[ks] = *(const h16x8*)(Wb + itm * 8192 + (16 * w + c16) * 128 + 32 * ks + 8 * gq); qf[ks] = *(const h16x8*)(Qb + itm * 8192 + (16 * w + c16) * 128 + 32 * ks + 8 * gq); } \
        _Pragma("unroll") for (int ks = 0; ks < 2; ++ks) { af[ks] = *(const h16x8*)(Ab + itm * 4096 + (16 * w + c16) * 64 + 32 * ks + 8 * gq); \
            _Pragma("unroll") for (int m2 = 0; m2 < 2; ++m2) kf_[m2][ks] = *(const h16x8*)(Kb + itm * 8192 + (16 * (2 * w + m2) + c16) * 64 + 32 * ks + 8 * gq); } \
        _Pragma("unroll") for (int r = 0; r < 4; ++r) uv[r] = Ub[itm * 8192 + (16 * w + 4 * gq + r) * 128 + e0 + c16]; \
        cd = cdec[itm]; } while (0)
    SCAN_LOAD(0);
    for (int n = 0; n < NCH; ++n) {
        h16x8 cwf[4], cqf[4], caf[2], ckf[2][2]; float cu[4]; const float ccd = cd;
#pragma unroll
        for (int ks = 0; ks < 4; ++ks) { cwf[ks] = wf[ks]; cqf[ks] = qf[ks]; }
#pragma unroll
        for (int ks = 0; ks < 2; ++ks) { caf[ks] = af[ks]; ckf[0][ks] = kf_[0][ks]; ckf[1][ks] = kf_[1][ks]; }
#pragma unroll
        for (int r = 0; r < 4; ++r) cu[r] = (float)uv[r];
        if (n + 1 < NCH) SCAN_LOAD(n + 1);
        f32x4 Pm = {0.f, 0.f, 0.f, 0.f}, O = {0.f, 0.f, 0.f, 0.f};
#pragma unroll
        for (int ks = 0; ks < 4; ++ks) { const h16x8 bs = *(const h16x8*)(St + c16 * 136 + 32 * ks + 8 * gq); Pm = MFMA16(cwf[ks], bs, Pm); O = MFMA16(cqf[ks], bs, O); }
        h16x4 vn;
#pragma unroll
        for (int r = 0; r < 4; ++r) vn[r] = (h16)(cu[r] - Pm[r]);
        *(h16x4*)(Vt + c16 * 72 + 16 * w + 4 * gq) = vn;
        lds_barrier();
#pragma unroll
        for (int m2 = 0; m2 < 2; ++m2)
#pragma unroll
            for (int r = 0; r < 4; ++r) S[m2][r] *= ccd;
#pragma unroll
        for (int ks = 0; ks < 2; ++ks) { const h16x8 bv = *(const h16x8*)(Vt + c16 * 72 + 32 * ks + 8 * gq); O = MFMA16(caf[ks], bv, O); S[0] = MFMA16(ckf[0][ks], bv, S[0]); S[1] = MFMA16(ckf[1][ks], bv, S[1]); }
#pragma unroll
        for (int r = 0; r < 4; ++r) { const int t = 64 * n + 16 * w + 4 * gq + r - 48; if (t >= 0) og[((size_t)b * T_ + t) * 512 + h * 128 + e0 + c16] = (h16)(O[r] * 0.08838834764831845f); }
#pragma unroll
        for (int m2 = 0; m2 < 2; ++m2) { h16x4 sv;
#pragma unroll
            for (int r = 0; r < 4; ++r) sv[r] = (h16)S[m2][r];
            *(h16x4*)(St + c16 * 136 + 16 * (2 * w + m2) + 4 * gq) = sv; }
        lds_barrier();
    }
#undef SCAN_LOAD
}

constexpr int CAP = 704;
__device__ __forceinline__ void dma16_asm(const void* gptr, unsigned lds_addr) {
    unsigned sv; lds_addr = (unsigned)__builtin_amdgcn_readfirstlane((int)lds_addr);
    asm volatile("s_mov_b32 %0, m0\n\ts_mov_b32 m0, %2\n\ts_nop 0\n\tglobal_load_lds_dwordx4 %1, off\n\ts_mov_b32 m0, %0" : "=&s"(sv) : "v"(gptr), "s"(lds_addr) : "memory");
}
__device__ __forceinline__ int dpp_scan_incl(int x) {
    x += __builtin_amdgcn_update_dpp(0, x, 0x111, 0xf, 0xf, false);
    x += __builtin_amdgcn_update_dpp(0, x, 0x112, 0xf, 0xf, false);
    x += __builtin_amdgcn_update_dpp(0, x, 0x114, 0xf, 0xf, false);
    x += __builtin_amdgcn_update_dpp(0, x, 0x118, 0xf, 0xf, false);
    x += __builtin_amdgcn_update_dpp(0, x, 0x142, 0xa, 0xf, false);
    x += __builtin_amdgcn_update_dpp(0, x, 0x143, 0xc, 0xf, false);
    return x;
}

__device__ __forceinline__ int topk_prune(float* sc, unsigned short* ix, unsigned* hist, int c, int lane, int limit, float& theta) {
    constexpr int NE = (CAP + 63) / 64;
    unsigned key[NE]; unsigned short idx[NE]; float val[NE];
#pragma unroll
    for (int it = 0; it < NE; ++it) { const int i = lane + 64 * it; const bool v = i < c; const float f = v ? sc[i] : 0.f; val[it] = f; idx[it] = v ? ix[i] : (unsigned short)0; key[it] = v ? ordkey(f) : 0u; }
    unsigned prefix = 0; int need = 256; int binpop = 0; bool exact = true; int sh = 0;
#pragma unroll
    for (int r = 0; r < 4; ++r) {
        const int shift = 24 - 8 * r;
        ((uint4*)hist)[lane] = make_uint4(0u, 0u, 0u, 0u);
        WAVE_FENCE();
#pragma unroll
        for (int it = 0; it < NE; ++it) {
            const bool m = (key[it] != 0u) && (r == 0 || ((key[it] ^ prefix) >> ((shift + 8) & 31)) == 0u);
            if (m) atomicAdd(&hist[(key[it] >> shift) & 255u], 1u);
        }
        WAVE_FENCE();
        const uint4 h4 = ((const uint4*)hist)[63 - lane];
        WAVE_FENCE();
        const int loc = (int)(h4.x + h4.y + h4.z + h4.w);
        const int incl = dpp_scan_incl(loc);
        const int c3 = incl - loc, c2 = c3 + (int)h4.w, c1 = c2 + (int)h4.z, c0 = c1 + (int)h4.y;
        int dsel = -1, cab = 0, hb = 0;
        if (c3 < need && need <= c3 + (int)h4.w) { dsel = 3; cab = c3; hb = (int)h4.w; }
        else if (c2 < need && need <= c2 + (int)h4.z) { dsel = 2; cab = c2; hb = (int)h4.z; }
        else if (c1 < need && need <= c1 + (int)h4.y) { dsel = 1; cab = c1; hb = (int)h4.y; }
        else if (c0 < need && need <= c0 + (int)h4.x) { dsel = 0; cab = c0; hb = (int)h4.x; }
        const u64 fm = __ballot(dsel >= 0);
        const int src = __builtin_amdgcn_readfirstlane(__ffsll((long long)fm) - 1);
        const int digit = __builtin_amdgcn_readlane(4 * (63 - lane) + dsel, src);
        const int cabv = __builtin_amdgcn_readlane(cab, src);
        binpop = __builtin_amdgcn_readlane(hb, src);
        need -= cabv; prefix |= (unsigned)digit << shift; sh = shift;
        if (r < 3 && (256 - need) + binpop <= limit) { exact = false; break; }
    }
    (void)sh;
    const unsigned thr = prefix; int out = 0, tb = 0;
#pragma unroll
    for (int it = 0; it < NE; ++it) {
        const bool v = key[it] != 0u; const bool gt = v && key[it] > thr; const bool eq = v && key[it] == thr;
        bool keep;
        if (exact) { const u64 meq = __ballot(eq); const int tr = tb + lanes_below(meq); keep = gt || (eq && tr < need); tb += __popcll(meq); }
        else keep = gt || eq;
        const u64 mk = __ballot(keep); const int slot = out + lanes_below(mk);
        if (keep) { sc[slot] = val[it]; ix[slot] = idx[it]; }
        out += __popcll(mk);
    }
    WAVE_FENCE();
    theta = ordinv(thr);
    return out;
}

constexpr int WL_SC = 0;
constexpr int WL_IX = 8 * CAP * 4;
constexpr int WL_RING = 0;
constexpr int SLOT_BYTES = 8704;
constexpr int WL_SEL = 34816;
constexpr int WL_NSEL = 38912;
constexpr int WL_BYTES = 38944;
static_assert(WL_IX + 8 * CAP * 2 <= WL_SEL && 4 * SLOT_BYTES <= WL_SEL, "DSA LDS map");

__device__ __forceinline__ void dsa_item(const Params& P, int item, unsigned char* wl, const float* biasd, int lane) {
    float* sc = (float*)(wl + WL_SC);
    unsigned short* ix = (unsigned short*)(wl + WL_IX);
    unsigned* hist = (unsigned*)(wl + WL_SEL);
    unsigned short* sel = (unsigned short*)(wl + WL_SEL);
    int* nselL = (int*)(wl + WL_NSEL);
    unsigned char* ring = wl + WL_RING;
    const h16* qidx = (const h16*)(P.ws + OFF_QIDX);
    const float* small = (const float*)(P.ws + OFF_SMALL);
    const h16* kvrow = (const h16*)(P.ws + OFF_KVROW);
    const h16* qk = (const h16*)(P.ws + OFF_QK);
    h16* ctxb = (h16*)(P.ws + OFF_CTX);
    const int row0 = item * 8; const int b = row0 >= T_ ? 1 : 0; const int t0 = row0 - b * T_;
    const int half = lane >> 5, kl = lane & 31;
    WAVE_FENCE();
    for (int rep_ = 0; rep_ <= (PROBE_TOPK2 | PROBE_SWEEP); ++rep_) {
        const bool dummy_ = PROBE_SWEEP && rep_ == 0;
        h16x8 afr[4];
        { const int qq = kl >> 2, hd = kl & 3; const h16* p = qidx + (size_t)(row0 + qq) * 256 + hd * 64 + 8 * half;
#pragma unroll
          for (int ks = 0; ks < 4; ++ks) afr[ks] = *(const h16x8*)(p + 16 * ks); }
        float wq[4][4]; float th[4]; int cnt[4];
#pragma unroll
        for (int g = 0; g < 4; ++g) { const float* sp = small + (size_t)(row0 + 2 * g + half) * 16;
#pragma unroll
            for (int hh = 0; hh < 4; ++hh) wq[g][hh] = sp[hh];
            th[g] = dummy_ ? INFINITY : -INFINITY; cnt[g] = 0; }
        const int ntiles = ((t0 + 7) >> 5) + 1;
        const h16* kfp = (const h16*)(P.ws + OFF_KFRAG) + (size_t)b * NKT * 2048 + lane * 8;
        h16x8 bt[4][4];
#pragma unroll
        for (int u = 0; u < 4; ++u) { const int tl = u < ntiles ? u : ntiles - 1;
#pragma unroll
            for (int ks = 0; ks < 4; ++ks) bt[u][ks] = *(const h16x8*)(kfp + (size_t)tl * 2048 + ks * 512); }
        const int ngroups = (ntiles + 3) >> 2;
        for (int grp = 0; grp <= ngroups; ++grp) {
            const bool last = grp == ngroups;
            if (!last) {
                const int tile0 = grp * 4;
                f32x16 acc[4];
#pragma unroll
                for (int u = 0; u < 4; ++u) {
#pragma unroll
                    for (int r = 0; r < 16; ++r) acc[u][r] = 0.f;
#pragma unroll
                    for (int ks = 0; ks < 4; ++ks) acc[u] = MFMA32(afr[ks], bt[u][ks], acc[u]);
                }
#pragma unroll
                for (int u = 0; u < 4; ++u) { const int tn = tile0 + u + 4 < ntiles ? tile0 + u + 4 : ntiles - 1;
#pragma unroll
                    for (int ks = 0; ks < 4; ++ks) bt[u][ks] = *(const h16x8*)(kfp + (size_t)tn * 2048 + ks * 512); }
#pragma unroll
                for (int u = 0; u < 4; ++u) {
                    const int key = (tile0 + u) * 32 + kl;
#pragma unroll
                    for (int g = 0; g < 4; ++g) {
                        float s = 0.f;
#pragma unroll
                        for (int hh = 0; hh < 4; ++hh) s = fmaf(wq[g][hh], fmaxf(acc[u][4 * g + hh], 0.f), s);
                        const int tq = t0 + 2 * g + half;
                        const bool pass = (key <= tq) && (s > th[g]);
                        const u64 m = __ballot(pass);
                        if (m != 0ull) {
                            const unsigned lo = (unsigned)m, hi = (unsigned)(m >> 32);
                            const int off = half ? __builtin_amdgcn_mbcnt_hi(hi, 0) : __builtin_amdgcn_mbcnt_lo(lo, 0);
                            const int qq = 2 * g + half;
                            if (pass) { const int slot = cnt[g] + off; sc[qq * CAP + slot] = s; ix[qq * CAP + slot] = (unsigned short)key; }
                            cnt[g] += half ? __popc(hi) : __popc(lo);
                        }
                    }
                }
            }
            const int lim = last ? 256 : CAP - 128;
            if (__any((cnt[0] > lim) || (cnt[1] > lim) || (cnt[2] > lim) || (cnt[3] > lim))) {
                WAVE_FENCE();
#pragma unroll 1
                for (int qq = 0; qq < 8; ++qq) {
                    const int g = qq >> 1, hs = qq & 1;
                    const int cv = g == 0 ? cnt[0] : (g == 1 ? cnt[1] : (g == 2 ? cnt[2] : cnt[3]));
                    const int c = __builtin_amdgcn_readlane(cv, hs * 32);
                    if (c > lim) {
                        float nth;
                        const int nc = topk_prune(sc + qq * CAP, ix + qq * CAP, hist, c, lane, last ? 256 : 320, nth);
#pragma unroll
                        for (int gg = 0; gg < 4; ++gg) if (gg == g && half == hs) { cnt[gg] = nc; th[gg] = nth; }
                    }
                }
            }
        }
        WAVE_FENCE();
#pragma unroll 1
        for (int qq = 0; qq < (dummy_ ? 0 : 8); ++qq) {
            const int g = qq >> 1, hs = qq & 1;
            const int cv = g == 0 ? cnt[0] : (g == 1 ? cnt[1] : (g == 2 ? cnt[2] : cnt[3]));
            const int c = __builtin_amdgcn_readlane(cv, hs * 32);
            if (lane == 0) nselL[qq] = c;
#pragma unroll
            for (int i4 = 0; i4 < 4; ++i4) { const int i = lane + 64 * i4; sel[qq * 256 + i] = i < c ? ix[qq * CAP + i] : (unsigned short)0; }
        }
        WAVE_FENCE();
    }
    const int gq = lane >> 4, c16 = lane & 15; const bool hv = c16 < 8;
    const unsigned ring_a = (unsigned)(size_t)(LAS unsigned char*)ring;
    const h16* kvb = kvrow + (size_t)b * T_ * 136;
    int poff[4];
#pragma unroll
    for (int i = 0; i < 4; ++i) poff[i] = (c16 ^ ((4 * i + gq) & 15)) * 8;
    const float b31 = biasd[127 * 8 + (c16 & 7)];
#define DSA_ISSUE(J_) do { const int jj_ = (J_) < 64 ? (J_) : 63; const unsigned short* sp_ = sel + (jj_ >> 3) * 256 + 32 * (jj_ & 7); \
        const h16* a_[8]; \
        _Pragma("unroll") for (int i = 0; i < 8; ++i) a_[i] = kvb + (size_t)sp_[4 * i + gq] * 136 + poff[i & 3]; \
        const h16* ar_ = kvb + (size_t)sp_[lane & 31] * 136 + 128; \
        const unsigned la_ = (unsigned)__builtin_amdgcn_readfirstlane((int)(ring_a + ((J_) & 3) * SLOT_BYTES)); unsigned sv_; unsigned long long ex_; \
        asm volatile("s_mov_b32 %0, m0\n\ts_mov_b32 m0, %2\n\ts_nop 0\n\t" \
            "global_load_lds_dwordx4 %3, off\n\ts_add_u32 m0, m0, 0x400\n\ts_nop 0\n\t" "global_load_lds_dwordx4 %4, off\n\ts_add_u32 m0, m0, 0x400\n\ts_nop 0\n\t" \
            "global_load_lds_dwordx4 %5, off\n\ts_add_u32 m0, m0, 0x400\n\ts_nop 0\n\t" "global_load_lds_dwordx4 %6, off\n\ts_add_u32 m0, m0, 0x400\n\ts_nop 0\n\t" \
            "global_load_lds_dwordx4 %7, off\n\ts_add_u32 m0, m0, 0x400\n\ts_nop 0\n\t" "global_load_lds_dwordx4 %8, off\n\ts_add_u32 m0, m0, 0x400\n\ts_nop 0\n\t" \
            "global_load_lds_dwordx4 %9, off\n\ts_add_u32 m0, m0, 0x400\n\ts_nop 0\n\t" "global_load_lds_dwordx4 %10, off\n\ts_add_u32 m0, m0, 0x400\n\ts_nop 0\n\t" \
            "s_mov_b64 %1, exec\n\ts_mov_b64 exec, 0xffffffff\n\tglobal_load_lds_dwordx4 %11, off\n\ts_mov_b64 exec, %1\n\ts_mov_b32 m0, %0" \
            : "=&s"(sv_), "=&s"(ex_) : "s"(la_), "v"(a_[0]), "v"(a_[1]), "v"(a_[2]), "v"(a_[3]), "v"(a_[4]), "v"(a_[5]), "v"(a_[6]), "v"(a_[7]), "v"(ar_) : "memory"); } while (0)
    for (int rep_ = 0; rep_ <= PROBE_ATT2; ++rep_) {
    asm volatile("s_waitcnt vmcnt(0) lgkmcnt(0)" ::: "memory");
    DSA_ISSUE(0); DSA_ISSUE(1); DSA_ISSUE(2);
#pragma unroll 1
    for (int qq = 0; qq < 8; ++qq) {
        const int rowq = row0 + qq, tq = t0 + qq, ns = nselL[qq];
        const unsigned short* selq = sel + qq * 256;
        h16x8 qf[4];
#pragma unroll
        for (int ks = 0; ks < 4; ++ks) {
            if (hv) qf[ks] = *(const h16x8*)(qk + (size_t)rowq * 1024 + c16 * 128 + 32 * ks + 8 * gq);
            else {
#pragma unroll
                for (int e = 0; e < 8; ++e) qf[ks][e] = (h16)0.f;
            }
        }
        float m_run = -INFINITY, l_run = 0.f;
        f32x4 ctx[8];
#pragma unroll
        for (int nt = 0; nt < 8; ++nt) ctx[nt] = (f32x4){0.f, 0.f, 0.f, 0.f};
#pragma unroll 1
        for (int c = 0; c < 8; ++c) {
            const int j = 8 * qq + c;
            DSA_ISSUE(j + 3);
            asm volatile("s_waitcnt vmcnt(27)" ::: "memory");
            const unsigned char* sl = ring + (j & 3) * SLOT_BYTES;
            h16x8 af[2][4];
#pragma unroll
            for (int mt = 0; mt < 2; ++mt)
#pragma unroll
                for (int ks = 0; ks < 4; ++ks) af[mt][ks] = *(const h16x8*)(sl + (16 * mt + c16) * 256 + (((4 * ks + gq) ^ c16) * 16));
            fp16x4 rt[2]; ushort4 sv[2];
#pragma unroll
            for (int mt = 0; mt < 2; ++mt) {
                rt[mt] = __builtin_amdgcn_ds_read_tr16_b64_v4f16((LAS fp16x4*)(sl + 8192 + (16 * mt + 4 * gq + (c16 >> 2)) * 16 + 8 * (c16 & 3)));
                sv[mt] = *(const ushort4*)(selq + 32 * c + 16 * mt + 4 * gq);
            }
            fp16x4 tb[8][2];
            { const int rw0 = 4 * gq + (c16 >> 2), rw1 = 16 + rw0;
#pragma unroll
              for (int nt = 0; nt < 8; ++nt) { const int pc = 2 * nt + ((c16 >> 1) & 1);
                tb[nt][0] = __builtin_amdgcn_ds_read_tr16_b64_v4f16((LAS fp16x4*)(sl + rw0 * 256 + ((pc ^ (rw0 & 15)) * 16) + 8 * (c16 & 1)));
                tb[nt][1] = __builtin_amdgcn_ds_read_tr16_b64_v4f16((LAS fp16x4*)(sl + rw1 * 256 + ((pc ^ (rw1 & 15)) * 16) + 8 * (c16 & 1))); } }
            f32x4 s4[2];
#pragma unroll
            for (int mt = 0; mt < 2; ++mt) { s4[mt] = (f32x4){0.f, 0.f, 0.f, 0.f};
#pragma unroll
                for (int ks = 0; ks < 4; ++ks) s4[mt] = MFMA16(af[mt][ks], qf[ks], s4[mt]); }
            int dist[2][4]; int dmin = 127;
#pragma unroll
            for (int mt = 0; mt < 2; ++mt) { const int sarr[4] = {(int)sv[mt].x, (int)sv[mt].y, (int)sv[mt].z, (int)sv[mt].w};
#pragma unroll
                for (int r = 0; r < 4; ++r) { int d = tq - sarr[r]; d = d < 0 ? 0 : (d > 127 ? 127 : d); dist[mt][r] = d; dmin = d < dmin ? d : dmin; } }
            float bias[2][4];
            if (__all(dmin == 127)) {
#pragma unroll
                for (int mt = 0; mt < 2; ++mt)
#pragma unroll
                    for (int r = 0; r < 4; ++r) bias[mt][r] = b31;
            } else {
#pragma unroll
                for (int mt = 0; mt < 2; ++mt)
#pragma unroll
                    for (int r = 0; r < 4; ++r) bias[mt][r] = biasd[dist[mt][r] * 8 + (c16 & 7)];
            }
            float lg[2][4]; float mx = -INFINITY;
#pragma unroll
            for (int mt = 0; mt < 2; ++mt) { const h16x4 rr = __builtin_bit_cast(h16x4, rt[mt]);
#pragma unroll
                for (int r = 0; r < 4; ++r) {
                    const int kidx = 32 * c + 16 * mt + 4 * gq + r; const bool valid = hv && (kidx < ns);
                    const float v = valid ? s4[mt][r] * (float)rr[r] + bias[mt][r] : -INFINITY;
                    lg[mt][r] = v; mx = fmaxf(mx, v);
                } }
            {
                const unsigned u0 = __float_as_uint(mx);
                const auto p16 = __builtin_amdgcn_permlane16_swap(u0, u0, false, false);
                const float y = fmaxf(__uint_as_float(p16[0]), __uint_as_float(p16[1]));
                const unsigned u1 = __float_as_uint(y);
                const auto p32 = __builtin_amdgcn_permlane32_swap(u1, u1, false, false);
                mx = fmaxf(__uint_as_float(p32[0]), __uint_as_float(p32[1]));
            }
            const float m_new = fmaxf(m_run, mx);
            const float alpha = (hv && m_new > -INFINITY) ? __expf(m_run - m_new) : 1.f;
            float rs = 0.f; float pp[2][4];
#pragma unroll
            for (int mt = 0; mt < 2; ++mt)
#pragma unroll
                for (int r = 0; r < 4; ++r) { const float p = (hv && lg[mt][r] > -INFINITY) ? __expf(lg[mt][r] - m_new) : 0.f; pp[mt][r] = p; rs += p; }
            {
                const unsigned u0 = __float_as_uint(rs);
                const auto p16 = __builtin_amdgcn_permlane16_swap(u0, u0, false, false);
                const float y = __uint_as_float(p16[0]) + __uint_as_float(p16[1]);
                const unsigned u1 = __float_as_uint(y);
                const auto p32 = __builtin_amdgcn_permlane32_swap(u1, u1, false, false);
                rs = __uint_as_float(p32[0]) + __uint_as_float(p32[1]);
            }
            l_run = l_run * alpha + rs; m_run = m_new;
            h16x8 pa;
#pragma unroll
            for (int jx = 0; jx < 8; ++jx) pa[jx] = (h16)pp[jx >> 2][jx & 3];
            if (__any(alpha != 1.f)) {
                float ar[4];
#pragma unroll
                for (int r = 0; r < 4; ++r) ar[r] = __shfl(alpha, 4 * gq + r);
#pragma unroll
                for (int nt = 0; nt < 8; ++nt)
#pragma unroll
                    for (int r = 0; r < 4; ++r) ctx[nt][r] *= ar[r];
            }
#pragma unroll
            for (int nt = 0; nt < 8; ++nt) {
                const h16x4 b0 = __builtin_bit_cast(h16x4, tb[nt][0]), b1 = __builtin_bit_cast(h16x4, tb[nt][1]);
                h16x8 bf; bf[0] = b0[0]; bf[1] = b0[1]; bf[2] = b0[2]; bf[3] = b0[3]; bf[4] = b1[0]; bf[5] = b1[1]; bf[6] = b1[2]; bf[7] = b1[3];
                ctx[nt] = MFMA16(pa, bf, ctx[nt]);
            }
        }
        float li[4];
#pragma unroll
        for (int r = 0; r < 4; ++r) li[r] = 1.f / __shfl(l_run, (4 * gq + r) & 7);
        if (gq < 2) {
#pragma unroll
            for (int nt = 0; nt < 8; ++nt)
#pragma unroll
                for (int r = 0; r < 4; ++r) ctxb[(size_t)rowq * 1024 + (4 * gq + r) * 128 + 16 * nt + c16] = (h16)(ctx[nt][r] * li[r]);
        }
    }
    asm volatile("s_waitcnt vmcnt(0)" ::: "memory");
    }
#undef DSA_ISSUE
    WAVE_FENCE();
}

__device__ __forceinline__ void phase3(const Params& P, int l, unsigned char* lds) {
    const int tid = opaque_tid(), lane = tid & 63, w = tid >> 6;
    float* biasd = (float*)(lds + 4 * WL_BYTES);
    __syncthreads();
    for (int i = tid; i < 1024; i += NTHREADS) biasd[i] = P.rel[(int)c_bucket[i >> 3] * 8 + (i & 7)];
    __syncthreads();
    for (int rep_ = 0; rep_ <= PROBE_SCAN2; ++rep_) for (int sw = blockIdx.x; sw < 64; sw += gridDim.x) gdn_scan(P, sw, lds);
    __syncthreads();
    unsigned* ctr = (unsigned*)(P.ws + OFF_CTL) + 4608 + l * 128;
    unsigned char* wl = lds + w * WL_BYTES;
    const int x0 = (int)xb_xcc_id() & 7; int d = 0;
    for (;;) {
        int item = -1;
        if (lane == 0) {
            while (d < 8) {
                const int xc = (x0 + d) & 7; const int bb = xc >> 2, sub = xc & 3; const int cnt = (1026 - sub + 3) >> 2;
                const int t = (int)__hip_atomic_fetch_add(ctr + xc * 16, 1u, __ATOMIC_RELAXED, __HIP_MEMORY_SCOPE_AGENT);
                if (t < cnt) { item = bb * 1026 + 4 * (cnt - 1 - t) + sub; break; }
                ++d;
            }
        }
        d = __builtin_amdgcn_readfirstlane(d);
        item = __builtin_amdgcn_readfirstlane(item);
        if (item < 0) break;
        dsa_item(P, item, wl, biasd, lane);
    }
}

__device__ __forceinline__ void phase4(const Params& P, int l, unsigned char* lds) {
    const int tid = opaque_tid(), lane = tid & 63, w = tid >> 6;
    (void)lds;
    for (int it = blockIdx.x * 4 + w; it < (NT + 31) / 32; it += gridDim.x * 4) p4_item(P, l, it, lane);
}

__device__ __forceinline__ void phase5(const Params& P, int l, unsigned char* lds) {
    h16* smem = (h16*)lds;
    const h16* W = (const h16*)(P.ws + OFF_WOT) + (size_t)l * 1024 * 1024;
    const h16* A = (const h16*)(P.ws + OFF_OMIX);
    float* sumsq_next = (float*)(P.ws + OFF_SUMSQ) + NTP;
    XcdQueue xq; xq.init((unsigned*)(P.ws + OFF_CTL) + 4352 + l * 128, 32, (int*)(lds + LDS_BYTES - 32));
    int xl, qi;
    while (xq.next(xl, qi)) {
        const int rb = 8 * xl + (qi & 7), tn = qi >> 3;
        EpiResBig ep; ep.layer = l; ep.row0 = rb * 256; ep.n0 = tn * 256; ep.meta = P.meta; ep.x = P.x; ep.metah = (float*)(P.ws + OFF_METAH); ep.out = P.out; ep.h16o = (h16*)(P.ws + OFF_H16); ep.sumsq_next = sumsq_next; ep.ss = 0.f; ep.nseg = 4;
        gemm_big(A + (size_t)rb * 256 * 1024, 1024, W + (size_t)tn * 256 * 1024, 1024, 1024, ep, smem);
    }
    __syncthreads();
    const int tid = opaque_tid();
    if ((tid >> 6) == 0) {
        for (int it = blockIdx.x; it < 32; it += gridDim.x) {
            EpiResBig ep; ep.layer = l; ep.row0 = 16384; ep.n0 = it * 32; ep.meta = P.meta; ep.x = P.x; ep.metah = (float*)(P.ws + OFF_METAH); ep.out = P.out; ep.h16o = (h16*)(P.ws + OFF_H16); ep.sumsq_next = sumsq_next; ep.ss = 0.f; ep.nseg = 1;
            skinny_tile(A + (size_t)16384 * 1024, 1024, W + (size_t)it * 32 * 1024, 1024, 1024, ep, (float*)lds, tid & 63);
        }
    }
}

__global__ void __launch_bounds__(NTHREADS) hybrid_fwd(Params P) {
    extern __shared__ __attribute__((aligned(16))) unsigned char lds[];
    cg::grid_group grid = cg::this_grid();
    volatile LAS unsigned* bst = (volatile LAS unsigned*)(lds + LDS_BYTES - 16);
    if (threadIdx.x < 4) bst[threadIdx.x] = 0u;
    __syncthreads();
    XcdBarrier xbar = xcd_barrier_post((unsigned*)(P.ws + OFF_CTL) + 256, bst);
    for (int ph = P.ph_lo; ph < P.ph_hi; ++ph) {
#ifndef ONLY
#define ONLY -1
#endif
        if (ph == 0) { if (ONLY < 0 || ((ONLY >> 0) & 1)) for (int rep_ = 0; rep_ <= PROBE_P0X; ++rep_) phase_prep(P, lds); }
        else {
            const int l = (ph - 1) / 5, s = (ph - 1) % 5;
            if (s == 0) { if (ONLY < 0 || ((ONLY >> 1) & 1)) for (int rep_ = 0; rep_ <= PROBE_P1X; ++rep_) phase_inproj(P, l, lds); }
            else if (s == 1) { if (ONLY < 0 || ((ONLY >> 2) & 1)) for (int rep_ = 0; rep_ <= PROBE_P2X; ++rep_) phase2(P, l, lds); }
            else if (s == 2) { if (ONLY < 0 || ((ONLY >> 3) & 1)) phase3(P, l, lds); }
            else if (s == 3) { if (ONLY < 0 || ((ONLY >> 4) & 1)) for (int rep_ = 0; rep_ <= PROBE_P4X; ++rep_) phase4(P, l, lds); }
            else { if (ONLY < 0 || ((ONLY >> 5) & 1)) for (int rep_ = 0; rep_ <= (l == 0 ? PROBE_P5L0X : 0); ++rep_) phase5(P, l, lds); }
        }
        if (ph + 1 < P.ph_hi) {
            if (ph == 0) grid.sync();
            else xcd_barrier(xbar);
            if (PROBE_SYNC) xcd_barrier(xbar);
        }
    }
}

extern "C" void kernel_launch(void* const* d_in, const int* in_sizes, int n_in, void* d_out, int out_size, void* d_ws, size_t ws_size, hipStream_t stream) {
    static int grid_blocks = 0;
    if (grid_blocks == 0) {
        if (n_in != 17 || ws_size < WS_END) { fprintf(stderr, "kernel_launch: unexpected inputs (n_in %d, ws %zu < %zu)\n", n_in, ws_size, (size_t)WS_END); grid_blocks = -1; return; }
        int dev = 0, cus = 0, per_cu = 0;
        hipGetDevice(&dev);
        hipDeviceGetAttribute(&cus, hipDeviceAttributeMultiprocessorCount, dev);
        if (hipFuncSetAttribute((const void*)hybrid_fwd, hipFuncAttributeMaxDynamicSharedMemorySize, LDS_BYTES) != hipSuccess) { fprintf(stderr, "kernel_launch: hipFuncSetAttribute failed\n"); grid_blocks = -1; return; }
        hipOccupancyMaxActiveBlocksPerMultiprocessor(&per_cu, (const void*)hybrid_fwd, NTHREADS, LDS_BYTES);
        if (per_cu < 1) { fprintf(stderr, "kernel_launch: occupancy query says 0 blocks per CU\n"); grid_blocks = -1; return; }
        grid_blocks = cus * per_cu;
    }
    if (grid_blocks < 0) return;
    hipMemsetAsync((char*)d_ws + OFF_CTL, 0, 32768, stream);
    hipMemsetAsync((char*)d_ws + OFF_SUMSQ, 0, (size_t)2 * NTP * 4, stream);
    Params p{};
    p.x = (const float*)d_in[0]; p.meta = (const float*)d_in[1]; p.rel = (const float*)d_in[2]; p.norm_gain = (const float*)d_in[3];
    p.w_in = (const float*)d_in[4]; p.g_cq = (const float*)d_in[5]; p.g_ckv = (const float*)d_in[6]; p.w_uq = (const float*)d_in[7];
    p.w_ukv = (const float*)d_in[8]; p.w_qidx = (const float*)d_in[9]; p.g_qn = (const float*)d_in[10]; p.g_kn = (const float*)d_in[11];
    p.conv_w = (const float*)d_in[12]; p.a_log = (const float*)d_in[13]; p.dt_bias = (const float*)d_in[14]; p.g_out = (const float*)d_in[15];
    p.w_out = (const float*)d_in[16];
    p.out = (float*)d_out; p.ws = (unsigned char*)d_ws;
#if N_LAUNCH_MODE == 1
    p.ph_lo = 0; p.ph_hi = NPHASE;
    void* args[] = {&p};
    hipError_t e = hipLaunchCooperativeKernel((const void*)hybrid_fwd, dim3(grid_blocks), dim3(NTHREADS), args, LDS_BYTES, stream);
    if (e != hipSuccess) fprintf(stderr, "cooperative launch failed: %s (grid %d)\n", hipGetErrorString(e), grid_blocks);
#else
    for (int ph = 0; ph < NPHASE; ++ph) {
        p.ph_lo = ph; p.ph_hi = ph + 1;
        hipLaunchKernelGGL(hybrid_fwd, dim3(grid_blocks), dim3(NTHREADS), LDS_BYTES, stream, p);
    }
#endif
}
```

```cpp
#include <hip/hip_runtime.h>
#include <hip/hip_cooperative_groups.h>
#include <stdio.h>
#include <stdint.h>
namespace cg = cooperative_groups;

#define PROBE_TOPK2 0
#define PROBE_ATT2 0
#define PROBE_P1X 0
#define PROBE_P2X 0
#define PROBE_SCAN2 0
#define PROBE_P4X 0
#define PROBE_P0X 0
#define PROBE_P5L0X 0
#define PROBE_SYNC 0
#define PROBE_SWEEP 0
#define PROBE_P2C 0
#define PROBE_CHAIN 0
#define PROBE_MFMA 0
#define PROBE_TSEC 0
#define PROBE_S1 0
#define PROBE_S3 0
#define PROBE_S5 0
#ifndef N_LAUNCH_MODE
#define N_LAUNCH_MODE 1
#endif

typedef _Float16 h16;
typedef h16 h16x8 __attribute__((ext_vector_type(8)));
typedef h16 h16x4 __attribute__((ext_vector_type(4)));
typedef float f32x4 __attribute__((ext_vector_type(4)));
typedef float f32x16 __attribute__((ext_vector_type(16)));
typedef unsigned long long u64;
typedef __fp16 fp16x4 __attribute__((__vector_size__(4 * sizeof(__fp16))));

#define MFMA32(a, b, c) __builtin_amdgcn_mfma_f32_32x32x16_f16(a, b, c, 0, 0, 0)
#define MFMA16(a, b, c) __builtin_amdgcn_mfma_f32_16x16x32_f16(a, b, c, 0, 0, 0)
#define WAVE_FENCE() do { __builtin_amdgcn_fence(__ATOMIC_SEQ_CST, "wavefront"); __builtin_amdgcn_wave_barrier(); } while (0)

constexpr int T_ = 8208;
constexpr int NT = 16416;
constexpr int NTP = 16512;
constexpr int NRB = 129;
constexpr int NCH = 129;
constexpr int NGI = 8 * NCH;
constexpr int NKT = 257;
constexpr float EPS = 1e-6f;
constexpr int NTHREADS = 256;
constexpr int LDS_BYTES = 163840;
constexpr int NPHASE = 11;

constexpr size_t OFF_CTL = 0;
constexpr size_t OFF_W1T = 32768;
constexpr size_t OFF_WOT = OFF_W1T + (size_t)2 * 3072 * 1024 * 2;
constexpr size_t OFF_WQ2T = OFF_WOT + (size_t)2 * 1024 * 1024 * 2;
constexpr size_t OFF_WUKT = OFF_WQ2T + (size_t)2 * 768 * 256 * 2;
constexpr size_t OFF_WKABS = OFF_WUKT + (size_t)2 * 512 * 128 * 2;
constexpr size_t OFF_WUVT = OFF_WKABS + (size_t)2 * 8 * 128 * 64 * 2;
constexpr size_t OFF_SMALL = OFF_WUVT + (size_t)2 * 8 * 64 * 128 * 2;
constexpr size_t OFF_SZA = OFF_SMALL + (size_t)NTP * 16 * 4;
constexpr size_t OFF_SZG = OFF_SZA + (size_t)NTP * 512 * 2;
constexpr size_t OFF_PROJG = OFF_SZG + (size_t)NTP * 512 * 2;
constexpr size_t OFF_PROJA = OFF_PROJG + (size_t)NTP * 1536 * 2;
constexpr size_t OFF_QIDX = OFF_PROJA + (size_t)NTP * 512 * 2;
constexpr size_t OFF_QN = OFF_QIDX + (size_t)NTP * 256 * 2;
constexpr size_t OFF_QK = OFF_QN + (size_t)NTP * 512 * 2;
constexpr size_t OFF_KVROW = OFF_QK + (size_t)NTP * 1024 * 2;
constexpr size_t OFF_KFRAG = OFF_KVROW + (size_t)NTP * 136 * 2;
constexpr size_t OFF_U = OFF_KFRAG + (size_t)2 * NKT * 2048 * 2;
constexpr size_t OFF_WM = OFF_U + (size_t)NGI * 8192 * 2;
constexpr size_t OFF_QD = OFF_WM + (size_t)NGI * 8192 * 2;
constexpr size_t OFF_KDT = OFF_QD + (size_t)NGI * 8192 * 2;
constexpr size_t OFF_AQK = OFF_KDT + (size_t)NGI * 8192 * 2;
constexpr size_t OFF_CDEC = OFF_AQK + (size_t)NGI * 4096 * 2;
constexpr size_t OFF_METAH = OFF_CDEC + 8192;
constexpr size_t OFF_SUMSQ = OFF_METAH + (size_t)2 * 16 * 1024 * 4;
constexpr size_t WS_END = OFF_SUMSQ + (size_t)2 * NTP * 4;
constexpr size_t OFF_H16 = OFF_QK;
constexpr size_t OFF_CTX = OFF_PROJG;
constexpr size_t OFF_OMIX = OFF_PROJG + (size_t)NTP * 1024 * 2;

struct Params {
    const float* x; const float* meta; const float* rel; const float* norm_gain; const float* w_in;
    const float* g_cq; const float* g_ckv; const float* w_uq; const float* w_ukv; const float* w_qidx;
    const float* g_qn; const float* g_kn; const float* conv_w; const float* a_log; const float* dt_bias;
    const float* g_out; const float* w_out;
    float* out; unsigned char* ws;
    int ph_lo, ph_hi;
};

__constant__ unsigned char c_bucket[128] = {
    0, 1, 2, 3, 4, 5, 6, 7, 8, 9, 10, 11, 12, 13, 14, 15, 16, 16, 16, 17, 17, 18, 18, 18, 19, 19, 19, 20, 20, 20, 20, 21,
    21, 21, 21, 22, 22, 22, 22, 22, 23, 23, 23, 23, 23, 23, 24, 24, 24, 24, 24, 24, 25, 25, 25, 25, 25, 25, 25, 26, 26, 26, 26, 26,
    26, 26, 26, 27, 27, 27, 27, 27, 27, 27, 27, 27, 27, 28, 28, 28, 28, 28, 28, 28, 28, 28, 28, 29, 29, 29, 29, 29, 29, 29, 29, 29,
    29, 29, 29, 30, 30, 30, 30, 30, 30, 30, 30, 30, 30, 30, 30, 30, 30, 31, 31, 31, 31, 31, 31, 31, 31, 31, 31, 31, 31, 31, 31, 31};

__device__ __forceinline__ unsigned long long* tsec_slot() { extern __shared__ __attribute__((aligned(16))) unsigned char tsec_lds__[]; return (unsigned long long*)(tsec_lds__ + LDS_BYTES - 128) + (threadIdx.x >> 6); }
#define TSEC_BEGIN(id) unsigned long long t__##id = 0; if (PROBE_TSEC == (id)) t__##id = wall_clock64();
#define TSEC_END(id) do { if (PROBE_TSEC == (id)) { const unsigned long long d__ = wall_clock64() - t__##id; if ((threadIdx.x & 63) == 0) *tsec_slot() += d__; } } while (0)
__device__ __forceinline__ float silu_f(float x) { return x * __builtin_amdgcn_rcpf(1.f + __expf(-x)); }
__device__ __forceinline__ int lanes_below(u64 m) { return __builtin_amdgcn_mbcnt_hi((unsigned)(m >> 32), __builtin_amdgcn_mbcnt_lo((unsigned)m, 0)); }
__device__ __forceinline__ unsigned ordkey(float f) { unsigned u = __float_as_uint(f); return (u & 0x80000000u) ? ~u : (u | 0x80000000u); }
__device__ __forceinline__ float ordinv(unsigned k) { unsigned u = (k & 0x80000000u) ? (k & 0x7fffffffu) : ~k; return __uint_as_float(u); }
__device__ __forceinline__ int opaque_tid() { int t = threadIdx.x; asm volatile("" : "+v"(t)); return t; }
__device__ __forceinline__ void lds_barrier() { asm volatile("s_waitcnt lgkmcnt(0)\n\ts_barrier" ::: "memory"); }

#define XB_TMO      128
#define XB_XCNT(j)  (256  + 64 * (j))
#define XB_XSUB(j)  (1280 + 64 * (j))
#define XB_XGEN(j)  (2304 + 64 * (j))
#define XB_TOP      3328
#define XB_TOPGEN   3392
#define XCD_BAR_WORDS 3456
#define XB_SPIN_CAP (1u << 22)
#define LAS __attribute__((address_space(3)))
__device__ __forceinline__ unsigned xb_ld(unsigned* p)              { return __hip_atomic_load(p, __ATOMIC_RELAXED, __HIP_MEMORY_SCOPE_AGENT); }
__device__ __forceinline__ unsigned xb_add(unsigned* p, unsigned v) { return __hip_atomic_fetch_add(p, v, __ATOMIC_RELAXED, __HIP_MEMORY_SCOPE_AGENT); }
__device__ __forceinline__ unsigned xb_xcc_id() { return (unsigned)__builtin_amdgcn_s_getreg((3 << 11) | 20) & 0xFu; }
#define XB_SPIN(cond, bar) do { unsigned _sp = 0; while (cond) { __builtin_amdgcn_s_sleep(1); \
    if ((++_sp & 255u) == 0u) { if (xb_ld(&(bar)[XB_TMO])) break; if (_sp > XB_SPIN_CAP) { atomicAdd(&(bar)[XB_TMO], 1u); break; } } } } while (0)
struct XcdBarrier { unsigned* bar; unsigned x; volatile LAS unsigned* st; };
__device__ __forceinline__ XcdBarrier xcd_barrier_post(unsigned* bar, volatile LAS unsigned* st) {
    XcdBarrier b; b.bar = bar; b.x = xb_xcc_id(); b.st = st;
    if (threadIdx.x == 0) (void)xb_add(&bar[XB_XCNT(b.x)], 1u);
    return b;
}
__device__ __forceinline__ void xcd_barrier_complete(unsigned* bar, unsigned x, unsigned& nloc, unsigned& nx) {
    const unsigned G = gridDim.x * gridDim.y * gridDim.z;
    unsigned sum, cnt, mine, sp = 0u;
    for (;;) {
        sum = 0u; cnt = 0u; mine = 0u;
#pragma unroll
        for (unsigned j = 0; j < 16; ++j) { const unsigned c = xb_ld(&bar[XB_XCNT(j)]); sum += c; cnt += (c > 0u) ? 1u : 0u; mine = (j == x) ? c : mine; }
        if (sum == G) break;
        __builtin_amdgcn_s_sleep(1);
        if ((++sp & 255u) == 0u) { if (xb_ld(&bar[XB_TMO])) break; if (sp > XB_SPIN_CAP) { atomicAdd(&bar[XB_TMO], 1u); break; } }
    }
    nloc = mine > 0u ? mine : 1u; nx = cnt > 0u ? cnt : 1u;
}
__device__ __forceinline__ void xcd_barrier(const XcdBarrier& b) {
    TSEC_BEGIN(5)
    asm volatile("s_waitcnt vmcnt(0)" ::: "memory");
    __syncthreads();
    if (threadIdx.x == 0) {
        unsigned* bar = b.bar;
        __builtin_amdgcn_s_waitcnt(0);
        unsigned nloc = b.st[0], nx = b.st[1];
        if (nloc == 0u) { xcd_barrier_complete(bar, b.x, nloc, nx); b.st[0] = nloc; b.st[1] = nx; }
        const unsigned old = xb_add(&bar[XB_XSUB(b.x)], 1u);
        const unsigned gen = old / nloc;
        if (old + 1u == (gen + 1u) * nloc) {
            __builtin_amdgcn_fence(__ATOMIC_RELEASE, "agent");
            asm volatile("s_waitcnt vmcnt(0)" ::: "memory");
            const unsigned og = xb_add(&bar[XB_TOP], 1u);
            const unsigned tg = og / nx;
            if (og + 1u == (tg + 1u) * nx) xb_add(&bar[XB_TOPGEN], 1u);
            else XB_SPIN(xb_ld(&bar[XB_TOPGEN]) == tg, bar);
            __builtin_amdgcn_fence(__ATOMIC_ACQUIRE, "agent");
            xb_add(&bar[XB_XGEN(b.x)], 1u);
            asm volatile("s_waitcnt vmcnt(0)" ::: "memory");
        } else {
            XB_SPIN(xb_ld(&bar[XB_XGEN(b.x)]) == gen, bar);
            __builtin_amdgcn_fence(__ATOMIC_ACQUIRE, "agent");
            asm volatile("s_waitcnt vmcnt(0)" ::: "memory");
        }
    }
    __syncthreads();
    TSEC_END(5);
}

struct XcdQueue {
    unsigned* ctr; int n_per; int x0; int d; int* slot;
    __device__ __forceinline__ void init(unsigned* c, int np, int* s) { ctr = c; n_per = np; x0 = (int)xb_xcc_id() & 7; d = 0; slot = s; }
    __device__ __forceinline__ bool next(int& xl, int& q) {
        __syncthreads();
        if (threadIdx.x == 0) {
            int res = -1;
            while (d < 8) {
                const int xc = (x0 + d) & 7;
                const unsigned t = __hip_atomic_fetch_add(ctr + xc * 16, 1u, __ATOMIC_RELAXED, __HIP_MEMORY_SCOPE_AGENT);
                if ((int)t < n_per) { res = xc * 65536 + (int)t; break; }
                ++d;
            }
            *slot = res;
        }
        __syncthreads();
        const int r = *slot;
        if (r < 0) return false;
        xl = r >> 16; q = r & 65535;
        return true;
    }
};

constexpr int GS = 72;

struct AF16 {
    const h16* p; int ld;
    __device__ __forceinline__ void init(int) {}
    __device__ __forceinline__ h16x8 load(int i, int row, int k) { return *(const h16x8*)(p + (size_t)row * ld + k); }
};

struct AH32 {
    const float* meta; const float* xs; int meta_bstride;
    const float* rp[4]; float ss[4];
    __device__ __forceinline__ const float* rowptr(int row) const {
        row = row < NT ? row : NT - 1;
        int b = row >= T_ ? 1 : 0; int t = row - b * T_;
        return t < 16 ? meta + (size_t)b * meta_bstride + (size_t)t * 1024 : xs + ((size_t)b * 8192 + (t - 16)) * 1024;
    }
    __device__ __forceinline__ h16x8 load(int i, int, int k) {
        const float4 v0 = *(const float4*)(rp[i] + k), v1 = *(const float4*)(rp[i] + k + 4);
        ss[i] += v0.x * v0.x + v0.y * v0.y + v0.z * v0.z + v0.w * v0.w + v1.x * v1.x + v1.y * v1.y + v1.z * v1.z + v1.w * v1.w;
        h16x8 r; r[0] = (h16)v0.x; r[1] = (h16)v0.y; r[2] = (h16)v0.z; r[3] = (h16)v0.w; r[4] = (h16)v1.x; r[5] = (h16)v1.y; r[6] = (h16)v1.z; r[7] = (h16)v1.w;
        return r;
    }
};

template <int BN, class AL, class EP>
__device__ __forceinline__ void gemm_tile(AL& al, int arow0, const h16* __restrict__ Bt, int ldb, int K, EP& ep, h16* smem) {
    const int tid = opaque_tid(), lane = tid & 63, w = tid >> 6, wm = w >> 1, wn = w & 1;
    constexpr int NTL = BN / 64;
    constexpr int NBG = BN / 32;
    constexpr int BUF = (128 + BN) * GS;
    f32x16 acc[2][NTL];
#pragma unroll
    for (int i = 0; i < 2; ++i)
#pragma unroll
        for (int j = 0; j < NTL; ++j)
#pragma unroll
            for (int r = 0; r < 16; ++r) acc[i][j][r] = 0.f;
    h16x8 ra[4], rb[NBG];
    const int nk = K >> 6;
#pragma unroll
    for (int i = 0; i < 4; ++i) { int g = tid + 256 * i; ra[i] = al.load(i, arow0 + (g >> 3), (g & 7) * 8); }
#pragma unroll
    for (int i = 0; i < NBG; ++i) { int g = tid + 256 * i; rb[i] = *(const h16x8*)(Bt + (size_t)(g >> 3) * ldb + (g & 7) * 8); }
    __syncthreads();
#pragma unroll
    for (int i = 0; i < 4; ++i) { int g = tid + 256 * i; *(h16x8*)(smem + (g >> 3) * GS + (g & 7) * 8) = ra[i]; }
#pragma unroll
    for (int i = 0; i < NBG; ++i) { int g = tid + 256 * i; *(h16x8*)(smem + 128 * GS + (g >> 3) * GS + (g & 7) * 8) = rb[i]; }
    __syncthreads();
    for (int kt = 0; kt < nk; ++kt) {
        const int cur = kt & 1;
        const h16* sA = smem + cur * BUF;
        const h16* sB = sA + 128 * GS;
        if (kt + 1 < nk) {
            const int k0 = (kt + 1) << 6;
#pragma unroll
            for (int i = 0; i < 4; ++i) { int g = tid + 256 * i; ra[i] = al.load(i, arow0 + (g >> 3), k0 + (g & 7) * 8); }
#pragma unroll
            for (int i = 0; i < NBG; ++i) { int g = tid + 256 * i; rb[i] = *(const h16x8*)(Bt + (size_t)(g >> 3) * ldb + k0 + (g & 7) * 8); }
        }
#pragma unroll
        for (int ks = 0; ks < 4; ++ks) {
            h16x8 af[2], bf[NTL];
#pragma unroll
            for (int mt = 0; mt < 2; ++mt) af[mt] = *(const h16x8*)(sA + (64 * wm + 32 * mt + (lane & 31)) * GS + 16 * ks + 8 * (lane >> 5));
#pragma unroll
            for (int nt = 0; nt < NTL; ++nt) bf[nt] = *(const h16x8*)(sB + ((BN / 2) * wn + 32 * nt + (lane & 31)) * GS + 16 * ks + 8 * (lane >> 5));
#pragma unroll
            for (int mt = 0; mt < 2; ++mt)
#pragma unroll
                for (int nt = 0; nt < NTL; ++nt) acc[mt][nt] = MFMA32(af[mt], bf[nt], acc[mt][nt]);
        }
        if (kt + 1 < nk) {
            h16* dA = smem + (cur ^ 1) * BUF;
            h16* dB = dA + 128 * GS;
#pragma unroll
            for (int i = 0; i < 4; ++i) { int g = tid + 256 * i; *(h16x8*)(dA + (g >> 3) * GS + (g & 7) * 8) = ra[i]; }
#pragma unroll
            for (int i = 0; i < NBG; ++i) { int g = tid + 256 * i; *(h16x8*)(dB + (g >> 3) * GS + (g & 7) * 8) = rb[i]; }
        }
        __syncthreads();
    }
    ep.pre(al);
    float* ft = (float*)smem;
#pragma unroll
    for (int mt = 0; mt < 2; ++mt)
#pragma unroll
        for (int nt = 0; nt < NTL; ++nt)
#pragma unroll
            for (int r = 0; r < 16; ++r) {
                const int rl = 64 * wm + 32 * mt + (r & 3) + 8 * (r >> 2) + 4 * (lane >> 5);
                const int cl = (BN / 2) * wn + 32 * nt + (lane & 31);
                ft[rl * (BN + 1) + cl] = acc[mt][nt][r];
            }
    __syncthreads();
    if (EP::kSweep) {
#pragma unroll 4
        for (int idx = tid; idx < 128 * BN; idx += NTHREADS) {
            const int rl = idx / BN, cl = idx % BN;
            float q = ep(rl, cl, ft[rl * (BN + 1) + cl]);
            if (EP::kRowSum) {
#pragma unroll
                for (int d = 1; d < 64; d <<= 1) q += __shfl_xor(q, d);
                if (lane == 0) ep.rowsum(rl, q);
            }
        }
    }
}

constexpr int GS2 = 72;
template <class EP>
__device__ __forceinline__ void gemm_big(const h16* __restrict__ A, int lda, const h16* __restrict__ Bt, int ldb, int K, EP& ep, h16* smem) {
    const int tid = opaque_tid(), lane = tid & 63, w = tid >> 6, wm = w >> 1, wn = w & 1;
    constexpr int BUF = 512 * GS2;
    f32x16 acc[4][4];
    float zero_ = 0.f; asm volatile("" : "+v"(zero_));
#pragma unroll
    for (int i = 0; i < 4; ++i)
#pragma unroll
        for (int j = 0; j < 4; ++j)
#pragma unroll
            for (int r = 0; r < 16; ++r) acc[i][j][r] = zero_;
    h16x8 ra[2][8], rb[2][8];
    const int nk = K >> 6;
    const h16* ap = A + (size_t)(tid >> 3) * lda + (tid & 7) * 8;
    const h16* bp = Bt + (size_t)(tid >> 3) * ldb + (tid & 7) * 8;
    const int soff = (tid >> 3) * GS2 + (tid & 7) * 8;
#pragma unroll
    for (int i = 0; i < 8; ++i) { ra[0][i] = *(const h16x8*)(ap + (size_t)(32 * i) * lda); rb[0][i] = *(const h16x8*)(bp + (size_t)(32 * i) * ldb); }
#pragma unroll
    for (int i = 0; i < 8; ++i) { ra[1][i] = *(const h16x8*)(ap + (size_t)(32 * i) * lda + 64); rb[1][i] = *(const h16x8*)(bp + (size_t)(32 * i) * ldb + 64); }
    __syncthreads();
#pragma unroll
    for (int i = 0; i < 8; ++i) { *(h16x8*)(smem + soff + 32 * i * GS2) = ra[0][i]; *(h16x8*)(smem + 256 * GS2 + soff + 32 * i * GS2) = rb[0][i]; }
    __syncthreads();
#define BIG_STEP(CUR, KT) do { \
        const h16* sA = smem + (CUR) * BUF + (128 * wm + (lane & 31)) * GS2 + 8 * (lane >> 5); \
        const h16* sB = smem + (CUR) * BUF + 256 * GS2 + (128 * wn + (lane & 31)) * GS2 + 8 * (lane >> 5); \
        h16* dW = smem + ((CUR) ^ 1) * BUF;     \
        int k0 = ((KT) + 2) << 6; k0 = k0 < K ? k0 : K - 64; \
        h16x8 af[2][4], bf[2][4]; \
        _Pragma("unroll") for (int t = 0; t < 4; ++t) { af[0][t] = *(const h16x8*)(sA + 32 * t * GS2); bf[0][t] = *(const h16x8*)(sB + 32 * t * GS2); } \
        __builtin_amdgcn_sched_barrier(0); \
        _Pragma("unroll") for (int ks = 0; ks < 4; ++ks) { \
            if (ks < 3) { _Pragma("unroll") for (int t = 0; t < 4; ++t) { af[(ks + 1) & 1][t] = *(const h16x8*)(sA + 32 * t * GS2 + 16 * (ks + 1)); bf[(ks + 1) & 1][t] = *(const h16x8*)(sB + 32 * t * GS2 + 16 * (ks + 1)); } } \
            _Pragma("unroll") for (int i = 2 * ks; i < 2 * ks + 2; ++i) { *(h16x8*)(dW + soff + 32 * i * GS2) = ra[(CUR) ^ 1][i]; *(h16x8*)(dW + 256 * GS2 + soff + 32 * i * GS2) = rb[(CUR) ^ 1][i]; } \
            _Pragma("unroll") for (int i = 2 * ks; i < 2 * ks + 2; ++i) { ra[CUR][i] = *(const h16x8*)(ap + (size_t)(32 * i) * lda + k0); rb[CUR][i] = *(const h16x8*)(bp + (size_t)(32 * i) * ldb + k0); } \
            _Pragma("unroll") for (int mt = 0; mt < 4; ++mt) _Pragma("unroll") for (int nt = 0; nt < 4; ++nt) acc[mt][nt] = MFMA32(af[ks & 1][mt], bf[ks & 1][nt], acc[mt][nt]); \
              \
            _Pragma("unroll") for (int q = 0; q < 4; ++q) { \
                __builtin_amdgcn_sched_group_barrier(0x8, 1, 0); __builtin_amdgcn_sched_group_barrier(0x100, 1, 0); \
                __builtin_amdgcn_sched_group_barrier(0x8, 1, 0); __builtin_amdgcn_sched_group_barrier(0x100, 1, 0); \
                __builtin_amdgcn_sched_group_barrier(0x8, 1, 0); __builtin_amdgcn_sched_group_barrier(0x200, 1, 0); \
                __builtin_amdgcn_sched_group_barrier(0x8, 1, 0); __builtin_amdgcn_sched_group_barrier(0x20, 1, 0); } \
            __builtin_amdgcn_sched_barrier(0); } \
        __syncthreads(); } while (0)
    TSEC_BEGIN(8)
    for (int kt = 0; kt < nk; kt += 2) { BIG_STEP(0, kt); BIG_STEP(1, kt + 1); }
    TSEC_END(8);
    TSEC_BEGIN(9)
#undef BIG_STEP
    float* st = (float*)smem + w * 1152;
    const int prow = lane >> 1, pc0 = (lane & 1) * 16;
    ep.template prefetch<0>(128 * wm + prow, 128 * wn + pc0);
#pragma unroll
    for (int mt = 0; mt < 4; ++mt) {
        if (mt == 0) ep.template prefetch<1>(128 * wm + 32 + prow, 128 * wn + pc0);
        if (mt == 1) ep.template prefetch<0>(128 * wm + 64 + prow, 128 * wn + pc0);
        if (mt == 2) ep.template prefetch<1>(128 * wm + 96 + prow, 128 * wn + pc0);
        ep.row_begin();
#pragma unroll
        for (int nt = 0; nt < 4; ++nt) {
#pragma unroll
            for (int r = 0; r < 16; ++r) st[((r & 3) + 8 * (r >> 2) + 4 * (lane >> 5)) * 36 + (lane & 31)] = acc[mt][nt][r];
            WAVE_FENCE();
            float v[16];
#pragma unroll
            for (int q = 0; q < 4; ++q) { const float4 t4 = *(const float4*)(st + prow * 36 + pc0 + 4 * q); v[4 * q] = t4.x; v[4 * q + 1] = t4.y; v[4 * q + 2] = t4.z; v[4 * q + 3] = t4.w; }
            WAVE_FENCE();
            if (mt & 1) ep.template store16<1>(nt, 128 * wm + 32 * mt + prow, 128 * wn + 32 * nt + pc0, v);
            else ep.template store16<0>(nt, 128 * wm + 32 * mt + prow, 128 * wn + 32 * nt + pc0, v);
        }
        ep.row_end(128 * wm + 32 * mt + prow, lane);
    }
    TSEC_END(9);
}

template <class EP>
__device__ __forceinline__ void skinny_tile(const h16* __restrict__ A, int lda, const h16* __restrict__ Bt, int ldb, int K, EP& ep, float* st, int tid) {
    const int lane = tid & 63, w = tid >> 6;
    f32x16 acc;
#pragma unroll
    for (int r = 0; r < 16; ++r) acc[r] = 0.f;
    const int kq = K >> 2;
    const h16* ap = A + (size_t)(lane & 31) * lda + 8 * (lane >> 5) + w * kq;
    const h16* bp = Bt + (size_t)(lane & 31) * ldb + 8 * (lane >> 5) + w * kq;
    if (w == 0) ep.template prefetch<0>(lane >> 1, (lane & 1) * 16);
    for (int k0 = 0; k0 < kq; k0 += 128) {
        h16x8 af[8], bf[8];
#pragma unroll
        for (int u = 0; u < 8; ++u) { af[u] = *(const h16x8*)(ap + k0 + 16 * u); bf[u] = *(const h16x8*)(bp + k0 + 16 * u); }
#pragma unroll
        for (int u = 0; u < 8; ++u) acc = MFMA32(af[u], bf[u], acc);
    }
    __syncthreads();
    float* my = st + w * 1152;
#pragma unroll
    for (int r = 0; r < 16; ++r) my[((r & 3) + 8 * (r >> 2) + 4 * (lane >> 5)) * 36 + (lane & 31)] = acc[r];
    __syncthreads();
    if (w == 0) {
        const int prow = lane >> 1, pc0 = (lane & 1) * 16;
        ep.row_begin();
        float v[16];
#pragma unroll
        for (int q = 0; q < 4; ++q) {
            float4 t4 = *(const float4*)(st + prow * 36 + pc0 + 4 * q);
#pragma unroll
            for (int ww = 1; ww < 4; ++ww) { const float4 u4 = *(const float4*)(st + ww * 1152 + prow * 36 + pc0 + 4 * q); t4.x += u4.x; t4.y += u4.y; t4.z += u4.z; t4.w += u4.w; }
            v[4 * q] = t4.x; v[4 * q + 1] = t4.y; v[4 * q + 2] = t4.z; v[4 * q + 3] = t4.w;
        }
        ep.template store16<0>(0, prow, pc0, v);
        ep.row_end(prow, lane);
    }
}

struct EpiInProj {
    static constexpr bool kSweep = true; static constexpr bool kRowSum = false;
    int row0, n0; const float* rstd; h16* projA; float* small; h16* sza; h16* szg; h16* projG;
    template <class AL_> __device__ __forceinline__ void pre(AL_&) {}
    __device__ __forceinline__ float operator()(int rl, int cl, float v) const {
        const int row = row0 + rl; const float y = v * rstd[rl]; const int c = n0 + cl;
        if (c < 512) { if (c < 448) projA[(size_t)row * 512 + c] = (h16)y; else if (c < 460) small[(size_t)row * 16 + (c - 448)] = y; }
        else if (c < 1024) sza[(size_t)row * 512 + (c - 512)] = (h16)silu_f(y);
        else if (c < 2560) projG[(size_t)row * 1536 + (c - 1024)] = (h16)y;
        else szg[(size_t)row * 512 + (c - 2560)] = (h16)silu_f(y);
        return 0.f;
    }
    __device__ __forceinline__ void rowsum(int, float) const {}
};
struct EpiIn2 : EpiInProj {
    float* rstd_w; int tid; const float* sumsq;
    template <class AL_> __device__ __forceinline__ void pre(AL_&) {
        if (tid < 128) rstd_w[tid] = rsqrtf(sumsq[row0 + tid] * (1.f / 1024.f) + EPS);
        __syncthreads();
    }
};
struct EpiTileF32 {
    static constexpr bool kSweep = false; static constexpr bool kRowSum = false;
    template <class AL_> __device__ __forceinline__ void pre(AL_&) {}
    __device__ __forceinline__ float operator()(int, int, float) const { return 0.f; }
    __device__ __forceinline__ void rowsum(int, float) const {}
};
struct EpiStoreH {
    static constexpr bool kSweep = true; static constexpr bool kRowSum = false;
    h16* dst; int ld; int row0; const float* rs;
    template <class AL_> __device__ __forceinline__ void pre(AL_&) {}
    __device__ __forceinline__ float operator()(int rl, int cl, float v) const { dst[(size_t)(row0 + rl) * ld + cl] = (h16)(rs ? v * rs[rl] : v); return 0.f; }
    __device__ __forceinline__ void rowsum(int, float) const {}
};
struct EpiGate {
    static constexpr bool kSweep = true; static constexpr bool kRowSum = false;
    h16* dst; const h16* gate; int row0; int c0;
    template <class AL_> __device__ __forceinline__ void pre(AL_&) {}
    __device__ __forceinline__ float operator()(int rl, int cl, float v) const {
        const size_t row = row0 + rl;
        dst[row * 1024 + c0 + cl] = (h16)(v * (float)gate[row * 512 + c0 + cl]);
        return 0.f;
    }
    __device__ __forceinline__ void rowsum(int, float) const {}
};
struct EpiResid {
    static constexpr bool kSweep = true; static constexpr bool kRowSum = true;
    int layer; int row0; int n0; const float* meta; const float* x; float* metah; float* out; h16* h16o; float* sumsq_next;
    template <class AL_> __device__ __forceinline__ void pre(AL_&) {}
    __device__ __forceinline__ float operator()(int rl, int cl, float v) const {
        const int row = row0 + rl; if (row >= NT) return 0.f;
        const int b = row >= T_ ? 1 : 0; const int t = row - b * T_; const int c = n0 + cl;
        if (layer == 0) {
            float hn;
            if (t < 16) { hn = meta[(size_t)t * 1024 + c] + v; metah[((size_t)b * 16 + t) * 1024 + c] = hn; }
            else { const size_t o = ((size_t)b * 8192 + (t - 16)) * 1024 + c; hn = x[o] + v; out[o] = hn; }
            h16o[(size_t)row * 1024 + c] = (h16)hn;
            return hn * hn;
        } else {
            if (t >= 16) { const size_t o = ((size_t)b * 8192 + (t - 16)) * 1024 + c; out[o] = out[o] + v; }
            return 0.f;
        }
    }
    __device__ __forceinline__ void rowsum(int rl, float q) const { if (layer == 0 && row0 + rl < NT) atomicAdd(sumsq_next + row0 + rl, q); }
};

__device__ __forceinline__ void store16h(h16* dst, const float* v) {
    h16x8 a, b;
#pragma unroll
    for (int e = 0; e < 8; ++e) { a[e] = (h16)v[e]; b[e] = (h16)v[8 + e]; }
    *(h16x8*)dst = a; *(h16x8*)(dst + 8) = b;
}
struct EpiInBig {
    int row0, n0; const float* sumsq; h16* projA; float* small; h16* sza; h16* szg; h16* projG;
    float ssq[2];
    __device__ __forceinline__ void row_begin() {}
    __device__ __forceinline__ void row_end(int, int) {}
    template <int B> __device__ __forceinline__ void prefetch(int rl, int) { ssq[B] = sumsq[row0 + rl]; }
    template <int B> __device__ __forceinline__ void store16(int, int rl, int cl, const float* v) const {
        const int row = row0 + rl; const int c = n0 + cl;
        const float rs = rsqrtf(ssq[B] * (1.f / 1024.f) + EPS);
        float y[16];
#pragma unroll
        for (int e = 0; e < 16; ++e) y[e] = v[e] * rs;
        if (c < 512) {
            if (c < 448) store16h(projA + (size_t)row * 512 + c, y);
            else if (c == 448) {
#pragma unroll
                for (int e = 0; e < 12; ++e) small[(size_t)row * 16 + e] = y[e];
            }
        } else if (c < 1024) {
#pragma unroll
            for (int e = 0; e < 16; ++e) y[e] = silu_f(y[e]);
            store16h(sza + (size_t)row * 512 + (c - 512), y);
        } else if (c < 2560) store16h(projG + (size_t)row * 1536 + (c - 1024), y);
        else {
#pragma unroll
            for (int e = 0; e < 16; ++e) y[e] = silu_f(y[e]);
            store16h(szg + (size_t)row * 512 + (c - 2560), y);
        }
    }
};
struct EpiResBig {
    int layer, row0, n0; const float* meta; const float* x; float* metah; float* out; h16* h16o; float* sumsq_next; float ss; int nseg;
    float4 pf[2][4][4];
    __device__ __forceinline__ void row_begin() { ss = 0.f; }
    __device__ __forceinline__ void row_end(int rl, int lane) {
        if (layer == 0) { float q = ss; q += __shfl_xor(q, 1); if ((lane & 1) == 0) atomicAdd(sumsq_next + row0 + rl, q); }
    }
    __device__ __forceinline__ const float* srcp(int row, int c) const {
        const int b = row >= T_ ? 1 : 0; const int t = row - b * T_;
        if (layer == 0) return t < 16 ? meta + (size_t)t * 1024 + c : x + ((size_t)b * 8192 + (t - 16)) * 1024 + c;
        return out + ((size_t)b * 8192 + (t < 16 ? 0 : t - 16)) * 1024 + c;
    }
    template <int B> __device__ __forceinline__ void prefetch(int rl, int cl) {
        const float* src = srcp(row0 + rl, n0 + cl);
#pragma unroll
        for (int nt = 0; nt < 4; ++nt)
            if (nt < nseg) {
#pragma unroll
                for (int q = 0; q < 4; ++q) pf[B][nt][q] = *(const float4*)(src + 32 * nt + 4 * q);
            }
    }
    template <int B> __device__ __forceinline__ void store16(int nt, int rl, int cl, const float* v) {
        const int row = row0 + rl; const int c = n0 + cl;
        const int b = row >= T_ ? 1 : 0; const int t = row - b * T_;
        float* dst;
        if (layer == 0) dst = t < 16 ? metah + ((size_t)b * 16 + t) * 1024 + c : out + ((size_t)b * 8192 + (t - 16)) * 1024 + c;
        else { if (t < 16) return; dst = out + ((size_t)b * 8192 + (t - 16)) * 1024 + c; }
        float hn[16];
#pragma unroll
        for (int q = 0; q < 4; ++q) {
            const float4 hv = pf[B][nt][q];
            float4 o4; o4.x = hv.x + v[4 * q]; o4.y = hv.y + v[4 * q + 1]; o4.z = hv.z + v[4 * q + 2]; o4.w = hv.w + v[4 * q + 3];
            *(float4*)(dst + 4 * q) = o4;
            hn[4 * q] = o4.x; hn[4 * q + 1] = o4.y; hn[4 * q + 2] = o4.z; hn[4 * q + 3] = o4.w;
        }
        if (layer == 0) {
            store16h(h16o + (size_t)row * 1024 + c, hn);
#pragma unroll
            for (int e = 0; e < 16; ++e) ss += hn[e] * hn[e];
        }
    }
};

__device__ __forceinline__ int in_src_col(int n) {
    if (n < 452) return n;
    if (n < 456) return 3012 + (n - 452);
    if (n < 460) return 3016 + (n - 456);
    if (n < 512) return -1;
    if (n < 1024) return 452 + (n - 512);
    if (n < 2560) return 964 + (n - 1024);
    return 2500 + (n - 2560);
}
__device__ __forceinline__ float prep_get(const Params& P, int l, int job, int h, int n, int k) {
    switch (job) {
        case 0: { const int s = in_src_col(n); if (s < 0) return 0.f; return P.norm_gain[l * 1024 + k] * P.w_in[((size_t)l * 1024 + k) * 3020 + s]; }
        case 1: return P.w_out[((size_t)l * 1024 + k) * 1024 + n];
        case 2: return P.g_cq[l * 256 + k] * (n < 512 ? P.w_uq[((size_t)l * 256 + k) * 512 + n] : P.w_qidx[((size_t)l * 256 + k) * 256 + (n - 512)]);
        case 3: return P.g_ckv[l * 128 + k] * P.w_ukv[((size_t)l * 128 + k) * 1024 + n];
        case 4: { const int kk = k >> 4, hf = (k >> 3) & 1, j = k & 7; const int d = 16 * kk + 8 * (j >> 2) + 4 * hf + (j & 3);
                  return P.w_ukv[((size_t)l * 128 + n) * 1024 + h * 64 + d] * P.g_kn[l * 64 + d] * P.g_qn[l * 64 + d] * 0.125f; }
        default: return P.w_ukv[((size_t)l * 128 + k) * 1024 + 512 + h * 64 + n];
    }
}
__device__ __forceinline__ void prep_tiles(const Params& P, unsigned char* lds, int l, int first_wg, int nwg);
__device__ __forceinline__ void phase_prep(const Params& P, unsigned char* lds) {
    float* tile = (float*)lds;
    const int tid = opaque_tid();
    {
        h16* h16o = (h16*)(P.ws + OFF_H16); float* sumsq = (float*)(P.ws + OFF_SUMSQ);
        const int lane = tid & 63, w = tid >> 6;
        const int nw = (int)gridDim.x * 4, wv = (int)blockIdx.x * 4 + w;
        for (int row0 = wv; row0 < NT; row0 += 4 * nw) {
            float4 a[4][2], c4[4][2];
#pragma unroll
            for (int u = 0; u < 4; ++u) {
                int row = row0 + u * nw; row = row < NT ? row : NT - 1;
                const int b = row >= T_ ? 1 : 0; const int t = row - b * T_;
                const float* src = t < 16 ? P.meta + (size_t)t * 1024 : P.x + ((size_t)b * 8192 + (t - 16)) * 1024;
#pragma unroll
                for (int q = 0; q < 2; ++q) { a[u][q] = *(const float4*)(src + q * 512 + lane * 8); c4[u][q] = *(const float4*)(src + q * 512 + lane * 8 + 4); }
            }
#pragma unroll
            for (int u = 0; u < 4; ++u) {
                const int row = row0 + u * nw;
                if (row < NT) {
                    float ss = 0.f;
#pragma unroll
                    for (int q = 0; q < 2; ++q) {
                        const float4 x0 = a[u][q], x1 = c4[u][q];
                        ss += x0.x * x0.x + x0.y * x0.y + x0.z * x0.z + x0.w * x0.w + x1.x * x1.x + x1.y * x1.y + x1.z * x1.z + x1.w * x1.w;
                        h16x8 o; o[0] = (h16)x0.x; o[1] = (h16)x0.y; o[2] = (h16)x0.z; o[3] = (h16)x0.w; o[4] = (h16)x1.x; o[5] = (h16)x1.y; o[6] = (h16)x1.z; o[7] = (h16)x1.w;
                        *(h16x8*)(h16o + (size_t)row * 1024 + q * 512 + lane * 8) = o;
                    }
#pragma unroll
                    for (int d = 1; d < 64; d <<= 1) ss += __shfl_xor(ss, d);
                    if (lane == 0) sumsq[row] = ss;
                }
            }
        }
    }
    prep_tiles(P, lds, 0, 0, (int)gridDim.x);
}
__device__ __forceinline__ void prep_tiles(const Params& P, unsigned char* lds, int l, int first_wg, int nwg) {
    float* tile = (float*)lds;
    const int tid = opaque_tid();
    for (int it = (int)blockIdx.x - first_wg; it >= 0 && it < 1120; it += nwg) {
        int r = it;
        int job, h = 0, N, K, tn, tk; h16* dst;
        if (r < 768) { job = 0; N = 3072; K = 1024; tn = r / 16; tk = r % 16; dst = (h16*)(P.ws + OFF_W1T) + (size_t)l * 3072 * 1024; }
        else if ((r -= 768) < 256) { job = 1; N = 1024; K = 1024; tn = r / 16; tk = r % 16; dst = (h16*)(P.ws + OFF_WOT) + (size_t)l * 1024 * 1024; }
        else if ((r -= 256) < 48) { job = 2; N = 768; K = 256; tn = r / 4; tk = r % 4; dst = (h16*)(P.ws + OFF_WQ2T) + (size_t)l * 768 * 256; }
        else if ((r -= 48) < 16) { job = 3; N = 512; K = 128; tn = r / 2; tk = r % 2; dst = (h16*)(P.ws + OFF_WUKT) + (size_t)l * 512 * 128; }
        else if ((r -= 16) < 16) { job = 4; N = 128; K = 64; h = r / 2; tn = r % 2; tk = 0; dst = (h16*)(P.ws + OFF_WKABS) + ((size_t)l * 8 + h) * 128 * 64; }
        else { r -= 16; job = 5; N = 64; K = 128; h = r / 2; tn = 0; tk = r % 2; dst = (h16*)(P.ws + OFF_WUVT) + ((size_t)l * 8 + h) * 64 * 128; }
        (void)N;
        const int n0 = tn * 64, k0 = tk * 64;
        __syncthreads();
#pragma unroll 4
        for (int q = 0; q < 16; ++q) { const int kk = q * 4 + (tid >> 6), nn = tid & 63; tile[kk * 65 + nn] = prep_get(P, l, job, h, n0 + nn, k0 + kk); }
        __syncthreads();
#pragma unroll 4
        for (int q = 0; q < 16; ++q) { const int nn = q * 4 + (tid >> 6), kk = tid & 63; dst[(size_t)(n0 + nn) * K + k0 + kk] = (h16)tile[kk * 65 + nn]; }
    }
}

__device__ __forceinline__ void phase_inproj(const Params& P, int l, unsigned char* lds, int rep_p1 = 0) {
    h16* smem = (h16*)lds;
    float* rstd = (float*)(lds + 73728);
    const int tid = opaque_tid();
    const h16* W = (const h16*)(P.ws + OFF_W1T) + (size_t)l * 3072 * 1024;
    const h16* A = (const h16*)(P.ws + OFF_H16);
    const float* sumsq = (const float*)(P.ws + OFF_SUMSQ) + (size_t)l * NTP;
    XcdQueue xq; xq.init((unsigned*)(P.ws + OFF_CTL) + 4096 + l * 128 + 2048 * rep_p1, 96, (int*)(lds + LDS_BYTES - 32));
    int xl, qi;
    while (xq.next(xl, qi)) {
        const int rb = 8 * xl + (qi & 7), tn = 4 * (qi >> 5) + ((qi >> 3) & 3);
        EpiInBig ep{rb * 256, tn * 256, sumsq, (h16*)(P.ws + OFF_PROJA), (float*)(P.ws + OFF_SMALL), (h16*)(P.ws + OFF_SZA), (h16*)(P.ws + OFF_SZG), (h16*)(P.ws + OFF_PROJG), {0.f, 0.f}};
        gemm_big(A + (size_t)rb * 256 * 1024, 1024, W + (size_t)tn * 256 * 1024, 1024, 1024, ep, smem);
    }
    __syncthreads();
    for (int it = blockIdx.x; it < 96; it += gridDim.x) {
        EpiInBig ep{16384, it * 32, sumsq, (h16*)(P.ws + OFF_PROJA), (float*)(P.ws + OFF_SMALL), (h16*)(P.ws + OFF_SZA), (h16*)(P.ws + OFF_SZG), (h16*)(P.ws + OFF_PROJG), {0.f, 0.f}};
        skinny_tile(A + (size_t)16384 * 1024, 1024, W + (size_t)it * 32 * 1024, 1024, 1024, ep, (float*)lds, tid);
    }
    (void)rstd;
}

__device__ __forceinline__ void p2a_item(const Params& P, int l, int rb, int j, unsigned char* lds) {
    h16* smem = (h16*)lds;
    float* ft = (float*)lds;
    float* rstdq = (float*)(lds + 73728);
    const int tid = opaque_tid(); const int row0 = rb * 128;
    const h16* projA = (const h16*)(P.ws + OFF_PROJA);
    __syncthreads();
    {
        const int row = row0 + (tid >> 1), hf = tid & 1; float s = 0.f;
#pragma unroll 4
        for (int q = 0; q < 16; ++q) { const h16x8 v = *(const h16x8*)(projA + (size_t)row * 512 + hf * 128 + q * 8);
#pragma unroll
            for (int e = 0; e < 8; ++e) { const float f = (float)v[e]; s += f * f; } }
        s += __shfl_xor(s, 1);
        if (hf == 0) rstdq[tid >> 1] = rsqrtf(s * (1.f / 256.f) + EPS);
    }
    __syncthreads();
    const h16* Wq2 = (const h16*)(P.ws + OFF_WQ2T) + (size_t)l * 768 * 256;
    AF16 al{projA, 512};
    if (j >= 4) {
        EpiStoreH ep{(h16*)(P.ws + OFF_QIDX) + (j - 4) * 128, 256, row0, rstdq};
        gemm_tile<128>(al, row0, Wq2 + (size_t)j * 128 * 256, 256, 256, ep, smem);
        return;
    }
    EpiTileF32 ep;
    gemm_tile<128>(al, row0, Wq2 + (size_t)j * 128 * 256, 256, 256, ep, smem);
    __syncthreads();
    h16* qn = (h16*)(P.ws + OFF_QN);
    {
        const int rl = tid >> 1, hh = tid & 1; float s = 0.f;
        const float rq = rstdq[rl];
        for (int d = 0; d < 64; ++d) { const float f = ft[rl * 129 + hh * 64 + d] * rq; s += f * f; }
        const float rs = rsqrtf(s * (1.f / 64.f) + EPS) * rq;
        h16* dst = qn + (size_t)(row0 + rl) * 512 + (2 * j + hh) * 64;
        const float* gq = P.g_qn + l * 64;
        for (int d = 0; d < 64; d += 8) { h16x8 o;
#pragma unroll
            for (int e = 0; e < 8; ++e) o[e] = (h16)(ft[rl * 129 + hh * 64 + d + e] * rs * gq[d + e]);
            *(h16x8*)(dst + d) = o; }
    }
    __threadfence_block();
    __syncthreads();
    for (int hh = 0; hh < 2; ++hh) {
        const int head = 2 * j + hh;
        AF16 al2{qn + head * 64, 512};
        EpiStoreH ep2{(h16*)(P.ws + OFF_QK) + head * 128, 1024, row0, nullptr};
        gemm_tile<128>(al2, row0, (const h16*)(P.ws + OFF_WKABS) + ((size_t)l * 8 + head) * 128 * 64, 64, 64, ep2, smem);
    }
}

__device__ __forceinline__ void p2b_item(const Params& P, int l, int rb, unsigned char* lds) {
    h16* smem = (h16*)lds;
    float* ft = (float*)lds;
    const int tid = opaque_tid(); const int row0 = rb * 128;
    const h16* projA = (const h16*)(P.ws + OFF_PROJA);
    h16* kvrow = (h16*)(P.ws + OFF_KVROW);
    __syncthreads();
    {
        const int row = row0 + (tid >> 1), hf = tid & 1; float s = 0.f; h16x8 v[8];
#pragma unroll
        for (int q = 0; q < 8; ++q) { v[q] = *(const h16x8*)(projA + (size_t)row * 512 + 256 + hf * 64 + q * 8);
#pragma unroll
            for (int e = 0; e < 8; ++e) { const float f = (float)v[q][e]; s += f * f; } }
        s += __shfl_xor(s, 1);
        const float rs = rsqrtf(s * (1.f / 128.f) + EPS);
        const float* g = P.g_ckv + l * 128 + hf * 64;
#pragma unroll
        for (int q = 0; q < 8; ++q) { h16x8 o;
#pragma unroll
            for (int e = 0; e < 8; ++e) o[e] = (h16)((float)v[q][e] * rs * g[q * 8 + e]);
            *(h16x8*)(kvrow + (size_t)row * 136 + hf * 64 + q * 8) = o; }
    }
    {
        h16* kfrag = (h16*)(P.ws + OFF_KFRAG);
#pragma unroll
        for (int q = 0; q < 4; ++q) {
            const int g = tid + 256 * q; const int row = row0 + (g >> 3), g8 = g & 7;
            if (row < NT) {
                const int b = row >= T_ ? 1 : 0; const int t = row - b * T_;
                const h16x8 v = *(const h16x8*)(projA + (size_t)row * 512 + 384 + g8 * 8);
                const int tile = t >> 5, ks = g8 >> 1, hh = g8 & 1;
                *(h16x8*)(kfrag + ((size_t)(b * NKT + tile) * 4 + ks) * 512 + (hh * 32 + (t & 31)) * 8) = v;
            }
        }
    }
    __threadfence_block();
    __syncthreads();
    const h16* Wuk = (const h16*)(P.ws + OFF_WUKT) + (size_t)l * 512 * 128;
    for (int tn = 0; tn < 4; ++tn) {
        AF16 al{kvrow, 136};
        EpiTileF32 ep;
        gemm_tile<128>(al, row0, Wuk + (size_t)tn * 128 * 128, 128, 128, ep, smem);
        __syncthreads();
        const int rl = tid >> 1, hh = tid & 1; float s = 0.f;
        for (int d = 0; d < 64; ++d) { const float f = ft[rl * 129 + hh * 64 + d]; s += f * f; }
        kvrow[(size_t)(row0 + rl) * 136 + 128 + 2 * tn + hh] = (h16)rsqrtf(s * (1.f / 64.f) + EPS);
        __syncthreads();
    }
}

__device__ __forceinline__ void p2c_item(const Params& P, int l, int item, unsigned char* lds) {
    h16* qh = (h16*)lds;
    h16* kh = (h16*)(lds + 17408);
    float* kf = (float*)(lds + 34816);
    float* vf = (float*)(lds + 67584);
    float* Lm = (float*)(lds + 100352);
    float* beta = (float*)(lds + 116736);
    float* dec = beta + 64;
    float* edec = dec + 64;
    const int tid = opaque_tid(), lane = tid & 63, w = tid >> 6;
    const int chain = item / NCH, n = item % NCH, b = chain >> 2, h = chain & 3;
    const h16* projG = (const h16*)(P.ws + OFF_PROJG);
    const float* small = (const float*)(P.ws + OFF_SMALL);
    const float* cw = P.conv_w + (size_t)l * 4 * 1536;
    __syncthreads();
#ifndef P2C
#define P2C 15
#endif
    float* cwl = (float*)(lds + 117504);
    for (int e = tid; e < 1536; e += NTHREADS) { const int m = e >> 9, jj = (e >> 7) & 3, c = e & 127; cwl[e] = cw[jj * 1536 + m * 512 + h * 128 + c]; }
    __syncthreads();
    for (int rs1_ = 0; rs1_ <= PROBE_S1; ++rs1_) if (P2C & 1) {
        const int i = tid >> 2, part = tid & 3;
        const int t = 64 * n + i - 48; const bool valid = t >= 0;
        const size_t row = (size_t)b * T_ + (valid ? t : 0);
        h16x8 rv[3][4][4];
#define CONV_LOAD(m_) do { _Pragma("unroll") for (int jj = 0; jj < 4; ++jj) { int tt = t - 3 + jj; tt = tt < 0 ? 0 : tt; \
            const h16* rp = projG + ((size_t)b * T_ + tt) * 1536 + (m_) * 512 + h * 128 + part * 32; \
            _Pragma("unroll") for (int c8 = 0; c8 < 4; ++c8) rv[m_][jj][c8] = *(const h16x8*)(rp + c8 * 8); } } while (0)
        CONV_LOAD(0); CONV_LOAD(1);
        float bl = 0.f, al = 0.f;
        if (part == 0) { bl = small[row * 16 + 4 + h]; al = small[row * 16 + 8 + h]; }
        float vals[32];
#pragma unroll
        for (int m = 0; m < 3; ++m) {
            if (m == 1) { CONV_LOAD(2); }
            __builtin_amdgcn_sched_barrier(0);
#pragma unroll
            for (int c = 0; c < 32; ++c) vals[c] = 0.f;
#pragma unroll
            for (int jj = 0; jj < 4; ++jj) {
                const float msk = (valid && (t - 3 + jj) >= 0) ? 1.f : 0.f;
                const float* wp = cwl + (m * 4 + jj) * 128 + part * 32;
#pragma unroll
                for (int c8 = 0; c8 < 4; ++c8) {
                    const float4 w0 = *(const float4*)(wp + c8 * 8), w1 = *(const float4*)(wp + c8 * 8 + 4);
                    const float wv[8] = {w0.x, w0.y, w0.z, w0.w, w1.x, w1.y, w1.z, w1.w};
#pragma unroll
                    for (int e = 0; e < 8; ++e) vals[c8 * 8 + e] += wv[e] * msk * (float)rv[m][jj][c8][e];
                }
            }
            float ss = 0.f;
#pragma unroll
            for (int c = 0; c < 32; ++c) { vals[c] = silu_f(vals[c]); ss += vals[c] * vals[c]; }
            if (m < 2) {
                ss += __shfl_xor(ss, 1); ss += __shfl_xor(ss, 2);
                const float rs = valid ? rsqrtf(ss + EPS) : 0.f;
                h16* dsth = (m == 0 ? qh : kh) + i * 136 + part * 32;
#pragma unroll
                for (int c8 = 0; c8 < 4; ++c8) { h16x8 o;
#pragma unroll
                    for (int e = 0; e < 8; ++e) o[e] = (h16)(vals[c8 * 8 + e] * rs);
                    *(h16x8*)(dsth + c8 * 8) = o; }
                if (m == 1) {
#pragma unroll
                    for (int c4 = 0; c4 < 8; ++c4) *(float4*)(kf + i * 128 + part * 32 + c4 * 4) = make_float4(vals[4 * c4] * rs, vals[4 * c4 + 1] * rs, vals[4 * c4 + 2] * rs, vals[4 * c4 + 3] * rs);
                }
            } else {
#pragma unroll
                for (int c4 = 0; c4 < 8; ++c4) *(float4*)(vf + i * 128 + part * 32 + c4 * 4) = valid ? make_float4(vals[4 * c4], vals[4 * c4 + 1], vals[4 * c4 + 2], vals[4 * c4 + 3]) : make_float4(0.f, 0.f, 0.f, 0.f);
            }
        }
#undef CONV_LOAD
        if (part == 0) {
            float bt = 0.f, g = 0.f;
            if (valid) {
                bt = 1.f / (1.f + __expf(-bl));
                const float xx = al + P.dt_bias[l * 4 + h];
                const float sp = xx > 20.f ? xx : log1pf(__expf(xx));
                g = -__expf(P.a_log[l * 4 + h]) * sp;
            }
            beta[i] = bt; dec[i] = g;
        }
    }
    __syncthreads();
    if (w == 0) {
        float v = dec[lane];
#pragma unroll
        for (int d = 1; d < 64; d <<= 1) { const float o = __shfl_up(v, d); if (lane >= d) v += o; }
        dec[lane] = v; edec[lane] = __expf(v);
    }
    __syncthreads();
    for (int rs3_ = 0; rs3_ <= PROBE_S3; ++rs3_) if (P2C & 2) {
        const int gq = lane >> 4, c16 = lane & 15;
        h16* aqk = (h16*)(P.ws + OFF_AQK) + (size_t)item * 4096;
        h16x8 ak[4], aq[4];
#pragma unroll
        for (int ks = 0; ks < 4; ++ks) { ak[ks] = *(const h16x8*)(kh + (16 * w + c16) * 136 + 32 * ks + 8 * gq); aq[ks] = *(const h16x8*)(qh + (16 * w + c16) * 136 + 32 * ks + 8 * gq); }
#pragma unroll
        for (int nt = 0; nt < 4; ++nt) {
            f32x4 kk = {0.f, 0.f, 0.f, 0.f}, qk = {0.f, 0.f, 0.f, 0.f};
#pragma unroll
            for (int ks = 0; ks < 4; ++ks) { const h16x8 bb = *(const h16x8*)(kh + (16 * nt + c16) * 136 + 32 * ks + 8 * gq); kk = MFMA16(ak[ks], bb, kk); qk = MFMA16(aq[ks], bb, qk); }
            const int jc = 16 * nt + c16; const float dj = dec[jc];
#pragma unroll
            for (int r = 0; r < 4; ++r) {
                const int ir = 16 * w + 4 * gq + r; const float gm = __expf(fminf(dec[ir] - dj, 0.f));
                Lm[ir * 64 + jc] = ir > jc ? beta[ir] * kk[r] * gm : 0.f;
                aqk[ir * 64 + jc] = (h16)(ir >= jc ? qk[r] * gm : 0.f);
            }
        }
    }
    __syncthreads();
    for (int rs5_ = 0; rs5_ <= PROBE_S5; ++rs5_) if (P2C & 8) {
        h16* qd = (h16*)(P.ws + OFF_QD) + (size_t)item * 8192;
        const int i = tid >> 2, part = tid & 3; const float ed = edec[i];
#pragma unroll
        for (int c8 = 0; c8 < 4; ++c8) { const h16x8 v = *(const h16x8*)(qh + i * 136 + part * 32 + c8 * 8); h16x8 o;
#pragma unroll
            for (int e = 0; e < 8; ++e) o[e] = (h16)((float)v[e] * ed);
            *(h16x8*)(qd + i * 128 + part * 32 + c8 * 8) = o; }
        h16* kdt = (h16*)(P.ws + OFF_KDT) + (size_t)item * 8192;
        const int d = tid & 127, ih = tid >> 7; const float dl = dec[63];
#pragma unroll
        for (int i8 = 0; i8 < 4; ++i8) { h16x8 o;
#pragma unroll
            for (int e = 0; e < 8; ++e) { const int ii = ih * 32 + i8 * 8 + e; o[e] = (h16)(kf[ii * 128 + d] * __expf(dl - dec[ii])); }
            *(h16x8*)(kdt + d * 64 + ih * 32 + i8 * 8) = o; }
        if (tid == 0) ((float*)(P.ws + OFF_CDEC))[item] = __expf(dl);
    }
    __syncthreads();
    if (P2C & 4) {
        float* scl = cwl;
        if (tid < 128) { const int i = tid & 63; scl[tid] = tid < 64 ? beta[i] : beta[i] * edec[i]; }
        __syncthreads();
        const int c = tid; const bool isu = c < 128; float* col = isu ? (vf + c) : (kf + (c - 128));
        const float* sc = scl + (isu ? 0 : 64);
        h16* dst = (h16*)(P.ws + (isu ? OFF_U : OFF_WM)) + (size_t)item * 8192 + (isu ? c : c - 128);
#pragma unroll 1
        for (int bi = 0; bi < 8; ++bi) {
            float sv[8];
            { const float4 s0 = *(const float4*)(sc + 8 * bi), s1 = *(const float4*)(sc + 8 * bi + 4);
              const float ss_[8] = {s0.x, s0.y, s0.z, s0.w, s1.x, s1.y, s1.z, s1.w};
#pragma unroll
              for (int r = 0; r < 8; ++r) sv[r] = col[(8 * bi + r) * 128] * ss_[r]; }
#pragma unroll 2
            for (int j4 = 0; j4 < 2 * bi; ++j4) {
                const float x0 = col[(4 * j4 + 0) * 128], x1 = col[(4 * j4 + 1) * 128], x2 = col[(4 * j4 + 2) * 128], x3 = col[(4 * j4 + 3) * 128];
#pragma unroll
                for (int r = 0; r < 8; ++r) { const float4 lv = *(const float4*)(Lm + (8 * bi + r) * 64 + 4 * j4); sv[r] -= lv.x * x0; sv[r] -= lv.y * x1; sv[r] -= lv.z * x2; sv[r] -= lv.w * x3; }
            }
            float4 la[8], lb[8];
#pragma unroll
            for (int r = 1; r < 8; ++r) { la[r] = *(const float4*)(Lm + (8 * bi + r) * 64 + 8 * bi); lb[r] = *(const float4*)(Lm + (8 * bi + r) * 64 + 8 * bi + 4); }
#pragma unroll
            for (int r = 1; r < 8; ++r) {
                const float lv[8] = {la[r].x, la[r].y, la[r].z, la[r].w, lb[r].x, lb[r].y, lb[r].z, lb[r].w};
#pragma unroll
                for (int q = 0; q < r; ++q) sv[r] -= lv[q] * sv[q];
            }
#pragma unroll
            for (int r = 0; r < 8; ++r) { col[(8 * bi + r) * 128] = sv[r]; dst[(8 * bi + r) * 128] = (h16)sv[r]; }
        }
    }
}

__device__ __forceinline__ float half_sum(float x) {
    const unsigned u = __float_as_uint(x); const auto p = __builtin_amdgcn_permlane32_swap(u, u, false, false);
    return __uint_as_float(p[0]) + __uint_as_float(p[1]);
}
__device__ __forceinline__ void store_tile_T(const f32x16& acc, float scale, float* st, h16* dst_row_lane  , bool ok, int lane) {
#pragma unroll
    for (int r = 0; r < 16; ++r) st[(lane & 31) * 33 + (r & 3) + 8 * (r >> 2) + 4 * (lane >> 5)] = acc[r] * scale;
    WAVE_FENCE();
    float v[16];
#pragma unroll
    for (int q = 0; q < 16; ++q) v[q] = st[(lane >> 1) * 33 + (lane & 1) * 16 + q];
    WAVE_FENCE();
    if (ok) store16h(dst_row_lane, v);
}

__device__ __forceinline__ void chain_item(const Params& P, int l, int item, float* st, int lane) {
    const int r0 = item * 32; const int tok = lane & 31, hf = lane >> 5;
    const int row = r0 + tok; const int rowc = row < NT ? row : NT - 1;
    const h16* projA = (const h16*)(P.ws + OFF_PROJA);
    const h16* Wq2 = (const h16*)(P.ws + OFF_WQ2T) + (size_t)l * 768 * 256;
    const h16* Wka = (const h16*)(P.ws + OFF_WKABS) + (size_t)l * 8 * 128 * 64;
    const h16* Wuk = (const h16*)(P.ws + OFF_WUKT) + (size_t)l * 512 * 128;
    h16* qidx = (h16*)(P.ws + OFF_QIDX); h16* qk = (h16*)(P.ws + OFF_QK); h16* kvrow = (h16*)(P.ws + OFF_KVROW);
    const int srow = r0 + (lane >> 1); const bool sok = srow < NT; const size_t srowc = sok ? srow : NT - 1;
    h16x8 bq[16]; float ss = 0.f;
#pragma unroll
    for (int ks = 0; ks < 16; ++ks) { bq[ks] = *(const h16x8*)(projA + (size_t)rowc * 512 + 16 * ks + 8 * hf);
#pragma unroll
        for (int e = 0; e < 8; ++e) { const float f = (float)bq[ks][e]; ss += f * f; } }
    ss = half_sum(ss);
    const float rstd_q = rsqrtf(ss * (1.f / 256.f) + EPS);
#pragma unroll 1
    for (int h = 0; h < 8; ++h) {
        f32x16 aq[2];
#pragma unroll
        for (int mt = 0; mt < 2; ++mt)
#pragma unroll
            for (int r = 0; r < 16; ++r) aq[mt][r] = 0.f;
        const h16* wp = Wq2 + (size_t)(64 * h + tok) * 256 + 8 * hf;
#pragma unroll
        for (int ks = 0; ks < 16; ++ks) {
            const h16x8 a0 = *(const h16x8*)(wp + 16 * ks), a1 = *(const h16x8*)(wp + 32 * 256 + 16 * ks);
            aq[0] = MFMA32(a0, bq[ks], aq[0]); aq[1] = MFMA32(a1, bq[ks], aq[1]);
        }
        __builtin_amdgcn_sched_group_barrier(0x20, 8, 0);
#pragma unroll
        for (int q = 0; q < 12; ++q) { __builtin_amdgcn_sched_group_barrier(0x8, 2, 0); __builtin_amdgcn_sched_group_barrier(0x20, 2, 0); }
        __builtin_amdgcn_sched_group_barrier(0x8, 8, 0);
        __builtin_amdgcn_sched_barrier(0);
        float sq = 0.f;
#pragma unroll
        for (int mt = 0; mt < 2; ++mt)
#pragma unroll
            for (int r = 0; r < 16; ++r) sq += aq[mt][r] * aq[mt][r];
        sq = half_sum(sq) * rstd_q * rstd_q;
        const float rsq = rsqrtf(sq * (1.f / 64.f) + EPS) * rstd_q;
        h16x8 qb[4];
#pragma unroll
        for (int kk = 0; kk < 4; ++kk)
#pragma unroll
            for (int j = 0; j < 8; ++j) qb[kk][j] = (h16)(aq[kk >> 1][8 * (kk & 1) + j] * rsq);
        const h16* kp = Wka + (size_t)h * 128 * 64 + (size_t)tok * 64 + 8 * hf;
#pragma unroll
        for (int ct = 0; ct < 4; ++ct) {
            f32x16 ak;
#pragma unroll
            for (int r = 0; r < 16; ++r) ak[r] = 0.f;
#pragma unroll
            for (int kk = 0; kk < 4; ++kk) { const h16x8 a = *(const h16x8*)(kp + (size_t)(32 * ct) * 64 + 16 * kk); ak = MFMA32(a, qb[kk], ak); }
            store_tile_T(ak, 1.f, st, qk + srowc * 1024 + h * 128 + 32 * ct + 16 * (lane & 1), sok, lane);
        }
    }
#pragma unroll 1
    for (int nt = 0; nt < 8; ++nt) {
        f32x16 ai;
#pragma unroll
        for (int r = 0; r < 16; ++r) ai[r] = 0.f;
        const h16* wp = Wq2 + (size_t)(512 + 32 * nt + tok) * 256 + 8 * hf;
#pragma unroll
        for (int ks = 0; ks < 16; ++ks) { const h16x8 a = *(const h16x8*)(wp + 16 * ks); ai = MFMA32(a, bq[ks], ai); }
#pragma unroll
        for (int r = 0; r < 16; ++r) ai[r] *= rstd_q;
        store_tile_T(ai, 1.f, st, qidx + srowc * 256 + 32 * nt + 16 * (lane & 1), sok, lane);
    }
    h16x8 bk[8]; float sk = 0.f;
#pragma unroll
    for (int ks = 0; ks < 8; ++ks) { bk[ks] = *(const h16x8*)(projA + (size_t)rowc * 512 + 256 + 16 * ks + 8 * hf);
#pragma unroll
        for (int e = 0; e < 8; ++e) { const float f = (float)bk[ks][e]; sk += f * f; } }
    sk = half_sum(sk);
    const float rstd_kv = rsqrtf(sk * (1.f / 128.f) + EPS);
    if (row < NT) {
        const float* g = P.g_ckv + l * 128;
#pragma unroll
        for (int ks = 0; ks < 8; ++ks) { h16x8 o;
#pragma unroll
            for (int e = 0; e < 8; ++e) o[e] = (h16)((float)bk[ks][e] * rstd_kv * g[16 * ks + 8 * hf + e]);
            *(h16x8*)(kvrow + (size_t)row * 136 + 16 * ks + 8 * hf) = o; }
    }
#pragma unroll 1
    for (int h = 0; h < 8; ++h) {
        f32x16 ak[2];
#pragma unroll
        for (int mt = 0; mt < 2; ++mt)
#pragma unroll
            for (int r = 0; r < 16; ++r) ak[mt][r] = 0.f;
        const h16* wp = Wuk + (size_t)(64 * h + tok) * 128 + 8 * hf;
#pragma unroll
        for (int ks = 0; ks < 8; ++ks) {
            const h16x8 a0 = *(const h16x8*)(wp + 16 * ks), a1 = *(const h16x8*)(wp + 32 * 128 + 16 * ks);
            ak[0] = MFMA32(a0, bk[ks], ak[0]); ak[1] = MFMA32(a1, bk[ks], ak[1]);
        }
        float sq = 0.f;
#pragma unroll
        for (int mt = 0; mt < 2; ++mt)
#pragma unroll
            for (int r = 0; r < 16; ++r) sq += ak[mt][r] * ak[mt][r];
        sq = half_sum(sq) * rstd_kv * rstd_kv;
        if (row < NT && hf == 0) kvrow[(size_t)row * 136 + 128 + h] = (h16)rsqrtf(sq * (1.f / 64.f) + EPS);
    }
    if (row < NT) {
        h16* kfrag = (h16*)(P.ws + OFF_KFRAG);
        const int b = row >= T_ ? 1 : 0; const int t = row - b * T_; const int tile = t >> 5;
#pragma unroll
        for (int q = 0; q < 4; ++q) {
            const int g8 = 2 * q + hf;
            const h16x8 v = *(const h16x8*)(projA + (size_t)row * 512 + 384 + g8 * 8);
            *(h16x8*)(kfrag + ((size_t)(b * NKT + tile) * 4 + (g8 >> 1)) * 512 + ((g8 & 1) * 32 + (t & 31)) * 8) = v;
        }
    }
}

__device__ __forceinline__ void p4_item(const Params& P, int l, int item, int lane) {
    const int r0 = item * 32; const int tok = lane & 31, hf = lane >> 5;
    const int row = r0 + tok; const bool ok = row < NT; const size_t rowc = ok ? row : NT - 1;
    const h16* ctx = (const h16*)(P.ws + OFF_CTX); const h16* Wuv = (const h16*)(P.ws + OFF_WUVT) + (size_t)l * 8 * 64 * 128;
    const h16* sza = (const h16*)(P.ws + OFF_SZA); const h16* szg = (const h16*)(P.ws + OFF_SZG); const h16* og = (const h16*)(P.ws + OFF_QN);
    h16* omix = (h16*)(P.ws + OFF_OMIX);
#pragma unroll 1
    for (int h = 0; h < 8; ++h) {
        h16x8 bc[8];
#pragma unroll
        for (int ks = 0; ks < 8; ++ks) bc[ks] = *(const h16x8*)(ctx + rowc * 1024 + h * 128 + 16 * ks + 8 * hf);
        f32x16 ao[2];
#pragma unroll
        for (int mt = 0; mt < 2; ++mt)
#pragma unroll
            for (int r = 0; r < 16; ++r) ao[mt][r] = 0.f;
        const h16* wp = Wuv + (size_t)h * 64 * 128 + (size_t)tok * 128 + 8 * hf;
#pragma unroll
        for (int ks = 0; ks < 8; ++ks) {
            const h16x8 a0 = *(const h16x8*)(wp + 16 * ks), a1 = *(const h16x8*)(wp + 32 * 128 + 16 * ks);
            ao[0] = MFMA32(a0, bc[ks], ao[0]); ao[1] = MFMA32(a1, bc[ks], ao[1]);
        }
        if (ok) {
#pragma unroll
            for (int mt = 0; mt < 2; ++mt)
#pragma unroll
                for (int g = 0; g < 4; ++g) {
                    const int d0 = h * 64 + 32 * mt + 8 * g + 4 * hf;
                    const h16x4 z = *(const h16x4*)(sza + (size_t)row * 512 + d0);
                    h16x4 o;
#pragma unroll
                    for (int e = 0; e < 4; ++e) o[e] = (h16)(ao[mt][4 * g + e] * (float)z[e]);
                    *(h16x4*)(omix + (size_t)row * 1024 + d0) = o;
                }
        }
    }
    const float* go = P.g_out + l * 128;
#pragma unroll 1
    for (int h = 0; h < 4; ++h) {
        h16x8 v[8]; float ss = 0.f;
#pragma unroll
        for (int q = 0; q < 8; ++q) { v[q] = *(const h16x8*)(og + rowc * 512 + h * 128 + 64 * hf + 8 * q);
#pragma unroll
            for (int e = 0; e < 8; ++e) { const float f = (float)v[q][e]; ss += f * f; } }
        ss = half_sum(ss);
        const float rs = rsqrtf(ss * (1.f / 128.f) + EPS);
        if (ok) {
#pragma unroll
            for (int q = 0; q < 8; ++q) { const h16x8 z = *(const h16x8*)(szg + (size_t)row * 512 + h * 128 + 64 * hf + 8 * q); h16x8 o;
#pragma unroll
                for (int e = 0; e < 8; ++e) o[e] = (h16)((float)v[q][e] * rs * go[64 * hf + 8 * q + e] * (float)z[e]);
                *(h16x8*)(omix + (size_t)row * 1024 + 512 + h * 128 + 64 * hf + 8 * q) = o; }
        }
    }
}

__device__ __forceinline__ void phase2(const Params& P, int l, unsigned char* lds) {
    const int tid = opaque_tid(), lane = tid & 63, w = tid >> 6;
    unsigned* ctr = (unsigned*)(P.ws + OFF_CTL) + 16 + l;
    int* slot = (int*)(lds + LDS_BYTES - 32);
    for (int rep_ = 0; rep_ <= (PROBE_P2C | PROBE_CHAIN | PROBE_P2X); ++rep_) {
    for (;;) {
        __syncthreads();
        if (tid == 0) *slot = (int)__hip_atomic_fetch_add(ctr + 4 * rep_, 1u, __ATOMIC_RELAXED, __HIP_MEMORY_SCOPE_AGENT);
        __syncthreads();
        const int it = *slot;
        if (it >= NGI + 129) break;
        if (it >= 129) { if (!PROBE_CHAIN || rep_ == 0) { TSEC_BEGIN(6) p2c_item(P, l, it - 129, lds); TSEC_END(6); } }
        else if (!PROBE_P2C || rep_ == 0) {
            const int ci = it * 4 + w;
            __syncthreads();
            TSEC_BEGIN(7)
            if (ci < (NT + 31) / 32) chain_item(P, l, ci, (float*)lds + w * 1152, lane);
            TSEC_END(7);
        }
    }
    }
}

constexpr int SNT = 2;
__device__ __forceinline__ void gdn_scan(const Params& P, int sw, unsigned char* lds) {
    h16* St = (h16*)lds;
    h16* Vt = (h16*)(lds + 16 * SNT * 272);
    const int tid = opaque_tid(), lane = tid & 63, w = tid >> 6, gq = lane >> 4, c16 = lane & 15;
    const int chain = sw / (8 / SNT), e0 = (sw % (8 / SNT)) * 16 * SNT, b = chain >> 2, h = chain & 3;
    const h16* Ub = (const h16*)(P.ws + OFF_U); const h16* Wb = (const h16*)(P.ws + OFF_WM);
    const h16* Qb = (const h16*)(P.ws + OFF_QD); const h16* Kb = (const h16*)(P.ws + OFF_KDT);
    const h16* Ab = (const h16*)(P.ws + OFF_AQK); const float* cdec = (const float*)(P.ws + OFF_CDEC);
    h16* og = (h16*)(P.ws + OFF_QN);
    __syncthreads();
    for (int i = tid; i < 16 * SNT * 136; i += NTHREADS) St[i] = (h16)0.f;
    f32x4 S[2][SNT];
#pragma unroll
    for (int m2 = 0; m2 < 2; ++m2)
#pragma unroll
        for (int nt = 0; nt < SNT; ++nt) S[m2][nt] = (f32x4){0.f, 0.f, 0.f, 0.f};
    __syncthreads();
    h16x8 wf[2][4], qf[2][4], af[2][2], kf_[2][2][2]; h16 uv[2][SNT][4]; float cd[2];
#define SCAN_LOAD(S_, n_) do { const int nn_ = (n_) < NCH ? (n_) : NCH - 1; const size_t itm = (size_t)chain * NCH + nn_; \
        _Pragma("unroll") for (int ks = 0; ks < 4; ++ks) { wf[S_][ks] = *(const h16x8*)(Wb + itm * 8192 + (16 * w + c16) * 128 + 32 * ks + 8 * gq); qf[S_][ks] = *(const h16x8*)(Qb + itm * 8192 + (16 * w + c16) * 128 + 32 * ks + 8 * gq); } \
        _Pragma("unroll") for (int ks = 0; ks < 2; ++ks) { af[S_][ks] = *(const h16x8*)(Ab + itm * 4096 + (16 * w + c16) * 64 + 32 * ks + 8 * gq); \
            _Pragma("unroll") for (int m2 = 0; m2 < 2; ++m2) kf_[S_][m2][ks] = *(const h16x8*)(Kb + itm * 8192 + (16 * (2 * w + m2) + c16) * 64 + 32 * ks + 8 * gq); } \
        _Pragma("unroll") for (int nt = 0; nt < SNT; ++nt) _Pragma("unroll") for (int r = 0; r < 4; ++r) uv[S_][nt][r] = Ub[itm * 8192 + (16 * w + 4 * gq + r) * 128 + e0 + 16 * nt + c16]; \
        cd[S_] = cdec[itm]; } while (0)
#define SCAN_STEP(S_, n_) do { \
        h16x8 cwf[4], cqf[4], caf[2], ckf[2][2]; float cu[SNT][4]; const float ccd = cd[S_]; \
        _Pragma("unroll") for (int ks = 0; ks < 4; ++ks) { cwf[ks] = wf[S_][ks]; cqf[ks] = qf[S_][ks]; } \
        _Pragma("unroll") for (int ks = 0; ks < 2; ++ks) { caf[ks] = af[S_][ks]; ckf[0][ks] = kf_[S_][0][ks]; ckf[1][ks] = kf_[S_][1][ks]; } \
        _Pragma("unroll") for (int nt = 0; nt < SNT; ++nt) _Pragma("unroll") for (int r = 0; r < 4; ++r) cu[nt][r] = (float)uv[S_][nt][r]; \
        SCAN_LOAD(S_, (n_) + 2); \
        f32x4 Pm[SNT], O[SNT]; \
        _Pragma("unroll") for (int nt = 0; nt < SNT; ++nt) { Pm[nt] = (f32x4){0.f, 0.f, 0.f, 0.f}; O[nt] = (f32x4){0.f, 0.f, 0.f, 0.f}; \
            _Pragma("unroll") for (int ks = 0; ks < 4; ++ks) { const h16x8 bs = *(const h16x8*)(St + (16 * nt + c16) * 136 + 32 * ks + 8 * gq); Pm[nt] = MFMA16(cwf[ks], bs, Pm[nt]); O[nt] = MFMA16(cqf[ks], bs, O[nt]); } \
            h16x4 vn; \
            _Pragma("unroll") for (int r = 0; r < 4; ++r) vn[r] = (h16)(cu[nt][r] - Pm[nt][r]); \
            *(h16x4*)(Vt + (16 * nt + c16) * 72 + 16 * w + 4 * gq) = vn; } \
        lds_barrier(); \
        _Pragma("unroll") for (int nt = 0; nt < SNT; ++nt) { \
            _Pragma("unroll") for (int m2 = 0; m2 < 2; ++m2) _Pragma("unroll") for (int r = 0; r < 4; ++r) S[m2][nt][r] *= ccd; \
            _Pragma("unroll") for (int ks = 0; ks < 2; ++ks) { const h16x8 bv = *(const h16x8*)(Vt + (16 * nt + c16) * 72 + 32 * ks + 8 * gq); O[nt] = MFMA16(caf[ks], bv, O[nt]); S[0][nt] = MFMA16(ckf[0][ks], bv, S[0][nt]); S[1][nt] = MFMA16(ckf[1][ks], bv, S[1][nt]); } \
            _Pragma("unroll") for (int r = 0; r < 4; ++r) { const int t = 64 * (n_) + 16 * w + 4 * gq + r - 48; if (t >= 0) og[((size_t)b * T_ + t) * 512 + h * 128 + e0 + 16 * nt + c16] = (h16)(O[nt][r] * 0.08838834764831845f); } \
            _Pragma("unroll") for (int m2 = 0; m2 < 2; ++m2) { h16x4 sv; \
                _Pragma("unroll") for (int r = 0; r < 4; ++r) sv[r] = (h16)S[m2][nt][r]; \
                *(h16x4*)(St + (16 * nt + c16) * 136 + 16 * (2 * w + m2) + 4 * gq) = sv; } } \
        lds_barrier(); } while (0)
    SCAN_LOAD(0, 0); SCAN_LOAD(1, 1);
    for (int n = 0; n + 1 < NCH; n += 2) { SCAN_STEP(0, n); SCAN_STEP(1, n + 1); }
    SCAN_STEP(0, NCH - 1);
#undef SCAN_STEP
#undef SCAN_LOAD
}

constexpr int CAP = 704;
__device__ __forceinline__ void dma16_asm(const void* gptr, unsigned lds_addr) {
    unsigned sv; lds_addr = (unsigned)__builtin_amdgcn_readfirstlane((int)lds_addr);
    asm volatile("s_mov_b32 %0, m0\n\ts_mov_b32 m0, %2\n\ts_nop 0\n\tglobal_load_lds_dwordx4 %1, off\n\ts_mov_b32 m0, %0" : "=&s"(sv) : "v"(gptr), "s"(lds_addr) : "memory");
}
__device__ __forceinline__ int dpp_scan_incl(int x) {
    x += __builtin_amdgcn_update_dpp(0, x, 0x111, 0xf, 0xf, false);
    x += __builtin_amdgcn_update_dpp(0, x, 0x112, 0xf, 0xf, false);
    x += __builtin_amdgcn_update_dpp(0, x, 0x114, 0xf, 0xf, false);
    x += __builtin_amdgcn_update_dpp(0, x, 0x118, 0xf, 0xf, false);
    x += __builtin_amdgcn_update_dpp(0, x, 0x142, 0xa, 0xf, false);
    x += __builtin_amdgcn_update_dpp(0, x, 0x143, 0xc, 0xf, false);
    return x;
}

__device__ __forceinline__ int topk_prune(float* sc, unsigned short* ix, unsigned* hist, int c, int lane, int K, int limit, float& theta, float& theta_next) {
    constexpr int NE = (CAP + 63) / 64;
    unsigned key[NE]; unsigned short idx[NE]; float val[NE];
#pragma unroll
    for (int it = 0; it < NE; ++it) { const int i = lane + 64 * it; const bool v = i < c; const float f = v ? sc[i] : 0.f; val[it] = f; idx[it] = v ? ix[i] : (unsigned short)0; key[it] = v ? ordkey(f) : 0u; }
    unsigned prefix = 0; int need = K; int binpop = 0; bool exact = true; int sh = 0;
    const unsigned tb0 = (unsigned)__builtin_amdgcn_readfirstlane((int)(key[0] >> 24));
    bool same = true;
#pragma unroll
    for (int it = 0; it < NE; ++it) same = same && (key[it] == 0u || (key[it] >> 24) == tb0);
    const bool skip0 = __all(same);
    if (skip0) prefix = tb0 << 24;
#pragma unroll
    for (int r = 0; r < 4; ++r) {
        if (r == 0 && skip0) continue;
        const int shift = 24 - 8 * r;
        ((uint4*)hist)[lane] = make_uint4(0u, 0u, 0u, 0u);
        WAVE_FENCE();
#pragma unroll
        for (int it = 0; it < NE; ++it) {
            const bool m = (key[it] != 0u) && (r == 0 || ((key[it] ^ prefix) >> ((shift + 8) & 31)) == 0u);
            if (m) atomicAdd(&hist[(key[it] >> shift) & 255u], 1u);
        }
        WAVE_FENCE();
        const uint4 h4 = ((const uint4*)hist)[63 - lane];
        WAVE_FENCE();
        const int loc = (int)(h4.x + h4.y + h4.z + h4.w);
        const int incl = dpp_scan_incl(loc);
        const int c3 = incl - loc, c2 = c3 + (int)h4.w, c1 = c2 + (int)h4.z, c0 = c1 + (int)h4.y;
        int dsel = -1, cab = 0, hb = 0;
        if (c3 < need && need <= c3 + (int)h4.w) { dsel = 3; cab = c3; hb = (int)h4.w; }
        else if (c2 < need && need <= c2 + (int)h4.z) { dsel = 2; cab = c2; hb = (int)h4.z; }
        else if (c1 < need && need <= c1 + (int)h4.y) { dsel = 1; cab = c1; hb = (int)h4.y; }
        else if (c0 < need && need <= c0 + (int)h4.x) { dsel = 0; cab = c0; hb = (int)h4.x; }
        const u64 fm = __ballot(dsel >= 0);
        const int src = __builtin_amdgcn_readfirstlane(__ffsll((long long)fm) - 1);
        const int digit = __builtin_amdgcn_readlane(4 * (63 - lane) + dsel, src);
        const int cabv = __builtin_amdgcn_readlane(cab, src);
        binpop = __builtin_amdgcn_readlane(hb, src);
        need -= cabv; prefix |= (unsigned)digit << shift; sh = shift;
        if (r < 3 && (K - need) + binpop <= limit) { exact = false; break; }
    }
    (void)sh;
    const unsigned thr = prefix; int out = 0, tb = 0;
#pragma unroll
    for (int it = 0; it < NE; ++it) {
        const bool v = key[it] != 0u; const bool gt = v && key[it] > thr; const bool eq = v && key[it] == thr;
        bool keep;
        if (exact && K == 256) { const u64 meq = __ballot(eq); const int tr = tb + lanes_below(meq); keep = gt || (eq && tr < need); tb += __popcll(meq); }
        else keep = gt || eq;
        const u64 mk = __ballot(keep); const int slot = out + lanes_below(mk);
        if (keep) { sc[slot] = val[it]; ix[slot] = idx[it]; }
        out += __popcll(mk);
    }
    WAVE_FENCE();
    theta = ordinv(thr); theta_next = ordinv(thr + 1u);
    return out;
}

constexpr int WL_SC = 0;
constexpr int WL_IX = 8 * CAP * 4;
constexpr int WL_RING = 0;
constexpr int SLOT_BYTES = 8704;
constexpr int WL_SEL = 34816;
constexpr int WL_NSEL = 38912;
constexpr int WL_BYTES = 38944;
static_assert(WL_IX + 8 * CAP * 2 <= WL_SEL && 4 * SLOT_BYTES <= WL_SEL, "DSA LDS map");

__device__ __forceinline__ void dsa_item(const Params& P, int item, int qlo, int qhi, unsigned char* wl, const float* biasd, int lane) {
    float* sc = (float*)(wl + WL_SC);
    unsigned short* ix = (unsigned short*)(wl + WL_IX);
    unsigned* hist = (unsigned*)(wl + WL_SEL);
    unsigned short* sel = (unsigned short*)(wl + WL_SEL);
    int* nselL = (int*)(wl + WL_NSEL);
    unsigned char* ring = wl + WL_RING;
    const h16* qidx = (const h16*)(P.ws + OFF_QIDX);
    const float* small = (const float*)(P.ws + OFF_SMALL);
    const h16* kvrow = (const h16*)(P.ws + OFF_KVROW);
    const h16* qk = (const h16*)(P.ws + OFF_QK);
    h16* ctxb = (h16*)(P.ws + OFF_CTX);
    const int row0 = item * 8; const int b = row0 >= T_ ? 1 : 0; const int t0 = row0 - b * T_;
    const int half = lane >> 5, kl = lane & 31;
    WAVE_FENCE();
    TSEC_BEGIN(3)
    for (int rep_ = 0; rep_ <= (PROBE_TOPK2 | PROBE_SWEEP); ++rep_) {
        const bool dummy_ = PROBE_SWEEP && rep_ == 0;
        h16x8 afr[4];
        { const int qq = kl >> 2, hd = kl & 3; const h16* p = qidx + (size_t)(row0 + qq) * 256 + hd * 64 + 8 * half;
#pragma unroll
          for (int ks = 0; ks < 4; ++ks) afr[ks] = *(const h16x8*)(p + 16 * ks); }
        float wq[4][4]; float th[4]; int cnt[4];
#pragma unroll
        for (int g = 0; g < 4; ++g) { const float* sp = small + (size_t)(row0 + 2 * g + half) * 16;
#pragma unroll
            for (int hh = 0; hh < 4; ++hh) wq[g][hh] = sp[hh];
            const int qme = 2 * g + half; th[g] = (dummy_ || qme < qlo || qme >= qhi) ? INFINITY : -INFINITY; cnt[g] = 0; }
        const int ntiles = ((t0 + 7) >> 5) + 1;
        bool safe_ = false;
      redo_sweep:
        const h16* kfp = (const h16*)(P.ws + OFF_KFRAG) + (size_t)b * NKT * 2048 + lane * 8;
        h16x8 bt[8][4];
#pragma unroll
        for (int u = 0; u < 8; ++u) { const int tl = u < ntiles ? u : ntiles - 1;
#pragma unroll
            for (int ks = 0; ks < 4; ++ks) bt[u][ks] = *(const h16x8*)(kfp + (size_t)tl * 2048 + ks * 512); }
        const int ngroups = (ntiles + 3) >> 2;
#define SWEEP_GROUP(PAR) \
                f32x16 acc[4]; \
                _Pragma("unroll") for (int u = 0; u < 4; ++u) { \
                    _Pragma("unroll") for (int r = 0; r < 16; ++r) acc[u][r] = 0.f; \
                    _Pragma("unroll") for (int ks = 0; ks < 4; ++ks) acc[u] = MFMA32(afr[ks], bt[4 * (PAR) + u][ks], acc[u]); \
                    const int tn = tile0 + u + 8 < ntiles ? tile0 + u + 8 : ntiles - 1;     \
                    _Pragma("unroll") for (int ks = 0; ks < 4; ++ks) bt[4 * (PAR) + u][ks] = *(const h16x8*)(kfp + (size_t)tn * 2048 + ks * 512); } \
                _Pragma("unroll") for (int q = 0; q < 16; ++q) { __builtin_amdgcn_sched_group_barrier(0x8, 1, 0); __builtin_amdgcn_sched_group_barrier(0x20, 1, 0); }     \
                __builtin_amdgcn_sched_barrier(0);
        for (int grp = 0; grp <= ngroups; ++grp) {
            const bool last = grp == ngroups;
            if (!last) {
                const int tile0 = grp * 4;
                f32x16 accs[4];
                if (grp & 1) { SWEEP_GROUP(1) _Pragma("unroll") for (int u = 0; u < 4; ++u) accs[u] = acc[u]; }
                else { SWEEP_GROUP(0) _Pragma("unroll") for (int u = 0; u < 4; ++u) accs[u] = acc[u]; }
#pragma unroll
                for (int u = 0; u < 4; ++u) {
                    const int key = (tile0 + u) * 32 + kl;
#pragma unroll
                    for (int g = 0; g < 4; ++g) {
                        float s = 0.f;
#pragma unroll
                        for (int hh = 0; hh < 4; ++hh) s = fmaf(wq[g][hh], fmaxf(accs[u][4 * g + hh], 0.f), s);
                        const int tq = t0 + 2 * g + half;
                        const bool pass = (key <= tq) && (s >= th[g]);
                        const u64 m = __ballot(pass);
                        {
                            const unsigned lo = (unsigned)m, hi = (unsigned)(m >> 32);
                            const int off = half ? __builtin_amdgcn_mbcnt_hi(hi, 0) : __builtin_amdgcn_mbcnt_lo(lo, 0);
                            const int qq = 2 * g + half;
                            if (pass) { const int slot = cnt[g] + off; sc[qq * CAP + slot] = s; ix[qq * CAP + slot] = (unsigned short)key; }
                            cnt[g] += half ? __popc(hi) : __popc(lo);
                        }
                    }
                }
            }
            const int lim = last ? 256 : CAP - 128;
            if (__any((cnt[0] > lim) || (cnt[1] > lim) || (cnt[2] > lim) || (cnt[3] > lim))) {
                WAVE_FENCE();
#pragma unroll 1
                for (int qq = 0; qq < 8; ++qq) {
                    const int g = qq >> 1, hs = qq & 1;
                    const int cv = g == 0 ? cnt[0] : (g == 1 ? cnt[1] : (g == 2 ? cnt[2] : cnt[3]));
                    const int c = __builtin_amdgcn_readlane(cv, hs * 32);
                    if (c > lim) {
                        float nth, nthn;
                        const int nall = t0 + qq + 1; int nseen = (grp + 1) * 128; nseen = nseen < nall ? nseen : nall;
                        int K = 256;
                        if (!last && !safe_) { K = (int)(448.f * (float)nseen / (float)nall) + 16; K = K < 48 ? 48 : (K > 256 ? 256 : K); }
                        TSEC_BEGIN(1) TSEC_BEGIN(2)
                        const int nc = topk_prune(sc + qq * CAP, ix + qq * CAP, hist, c, lane, K, last ? 256 : K + 64, nth, nthn);
                        if (!last) TSEC_END(1); else TSEC_END(2);
                        float nv = K == 256 ? nthn : nth;
                        int ncf = nc;
                        if (K < 256 && nc > lim) {
                            ncf = topk_prune(sc + qq * CAP, ix + qq * CAP, hist, nc, lane, 256, 320, nth, nthn); nv = nthn;
                        }
#pragma unroll
                        for (int gg = 0; gg < 4; ++gg) if (gg == g && half == hs) { cnt[gg] = ncf; th[gg] = nv; }
                    }
                }
            }
        }
        {
            bool okq = true;
#pragma unroll
            for (int g = 0; g < 4; ++g) { const int qme = 2 * g + half; okq = okq && (qme < qlo || qme >= qhi || cnt[g] >= 256 || cnt[g] >= t0 + qme + 1); }
            if (!__all(okq) && !safe_ && !dummy_) {
                safe_ = true;
#pragma unroll
                for (int g = 0; g < 4; ++g) { const int qme = 2 * g + half; th[g] = (qme < qlo || qme >= qhi) ? INFINITY : -INFINITY; cnt[g] = 0; }
                WAVE_FENCE();
                goto redo_sweep;
            }
        }
#undef SWEEP_GROUP
        WAVE_FENCE();
#pragma unroll 1
        for (int qq = qlo; qq < (dummy_ ? 0 : qhi); ++qq) {
            const int g = qq >> 1, hs = qq & 1;
            const int cv = g == 0 ? cnt[0] : (g == 1 ? cnt[1] : (g == 2 ? cnt[2] : cnt[3]));
            const int c = __builtin_amdgcn_readlane(cv, hs * 32);
            if (lane == 0) nselL[qq] = c;
#pragma unroll
            for (int i4 = 0; i4 < 4; ++i4) { const int i = lane + 64 * i4; sel[qq * 256 + i] = i < c ? ix[qq * CAP + i] : (unsigned short)0; }
        }
        WAVE_FENCE();
    }
    TSEC_END(3);
    TSEC_BEGIN(4)
    const int gq = lane >> 4, c16 = lane & 15; const bool hv = c16 < 8;
    const unsigned ring_a = (unsigned)(size_t)(LAS unsigned char*)ring;
    const h16* kvb = kvrow + (size_t)b * T_ * 136;
    int poff[4];
#pragma unroll
    for (int i = 0; i < 4; ++i) poff[i] = (c16 ^ ((4 * i + gq) & 15)) * 8;
    const float b31 = biasd[127 * 8 + (c16 & 7)];
#define DSA_ISSUE(J_) do { const int jj_ = (J_) < 8 * qhi ? (J_) : 8 * qhi - 1; const unsigned short* sp_ = sel + (jj_ >> 3) * 256 + 32 * (jj_ & 7); \
        const h16* a_[8]; \
        _Pragma("unroll") for (int i = 0; i < 8; ++i) a_[i] = kvb + (size_t)sp_[4 * i + gq] * 136 + poff[i & 3]; \
        const h16* ar_ = kvb + (size_t)sp_[lane & 31] * 136 + 128; \
        const unsigned la_ = (unsigned)__builtin_amdgcn_readfirstlane((int)(ring_a + ((J_) & 3) * SLOT_BYTES)); unsigned sv_; unsigned long long ex_; \
        asm volatile("s_mov_b32 %0, m0\n\ts_mov_b32 m0, %2\n\ts_nop 0\n\t" \
            "global_load_lds_dwordx4 %3, off\n\ts_add_u32 m0, m0, 0x400\n\ts_nop 0\n\t" "global_load_lds_dwordx4 %4, off\n\ts_add_u32 m0, m0, 0x400\n\ts_nop 0\n\t" \
            "global_load_lds_dwordx4 %5, off\n\ts_add_u32 m0, m0, 0x400\n\ts_nop 0\n\t" "global_load_lds_dwordx4 %6, off\n\ts_add_u32 m0, m0, 0x400\n\ts_nop 0\n\t" \
            "global_load_lds_dwordx4 %7, off\n\ts_add_u32 m0, m0, 0x400\n\ts_nop 0\n\t" "global_load_lds_dwordx4 %8, off\n\ts_add_u32 m0, m0, 0x400\n\ts_nop 0\n\t" \
            "global_load_lds_dwordx4 %9, off\n\ts_add_u32 m0, m0, 0x400\n\ts_nop 0\n\t" "global_load_lds_dwordx4 %10, off\n\ts_add_u32 m0, m0, 0x400\n\ts_nop 0\n\t" \
            "s_mov_b64 %1, exec\n\ts_mov_b64 exec, 0xffffffff\n\tglobal_load_lds_dwordx4 %11, off\n\ts_mov_b64 exec, %1\n\ts_mov_b32 m0, %0" \
            : "=&s"(sv_), "=&s"(ex_) : "s"(la_), "v"(a_[0]), "v"(a_[1]), "v"(a_[2]), "v"(a_[3]), "v"(a_[4]), "v"(a_[5]), "v"(a_[6]), "v"(a_[7]), "v"(ar_) : "memory"); } while (0)
    for (int rep_ = 0; rep_ <= PROBE_ATT2; ++rep_) {
    asm volatile("s_waitcnt vmcnt(0) lgkmcnt(0)" ::: "memory");
    DSA_ISSUE(8 * qlo); DSA_ISSUE(8 * qlo + 1); DSA_ISSUE(8 * qlo + 2);
#pragma unroll 1
    for (int qq = qlo; qq < qhi; ++qq) {
        const int rowq = row0 + qq, tq = t0 + qq, ns = nselL[qq];
        const unsigned short* selq = sel + qq * 256;
        h16x8 qf[4];
#pragma unroll
        for (int ks = 0; ks < 4; ++ks) {
            if (hv) qf[ks] = *(const h16x8*)(qk + (size_t)rowq * 1024 + c16 * 128 + 32 * ks + 8 * gq);
            else {
#pragma unroll
                for (int e = 0; e < 8; ++e) qf[ks][e] = (h16)0.f;
            }
        }
        float m_run = -INFINITY, l_run = 0.f;
        f32x4 ctx[8];
#pragma unroll
        for (int nt = 0; nt < 8; ++nt) ctx[nt] = (f32x4){0.f, 0.f, 0.f, 0.f};
#pragma unroll 1
        for (int c = 0; c < 8; ++c) {
            const int j = 8 * qq + c;
            DSA_ISSUE(j + 3);
            asm volatile("s_waitcnt vmcnt(27)" ::: "memory");
            const unsigned char* sl = ring + (j & 3) * SLOT_BYTES;
            h16x8 af[2][4];
#pragma unroll
            for (int mt = 0; mt < 2; ++mt)
#pragma unroll
                for (int ks = 0; ks < 4; ++ks) af[mt][ks] = *(const h16x8*)(sl + (16 * mt + c16) * 256 + (((4 * ks + gq) ^ c16) * 16));
            fp16x4 rt[2]; ushort4 sv[2];
#pragma unroll
            for (int mt = 0; mt < 2; ++mt) {
                rt[mt] = __builtin_amdgcn_ds_read_tr16_b64_v4f16((LAS fp16x4*)(sl + 8192 + (16 * mt + 4 * gq + (c16 >> 2)) * 16 + 8 * (c16 & 3)));
                sv[mt] = *(const ushort4*)(selq + 32 * c + 16 * mt + 4 * gq);
            }
            fp16x4 tb[8][2];
            { const int rw0 = 4 * gq + (c16 >> 2), rw1 = 16 + rw0;
#pragma unroll
              for (int nt = 0; nt < 8; ++nt) { const int pc = 2 * nt + ((c16 >> 1) & 1);
                tb[nt][0] = __builtin_amdgcn_ds_read_tr16_b64_v4f16((LAS fp16x4*)(sl + rw0 * 256 + ((pc ^ (rw0 & 15)) * 16) + 8 * (c16 & 1)));
                tb[nt][1] = __builtin_amdgcn_ds_read_tr16_b64_v4f16((LAS fp16x4*)(sl + rw1 * 256 + ((pc ^ (rw1 & 15)) * 16) + 8 * (c16 & 1))); } }
            f32x4 s4[2];
#pragma unroll
            for (int mt = 0; mt < 2; ++mt) { s4[mt] = (f32x4){0.f, 0.f, 0.f, 0.f};
#pragma unroll
                for (int ks = 0; ks < 4; ++ks) s4[mt] = MFMA16(af[mt][ks], qf[ks], s4[mt]); }
            int dist[2][4]; int dmin = 127;
#pragma unroll
            for (int mt = 0; mt < 2; ++mt) { const int sarr[4] = {(int)sv[mt].x, (int)sv[mt].y, (int)sv[mt].z, (int)sv[mt].w};
#pragma unroll
                for (int r = 0; r < 4; ++r) { int d = tq - sarr[r]; d = d < 0 ? 0 : (d > 127 ? 127 : d); dist[mt][r] = d; dmin = d < dmin ? d : dmin; } }
            float bias[2][4];
            if (__all(dmin == 127)) {
#pragma unroll
                for (int mt = 0; mt < 2; ++mt)
#pragma unroll
                    for (int r = 0; r < 4; ++r) bias[mt][r] = b31;
            } else {
#pragma unroll
                for (int mt = 0; mt < 2; ++mt)
#pragma unroll
                    for (int r = 0; r < 4; ++r) bias[mt][r] = biasd[dist[mt][r] * 8 + (c16 & 7)];
            }
            float lg[2][4]; float mx = -INFINITY;
#pragma unroll
            for (int mt = 0; mt < 2; ++mt) { const h16x4 rr = __builtin_bit_cast(h16x4, rt[mt]);
#pragma unroll
                for (int r = 0; r < 4; ++r) {
                    const int kidx = 32 * c + 16 * mt + 4 * gq + r; const bool valid = hv && (kidx < ns);
                    const float v = valid ? s4[mt][r] * (float)rr[r] + bias[mt][r] : -INFINITY;
                    lg[mt][r] = v; mx = fmaxf(mx, v);
                } }
            {
                const unsigned u0 = __float_as_uint(mx);
                const auto p16 = __builtin_amdgcn_permlane16_swap(u0, u0, false, false);
                const float y = fmaxf(__uint_as_float(p16[0]), __uint_as_float(p16[1]));
                const unsigned u1 = __float_as_uint(y);
                const auto p32 = __builtin_amdgcn_permlane32_swap(u1, u1, false, false);
                mx = fmaxf(__uint_as_float(p32[0]), __uint_as_float(p32[1]));
            }
            const float m_new = fmaxf(m_run, mx);
            const float alpha = (hv && m_new > -INFINITY) ? __expf(m_run - m_new) : 1.f;
            float rs = 0.f; float pp[2][4];
#pragma unroll
            for (int mt = 0; mt < 2; ++mt)
#pragma unroll
                for (int r = 0; r < 4; ++r) { const float p = (hv && lg[mt][r] > -INFINITY) ? __expf(lg[mt][r] - m_new) : 0.f; pp[mt][r] = p; rs += p; }
            {
                const unsigned u0 = __float_as_uint(rs);
                const auto p16 = __builtin_amdgcn_permlane16_swap(u0, u0, false, false);
                const float y = __uint_as_float(p16[0]) + __uint_as_float(p16[1]);
                const unsigned u1 = __float_as_uint(y);
                const auto p32 = __builtin_amdgcn_permlane32_swap(u1, u1, false, false);
                rs = __uint_as_float(p32[0]) + __uint_as_float(p32[1]);
            }
            l_run = l_run * alpha + rs; m_run = m_new;
            h16x8 pa;
#pragma unroll
            for (int jx = 0; jx < 8; ++jx) pa[jx] = (h16)pp[jx >> 2][jx & 3];
            if (__any(alpha != 1.f)) {
                float ar[4];
#pragma unroll
                for (int r = 0; r < 4; ++r) ar[r] = __shfl(alpha, 4 * gq + r);
#pragma unroll
                for (int nt = 0; nt < 8; ++nt)
#pragma unroll
                    for (int r = 0; r < 4; ++r) ctx[nt][r] *= ar[r];
            }
#pragma unroll
            for (int nt = 0; nt < 8; ++nt) {
                const h16x4 b0 = __builtin_bit_cast(h16x4, tb[nt][0]), b1 = __builtin_bit_cast(h16x4, tb[nt][1]);
                h16x8 bf; bf[0] = b0[0]; bf[1] = b0[1]; bf[2] = b0[2]; bf[3] = b0[3]; bf[4] = b1[0]; bf[5] = b1[1]; bf[6] = b1[2]; bf[7] = b1[3];
                ctx[nt] = MFMA16(pa, bf, ctx[nt]);
            }
        }
        float li[4];
#pragma unroll
        for (int r = 0; r < 4; ++r) li[r] = 1.f / __shfl(l_run, (4 * gq + r) & 7);
        if (gq < 2) {
#pragma unroll
            for (int nt = 0; nt < 8; ++nt)
#pragma unroll
                for (int r = 0; r < 4; ++r) ctxb[(size_t)rowq * 1024 + (4 * gq + r) * 128 + 16 * nt + c16] = (h16)(ctx[nt][r] * li[r]);
        }
    }
    asm volatile("s_waitcnt vmcnt(0)" ::: "memory");
    }
#undef DSA_ISSUE
    WAVE_FENCE();
    TSEC_END(4);
}

__device__ __forceinline__ void phase3(const Params& P, int l, unsigned char* lds) {
    const int tid = opaque_tid(), lane = tid & 63, w = tid >> 6;
    float* biasd = (float*)(lds + 4 * WL_BYTES);
    __syncthreads();
    for (int i = tid; i < 1024; i += NTHREADS) biasd[i] = P.rel[(int)c_bucket[i >> 3] * 8 + (i & 7)];
    __syncthreads();
    { TSEC_BEGIN(10)
    for (int rep_ = 0; rep_ <= PROBE_SCAN2; ++rep_) for (int sw = blockIdx.x; sw < 8 * (8 / SNT); sw += gridDim.x) gdn_scan(P, sw, lds);
    TSEC_END(10); }
    __syncthreads();
    unsigned* ctr = (unsigned*)(P.ws + OFF_CTL) + 4608 + l * 128;
    unsigned char* wl = lds + w * WL_BYTES;
    const int x0 = (int)xb_xcc_id() & 7; int d = 0;
    for (;;) {
        int item = -1;
        if (lane == 0) {
            while (d < 8) {
                const int xc = (x0 + d) & 7; const int bb = xc >> 2, sub = xc & 3; const int cnt = (1026 - sub + 3) >> 2;
                const int pf = 230;
                const int t = (int)__hip_atomic_fetch_add(ctr + xc * 16, 1u, __ATOMIC_RELAXED, __HIP_MEMORY_SCOPE_AGENT);
                if (t < pf + 2 * (cnt - pf)) {
                    const int p = t < pf ? t : pf + ((t - pf) >> 1);
                    item = (bb * 1026 + 4 * (cnt - 1 - p) + sub) * 4 + (t < pf ? 0 : 1 + ((t - pf) & 1));
                    break;
                }
                ++d;
            }
        }
        d = __builtin_amdgcn_readfirstlane(d);
        item = __builtin_amdgcn_readfirstlane(item);
        if (item < 0) break;
        { const int hsel = item & 3; dsa_item(P, item >> 2, hsel == 2 ? 4 : 0, hsel == 1 ? 4 : 8, wl, biasd, lane); }
    }
}

__device__ __forceinline__ void phase4(const Params& P, int l, unsigned char* lds) {
    const int tid = opaque_tid(), lane = tid & 63, w = tid >> 6;
    (void)lds;
    if (l == 0 && (int)gridDim.x > 160 && (int)blockIdx.x >= 129) { prep_tiles(P, lds, 1, 129, (int)gridDim.x - 129); return; }
    TSEC_BEGIN(11)
    for (int it = blockIdx.x * 4 + w; it < (NT + 31) / 32; it += gridDim.x * 4) p4_item(P, l, it, lane);
    TSEC_END(11);
    if (l == 0 && (int)gridDim.x <= 160) { __syncthreads(); prep_tiles(P, lds, 1, 0, (int)gridDim.x); }
}

__device__ __forceinline__ void phase5(const Params& P, int l, unsigned char* lds) {
    h16* smem = (h16*)lds;
    const h16* W = (const h16*)(P.ws + OFF_WOT) + (size_t)l * 1024 * 1024;
    const h16* A = (const h16*)(P.ws + OFF_OMIX);
    float* sumsq_next = (float*)(P.ws + OFF_SUMSQ) + NTP;
    XcdQueue xq; xq.init((unsigned*)(P.ws + OFF_CTL) + 4352 + l * 128, 32, (int*)(lds + LDS_BYTES - 32));
    int xl, qi;
    while (xq.next(xl, qi)) {
        const int rb = 8 * xl + (qi & 7), tn = qi >> 3;
        EpiResBig ep; ep.layer = l; ep.row0 = rb * 256; ep.n0 = tn * 256; ep.meta = P.meta; ep.x = P.x; ep.metah = (float*)(P.ws + OFF_METAH); ep.out = P.out; ep.h16o = (h16*)(P.ws + OFF_H16); ep.sumsq_next = sumsq_next; ep.ss = 0.f; ep.nseg = 4;
        gemm_big(A + (size_t)rb * 256 * 1024, 1024, W + (size_t)tn * 256 * 1024, 1024, 1024, ep, smem);
    }
    __syncthreads();
    const int tid = opaque_tid();
    for (int it = blockIdx.x; it < 32; it += gridDim.x) {
        EpiResBig ep; ep.layer = l; ep.row0 = 16384; ep.n0 = it * 32; ep.meta = P.meta; ep.x = P.x; ep.metah = (float*)(P.ws + OFF_METAH); ep.out = P.out; ep.h16o = (h16*)(P.ws + OFF_H16); ep.sumsq_next = sumsq_next; ep.ss = 0.f; ep.nseg = 1;
        skinny_tile(A + (size_t)16384 * 1024, 1024, W + (size_t)it * 32 * 1024, 1024, 1024, ep, (float*)lds, tid);
    }
}

__global__ void __launch_bounds__(NTHREADS) hybrid_fwd(Params P) {
    extern __shared__ __attribute__((aligned(16))) unsigned char lds[];
    cg::grid_group grid = cg::this_grid();
    volatile LAS unsigned* bst = (volatile LAS unsigned*)(lds + LDS_BYTES - 16);
    if (threadIdx.x < 4) bst[threadIdx.x] = 0u;
    if (PROBE_TSEC && (threadIdx.x & 63) == 0) *tsec_slot() = 0ull;
    __syncthreads();
    XcdBarrier xbar = xcd_barrier_post((unsigned*)(P.ws + OFF_CTL) + 256, bst);
    if (PROBE_MFMA) {
        f32x16 pa[8]; h16x8 fa, fb;
#pragma unroll
        for (int e = 0; e < 8; ++e) { fa[e] = (h16)(0.001f * (threadIdx.x & 7)); fb[e] = (h16)0.5f; }
#pragma unroll
        for (int i = 0; i < 8; ++i)
#pragma unroll
            for (int r = 0; r < 16; ++r) pa[i][r] = 0.f;
        h16* lp = (h16*)lds + (threadIdx.x & 31) * 72 + 8 * ((threadIdx.x >> 5) & 1) + (threadIdx.x >> 6) * 2304;
#pragma unroll 1
        for (int it = 0; it < 256; ++it) {
            if (PROBE_MFMA == 2) {
                h16x8 t[8];
#pragma unroll
                for (int q = 0; q < 8; ++q) t[q] = *(const h16x8*)(lp + q * 32 * 72 + (it & 3) * 16);
#pragma unroll
                for (int q = 0; q < 4; ++q) *(h16x8*)(lp + 40000 + q * 32 * 72) = fb;
#pragma unroll
                for (int i = 0; i < 16; ++i) pa[i & 7] = MFMA32(t[i & 7], fb, pa[i & 7]);
#pragma unroll
                for (int q = 0; q < 12; ++q) { __builtin_amdgcn_sched_group_barrier(0x8, 1, 0); __builtin_amdgcn_sched_group_barrier(0x300, 1, 0); }
                __builtin_amdgcn_sched_group_barrier(0x8, 4, 0);
                __builtin_amdgcn_sched_barrier(0);
            } else {
#pragma unroll
                for (int i = 0; i < 16; ++i) pa[i & 7] = MFMA32(fa, fb, pa[i & 7]);
            }
        }
        float sacc = 0.f;
#pragma unroll
        for (int i = 0; i < 8; ++i) sacc += pa[i][0];
        if (sacc == 12345.678f) ((float*)(P.ws + OFF_CTL))[40] = sacc;
    }
    for (int ph = P.ph_lo; ph < P.ph_hi; ++ph) {
#ifndef ONLY
#define ONLY -1
#endif
        if (ph == 0) { TSEC_BEGIN(13) if (ONLY < 0 || ((ONLY >> 0) & 1)) for (int rep_ = 0; rep_ <= PROBE_P0X; ++rep_) phase_prep(P, lds); TSEC_END(13); }
        else {
            const int l = (ph - 1) / 5, s = (ph - 1) % 5;
            if (s == 0) { if (ONLY < 0 || ((ONLY >> 1) & 1)) for (int rep_ = 0; rep_ <= PROBE_P1X; ++rep_) phase_inproj(P, l, lds, rep_); }
            else if (s == 1) { if (ONLY < 0 || ((ONLY >> 2) & 1)) phase2(P, l, lds); }
            else if (s == 2) { if (ONLY < 0 || ((ONLY >> 3) & 1)) phase3(P, l, lds); }
            else if (s == 3) { if (ONLY < 0 || ((ONLY >> 4) & 1)) for (int rep_ = 0; rep_ <= PROBE_P4X; ++rep_) phase4(P, l, lds); }
            else { if (ONLY < 0 || ((ONLY >> 5) & 1)) for (int rep_ = 0; rep_ <= (l == 0 ? PROBE_P5L0X : 0); ++rep_) phase5(P, l, lds); }
        }
        if (ph + 1 < P.ph_hi) {
            if (P.ph_hi > 1000) grid.sync();
            { TSEC_BEGIN(20) if (PROBE_TSEC >= 20 && PROBE_TSEC - 20 == ph) t__20 = wall_clock64(); xcd_barrier(xbar); if (PROBE_TSEC >= 20 && PROBE_TSEC - 20 == ph) { const unsigned long long d__ = wall_clock64() - t__20; if ((threadIdx.x & 63) == 0) *tsec_slot() += d__; } }
            if (PROBE_SYNC) xcd_barrier(xbar);
        }
    }
    if (PROBE_TSEC) {
        unsigned long long* acc = (unsigned long long*)((unsigned*)(P.ws + OFF_CTL) + 32);
        __syncthreads();
        if ((threadIdx.x & 63) == 0) atomicAdd(acc, *tsec_slot());
        xcd_barrier(xbar);
        if (blockIdx.x == 0 && threadIdx.x == 0) {
            const unsigned long long tot = __hip_atomic_load(acc, __ATOMIC_RELAXED, __HIP_MEMORY_SCOPE_AGENT);
            const unsigned long long avg = tot / (gridDim.x * 4);
            const unsigned long long t0 = wall_clock64();
            while (wall_clock64() - t0 < avg) __builtin_amdgcn_s_sleep(4);
        }
    }
}

extern "C" void kernel_launch(void* const* d_in, const int* in_sizes, int n_in, void* d_out, int out_size, void* d_ws, size_t ws_size, hipStream_t stream) {
    static int grid_blocks = 0;
    if (grid_blocks == 0) {
        if (n_in != 17 || ws_size < WS_END) { fprintf(stderr, "kernel_launch: unexpected inputs (n_in %d, ws %zu < %zu)\n", n_in, ws_size, (size_t)WS_END); grid_blocks = -1; return; }
        int dev = 0, cus = 0, per_cu = 0;
        hipGetDevice(&dev);
        hipDeviceGetAttribute(&cus, hipDeviceAttributeMultiprocessorCount, dev);
        if (hipFuncSetAttribute((const void*)hybrid_fwd, hipFuncAttributeMaxDynamicSharedMemorySize, LDS_BYTES) != hipSuccess) { fprintf(stderr, "kernel_launch: hipFuncSetAttribute failed\n"); grid_blocks = -1; return; }
        hipOccupancyMaxActiveBlocksPerMultiprocessor(&per_cu, (const void*)hybrid_fwd, NTHREADS, LDS_BYTES);
        if (per_cu < 1) { fprintf(stderr, "kernel_launch: occupancy query says 0 blocks per CU\n"); grid_blocks = -1; return; }
        grid_blocks = cus * per_cu;
    }
    if (grid_blocks < 0) return;
    hipMemsetAsync((char*)d_ws + OFF_CTL, 0, 32768, stream);
    hipMemsetAsync((char*)d_ws + OFF_SUMSQ, 0, (size_t)2 * NTP * 4, stream);
    Params p{};
    p.x = (const float*)d_in[0]; p.meta = (const float*)d_in[1]; p.rel = (const float*)d_in[2]; p.norm_gain = (const float*)d_in[3];
    p.w_in = (const float*)d_in[4]; p.g_cq = (const float*)d_in[5]; p.g_ckv = (const float*)d_in[6]; p.w_uq = (const float*)d_in[7];
    p.w_ukv = (const float*)d_in[8]; p.w_qidx = (const float*)d_in[9]; p.g_qn = (const float*)d_in[10]; p.g_kn = (const float*)d_in[11];
    p.conv_w = (const float*)d_in[12]; p.a_log = (const float*)d_in[13]; p.dt_bias = (const float*)d_in[14]; p.g_out = (const float*)d_in[15];
    p.w_out = (const float*)d_in[16];
    p.out = (float*)d_out; p.ws = (unsigned char*)d_ws;
#if N_LAUNCH_MODE == 1
    p.ph_lo = 0; p.ph_hi = NPHASE;
    void* args[] = {&p};
    hipError_t e = hipLaunchCooperativeKernel((const void*)hybrid_fwd, dim3(grid_blocks), dim3(NTHREADS), args, LDS_BYTES, stream);
    if (e != hipSuccess) fprintf(stderr, "cooperative launch failed: %s (grid %d)\n", hipGetErrorString(e), grid_blocks);
#else
    for (int ph = 0; ph < NPHASE; ++ph) {
        p.ph_lo = ph; p.ph_hi = ph + 1;
        hipLaunchKernelGGL(hybrid_fwd, dim3(grid_blocks), dim3(NTHREADS), LDS_BYTES, stream, p);
    }
#endif
}
```

```cpp
#include <hip/hip_runtime.h>
#include <hip/hip_cooperative_groups.h>
#include <stdio.h>
#include <stdint.h>
namespace cg = cooperative_groups;

#define PROBE_TOPK2 0
#define PROBE_ATT2 0
#define PROBE_P1X 0
#define PROBE_P2X 0
#define PROBE_SCAN2 0
#define PROBE_P4X 0
#define PROBE_P0X 0
#define PROBE_P5L0X 0
#define PROBE_SYNC 0
#define PROBE_SWEEP 0
#define PROBE_P2C 0
#define PROBE_CHAIN 0
#define PROBE_MFMA 0
#define PROBE_TSEC 0
#define PROBE_S1 0
#define PROBE_S3 0
#define PROBE_S5 0
#ifndef N_LAUNCH_MODE
#define N_LAUNCH_MODE 1
#endif

typedef _Float16 h16;
typedef h16 h16x8 __attribute__((ext_vector_type(8)));
typedef h16 h16x4 __attribute__((ext_vector_type(4)));
typedef float f32x4 __attribute__((ext_vector_type(4)));
typedef float f32x16 __attribute__((ext_vector_type(16)));
typedef unsigned long long u64;
typedef __fp16 fp16x4 __attribute__((__vector_size__(4 * sizeof(__fp16))));

#define MFMA32(a, b, c) __builtin_amdgcn_mfma_f32_32x32x16_f16(a, b, c, 0, 0, 0)
#define MFMA16(a, b, c) __builtin_amdgcn_mfma_f32_16x16x32_f16(a, b, c, 0, 0, 0)
#define WAVE_FENCE() do { __builtin_amdgcn_fence(__ATOMIC_SEQ_CST, "wavefront"); __builtin_amdgcn_wave_barrier(); } while (0)

constexpr int T_ = 8208;
constexpr int NT = 16416;
constexpr int NTP = 16512;
constexpr int NRB = 129;
constexpr int NCH = 129;
constexpr int NGI = 8 * NCH;
constexpr int NKT = 257;
constexpr float EPS = 1e-6f;
constexpr int NTHREADS = 256;
constexpr int LDS_BYTES = 163840;
constexpr int NPHASE = 11;

constexpr size_t OFF_CTL = 0;
constexpr size_t OFF_W1T = 32768;
constexpr size_t OFF_WOT = OFF_W1T + (size_t)2 * 3072 * 1024 * 2;
constexpr size_t OFF_WQ2T = OFF_WOT + (size_t)2 * 1024 * 1024 * 2;
constexpr size_t OFF_WUKT = OFF_WQ2T + (size_t)2 * 768 * 256 * 2;
constexpr size_t OFF_WKABS = OFF_WUKT + (size_t)2 * 512 * 128 * 2;
constexpr size_t OFF_WUVT = OFF_WKABS + (size_t)2 * 8 * 128 * 64 * 2;
constexpr size_t OFF_SMALL = OFF_WUVT + (size_t)2 * 8 * 64 * 128 * 2;
constexpr size_t OFF_SZA = OFF_SMALL + (size_t)NTP * 16 * 4;
constexpr size_t OFF_SZG = OFF_SZA + (size_t)NTP * 512 * 2;
constexpr size_t OFF_PROJG = OFF_SZG + (size_t)NTP * 512 * 2;
constexpr size_t OFF_PROJA = OFF_PROJG + (size_t)NTP * 1536 * 2;
constexpr size_t OFF_QIDX = OFF_PROJA + (size_t)NTP * 512 * 2;
constexpr size_t OFF_QN = OFF_QIDX + (size_t)NTP * 256 * 2;
constexpr size_t OFF_QK = OFF_QN + (size_t)NTP * 512 * 2;
constexpr size_t OFF_KVROW = OFF_QK + (size_t)NTP * 1024 * 2;
constexpr size_t OFF_KFRAG = OFF_KVROW + (size_t)NTP * 136 * 2;
constexpr size_t OFF_U = OFF_KFRAG + (size_t)2 * NKT * 2048 * 2;
constexpr size_t OFF_WM = OFF_U + (size_t)NGI * 8192 * 2;
constexpr size_t OFF_QD = OFF_WM + (size_t)NGI * 8192 * 2;
constexpr size_t OFF_KDT = OFF_QD + (size_t)NGI * 8192 * 2;
constexpr size_t OFF_AQK = OFF_KDT + (size_t)NGI * 8192 * 2;
constexpr size_t OFF_CDEC = OFF_AQK + (size_t)NGI * 4096 * 2;
constexpr size_t OFF_METAH = OFF_CDEC + 8192;
constexpr size_t OFF_SUMSQ = OFF_METAH + (size_t)2 * 16 * 1024 * 4;
constexpr size_t WS_END = OFF_SUMSQ + (size_t)2 * NTP * 4;
constexpr size_t OFF_H16 = OFF_QK;
constexpr size_t OFF_CTX = OFF_PROJG;
constexpr size_t OFF_OMIX = OFF_PROJG + (size_t)NTP * 1024 * 2;

struct Params {
    const float* x; const float* meta; const float* rel; const float* norm_gain; const float* w_in;
    const float* g_cq; const float* g_ckv; const float* w_uq; const float* w_ukv; const float* w_qidx;
    const float* g_qn; const float* g_kn; const float* conv_w; const float* a_log; const float* dt_bias;
    const float* g_out; const float* w_out;
    float* out; unsigned char* ws;
    int ph_lo, ph_hi;
};

__constant__ unsigned char c_bucket[128] = {
    0, 1, 2, 3, 4, 5, 6, 7, 8, 9, 10, 11, 12, 13, 14, 15, 16, 16, 16, 17, 17, 18, 18, 18, 19, 19, 19, 20, 20, 20, 20, 21,
    21, 21, 21, 22, 22, 22, 22, 22, 23, 23, 23, 23, 23, 23, 24, 24, 24, 24, 24, 24, 25, 25, 25, 25, 25, 25, 25, 26, 26, 26, 26, 26,
    26, 26, 26, 27, 27, 27, 27, 27, 27, 27, 27, 27, 27, 28, 28, 28, 28, 28, 28, 28, 28, 28, 28, 29, 29, 29, 29, 29, 29, 29, 29, 29,
    29, 29, 29, 30, 30, 30, 30, 30, 30, 30, 30, 30, 30, 30, 30, 30, 30, 31, 31, 31, 31, 31, 31, 31, 31, 31, 31, 31, 31, 31, 31, 31};

__device__ __forceinline__ unsigned long long* tsec_slot() { extern __shared__ __attribute__((aligned(16))) unsigned char tsec_lds__[]; return (unsigned long long*)(tsec_lds__ + LDS_BYTES - 128) + (threadIdx.x >> 6); }
#define TSEC_BEGIN(id) unsigned long long t__##id = 0; if (PROBE_TSEC == (id)) t__##id = wall_clock64();
#define TSEC_END(id) do { if (PROBE_TSEC == (id)) { const unsigned long long d__ = wall_clock64() - t__##id; if ((threadIdx.x & 63) == 0) *tsec_slot() += d__; } } while (0)
__device__ __forceinline__ float silu_f(float x) { return x * __builtin_amdgcn_rcpf(1.f + __expf(-x)); }
__device__ __forceinline__ int lanes_below(u64 m) { return __builtin_amdgcn_mbcnt_hi((unsigned)(m >> 32), __builtin_amdgcn_mbcnt_lo((unsigned)m, 0)); }
__device__ __forceinline__ int lanes_below_from(u64 m, int base) { return __builtin_amdgcn_mbcnt_hi((unsigned)(m >> 32), __builtin_amdgcn_mbcnt_lo((unsigned)m, base)); }
__device__ __forceinline__ float relu1(float x) { const int i = __float_as_int(x); return __int_as_float(i > 0 ? i : 0); }
__device__ __forceinline__ unsigned ordkey(float f) { unsigned u = __float_as_uint(f); return (u & 0x80000000u) ? ~u : (u | 0x80000000u); }
__device__ __forceinline__ float ordinv(unsigned k) { unsigned u = (k & 0x80000000u) ? (k & 0x7fffffffu) : ~k; return __uint_as_float(u); }
__device__ __forceinline__ int opaque_tid() { int t = threadIdx.x; asm volatile("" : "+v"(t)); return t; }
__device__ __forceinline__ void lds_barrier() { asm volatile("s_waitcnt lgkmcnt(0)\n\ts_barrier" ::: "memory"); }

#define XB_TMO      128
#define XB_XCNT(j)  (256  + 64 * (j))
#define XB_XSUB(j)  (1280 + 64 * (j))
#define XB_XGEN(j)  (2304 + 64 * (j))
#define XB_TOP      3328
#define XB_TOPGEN   3392
#define XCD_BAR_WORDS 3456
#define XB_SPIN_CAP (1u << 22)
#define LAS __attribute__((address_space(3)))
__device__ __forceinline__ unsigned xb_ld(unsigned* p)              { return __hip_atomic_load(p, __ATOMIC_RELAXED, __HIP_MEMORY_SCOPE_AGENT); }
__device__ __forceinline__ unsigned xb_add(unsigned* p, unsigned v) { return __hip_atomic_fetch_add(p, v, __ATOMIC_RELAXED, __HIP_MEMORY_SCOPE_AGENT); }
__device__ __forceinline__ unsigned xb_xcc_id() { return (unsigned)__builtin_amdgcn_s_getreg((3 << 11) | 20) & 0xFu; }
#define XB_SPIN(cond, bar) do { unsigned _sp = 0; while (cond) { __builtin_amdgcn_s_sleep(1); \
    if ((++_sp & 255u) == 0u) { if (xb_ld(&(bar)[XB_TMO])) break; if (_sp > XB_SPIN_CAP) { atomicAdd(&(bar)[XB_TMO], 1u); break; } } } } while (0)
struct XcdBarrier { unsigned* bar; unsigned x; volatile LAS unsigned* st; };
__device__ __forceinline__ XcdBarrier xcd_barrier_post(unsigned* bar, volatile LAS unsigned* st) {
    XcdBarrier b; b.bar = bar; b.x = xb_xcc_id(); b.st = st;
    if (threadIdx.x == 0) (void)xb_add(&bar[XB_XCNT(b.x)], 1u);
    return b;
}
__device__ __forceinline__ void xcd_barrier_complete(unsigned* bar, unsigned x, unsigned& nloc, unsigned& nx) {
    const unsigned G = gridDim.x * gridDim.y * gridDim.z;
    unsigned sum, cnt, mine, sp = 0u;
    for (;;) {
        sum = 0u; cnt = 0u; mine = 0u;
#pragma unroll
        for (unsigned j = 0; j < 16; ++j) { const unsigned c = xb_ld(&bar[XB_XCNT(j)]); sum += c; cnt += (c > 0u) ? 1u : 0u; mine = (j == x) ? c : mine; }
        if (sum == G) break;
        __builtin_amdgcn_s_sleep(1);
        if ((++sp & 255u) == 0u) { if (xb_ld(&bar[XB_TMO])) break; if (sp > XB_SPIN_CAP) { atomicAdd(&bar[XB_TMO], 1u); break; } }
    }
    nloc = mine > 0u ? mine : 1u; nx = cnt > 0u ? cnt : 1u;
}
__device__ __forceinline__ void xcd_barrier(const XcdBarrier& b) {
    TSEC_BEGIN(5)
    asm volatile("s_waitcnt vmcnt(0)" ::: "memory");
    __syncthreads();
    if (threadIdx.x == 0) {
        unsigned* bar = b.bar;
        __builtin_amdgcn_s_waitcnt(0);
        unsigned nloc = b.st[0], nx = b.st[1];
        if (nloc == 0u) { xcd_barrier_complete(bar, b.x, nloc, nx); b.st[0] = nloc; b.st[1] = nx; }
        const unsigned old = xb_add(&bar[XB_XSUB(b.x)], 1u);
        const unsigned gen = old / nloc;
        if (old + 1u == (gen + 1u) * nloc) {
            __builtin_amdgcn_fence(__ATOMIC_RELEASE, "agent");
            asm volatile("s_waitcnt vmcnt(0)" ::: "memory");
            const unsigned og = xb_add(&bar[XB_TOP], 1u);
            const unsigned tg = og / nx;
            if (og + 1u == (tg + 1u) * nx) xb_add(&bar[XB_TOPGEN], 1u);
            else XB_SPIN(xb_ld(&bar[XB_TOPGEN]) == tg, bar);
            __builtin_amdgcn_fence(__ATOMIC_ACQUIRE, "agent");
            xb_add(&bar[XB_XGEN(b.x)], 1u);
            asm volatile("s_waitcnt vmcnt(0)" ::: "memory");
        } else {
            XB_SPIN(xb_ld(&bar[XB_XGEN(b.x)]) == gen, bar);
            __builtin_amdgcn_fence(__ATOMIC_ACQUIRE, "agent");
            asm volatile("s_waitcnt vmcnt(0)" ::: "memory");
        }
    }
    __syncthreads();
    TSEC_END(5);
}

struct XcdQueue {
    unsigned* ctr; int n_per; int x0; int d; int* slot;
    __device__ __forceinline__ void init(unsigned* c, int np, int* s) { ctr = c; n_per = np; x0 = (int)xb_xcc_id() & 7; d = 0; slot = s; }
    __device__ __forceinline__ bool next(int& xl, int& q) {
        __syncthreads();
        if (threadIdx.x == 0) {
            int res = -1;
            while (d < 8) {
                const int xc = (x0 + d) & 7;
                const unsigned t = __hip_atomic_fetch_add(ctr + xc * 16, 1u, __ATOMIC_RELAXED, __HIP_MEMORY_SCOPE_AGENT);
                if ((int)t < n_per) { res = xc * 65536 + (int)t; break; }
                ++d;
            }
            *slot = res;
        }
        __syncthreads();
        const int r = *slot;
        if (r < 0) return false;
        xl = r >> 16; q = r & 65535;
        return true;
    }
};

constexpr int GS = 72;

struct AF16 {
    const h16* p; int ld;
    __device__ __forceinline__ void init(int) {}
    __device__ __forceinline__ h16x8 load(int i, int row, int k) { return *(const h16x8*)(p + (size_t)row * ld + k); }
};

struct AH32 {
    const float* meta; const float* xs; int meta_bstride;
    const float* rp[4]; float ss[4];
    __device__ __forceinline__ const float* rowptr(int row) const {
        row = row < NT ? row : NT - 1;
        int b = row >= T_ ? 1 : 0; int t = row - b * T_;
        return t < 16 ? meta + (size_t)b * meta_bstride + (size_t)t * 1024 : xs + ((size_t)b * 8192 + (t - 16)) * 1024;
    }
    __device__ __forceinline__ h16x8 load(int i, int, int k) {
        const float4 v0 = *(const float4*)(rp[i] + k), v1 = *(const float4*)(rp[i] + k + 4);
        ss[i] += v0.x * v0.x + v0.y * v0.y + v0.z * v0.z + v0.w * v0.w + v1.x * v1.x + v1.y * v1.y + v1.z * v1.z + v1.w * v1.w;
        h16x8 r; r[0] = (h16)v0.x; r[1] = (h16)v0.y; r[2] = (h16)v0.z; r[3] = (h16)v0.w; r[4] = (h16)v1.x; r[5] = (h16)v1.y; r[6] = (h16)v1.z; r[7] = (h16)v1.w;
        return r;
    }
};

template <int BN, class AL, class EP>
__device__ __forceinline__ void gemm_tile(AL& al, int arow0, const h16* __restrict__ Bt, int ldb, int K, EP& ep, h16* smem) {
    const int tid = opaque_tid(), lane = tid & 63, w = tid >> 6, wm = w >> 1, wn = w & 1;
    constexpr int NTL = BN / 64;
    constexpr int NBG = BN / 32;
    constexpr int BUF = (128 + BN) * GS;
    f32x16 acc[2][NTL];
#pragma unroll
    for (int i = 0; i < 2; ++i)
#pragma unroll
        for (int j = 0; j < NTL; ++j)
#pragma unroll
            for (int r = 0; r < 16; ++r) acc[i][j][r] = 0.f;
    h16x8 ra[4], rb[NBG];
    const int nk = K >> 6;
#pragma unroll
    for (int i = 0; i < 4; ++i) { int g = tid + 256 * i; ra[i] = al.load(i, arow0 + (g >> 3), (g & 7) * 8); }
#pragma unroll
    for (int i = 0; i < NBG; ++i) { int g = tid + 256 * i; rb[i] = *(const h16x8*)(Bt + (size_t)(g >> 3) * ldb + (g & 7) * 8); }
    __syncthreads();
#pragma unroll
    for (int i = 0; i < 4; ++i) { int g = tid + 256 * i; *(h16x8*)(smem + (g >> 3) * GS + (g & 7) * 8) = ra[i]; }
#pragma unroll
    for (int i = 0; i < NBG; ++i) { int g = tid + 256 * i; *(h16x8*)(smem + 128 * GS + (g >> 3) * GS + (g & 7) * 8) = rb[i]; }
    __syncthreads();
    for (int kt = 0; kt < nk; ++kt) {
        const int cur = kt & 1;
        const h16* sA = smem + cur * BUF;
        const h16* sB = sA + 128 * GS;
        if (kt + 1 < nk) {
            const int k0 = (kt + 1) << 6;
#pragma unroll
            for (int i = 0; i < 4; ++i) { int g = tid + 256 * i; ra[i] = al.load(i, arow0 + (g >> 3), k0 + (g & 7) * 8); }
#pragma unroll
            for (int i = 0; i < NBG; ++i) { int g = tid + 256 * i; rb[i] = *(const h16x8*)(Bt + (size_t)(g >> 3) * ldb + k0 + (g & 7) * 8); }
        }
#pragma unroll
        for (int ks = 0; ks < 4; ++ks) {
            h16x8 af[2], bf[NTL];
#pragma unroll
            for (int mt = 0; mt < 2; ++mt) af[mt] = *(const h16x8*)(sA + (64 * wm + 32 * mt + (lane & 31)) * GS + 16 * ks + 8 * (lane >> 5));
#pragma unroll
            for (int nt = 0; nt < NTL; ++nt) bf[nt] = *(const h16x8*)(sB + ((BN / 2) * wn + 32 * nt + (lane & 31)) * GS + 16 * ks + 8 * (lane >> 5));
#pragma unroll
            for (int mt = 0; mt < 2; ++mt)
#pragma unroll
                for (int nt = 0; nt < NTL; ++nt) acc[mt][nt] = MFMA32(af[mt], bf[nt], acc[mt][nt]);
        }
        if (kt + 1 < nk) {
            h16* dA = smem + (cur ^ 1) * BUF;
            h16* dB = dA + 128 * GS;
#pragma unroll
            for (int i = 0; i < 4; ++i) { int g = tid + 256 * i; *(h16x8*)(dA + (g >> 3) * GS + (g & 7) * 8) = ra[i]; }
#pragma unroll
            for (int i = 0; i < NBG; ++i) { int g = tid + 256 * i; *(h16x8*)(dB + (g >> 3) * GS + (g & 7) * 8) = rb[i]; }
        }
        __syncthreads();
    }
    ep.pre(al);
    float* ft = (float*)smem;
#pragma unroll
    for (int mt = 0; mt < 2; ++mt)
#pragma unroll
        for (int nt = 0; nt < NTL; ++nt)
#pragma unroll
            for (int r = 0; r < 16; ++r) {
                const int rl = 64 * wm + 32 * mt + (r & 3) + 8 * (r >> 2) + 4 * (lane >> 5);
                const int cl = (BN / 2) * wn + 32 * nt + (lane & 31);
                ft[rl * (BN + 1) + cl] = acc[mt][nt][r];
            }
    __syncthreads();
    if (EP::kSweep) {
#pragma unroll 4
        for (int idx = tid; idx < 128 * BN; idx += NTHREADS) {
            const int rl = idx / BN, cl = idx % BN;
            float q = ep(rl, cl, ft[rl * (BN + 1) + cl]);
            if (EP::kRowSum) {
#pragma unroll
                for (int d = 1; d < 64; d <<= 1) q += __shfl_xor(q, d);
                if (lane == 0) ep.rowsum(rl, q);
            }
        }
    }
}

constexpr int GS2 = 72;
template <class EP>
__device__ __forceinline__ void gemm_big(const h16* __restrict__ A, int lda, const h16* __restrict__ Bt, int ldb, int K, EP& ep, h16* smem) {
    const int tid = opaque_tid(), lane = tid & 63, w = tid >> 6, wm = w >> 1, wn = w & 1;
    constexpr int BUF = 512 * GS2;
    f32x16 acc[4][4];
    float zero_ = 0.f; asm volatile("" : "+v"(zero_));
#pragma unroll
    for (int i = 0; i < 4; ++i)
#pragma unroll
        for (int j = 0; j < 4; ++j)
#pragma unroll
            for (int r = 0; r < 16; ++r) acc[i][j][r] = zero_;
    h16x8 ra[2][8], rb[2][8];
    const int nk = K >> 6;
    const h16* ap = A + (size_t)(tid >> 3) * lda + (tid & 7) * 8;
    const h16* bp = Bt + (size_t)(tid >> 3) * ldb + (tid & 7) * 8;
    const int soff = (tid >> 3) * GS2 + (tid & 7) * 8;
#pragma unroll
    for (int i = 0; i < 8; ++i) { ra[0][i] = *(const h16x8*)(ap + (size_t)(32 * i) * lda); rb[0][i] = *(const h16x8*)(bp + (size_t)(32 * i) * ldb); }
#pragma unroll
    for (int i = 0; i < 8; ++i) { ra[1][i] = *(const h16x8*)(ap + (size_t)(32 * i) * lda + 64); rb[1][i] = *(const h16x8*)(bp + (size_t)(32 * i) * ldb + 64); }
    __syncthreads();
#pragma unroll
    for (int i = 0; i < 8; ++i) { *(h16x8*)(smem + soff + 32 * i * GS2) = ra[0][i]; *(h16x8*)(smem + 256 * GS2 + soff + 32 * i * GS2) = rb[0][i]; }
    __syncthreads();
#define BIG_STEP(CUR, KT) do { \
        const h16* sA = smem + (CUR) * BUF + (128 * wm + (lane & 31)) * GS2 + 8 * (lane >> 5); \
        const h16* sB = smem + (CUR) * BUF + 256 * GS2 + (128 * wn + (lane & 31)) * GS2 + 8 * (lane >> 5); \
        h16* dW = smem + ((CUR) ^ 1) * BUF;     \
        int k0 = ((KT) + 2) << 6; k0 = k0 < K ? k0 : K - 64; \
        h16x8 af[2][4], bf[2][4]; \
        _Pragma("unroll") for (int t = 0; t < 4; ++t) { af[0][t] = *(const h16x8*)(sA + 32 * t * GS2); bf[0][t] = *(const h16x8*)(sB + 32 * t * GS2); } \
        __builtin_amdgcn_sched_barrier(0); \
        _Pragma("unroll") for (int ks = 0; ks < 4; ++ks) { \
            if (ks < 3) { _Pragma("unroll") for (int t = 0; t < 4; ++t) { af[(ks + 1) & 1][t] = *(const h16x8*)(sA + 32 * t * GS2 + 16 * (ks + 1)); bf[(ks + 1) & 1][t] = *(const h16x8*)(sB + 32 * t * GS2 + 16 * (ks + 1)); } } \
            _Pragma("unroll") for (int i = 2 * ks; i < 2 * ks + 2; ++i) { *(h16x8*)(dW + soff + 32 * i * GS2) = ra[(CUR) ^ 1][i]; *(h16x8*)(dW + 256 * GS2 + soff + 32 * i * GS2) = rb[(CUR) ^ 1][i]; } \
            _Pragma("unroll") for (int i = 2 * ks; i < 2 * ks + 2; ++i) { ra[CUR][i] = *(const h16x8*)(ap + (size_t)(32 * i) * lda + k0); rb[CUR][i] = *(const h16x8*)(bp + (size_t)(32 * i) * ldb + k0); } \
            _Pragma("unroll") for (int mt = 0; mt < 4; ++mt) _Pragma("unroll") for (int nt = 0; nt < 4; ++nt) acc[mt][nt] = MFMA32(af[ks & 1][mt], bf[ks & 1][nt], acc[mt][nt]); \
              \
            _Pragma("unroll") for (int q = 0; q < 4; ++q) { \
                __builtin_amdgcn_sched_group_barrier(0x8, 1, 0); __builtin_amdgcn_sched_group_barrier(0x100, 1, 0); \
                __builtin_amdgcn_sched_group_barrier(0x8, 1, 0); __builtin_amdgcn_sched_group_barrier(0x100, 1, 0); \
                __builtin_amdgcn_sched_group_barrier(0x8, 1, 0); __builtin_amdgcn_sched_group_barrier(0x200, 1, 0); \
                __builtin_amdgcn_sched_group_barrier(0x8, 1, 0); __builtin_amdgcn_sched_group_barrier(0x20, 1, 0); } \
            __builtin_amdgcn_sched_barrier(0); } \
        __syncthreads(); } while (0)
    TSEC_BEGIN(8)
    for (int kt = 0; kt < nk; kt += 2) { BIG_STEP(0, kt); BIG_STEP(1, kt + 1); }
    TSEC_END(8);
    TSEC_BEGIN(9)
#undef BIG_STEP
    float* st = (float*)smem + w * 1152;
    const int prow = lane >> 1, pc0 = (lane & 1) * 16;
    ep.template prefetch<0>(128 * wm + prow, 128 * wn + pc0);
#pragma unroll
    for (int mt = 0; mt < 4; ++mt) {
        if (mt == 0) ep.template prefetch<1>(128 * wm + 32 + prow, 128 * wn + pc0);
        if (mt == 1) ep.template prefetch<0>(128 * wm + 64 + prow, 128 * wn + pc0);
        if (mt == 2) ep.template prefetch<1>(128 * wm + 96 + prow, 128 * wn + pc0);
        ep.row_begin();
#pragma unroll
        for (int nt = 0; nt < 4; ++nt) {
#pragma unroll
            for (int r = 0; r < 16; ++r) st[((r & 3) + 8 * (r >> 2) + 4 * (lane >> 5)) * 36 + (lane & 31)] = acc[mt][nt][r];
            WAVE_FENCE();
            float v[16];
#pragma unroll
            for (int q = 0; q < 4; ++q) { const float4 t4 = *(const float4*)(st + prow * 36 + pc0 + 4 * q); v[4 * q] = t4.x; v[4 * q + 1] = t4.y; v[4 * q + 2] = t4.z; v[4 * q + 3] = t4.w; }
            WAVE_FENCE();
            if (mt & 1) ep.template store16<1>(nt, 128 * wm + 32 * mt + prow, 128 * wn + 32 * nt + pc0, v);
            else ep.template store16<0>(nt, 128 * wm + 32 * mt + prow, 128 * wn + 32 * nt + pc0, v);
        }
        ep.row_end(128 * wm + 32 * mt + prow, lane);
    }
    TSEC_END(9);
}

template <class EP>
__device__ __forceinline__ void skinny_tile(const h16* __restrict__ A, int lda, const h16* __restrict__ Bt, int ldb, int K, EP& ep, float* st, int tid) {
    const int lane = tid & 63, w = tid >> 6;
    f32x16 acc;
#pragma unroll
    for (int r = 0; r < 16; ++r) acc[r] = 0.f;
    const int kq = K >> 2;
    const h16* ap = A + (size_t)(lane & 31) * lda + 8 * (lane >> 5) + w * kq;
    const h16* bp = Bt + (size_t)(lane & 31) * ldb + 8 * (lane >> 5) + w * kq;
    if (w == 0) ep.template prefetch<0>(lane >> 1, (lane & 1) * 16);
    for (int k0 = 0; k0 < kq; k0 += 128) {
        h16x8 af[8], bf[8];
#pragma unroll
        for (int u = 0; u < 8; ++u) { af[u] = *(const h16x8*)(ap + k0 + 16 * u); bf[u] = *(const h16x8*)(bp + k0 + 16 * u); }
#pragma unroll
        for (int u = 0; u < 8; ++u) acc = MFMA32(af[u], bf[u], acc);
    }
    __syncthreads();
    float* my = st + w * 1152;
#pragma unroll
    for (int r = 0; r < 16; ++r) my[((r & 3) + 8 * (r >> 2) + 4 * (lane >> 5)) * 36 + (lane & 31)] = acc[r];
    __syncthreads();
    if (w == 0) {
        const int prow = lane >> 1, pc0 = (lane & 1) * 16;
        ep.row_begin();
        float v[16];
#pragma unroll
        for (int q = 0; q < 4; ++q) {
            float4 t4 = *(const float4*)(st + prow * 36 + pc0 + 4 * q);
#pragma unroll
            for (int ww = 1; ww < 4; ++ww) { const float4 u4 = *(const float4*)(st + ww * 1152 + prow * 36 + pc0 + 4 * q); t4.x += u4.x; t4.y += u4.y; t4.z += u4.z; t4.w += u4.w; }
            v[4 * q] = t4.x; v[4 * q + 1] = t4.y; v[4 * q + 2] = t4.z; v[4 * q + 3] = t4.w;
        }
        ep.template store16<0>(0, prow, pc0, v);
        ep.row_end(prow, lane);
    }
}

struct EpiInProj {
    static constexpr bool kSweep = true; static constexpr bool kRowSum = false;
    int row0, n0; const float* rstd; h16* projA; float* small; h16* sza; h16* szg; h16* projG;
    template <class AL_> __device__ __forceinline__ void pre(AL_&) {}
    __device__ __forceinline__ float operator()(int rl, int cl, float v) const {
        const int row = row0 + rl; const float y = v * rstd[rl]; const int c = n0 + cl;
        if (c < 512) { if (c < 448) projA[(size_t)row * 512 + c] = (h16)y; else if (c < 460) small[(size_t)row * 16 + (c - 448)] = y; }
        else if (c < 1024) sza[(size_t)row * 512 + (c - 512)] = (h16)silu_f(y);
        else if (c < 2560) projG[(size_t)row * 1536 + (c - 1024)] = (h16)y;
        else szg[(size_t)row * 512 + (c - 2560)] = (h16)silu_f(y);
        return 0.f;
    }
    __device__ __forceinline__ void rowsum(int, float) const {}
};
struct EpiIn2 : EpiInProj {
    float* rstd_w; int tid; const float* sumsq;
    template <class AL_> __device__ __forceinline__ void pre(AL_&) {
        if (tid < 128) rstd_w[tid] = rsqrtf(sumsq[row0 + tid] * (1.f / 1024.f) + EPS);
        __syncthreads();
    }
};
struct EpiTileF32 {
    static constexpr bool kSweep = false; static constexpr bool kRowSum = false;
    template <class AL_> __device__ __forceinline__ void pre(AL_&) {}
    __device__ __forceinline__ float operator()(int, int, float) const { return 0.f; }
    __device__ __forceinline__ void rowsum(int, float) const {}
};
struct EpiStoreH {
    static constexpr bool kSweep = true; static constexpr bool kRowSum = false;
    h16* dst; int ld; int row0; const float* rs;
    template <class AL_> __device__ __forceinline__ void pre(AL_&) {}
    __device__ __forceinline__ float operator()(int rl, int cl, float v) const { dst[(size_t)(row0 + rl) * ld + cl] = (h16)(rs ? v * rs[rl] : v); return 0.f; }
    __device__ __forceinline__ void rowsum(int, float) const {}
};
struct EpiGate {
    static constexpr bool kSweep = true; static constexpr bool kRowSum = false;
    h16* dst; const h16* gate; int row0; int c0;
    template <class AL_> __device__ __forceinline__ void pre(AL_&) {}
    __device__ __forceinline__ float operator()(int rl, int cl, float v) const {
        const size_t row = row0 + rl;
        dst[row * 1024 + c0 + cl] = (h16)(v * (float)gate[row * 512 + c0 + cl]);
        return 0.f;
    }
    __device__ __forceinline__ void rowsum(int, float) const {}
};
struct EpiResid {
    static constexpr bool kSweep = true; static constexpr bool kRowSum = true;
    int layer; int row0; int n0; const float* meta; const float* x; float* metah; float* out; h16* h16o; float* sumsq_next;
    template <class AL_> __device__ __forceinline__ void pre(AL_&) {}
    __device__ __forceinline__ float operator()(int rl, int cl, float v) const {
        const int row = row0 + rl; if (row >= NT) return 0.f;
        const int b = row >= T_ ? 1 : 0; const int t = row - b * T_; const int c = n0 + cl;
        if (layer == 0) {
            float hn;
            if (t < 16) { hn = meta[(size_t)t * 1024 + c] + v; metah[((size_t)b * 16 + t) * 1024 + c] = hn; }
            else { const size_t o = ((size_t)b * 8192 + (t - 16)) * 1024 + c; hn = x[o] + v; out[o] = hn; }
            h16o[(size_t)row * 1024 + c] = (h16)hn;
            return hn * hn;
        } else {
            if (t >= 16) { const size_t o = ((size_t)b * 8192 + (t - 16)) * 1024 + c; out[o] = out[o] + v; }
            return 0.f;
        }
    }
    __device__ __forceinline__ void rowsum(int rl, float q) const { if (layer == 0 && row0 + rl < NT) atomicAdd(sumsq_next + row0 + rl, q); }
};

__device__ __forceinline__ void store16h(h16* dst, const float* v) {
    h16x8 a, b;
#pragma unroll
    for (int e = 0; e < 8; ++e) { a[e] = (h16)v[e]; b[e] = (h16)v[8 + e]; }
    *(h16x8*)dst = a; *(h16x8*)(dst + 8) = b;
}
struct EpiInBig {
    int row0, n0; const float* sumsq; h16* projA; float* small; h16* sza; h16* szg; h16* projG;
    float ssq[2];
    __device__ __forceinline__ void row_begin() {}
    __device__ __forceinline__ void row_end(int, int) {}
    template <int B> __device__ __forceinline__ void prefetch(int rl, int) { ssq[B] = sumsq[row0 + rl]; }
    template <int B> __device__ __forceinline__ void store16(int, int rl, int cl, const float* v) const {
        const int row = row0 + rl; const int c = n0 + cl;
        const float rs = rsqrtf(ssq[B] * (1.f / 1024.f) + EPS);
        float y[16];
#pragma unroll
        for (int e = 0; e < 16; ++e) y[e] = v[e] * rs;
        if (c < 512) {
            if (c < 448) store16h(projA + (size_t)row * 512 + c, y);
            else if (c == 448) {
#pragma unroll
                for (int e = 0; e < 12; ++e) small[(size_t)row * 16 + e] = y[e];
            }
        } else if (c < 1024) {
#pragma unroll
            for (int e = 0; e < 16; ++e) y[e] = silu_f(y[e]);
            store16h(sza + (size_t)row * 512 + (c - 512), y);
        } else if (c < 2560) store16h(projG + (size_t)row * 1536 + (c - 1024), y);
        else {
#pragma unroll
            for (int e = 0; e < 16; ++e) y[e] = silu_f(y[e]);
            store16h(szg + (size_t)row * 512 + (c - 2560), y);
        }
    }
};
struct EpiResBig {
    int layer, row0, n0; const float* meta; const float* x; float* metah; float* out; h16* h16o; float* sumsq_next; float ss; int nseg;
    float4 pf[2][4][4];
    __device__ __forceinline__ void row_begin() { ss = 0.f; }
    __device__ __forceinline__ void row_end(int rl, int lane) {
        if (layer == 0) { float q = ss; q += __shfl_xor(q, 1); if ((lane & 1) == 0) atomicAdd(sumsq_next + row0 + rl, q); }
    }
    __device__ __forceinline__ const float* srcp(int row, int c) const {
        const int b = row >= T_ ? 1 : 0; const int t = row - b * T_;
        if (layer == 0) return t < 16 ? meta + (size_t)t * 1024 + c : x + ((size_t)b * 8192 + (t - 16)) * 1024 + c;
        return out + ((size_t)b * 8192 + (t < 16 ? 0 : t - 16)) * 1024 + c;
    }
    template <int B> __device__ __forceinline__ void prefetch(int rl, int cl) {
        const float* src = srcp(row0 + rl, n0 + cl);
#pragma unroll
        for (int nt = 0; nt < 4; ++nt)
            if (nt < nseg) {
#pragma unroll
                for (int q = 0; q < 4; ++q) pf[B][nt][q] = *(const float4*)(src + 32 * nt + 4 * q);
            }
    }
    template <int B> __device__ __forceinline__ void store16(int nt, int rl, int cl, const float* v) {
        const int row = row0 + rl; const int c = n0 + cl;
        const int b = row >= T_ ? 1 : 0; const int t = row - b * T_;
        float* dst;
        if (layer == 0) dst = t < 16 ? metah + ((size_t)b * 16 + t) * 1024 + c : out + ((size_t)b * 8192 + (t - 16)) * 1024 + c;
        else { if (t < 16) return; dst = out + ((size_t)b * 8192 + (t - 16)) * 1024 + c; }
        float hn[16];
#pragma unroll
        for (int q = 0; q < 4; ++q) {
            const float4 hv = pf[B][nt][q];
            float4 o4; o4.x = hv.x + v[4 * q]; o4.y = hv.y + v[4 * q + 1]; o4.z = hv.z + v[4 * q + 2]; o4.w = hv.w + v[4 * q + 3];
            *(float4*)(dst + 4 * q) = o4;
            hn[4 * q] = o4.x; hn[4 * q + 1] = o4.y; hn[4 * q + 2] = o4.z; hn[4 * q + 3] = o4.w;
        }
        if (layer == 0) {
            store16h(h16o + (size_t)row * 1024 + c, hn);
#pragma unroll
            for (int e = 0; e < 16; ++e) ss += hn[e] * hn[e];
        }
    }
};

__device__ __forceinline__ int in_src_col(int n) {
    if (n < 452) return n;
    if (n < 456) return 3012 + (n - 452);
    if (n < 460) return 3016 + (n - 456);
    if (n < 512) return -1;
    if (n < 1024) return 452 + (n - 512);
    if (n < 2560) return 964 + (n - 1024);
    return 2500 + (n - 2560);
}
__device__ __forceinline__ float prep_get(const Params& P, int l, int job, int h, int n, int k) {
    switch (job) {
        case 0: { const int s = in_src_col(n); if (s < 0) return 0.f; return P.norm_gain[l * 1024 + k] * P.w_in[((size_t)l * 1024 + k) * 3020 + s]; }
        case 1: return P.w_out[((size_t)l * 1024 + k) * 1024 + n];
        case 2: return P.g_cq[l * 256 + k] * (n < 512 ? P.w_uq[((size_t)l * 256 + k) * 512 + n] : P.w_qidx[((size_t)l * 256 + k) * 256 + (n - 512)]);
        case 3: return P.g_ckv[l * 128 + k] * P.w_ukv[((size_t)l * 128 + k) * 1024 + n];
        case 4: { const int kk = k >> 4, hf = (k >> 3) & 1, j = k & 7; const int d = 16 * kk + 8 * (j >> 2) + 4 * hf + (j & 3);
                  return P.w_ukv[((size_t)l * 128 + n) * 1024 + h * 64 + d] * P.g_kn[l * 64 + d] * P.g_qn[l * 64 + d] * 0.125f; }
        default: return P.w_ukv[((size_t)l * 128 + k) * 1024 + 512 + h * 64 + n];
    }
}
__device__ __forceinline__ void prep_tiles(const Params& P, unsigned char* lds, int l, int first_wg, int nwg);
__device__ __forceinline__ void phase_prep(const Params& P, unsigned char* lds) {
    float* tile = (float*)lds;
    const int tid = opaque_tid();
    {
        h16* h16o = (h16*)(P.ws + OFF_H16); float* sumsq = (float*)(P.ws + OFF_SUMSQ);
        const int lane = tid & 63, w = tid >> 6;
        for (int row = blockIdx.x * 4 + w; row < NT; row += gridDim.x * 4) {
            const int b = row >= T_ ? 1 : 0; const int t = row - b * T_;
            const float* src = t < 16 ? P.meta + (size_t)t * 1024 : P.x + ((size_t)b * 8192 + (t - 16)) * 1024;
            float ss = 0.f;
#pragma unroll
            for (int q = 0; q < 2; ++q) {
                const float4 a = *(const float4*)(src + q * 512 + lane * 8), c4 = *(const float4*)(src + q * 512 + lane * 8 + 4);
                ss += a.x * a.x + a.y * a.y + a.z * a.z + a.w * a.w + c4.x * c4.x + c4.y * c4.y + c4.z * c4.z + c4.w * c4.w;
                h16x8 o; o[0] = (h16)a.x; o[1] = (h16)a.y; o[2] = (h16)a.z; o[3] = (h16)a.w; o[4] = (h16)c4.x; o[5] = (h16)c4.y; o[6] = (h16)c4.z; o[7] = (h16)c4.w;
                *(h16x8*)(h16o + (size_t)row * 1024 + q * 512 + lane * 8) = o;
            }
#pragma unroll
            for (int d = 1; d < 64; d <<= 1) ss += __shfl_xor(ss, d);
            if (lane == 0) sumsq[row] = ss;
        }
    }
    prep_tiles(P, lds, 0, 0, (int)gridDim.x);
}
__device__ __forceinline__ void prep_tiles(const Params& P, unsigned char* lds, int l, int first_wg, int nwg) {
    float* tile = (float*)lds;
    const int tid = opaque_tid();
    for (int it = (int)blockIdx.x - first_wg; it >= 0 && it < 1120; it += nwg) {
        int r = it;
        int job, h = 0, N, K, tn, tk; h16* dst;
        if (r < 768) { job = 0; N = 3072; K = 1024; tn = r / 16; tk = r % 16; dst = (h16*)(P.ws + OFF_W1T) + (size_t)l * 3072 * 1024; }
        else if ((r -= 768) < 256) { job = 1; N = 1024; K = 1024; tn = r / 16; tk = r % 16; dst = (h16*)(P.ws + OFF_WOT) + (size_t)l * 1024 * 1024; }
        else if ((r -= 256) < 48) { job = 2; N = 768; K = 256; tn = r / 4; tk = r % 4; dst = (h16*)(P.ws + OFF_WQ2T) + (size_t)l * 768 * 256; }
        else if ((r -= 48) < 16) { job = 3; N = 512; K = 128; tn = r / 2; tk = r % 2; dst = (h16*)(P.ws + OFF_WUKT) + (size_t)l * 512 * 128; }
        else if ((r -= 16) < 16) { job = 4; N = 128; K = 64; h = r / 2; tn = r % 2; tk = 0; dst = (h16*)(P.ws + OFF_WKABS) + ((size_t)l * 8 + h) * 128 * 64; }
        else { r -= 16; job = 5; N = 64; K = 128; h = r / 2; tn = 0; tk = r % 2; dst = (h16*)(P.ws + OFF_WUVT) + ((size_t)l * 8 + h) * 64 * 128; }
        (void)N;
        const int n0 = tn * 64, k0 = tk * 64;
        __syncthreads();
#pragma unroll 4
        for (int q = 0; q < 16; ++q) { const int kk = q * 4 + (tid >> 6), nn = tid & 63; tile[kk * 65 + nn] = prep_get(P, l, job, h, n0 + nn, k0 + kk); }
        __syncthreads();
#pragma unroll 4
        for (int q = 0; q < 16; ++q) { const int nn = q * 4 + (tid >> 6), kk = tid & 63; dst[(size_t)(n0 + nn) * K + k0 + kk] = (h16)tile[kk * 65 + nn]; }
    }
}

__device__ __forceinline__ void phase_inproj(const Params& P, int l, unsigned char* lds, int rep_p1 = 0) {
    h16* smem = (h16*)lds;
    float* rstd = (float*)(lds + 73728);
    const int tid = opaque_tid();
    const h16* W = (const h16*)(P.ws + OFF_W1T) + (size_t)l * 3072 * 1024;
    const h16* A = (const h16*)(P.ws + OFF_H16);
    const float* sumsq = (const float*)(P.ws + OFF_SUMSQ) + (size_t)l * NTP;
    XcdQueue xq; xq.init((unsigned*)(P.ws + OFF_CTL) + 4096 + l * 128 + 2048 * rep_p1, 96, (int*)(lds + LDS_BYTES - 32));
    int xl, qi;
    while (xq.next(xl, qi)) {
        const int rb = 8 * xl + (qi & 7), tn = 4 * (qi >> 5) + ((qi >> 3) & 3);
        EpiInBig ep{rb * 256, tn * 256, sumsq, (h16*)(P.ws + OFF_PROJA), (float*)(P.ws + OFF_SMALL), (h16*)(P.ws + OFF_SZA), (h16*)(P.ws + OFF_SZG), (h16*)(P.ws + OFF_PROJG), {0.f, 0.f}};
        gemm_big(A + (size_t)rb * 256 * 1024, 1024, W + (size_t)tn * 256 * 1024, 1024, 1024, ep, smem);
    }
    __syncthreads();
    for (int it = blockIdx.x; it < 96; it += gridDim.x) {
        EpiInBig ep{16384, it * 32, sumsq, (h16*)(P.ws + OFF_PROJA), (float*)(P.ws + OFF_SMALL), (h16*)(P.ws + OFF_SZA), (h16*)(P.ws + OFF_SZG), (h16*)(P.ws + OFF_PROJG), {0.f, 0.f}};
        skinny_tile(A + (size_t)16384 * 1024, 1024, W + (size_t)it * 32 * 1024, 1024, 1024, ep, (float*)lds, tid);
    }
    (void)rstd;
}

__device__ __forceinline__ void p2a_item(const Params& P, int l, int rb, int j, unsigned char* lds) {
    h16* smem = (h16*)lds;
    float* ft = (float*)lds;
    float* rstdq = (float*)(lds + 73728);
    const int tid = opaque_tid(); const int row0 = rb * 128;
    const h16* projA = (const h16*)(P.ws + OFF_PROJA);
    __syncthreads();
    {
        const int row = row0 + (tid >> 1), hf = tid & 1; float s = 0.f;
#pragma unroll 4
        for (int q = 0; q < 16; ++q) { const h16x8 v = *(const h16x8*)(projA + (size_t)row * 512 + hf * 128 + q * 8);
#pragma unroll
            for (int e = 0; e < 8; ++e) { const float f = (float)v[e]; s += f * f; } }
        s += __shfl_xor(s, 1);
        if (hf == 0) rstdq[tid >> 1] = rsqrtf(s * (1.f / 256.f) + EPS);
    }
    __syncthreads();
    const h16* Wq2 = (const h16*)(P.ws + OFF_WQ2T) + (size_t)l * 768 * 256;
    AF16 al{projA, 512};
    if (j >= 4) {
        EpiStoreH ep{(h16*)(P.ws + OFF_QIDX) + (j - 4) * 128, 256, row0, rstdq};
        gemm_tile<128>(al, row0, Wq2 + (size_t)j * 128 * 256, 256, 256, ep, smem);
        return;
    }
    EpiTileF32 ep;
    gemm_tile<128>(al, row0, Wq2 + (size_t)j * 128 * 256, 256, 256, ep, smem);
    __syncthreads();
    h16* qn = (h16*)(P.ws + OFF_QN);
    {
        const int rl = tid >> 1, hh = tid & 1; float s = 0.f;
        const float rq = rstdq[rl];
        for (int d = 0; d < 64; ++d) { const float f = ft[rl * 129 + hh * 64 + d] * rq; s += f * f; }
        const float rs = rsqrtf(s * (1.f / 64.f) + EPS) * rq;
        h16* dst = qn + (size_t)(row0 + rl) * 512 + (2 * j + hh) * 64;
        const float* gq = P.g_qn + l * 64;
        for (int d = 0; d < 64; d += 8) { h16x8 o;
#pragma unroll
            for (int e = 0; e < 8; ++e) o[e] = (h16)(ft[rl * 129 + hh * 64 + d + e] * rs * gq[d + e]);
            *(h16x8*)(dst + d) = o; }
    }
    __threadfence_block();
    __syncthreads();
    for (int hh = 0; hh < 2; ++hh) {
        const int head = 2 * j + hh;
        AF16 al2{qn + head * 64, 512};
        EpiStoreH ep2{(h16*)(P.ws + OFF_QK) + head * 128, 1024, row0, nullptr};
        gemm_tile<128>(al2, row0, (const h16*)(P.ws + OFF_WKABS) + ((size_t)l * 8 + head) * 128 * 64, 64, 64, ep2, smem);
    }
}

__device__ __forceinline__ void p2b_item(const Params& P, int l, int rb, unsigned char* lds) {
    h16* smem = (h16*)lds;
    float* ft = (float*)lds;
    const int tid = opaque_tid(); const int row0 = rb * 128;
    const h16* projA = (const h16*)(P.ws + OFF_PROJA);
    h16* kvrow = (h16*)(P.ws + OFF_KVROW);
    __syncthreads();
    {
        const int row = row0 + (tid >> 1), hf = tid & 1; float s = 0.f; h16x8 v[8];
#pragma unroll
        for (int q = 0; q < 8; ++q) { v[q] = *(const h16x8*)(projA + (size_t)row * 512 + 256 + hf * 64 + q * 8);
#pragma unroll
            for (int e = 0; e < 8; ++e) { const float f = (float)v[q][e]; s += f * f; } }
        s += __shfl_xor(s, 1);
        const float rs = rsqrtf(s * (1.f / 128.f) + EPS);
        const float* g = P.g_ckv + l * 128 + hf * 64;
#pragma unroll
        for (int q = 0; q < 8; ++q) { h16x8 o;
#pragma unroll
            for (int e = 0; e < 8; ++e) o[e] = (h16)((float)v[q][e] * rs * g[q * 8 + e]);
            *(h16x8*)(kvrow + (size_t)row * 136 + hf * 64 + q * 8) = o; }
    }
    {
        h16* kfrag = (h16*)(P.ws + OFF_KFRAG);
#pragma unroll
        for (int q = 0; q < 4; ++q) {
            const int g = tid + 256 * q; const int row = row0 + (g >> 3), g8 = g & 7;
            if (row < NT) {
                const int b = row >= T_ ? 1 : 0; const int t = row - b * T_;
                const h16x8 v = *(const h16x8*)(projA + (size_t)row * 512 + 384 + g8 * 8);
                const int tile = t >> 5, ks = g8 >> 1, hh = g8 & 1;
                *(h16x8*)(kfrag + ((size_t)(b * NKT + tile) * 4 + ks) * 512 + (hh * 32 + (t & 31)) * 8) = v;
            }
        }
    }
    __threadfence_block();
    __syncthreads();
    const h16* Wuk = (const h16*)(P.ws + OFF_WUKT) + (size_t)l * 512 * 128;
    for (int tn = 0; tn < 4; ++tn) {
        AF16 al{kvrow, 136};
        EpiTileF32 ep;
        gemm_tile<128>(al, row0, Wuk + (size_t)tn * 128 * 128, 128, 128, ep, smem);
        __syncthreads();
        const int rl = tid >> 1, hh = tid & 1; float s = 0.f;
        for (int d = 0; d < 64; ++d) { const float f = ft[rl * 129 + hh * 64 + d]; s += f * f; }
        kvrow[(size_t)(row0 + rl) * 136 + 128 + 2 * tn + hh] = (h16)rsqrtf(s * (1.f / 64.f) + EPS);
        __syncthreads();
    }
}

__device__ __forceinline__ void p2c_item(const Params& P, int l, int item, unsigned char* lds) {
    h16* qh = (h16*)lds;
    h16* kh = (h16*)(lds + 17408);
    float* kf = (float*)(lds + 34816);
    float* vf = (float*)(lds + 67584);
    float* Lm = (float*)(lds + 100352);
    float* beta = (float*)(lds + 116736);
    float* dec = beta + 64;
    float* edec = dec + 64;
    const int tid = opaque_tid(), lane = tid & 63, w = tid >> 6;
    const int chain = item / NCH, n = item % NCH, b = chain >> 2, h = chain & 3;
    const h16* projG = (const h16*)(P.ws + OFF_PROJG);
    const float* small = (const float*)(P.ws + OFF_SMALL);
    const float* cw = P.conv_w + (size_t)l * 4 * 1536;
    __syncthreads();
#ifndef P2C
#define P2C 15
#endif
    float* cwl = (float*)(lds + 117504);
    for (int e = tid; e < 1536; e += NTHREADS) { const int m = e >> 9, jj = (e >> 7) & 3, c = e & 127; cwl[e] = cw[jj * 1536 + m * 512 + h * 128 + c]; }
    __syncthreads();
    for (int rs1_ = 0; rs1_ <= PROBE_S1; ++rs1_) if (P2C & 1) {
        const int i = tid >> 2, part = tid & 3;
        const int t = 64 * n + i - 48; const bool valid = t >= 0;
        const size_t row = (size_t)b * T_ + (valid ? t : 0);
        h16x8 rv[3][4][4];
#define CONV_LOAD(m_) do { _Pragma("unroll") for (int jj = 0; jj < 4; ++jj) { int tt = t - 3 + jj; tt = tt < 0 ? 0 : tt; \
            const h16* rp = projG + ((size_t)b * T_ + tt) * 1536 + (m_) * 512 + h * 128 + part * 32; \
            _Pragma("unroll") for (int c8 = 0; c8 < 4; ++c8) rv[m_][jj][c8] = *(const h16x8*)(rp + c8 * 8); } } while (0)
        CONV_LOAD(0); CONV_LOAD(1);
        float bl = 0.f, al = 0.f;
        if (part == 0) { bl = small[row * 16 + 4 + h]; al = small[row * 16 + 8 + h]; }
        float vals[32];
#pragma unroll
        for (int m = 0; m < 3; ++m) {
            if (m == 1) { CONV_LOAD(2); }
            __builtin_amdgcn_sched_barrier(0);
#pragma unroll
            for (int c = 0; c < 32; ++c) vals[c] = 0.f;
#pragma unroll
            for (int jj = 0; jj < 4; ++jj) {
                const float msk = (valid && (t - 3 + jj) >= 0) ? 1.f : 0.f;
                const float* wp = cwl + (m * 4 + jj) * 128 + part * 32;
#pragma unroll
                for (int c8 = 0; c8 < 4; ++c8) {
                    const float4 w0 = *(const float4*)(wp + c8 * 8), w1 = *(const float4*)(wp + c8 * 8 + 4);
                    const float wv[8] = {w0.x, w0.y, w0.z, w0.w, w1.x, w1.y, w1.z, w1.w};
#pragma unroll
                    for (int e = 0; e < 8; ++e) vals[c8 * 8 + e] += wv[e] * msk * (float)rv[m][jj][c8][e];
                }
            }
            float ss = 0.f;
#pragma unroll
            for (int c = 0; c < 32; ++c) { vals[c] = silu_f(vals[c]); ss += vals[c] * vals[c]; }
            if (m < 2) {
                ss += __shfl_xor(ss, 1); ss += __shfl_xor(ss, 2);
                const float rs = valid ? rsqrtf(ss + EPS) : 0.f;
                h16* dsth = (m == 0 ? qh : kh) + i * 136 + part * 32;
#pragma unroll
                for (int c8 = 0; c8 < 4; ++c8) { h16x8 o;
#pragma unroll
                    for (int e = 0; e < 8; ++e) o[e] = (h16)(vals[c8 * 8 + e] * rs);
                    *(h16x8*)(dsth + c8 * 8) = o; }
                if (m == 1) {
#pragma unroll
                    for (int c4 = 0; c4 < 8; ++c4) *(float4*)(kf + i * 128 + part * 32 + c4 * 4) = make_float4(vals[4 * c4] * rs, vals[4 * c4 + 1] * rs, vals[4 * c4 + 2] * rs, vals[4 * c4 + 3] * rs);
                }
            } else {
#pragma unroll
                for (int c4 = 0; c4 < 8; ++c4) *(float4*)(vf + i * 128 + part * 32 + c4 * 4) = valid ? make_float4(vals[4 * c4], vals[4 * c4 + 1], vals[4 * c4 + 2], vals[4 * c4 + 3]) : make_float4(0.f, 0.f, 0.f, 0.f);
            }
        }
#undef CONV_LOAD
        if (part == 0) {
            float bt = 0.f, g = 0.f;
            if (valid) {
                bt = 1.f / (1.f + __expf(-bl));
                const float xx = al + P.dt_bias[l * 4 + h];
                const float sp = xx > 20.f ? xx : log1pf(__expf(xx));
                g = -__expf(P.a_log[l * 4 + h]) * sp;
            }
            beta[i] = bt; dec[i] = g;
        }
    }
    __syncthreads();
    if (w == 0) {
        float v = dec[lane];
#pragma unroll
        for (int d = 1; d < 64; d <<= 1) { const float o = __shfl_up(v, d); if (lane >= d) v += o; }
        dec[lane] = v; edec[lane] = __expf(v);
    }
    __syncthreads();
    for (int rs3_ = 0; rs3_ <= PROBE_S3; ++rs3_) if (P2C & 2) {
        const int gq = lane >> 4, c16 = lane & 15;
        h16* aqk = (h16*)(P.ws + OFF_AQK) + (size_t)item * 4096;
        h16x8 ak[4], aq[4];
#pragma unroll
        for (int ks = 0; ks < 4; ++ks) { ak[ks] = *(const h16x8*)(kh + (16 * w + c16) * 136 + 32 * ks + 8 * gq); aq[ks] = *(const h16x8*)(qh + (16 * w + c16) * 136 + 32 * ks + 8 * gq); }
#pragma unroll
        for (int nt = 0; nt < 4; ++nt) {
            f32x4 kk = {0.f, 0.f, 0.f, 0.f}, qk = {0.f, 0.f, 0.f, 0.f};
#pragma unroll
            for (int ks = 0; ks < 4; ++ks) { const h16x8 bb = *(const h16x8*)(kh + (16 * nt + c16) * 136 + 32 * ks + 8 * gq); kk = MFMA16(ak[ks], bb, kk); qk = MFMA16(aq[ks], bb, qk); }
            const int jc = 16 * nt + c16; const float dj = dec[jc];
#pragma unroll
            for (int r = 0; r < 4; ++r) {
                const int ir = 16 * w + 4 * gq + r; const float gm = __expf(fminf(dec[ir] - dj, 0.f));
                Lm[ir * 64 + jc] = ir > jc ? beta[ir] * kk[r] * gm : 0.f;
                aqk[ir * 64 + jc] = (h16)(ir >= jc ? qk[r] * gm : 0.f);
            }
        }
    }
    __syncthreads();
    for (int rs5_ = 0; rs5_ <= PROBE_S5; ++rs5_) if (P2C & 8) {
        h16* qd = (h16*)(P.ws + OFF_QD) + (size_t)item * 8192;
        const int i = tid >> 2, part = tid & 3; const float ed = edec[i];
#pragma unroll
        for (int c8 = 0; c8 < 4; ++c8) { const h16x8 v = *(const h16x8*)(qh + i * 136 + part * 32 + c8 * 8); h16x8 o;
#pragma unroll
            for (int e = 0; e < 8; ++e) o[e] = (h16)((float)v[e] * ed);
            *(h16x8*)(qd + i * 128 + part * 32 + c8 * 8) = o; }
        h16* kdt = (h16*)(P.ws + OFF_KDT) + (size_t)item * 8192;
        const int d = tid & 127, ih = tid >> 7; const float dl = dec[63];
#pragma unroll
        for (int i8 = 0; i8 < 4; ++i8) { h16x8 o;
#pragma unroll
            for (int e = 0; e < 8; ++e) { const int ii = ih * 32 + i8 * 8 + e; o[e] = (h16)(kf[ii * 128 + d] * __expf(dl - dec[ii])); }
            *(h16x8*)(kdt + d * 64 + ih * 32 + i8 * 8) = o; }
        if (tid == 0) ((float*)(P.ws + OFF_CDEC))[item] = __expf(dl);
    }
    __syncthreads();
    if (P2C & 4) {
        float* scl = cwl;
        if (tid < 128) { const int i = tid & 63; scl[tid] = tid < 64 ? beta[i] : beta[i] * edec[i]; }
        __syncthreads();
        const int c = tid; const bool isu = c < 128; float* col = isu ? (vf + c) : (kf + (c - 128));
        const float* sc = scl + (isu ? 0 : 64);
        h16* dst = (h16*)(P.ws + (isu ? OFF_U : OFF_WM)) + (size_t)item * 8192 + (isu ? c : c - 128);
#pragma unroll 1
        for (int bi = 0; bi < 8; ++bi) {
            float sv[8];
            { const float4 s0 = *(const float4*)(sc + 8 * bi), s1 = *(const float4*)(sc + 8 * bi + 4);
              const float ss_[8] = {s0.x, s0.y, s0.z, s0.w, s1.x, s1.y, s1.z, s1.w};
#pragma unroll
              for (int r = 0; r < 8; ++r) sv[r] = col[(8 * bi + r) * 128] * ss_[r]; }
#pragma unroll 2
            for (int j4 = 0; j4 < 2 * bi; ++j4) {
                const float x0 = col[(4 * j4 + 0) * 128], x1 = col[(4 * j4 + 1) * 128], x2 = col[(4 * j4 + 2) * 128], x3 = col[(4 * j4 + 3) * 128];
#pragma unroll
                for (int r = 0; r < 8; ++r) { const float4 lv = *(const float4*)(Lm + (8 * bi + r) * 64 + 4 * j4); sv[r] -= lv.x * x0; sv[r] -= lv.y * x1; sv[r] -= lv.z * x2; sv[r] -= lv.w * x3; }
            }
            float4 la[8], lb[8];
#pragma unroll
            for (int r = 1; r < 8; ++r) { la[r] = *(const float4*)(Lm + (8 * bi + r) * 64 + 8 * bi); lb[r] = *(const float4*)(Lm + (8 * bi + r) * 64 + 8 * bi + 4); }
#pragma unroll
            for (int r = 1; r < 8; ++r) {
                const float lv[8] = {la[r].x, la[r].y, la[r].z, la[r].w, lb[r].x, lb[r].y, lb[r].z, lb[r].w};
#pragma unroll
                for (int q = 0; q < r; ++q) sv[r] -= lv[q] * sv[q];
            }
#pragma unroll
            for (int r = 0; r < 8; ++r) { col[(8 * bi + r) * 128] = sv[r]; dst[(8 * bi + r) * 128] = (h16)sv[r]; }
        }
    }
}

__device__ __forceinline__ float half_sum(float x) {
    const unsigned u = __float_as_uint(x); const auto p = __builtin_amdgcn_permlane32_swap(u, u, false, false);
    return __uint_as_float(p[0]) + __uint_as_float(p[1]);
}
__device__ __forceinline__ void store_tile_T(const f32x16& acc, float scale, float* st, h16* dst_row_lane  , bool ok, int lane) {
#pragma unroll
    for (int r = 0; r < 16; ++r) st[(lane & 31) * 33 + (r & 3) + 8 * (r >> 2) + 4 * (lane >> 5)] = acc[r] * scale;
    WAVE_FENCE();
    float v[16];
#pragma unroll
    for (int q = 0; q < 16; ++q) v[q] = st[(lane >> 1) * 33 + (lane & 1) * 16 + q];
    WAVE_FENCE();
    if (ok) store16h(dst_row_lane, v);
}

__device__ __forceinline__ void chain_item(const Params& P, int l, int item, float* st, int lane) {
    const int r0 = item * 32; const int tok = lane & 31, hf = lane >> 5;
    const int row = r0 + tok; const int rowc = row < NT ? row : NT - 1;
    const h16* projA = (const h16*)(P.ws + OFF_PROJA);
    const h16* Wq2 = (const h16*)(P.ws + OFF_WQ2T) + (size_t)l * 768 * 256;
    const h16* Wka = (const h16*)(P.ws + OFF_WKABS) + (size_t)l * 8 * 128 * 64;
    const h16* Wuk = (const h16*)(P.ws + OFF_WUKT) + (size_t)l * 512 * 128;
    h16* qidx = (h16*)(P.ws + OFF_QIDX); h16* qk = (h16*)(P.ws + OFF_QK); h16* kvrow = (h16*)(P.ws + OFF_KVROW);
    const int srow = r0 + (lane >> 1); const bool sok = srow < NT; const size_t srowc = sok ? srow : NT - 1;
    h16x8 bq[16]; float ss = 0.f;
#pragma unroll
    for (int ks = 0; ks < 16; ++ks) { bq[ks] = *(const h16x8*)(projA + (size_t)rowc * 512 + 16 * ks + 8 * hf);
#pragma unroll
        for (int e = 0; e < 8; ++e) { const float f = (float)bq[ks][e]; ss += f * f; } }
    ss = half_sum(ss);
    const float rstd_q = rsqrtf(ss * (1.f / 256.f) + EPS);
#pragma unroll 1
    for (int h = 0; h < 8; ++h) {
        f32x16 aq[2];
#pragma unroll
        for (int mt = 0; mt < 2; ++mt)
#pragma unroll
            for (int r = 0; r < 16; ++r) aq[mt][r] = 0.f;
        const h16* wp = Wq2 + (size_t)(64 * h + tok) * 256 + 8 * hf;
#pragma unroll
        for (int ks = 0; ks < 16; ++ks) {
            const h16x8 a0 = *(const h16x8*)(wp + 16 * ks), a1 = *(const h16x8*)(wp + 32 * 256 + 16 * ks);
            aq[0] = MFMA32(a0, bq[ks], aq[0]); aq[1] = MFMA32(a1, bq[ks], aq[1]);
        }
        __builtin_amdgcn_sched_group_barrier(0x20, 8, 0);
#pragma unroll
        for (int q = 0; q < 12; ++q) { __builtin_amdgcn_sched_group_barrier(0x8, 2, 0); __builtin_amdgcn_sched_group_barrier(0x20, 2, 0); }
        __builtin_amdgcn_sched_group_barrier(0x8, 8, 0);
        __builtin_amdgcn_sched_barrier(0);
        float sq = 0.f;
#pragma unroll
        for (int mt = 0; mt < 2; ++mt)
#pragma unroll
            for (int r = 0; r < 16; ++r) sq += aq[mt][r] * aq[mt][r];
        sq = half_sum(sq) * rstd_q * rstd_q;
        const float rsq = rsqrtf(sq * (1.f / 64.f) + EPS) * rstd_q;
        h16x8 qb[4];
#pragma unroll
        for (int kk = 0; kk < 4; ++kk)
#pragma unroll
            for (int j = 0; j < 8; ++j) qb[kk][j] = (h16)(aq[kk >> 1][8 * (kk & 1) + j] * rsq);
        const h16* kp = Wka + (size_t)h * 128 * 64 + (size_t)tok * 64 + 8 * hf;
#pragma unroll
        for (int ct = 0; ct < 4; ++ct) {
            f32x16 ak;
#pragma unroll
            for (int r = 0; r < 16; ++r) ak[r] = 0.f;
#pragma unroll
            for (int kk = 0; kk < 4; ++kk) { const h16x8 a = *(const h16x8*)(kp + (size_t)(32 * ct) * 64 + 16 * kk); ak = MFMA32(a, qb[kk], ak); }
            store_tile_T(ak, 1.f, st, qk + srowc * 1024 + h * 128 + 32 * ct + 16 * (lane & 1), sok, lane);
        }
    }
#pragma unroll 1
    for (int nt = 0; nt < 8; ++nt) {
        f32x16 ai;
#pragma unroll
        for (int r = 0; r < 16; ++r) ai[r] = 0.f;
        const h16* wp = Wq2 + (size_t)(512 + 32 * nt + tok) * 256 + 8 * hf;
#pragma unroll
        for (int ks = 0; ks < 16; ++ks) { const h16x8 a = *(const h16x8*)(wp + 16 * ks); ai = MFMA32(a, bq[ks], ai); }
#pragma unroll
        for (int r = 0; r < 16; ++r) ai[r] *= rstd_q;
        store_tile_T(ai, 1.f, st, qidx + srowc * 256 + 32 * nt + 16 * (lane & 1), sok, lane);
    }
    h16x8 bk[8]; float sk = 0.f;
#pragma unroll
    for (int ks = 0; ks < 8; ++ks) { bk[ks] = *(const h16x8*)(projA + (size_t)rowc * 512 + 256 + 16 * ks + 8 * hf);
#pragma unroll
        for (int e = 0; e < 8; ++e) { const float f = (float)bk[ks][e]; sk += f * f; } }
    sk = half_sum(sk);
    const float rstd_kv = rsqrtf(sk * (1.f / 128.f) + EPS);
    if (row < NT) {
        const float* g = P.g_ckv + l * 128;
#pragma unroll
        for (int ks = 0; ks < 8; ++ks) { h16x8 o;
#pragma unroll
            for (int e = 0; e < 8; ++e) o[e] = (h16)((float)bk[ks][e] * rstd_kv * g[16 * ks + 8 * hf + e]);
            *(h16x8*)(kvrow + (size_t)row * 136 + 16 * ks + 8 * hf) = o; }
    }
#pragma unroll 1
    for (int h = 0; h < 8; ++h) {
        f32x16 ak[2];
#pragma unroll
        for (int mt = 0; mt < 2; ++mt)
#pragma unroll
            for (int r = 0; r < 16; ++r) ak[mt][r] = 0.f;
        const h16* wp = Wuk + (size_t)(64 * h + tok) * 128 + 8 * hf;
#pragma unroll
        for (int ks = 0; ks < 8; ++ks) {
            const h16x8 a0 = *(const h16x8*)(wp + 16 * ks), a1 = *(const h16x8*)(wp + 32 * 128 + 16 * ks);
            ak[0] = MFMA32(a0, bk[ks], ak[0]); ak[1] = MFMA32(a1, bk[ks], ak[1]);
        }
        float sq = 0.f;
#pragma unroll
        for (int mt = 0; mt < 2; ++mt)
#pragma unroll
            for (int r = 0; r < 16; ++r) sq += ak[mt][r] * ak[mt][r];
        sq = half_sum(sq) * rstd_kv * rstd_kv;
        if (row < NT && hf == 0) kvrow[(size_t)row * 136 + 128 + h] = (h16)rsqrtf(sq * (1.f / 64.f) + EPS);
    }
    if (row < NT) {
        h16* kfrag = (h16*)(P.ws + OFF_KFRAG);
        const int b = row >= T_ ? 1 : 0; const int t = row - b * T_; const int tile = t >> 5;
#pragma unroll
        for (int q = 0; q < 4; ++q) {
            const int g8 = 2 * q + hf;
            const h16x8 v = *(const h16x8*)(projA + (size_t)row * 512 + 384 + g8 * 8);
            *(h16x8*)(kfrag + ((size_t)(b * NKT + tile) * 4 + (g8 >> 1)) * 512 + ((g8 & 1) * 32 + (t & 31)) * 8) = v;
        }
    }
}

__device__ __forceinline__ void p4_item(const Params& P, int l, int item, int lane) {
    const int r0 = item * 32; const int tok = lane & 31, hf = lane >> 5;
    const int row = r0 + tok; const bool ok = row < NT; const size_t rowc = ok ? row : NT - 1;
    const h16* ctx = (const h16*)(P.ws + OFF_CTX); const h16* Wuv = (const h16*)(P.ws + OFF_WUVT) + (size_t)l * 8 * 64 * 128;
    const h16* sza = (const h16*)(P.ws + OFF_SZA); const h16* szg = (const h16*)(P.ws + OFF_SZG); const h16* og = (const h16*)(P.ws + OFF_QN);
    h16* omix = (h16*)(P.ws + OFF_OMIX);
#pragma unroll 1
    for (int h = 0; h < 8; ++h) {
        h16x8 bc[8];
#pragma unroll
        for (int ks = 0; ks < 8; ++ks) bc[ks] = *(const h16x8*)(ctx + rowc * 1024 + h * 128 + 16 * ks + 8 * hf);
        f32x16 ao[2];
#pragma unroll
        for (int mt = 0; mt < 2; ++mt)
#pragma unroll
            for (int r = 0; r < 16; ++r) ao[mt][r] = 0.f;
        const h16* wp = Wuv + (size_t)h * 64 * 128 + (size_t)tok * 128 + 8 * hf;
#pragma unroll
        for (int ks = 0; ks < 8; ++ks) {
            const h16x8 a0 = *(const h16x8*)(wp + 16 * ks), a1 = *(const h16x8*)(wp + 32 * 128 + 16 * ks);
            ao[0] = MFMA32(a0, bc[ks], ao[0]); ao[1] = MFMA32(a1, bc[ks], ao[1]);
        }
        if (ok) {
#pragma unroll
            for (int mt = 0; mt < 2; ++mt)
#pragma unroll
                for (int g = 0; g < 4; ++g) {
                    const int d0 = h * 64 + 32 * mt + 8 * g + 4 * hf;
                    const h16x4 z = *(const h16x4*)(sza + (size_t)row * 512 + d0);
                    h16x4 o;
#pragma unroll
                    for (int e = 0; e < 4; ++e) o[e] = (h16)(ao[mt][4 * g + e] * (float)z[e]);
                    *(h16x4*)(omix + (size_t)row * 1024 + d0) = o;
                }
        }
    }
    const float* go = P.g_out + l * 128;
#pragma unroll 1
    for (int h = 0; h < 4; ++h) {
        h16x8 v[8]; float ss = 0.f;
#pragma unroll
        for (int q = 0; q < 8; ++q) { v[q] = *(const h16x8*)(og + rowc * 512 + h * 128 + 64 * hf + 8 * q);
#pragma unroll
            for (int e = 0; e < 8; ++e) { const float f = (float)v[q][e]; ss += f * f; } }
        ss = half_sum(ss);
        const float rs = rsqrtf(ss * (1.f / 128.f) + EPS);
        if (ok) {
#pragma unroll
            for (int q = 0; q < 8; ++q) { const h16x8 z = *(const h16x8*)(szg + (size_t)row * 512 + h * 128 + 64 * hf + 8 * q); h16x8 o;
#pragma unroll
                for (int e = 0; e < 8; ++e) o[e] = (h16)((float)v[q][e] * rs * go[64 * hf + 8 * q + e] * (float)z[e]);
                *(h16x8*)(omix + (size_t)row * 1024 + 512 + h * 128 + 64 * hf + 8 * q) = o; }
        }
    }
}

__device__ __forceinline__ void phase2(const Params& P, int l, unsigned char* lds) {
    const int tid = opaque_tid(), lane = tid & 63, w = tid >> 6;
    unsigned* ctr = (unsigned*)(P.ws + OFF_CTL) + 16 + l;
    int* slot = (int*)(lds + LDS_BYTES - 32);
    for (int rep_ = 0; rep_ <= (PROBE_P2C | PROBE_CHAIN | PROBE_P2X); ++rep_) {
    for (;;) {
        __syncthreads();
        if (tid == 0) *slot = (int)__hip_atomic_fetch_add(ctr + 4 * rep_, 1u, __ATOMIC_RELAXED, __HIP_MEMORY_SCOPE_AGENT);
        __syncthreads();
        const int it = *slot;
        if (it >= NGI + 129) break;
        if (it >= 129) { if (!PROBE_CHAIN || rep_ == 0) { TSEC_BEGIN(6) p2c_item(P, l, it - 129, lds); TSEC_END(6); } }
        else if (!PROBE_P2C || rep_ == 0) {
            const int ci = it * 4 + w;
            __syncthreads();
            TSEC_BEGIN(7)
            if (ci < (NT + 31) / 32) chain_item(P, l, ci, (float*)lds + w * 1152, lane);
            TSEC_END(7);
        }
    }
    }
}

constexpr int SNT = 2;
__device__ __forceinline__ void gdn_scan(const Params& P, int sw, unsigned char* lds) {
    h16* St = (h16*)lds;
    h16* Vt = (h16*)(lds + 16 * SNT * 272);
    const int tid = opaque_tid(), lane = tid & 63, w = tid >> 6, gq = lane >> 4, c16 = lane & 15;
    const int chain = sw / (8 / SNT), e0 = (sw % (8 / SNT)) * 16 * SNT, b = chain >> 2, h = chain & 3;
    const h16* Ub = (const h16*)(P.ws + OFF_U); const h16* Wb = (const h16*)(P.ws + OFF_WM);
    const h16* Qb = (const h16*)(P.ws + OFF_QD); const h16* Kb = (const h16*)(P.ws + OFF_KDT);
    const h16* Ab = (const h16*)(P.ws + OFF_AQK); const float* cdec = (const float*)(P.ws + OFF_CDEC);
    h16* og = (h16*)(P.ws + OFF_QN);
    __syncthreads();
    for (int i = tid; i < 16 * SNT * 136; i += NTHREADS) St[i] = (h16)0.f;
    f32x4 S[2][SNT];
#pragma unroll
    for (int m2 = 0; m2 < 2; ++m2)
#pragma unroll
        for (int nt = 0; nt < SNT; ++nt) S[m2][nt] = (f32x4){0.f, 0.f, 0.f, 0.f};
    __syncthreads();
    h16x8 wf[2][4], qf[2][4], af[2][2], kf_[2][2][2]; h16 uv[2][SNT][4]; float cd[2];
#define SCAN_LOAD(S_, n_) do { const int nn_ = (n_) < NCH ? (n_) : NCH - 1; const size_t itm = (size_t)chain * NCH + nn_; \
        _Pragma("unroll") for (int ks = 0; ks < 4; ++ks) { wf[S_][ks] = *(const h16x8*)(Wb + itm * 8192 + (16 * w + c16) * 128 + 32 * ks + 8 * gq); qf[S_][ks] = *(const h16x8*)(Qb + itm * 8192 + (16 * w + c16) * 128 + 32 * ks + 8 * gq); } \
        _Pragma("unroll") for (int ks = 0; ks < 2; ++ks) { af[S_][ks] = *(const h16x8*)(Ab + itm * 4096 + (16 * w + c16) * 64 + 32 * ks + 8 * gq); \
            _Pragma("unroll") for (int m2 = 0; m2 < 2; ++m2) kf_[S_][m2][ks] = *(const h16x8*)(Kb + itm * 8192 + (16 * (2 * w + m2) + c16) * 64 + 32 * ks + 8 * gq); } \
        _Pragma("unroll") for (int nt = 0; nt < SNT; ++nt) _Pragma("unroll") for (int r = 0; r < 4; ++r) uv[S_][nt][r] = Ub[itm * 8192 + (16 * w + 4 * gq + r) * 128 + e0 + 16 * nt + c16]; \
        cd[S_] = cdec[itm]; } while (0)
#define SCAN_STEP(S_, n_) do { \
        h16x8 cwf[4], cqf[4], caf[2], ckf[2][2]; float cu[SNT][4]; const float ccd = cd[S_]; \
        _Pragma("unroll") for (int ks = 0; ks < 4; ++ks) { cwf[ks] = wf[S_][ks]; cqf[ks] = qf[S_][ks]; } \
        _Pragma("unroll") for (int ks = 0; ks < 2; ++ks) { caf[ks] = af[S_][ks]; ckf[0][ks] = kf_[S_][0][ks]; ckf[1][ks] = kf_[S_][1][ks]; } \
        _Pragma("unroll") for (int nt = 0; nt < SNT; ++nt) _Pragma("unroll") for (int r = 0; r < 4; ++r) cu[nt][r] = (float)uv[S_][nt][r]; \
        SCAN_LOAD(S_, (n_) + 2); \
        f32x4 Pm[SNT], O[SNT]; \
        _Pragma("unroll") for (int nt = 0; nt < SNT; ++nt) { Pm[nt] = (f32x4){0.f, 0.f, 0.f, 0.f}; O[nt] = (f32x4){0.f, 0.f, 0.f, 0.f}; \
            _Pragma("unroll") for (int ks = 0; ks < 4; ++ks) { const h16x8 bs = *(const h16x8*)(St + (16 * nt + c16) * 136 + 32 * ks + 8 * gq); Pm[nt] = MFMA16(cwf[ks], bs, Pm[nt]); O[nt] = MFMA16(cqf[ks], bs, O[nt]); } \
            h16x4 vn; \
            _Pragma("unroll") for (int r = 0; r < 4; ++r) vn[r] = (h16)(cu[nt][r] - Pm[nt][r]); \
            *(h16x4*)(Vt + (16 * nt + c16) * 72 + 16 * w + 4 * gq) = vn; } \
        lds_barrier(); \
        _Pragma("unroll") for (int nt = 0; nt < SNT; ++nt) { \
            _Pragma("unroll") for (int m2 = 0; m2 < 2; ++m2) _Pragma("unroll") for (int r = 0; r < 4; ++r) S[m2][nt][r] *= ccd; \
            _Pragma("unroll") for (int ks = 0; ks < 2; ++ks) { const h16x8 bv = *(const h16x8*)(Vt + (16 * nt + c16) * 72 + 32 * ks + 8 * gq); O[nt] = MFMA16(caf[ks], bv, O[nt]); S[0][nt] = MFMA16(ckf[0][ks], bv, S[0][nt]); S[1][nt] = MFMA16(ckf[1][ks], bv, S[1][nt]); } \
            _Pragma("unroll") for (int r = 0; r < 4; ++r) { const int t = 64 * (n_) + 16 * w + 4 * gq + r - 48; if (t >= 0) og[((size_t)b * T_ + t) * 512 + h * 128 + e0 + 16 * nt + c16] = (h16)(O[nt][r] * 0.08838834764831845f); } \
            _Pragma("unroll") for (int m2 = 0; m2 < 2; ++m2) { h16x4 sv; \
                _Pragma("unroll") for (int r = 0; r < 4; ++r) sv[r] = (h16)S[m2][nt][r]; \
                *(h16x4*)(St + (16 * nt + c16) * 136 + 16 * (2 * w + m2) + 4 * gq) = sv; } } \
        lds_barrier(); } while (0)
    SCAN_LOAD(0, 0); SCAN_LOAD(1, 1);
    for (int n = 0; n + 1 < NCH; n += 2) { SCAN_STEP(0, n); SCAN_STEP(1, n + 1); }
    SCAN_STEP(0, NCH - 1);
#undef SCAN_STEP
#undef SCAN_LOAD
}

constexpr int CAP = 704;
__device__ __forceinline__ void dma16_asm(const void* gptr, unsigned lds_addr) {
    unsigned sv; lds_addr = (unsigned)__builtin_amdgcn_readfirstlane((int)lds_addr);
    asm volatile("s_mov_b32 %0, m0\n\ts_mov_b32 m0, %2\n\ts_nop 0\n\tglobal_load_lds_dwordx4 %1, off\n\ts_mov_b32 m0, %0" : "=&s"(sv) : "v"(gptr), "s"(lds_addr) : "memory");
}
__device__ __forceinline__ int dpp_scan_incl(int x) {
    x += __builtin_amdgcn_update_dpp(0, x, 0x111, 0xf, 0xf, false);
    x += __builtin_amdgcn_update_dpp(0, x, 0x112, 0xf, 0xf, false);
    x += __builtin_amdgcn_update_dpp(0, x, 0x114, 0xf, 0xf, false);
    x += __builtin_amdgcn_update_dpp(0, x, 0x118, 0xf, 0xf, false);
    x += __builtin_amdgcn_update_dpp(0, x, 0x142, 0xa, 0xf, false);
    x += __builtin_amdgcn_update_dpp(0, x, 0x143, 0xc, 0xf, false);
    return x;
}

__device__ __forceinline__ int topk_prune(float* sc, unsigned short* ix, unsigned* hist, int c, int lane, int K, int limit, float& theta, float& theta_next) {
    constexpr int NE = (CAP + 63) / 64;
    unsigned key[NE]; unsigned short idx[NE]; float val[NE];
#pragma unroll
    for (int it = 0; it < NE; ++it) { const int i = lane + 64 * it; const bool v = i < c; const float f = v ? sc[i] : 0.f; val[it] = f; idx[it] = v ? ix[i] : (unsigned short)0; key[it] = v ? ordkey(f) : 0u; }
    unsigned prefix = 0; int need = K; int binpop = 0; bool exact = true; int sh = 0;
    const unsigned tb0 = (unsigned)__builtin_amdgcn_readfirstlane((int)(key[0] >> 24));
    bool same = true;
#pragma unroll
    for (int it = 0; it < NE; ++it) same = same && (key[it] == 0u || (key[it] >> 24) == tb0);
    const bool skip0 = __all(same);
    if (skip0) prefix = tb0 << 24;
#pragma unroll
    for (int r = 0; r < 4; ++r) {
        if (r == 0 && skip0) continue;
        const int shift = 24 - 8 * r;
        ((uint4*)hist)[lane] = make_uint4(0u, 0u, 0u, 0u);
        WAVE_FENCE();
#pragma unroll
        for (int it = 0; it < NE; ++it) {
            const bool m = (key[it] != 0u) && (r == 0 || ((key[it] ^ prefix) >> ((shift + 8) & 31)) == 0u);
            if (m) atomicAdd(&hist[(key[it] >> shift) & 255u], 1u);
        }
        WAVE_FENCE();
        const uint4 h4 = ((const uint4*)hist)[63 - lane];
        WAVE_FENCE();
        const int loc = (int)(h4.x + h4.y + h4.z + h4.w);
        const int incl = dpp_scan_incl(loc);
        const int c3 = incl - loc, c2 = c3 + (int)h4.w, c1 = c2 + (int)h4.z, c0 = c1 + (int)h4.y;
        int dsel = -1, cab = 0, hb = 0;
        if (c3 < need && need <= c3 + (int)h4.w) { dsel = 3; cab = c3; hb = (int)h4.w; }
        else if (c2 < need && need <= c2 + (int)h4.z) { dsel = 2; cab = c2; hb = (int)h4.z; }
        else if (c1 < need && need <= c1 + (int)h4.y) { dsel = 1; cab = c1; hb = (int)h4.y; }
        else if (c0 < need && need <= c0 + (int)h4.x) { dsel = 0; cab = c0; hb = (int)h4.x; }
        const u64 fm = __ballot(dsel >= 0);
        const int src = __builtin_amdgcn_readfirstlane(__ffsll((long long)fm) - 1);
        const int digit = __builtin_amdgcn_readlane(4 * (63 - lane) + dsel, src);
        const int cabv = __builtin_amdgcn_readlane(cab, src);
        binpop = __builtin_amdgcn_readlane(hb, src);
        need -= cabv; prefix |= (unsigned)digit << shift; sh = shift;
        if (r < 3 && (K - need) + binpop <= limit) { exact = false; break; }
    }
    (void)sh;
    const unsigned thr = prefix; int out = 0, tb = 0;
#pragma unroll
    for (int it = 0; it < NE; ++it) {
        const bool v = key[it] != 0u; const bool gt = v && key[it] > thr; const bool eq = v && key[it] == thr;
        bool keep;
        if (exact && K == 256) { const u64 meq = __ballot(eq); const int tr = tb + lanes_below(meq); keep = gt || (eq && tr < need); tb += __popcll(meq); }
        else keep = gt || eq;
        const u64 mk = __ballot(keep); const int slot = out + lanes_below(mk);
        if (keep) { sc[slot] = val[it]; ix[slot] = idx[it]; }
        out += __popcll(mk);
    }
    WAVE_FENCE();
    theta = ordinv(thr); theta_next = ordinv(thr + 1u);
    return out;
}

constexpr int WL_SC = 0;
constexpr int WL_IX = 8 * CAP * 4;
constexpr int WL_RING = 0;
constexpr int SLOT_BYTES = 8704;
constexpr int WL_SEL = 34816;
constexpr int WL_NSEL = 38912;
constexpr int WL_BYTES = 38944;
static_assert(WL_IX + 8 * CAP * 2 <= WL_SEL && 4 * SLOT_BYTES <= WL_SEL, "DSA LDS map");

__device__ __forceinline__ void dsa_item(const Params& P, int item, int qlo, int qhi, unsigned char* wl, const float* biasd, int lane) {
    float* sc = (float*)(wl + WL_SC);
    unsigned short* ix = (unsigned short*)(wl + WL_IX);
    unsigned* hist = (unsigned*)(wl + WL_SEL);
    unsigned short* sel = (unsigned short*)(wl + WL_SEL);
    int* nselL = (int*)(wl + WL_NSEL);
    unsigned char* ring = wl + WL_RING;
    const h16* qidx = (const h16*)(P.ws + OFF_QIDX);
    const float* small = (const float*)(P.ws + OFF_SMALL);
    const h16* kvrow = (const h16*)(P.ws + OFF_KVROW);
    const h16* qk = (const h16*)(P.ws + OFF_QK);
    h16* ctxb = (h16*)(P.ws + OFF_CTX);
    const int row0 = item * 8; const int b = row0 >= T_ ? 1 : 0; const int t0 = row0 - b * T_;
    const int half = lane >> 5, kl = lane & 31;
    WAVE_FENCE();
    TSEC_BEGIN(3)
    for (int rep_ = 0; rep_ <= (PROBE_TOPK2 | PROBE_SWEEP); ++rep_) {
        const bool dummy_ = PROBE_SWEEP && rep_ == 0;
        h16x8 afr[4];
        { const int qq = kl >> 2, hd = kl & 3; const h16* p = qidx + (size_t)(row0 + qq) * 256 + hd * 64 + 8 * half;
#pragma unroll
          for (int ks = 0; ks < 4; ++ks) afr[ks] = *(const h16x8*)(p + 16 * ks); }
        float wq[4][4]; float thq[8]; int cntq[8];
#pragma unroll
        for (int g = 0; g < 4; ++g) { const float* sp = small + (size_t)(row0 + 2 * g + half) * 16;
#pragma unroll
            for (int hh = 0; hh < 4; ++hh) wq[g][hh] = sp[hh]; }
#pragma unroll
        for (int qq = 0; qq < 8; ++qq) { thq[qq] = (dummy_ || qq < qlo || qq >= qhi) ? INFINITY : -INFINITY; cntq[qq] = 0; }
        const int ntiles = ((t0 + 7) >> 5) + 1;
        bool safe_ = false;
      redo_sweep:
        const h16* kfp = (const h16*)(P.ws + OFF_KFRAG) + (size_t)b * NKT * 2048 + lane * 8;
        h16x8 bt[8][4];
#pragma unroll
        for (int u = 0; u < 8; ++u) { const int tl = u < ntiles ? u : ntiles - 1;
#pragma unroll
            for (int ks = 0; ks < 4; ++ks) bt[u][ks] = *(const h16x8*)(kfp + (size_t)tl * 2048 + ks * 512); }
        const int ngroups = (ntiles + 3) >> 2;
#define SWEEP_GROUP(PAR) \
                f32x16 acc[4]; \
                _Pragma("unroll") for (int u = 0; u < 4; ++u) { \
                    _Pragma("unroll") for (int r = 0; r < 16; ++r) acc[u][r] = 0.f; \
                    _Pragma("unroll") for (int ks = 0; ks < 4; ++ks) acc[u] = MFMA32(afr[ks], bt[4 * (PAR) + u][ks], acc[u]); \
                    const int tn = tile0 + u + 8 < ntiles ? tile0 + u + 8 : ntiles - 1;     \
                    _Pragma("unroll") for (int ks = 0; ks < 4; ++ks) bt[4 * (PAR) + u][ks] = *(const h16x8*)(kfp + (size_t)tn * 2048 + ks * 512); } \
                _Pragma("unroll") for (int q = 0; q < 16; ++q) { __builtin_amdgcn_sched_group_barrier(0x8, 1, 0); __builtin_amdgcn_sched_group_barrier(0x20, 1, 0); }     \
                __builtin_amdgcn_sched_barrier(0);
        for (int grp = 0; grp <= ngroups; ++grp) {
            const bool last = grp == ngroups;
            if (!last) {
                const int tile0 = grp * 4;
                f32x16 accs[4];
                if (grp & 1) { SWEEP_GROUP(1) _Pragma("unroll") for (int u = 0; u < 4; ++u) accs[u] = acc[u]; }
                else { SWEEP_GROUP(0) _Pragma("unroll") for (int u = 0; u < 4; ++u) accs[u] = acc[u]; }
#pragma unroll
                for (int p = 0; p < 2; ++p) {
                    const int key = (tile0 + 2 * p) * 32 + lane;
#pragma unroll
                    for (int g = 0; g < 4; ++g) {
                        float sa = 0.f, sb = 0.f;
#pragma unroll
                        for (int hh = 0; hh < 4; ++hh) { sa = fmaf(wq[g][hh], relu1(accs[2 * p][4 * g + hh]), sa); sb = fmaf(wq[g][hh], relu1(accs[2 * p + 1][4 * g + hh]), sb); }
                        const auto sw = __builtin_amdgcn_permlane32_swap(__float_as_uint(sa), __float_as_uint(sb), false, false);
#pragma unroll
                        for (int o = 0; o < 2; ++o) {
                            const int qq = 2 * g + o; const float sv = __uint_as_float(sw[o]);
                            u64 mge; asm("v_cmp_ge_f32 %0, %1, %2" : "=s"(mge) : "v"(sv), "v"(thq[qq]));
                            const u64 m = __builtin_amdgcn_ballot_w64(key <= t0 + qq) & mge;
                            const bool pass = __builtin_amdgcn_inverse_ballot_w64(m);
                            const int slot = lanes_below_from(m, cntq[qq]);
                            if (pass) { sc[qq * CAP + slot] = sv; ix[qq * CAP + slot] = (unsigned short)key; }
                            cntq[qq] += __builtin_popcountll(m);
                        }
                    }
                }
            }
            const int lim = last ? 256 : CAP - 128;
            int cmax = cntq[0];
#pragma unroll
            for (int qq = 1; qq < 8; ++qq) cmax = cntq[qq] > cmax ? cntq[qq] : cmax;
            if (cmax > lim) {
                WAVE_FENCE();
#pragma unroll 1
                for (int qq = 0; qq < 8; ++qq) {
                    int c = cntq[0];
#pragma unroll
                    for (int j = 1; j < 8; ++j) c = qq == j ? cntq[j] : c;
                    c = __builtin_amdgcn_readfirstlane(c);
                    if (c > lim) {
                        float nth, nthn;
                        const int nall = t0 + qq + 1; int nseen = (grp + 1) * 128; nseen = nseen < nall ? nseen : nall;
                        int K = 256;
                        if (!last && !safe_) { K = (int)(448.f * (float)nseen / (float)nall) + 16; K = K < 48 ? 48 : (K > 256 ? 256 : K); }
                        TSEC_BEGIN(1) TSEC_BEGIN(2)
                        const int nc = topk_prune(sc + qq * CAP, ix + qq * CAP, hist, c, lane, K, last ? 256 : K + 64, nth, nthn);
                        if (!last) TSEC_END(1); else TSEC_END(2);
                        float nv = K == 256 ? nthn : nth;
                        int ncf = nc;
                        if (K < 256 && nc > lim) {
                            ncf = topk_prune(sc + qq * CAP, ix + qq * CAP, hist, nc, lane, 256, 320, nth, nthn); nv = nthn;
                        }
#pragma unroll
                        for (int j = 0; j < 8; ++j) if (j == qq) { cntq[j] = ncf; thq[j] = nv; }
                    }
                }
            }
        }
        {
            bool okq = true;
#pragma unroll
            for (int qq = 0; qq < 8; ++qq) okq = okq && (qq < qlo || qq >= qhi || cntq[qq] >= 256 || cntq[qq] >= t0 + qq + 1);
            if (!okq && !safe_ && !dummy_) {
                safe_ = true;
#pragma unroll
                for (int qq = 0; qq < 8; ++qq) { thq[qq] = (qq < qlo || qq >= qhi) ? INFINITY : -INFINITY; cntq[qq] = 0; }
                WAVE_FENCE();
                goto redo_sweep;
            }
        }
#undef SWEEP_GROUP
        WAVE_FENCE();
#pragma unroll 1
        for (int qq = qlo; qq < (dummy_ ? 0 : qhi); ++qq) {
            int c = cntq[0];
#pragma unroll
            for (int j = 1; j < 8; ++j) c = qq == j ? cntq[j] : c;
            c = __builtin_amdgcn_readfirstlane(c);
            if (lane == 0) nselL[qq] = c;
#pragma unroll
            for (int i4 = 0; i4 < 4; ++i4) { const int i = lane + 64 * i4; sel[qq * 256 + i] = i < c ? ix[qq * CAP + i] : (unsigned short)0; }
        }
        WAVE_FENCE();
    }
    TSEC_END(3);
    TSEC_BEGIN(4)
    const int gq = lane >> 4, c16 = lane & 15; const bool hv = c16 < 8;
    const unsigned ring_a = (unsigned)(size_t)(LAS unsigned char*)ring;
    const h16* kvb = kvrow + (size_t)b * T_ * 136;
    int poff[4];
#pragma unroll
    for (int i = 0; i < 4; ++i) poff[i] = (c16 ^ ((4 * i + gq) & 15)) * 8;
    const float b31 = biasd[127 * 8 + (c16 & 7)];
#define DSA_ISSUE(J_) do { const int jj_ = (J_) < 8 * qhi ? (J_) : 8 * qhi - 1; const unsigned short* sp_ = sel + (jj_ >> 3) * 256 + 32 * (jj_ & 7); \
        const h16* a_[8]; \
        _Pragma("unroll") for (int i = 0; i < 8; ++i) a_[i] = kvb + (size_t)sp_[4 * i + gq] * 136 + poff[i & 3]; \
        const h16* ar_ = kvb + (size_t)sp_[lane & 31] * 136 + 128; \
        const unsigned la_ = (unsigned)__builtin_amdgcn_readfirstlane((int)(ring_a + ((J_) & 3) * SLOT_BYTES)); unsigned sv_; unsigned long long ex_; \
        asm volatile("s_mov_b32 %0, m0\n\ts_mov_b32 m0, %2\n\ts_nop 0\n\t" \
            "global_load_lds_dwordx4 %3, off\n\ts_add_u32 m0, m0, 0x400\n\ts_nop 0\n\t" "global_load_lds_dwordx4 %4, off\n\ts_add_u32 m0, m0, 0x400\n\ts_nop 0\n\t" \
            "global_load_lds_dwordx4 %5, off\n\ts_add_u32 m0, m0, 0x400\n\ts_nop 0\n\t" "global_load_lds_dwordx4 %6, off\n\ts_add_u32 m0, m0, 0x400\n\ts_nop 0\n\t" \
            "global_load_lds_dwordx4 %7, off\n\ts_add_u32 m0, m0, 0x400\n\ts_nop 0\n\t" "global_load_lds_dwordx4 %8, off\n\ts_add_u32 m0, m0, 0x400\n\ts_nop 0\n\t" \
            "global_load_lds_dwordx4 %9, off\n\ts_add_u32 m0, m0, 0x400\n\ts_nop 0\n\t" "global_load_lds_dwordx4 %10, off\n\ts_add_u32 m0, m0, 0x400\n\ts_nop 0\n\t" \
            "s_mov_b64 %1, exec\n\ts_mov_b64 exec, 0xffffffff\n\tglobal_load_lds_dwordx4 %11, off\n\ts_mov_b64 exec, %1\n\ts_mov_b32 m0, %0" \
            : "=&s"(sv_), "=&s"(ex_) : "s"(la_), "v"(a_[0]), "v"(a_[1]), "v"(a_[2]), "v"(a_[3]), "v"(a_[4]), "v"(a_[5]), "v"(a_[6]), "v"(a_[7]), "v"(ar_) : "memory"); } while (0)
    for (int rep_ = 0; rep_ <= PROBE_ATT2; ++rep_) {
    asm volatile("s_waitcnt vmcnt(0) lgkmcnt(0)" ::: "memory");
    DSA_ISSUE(8 * qlo); DSA_ISSUE(8 * qlo + 1); DSA_ISSUE(8 * qlo + 2);
#pragma unroll 1
    for (int qq = qlo; qq < qhi; ++qq) {
        const int rowq = row0 + qq, tq = t0 + qq, ns = nselL[qq];
        const unsigned short* selq = sel + qq * 256;
        h16x8 qf[4];
#pragma unroll
        for (int ks = 0; ks < 4; ++ks) {
            if (hv) qf[ks] = *(const h16x8*)(qk + (size_t)rowq * 1024 + c16 * 128 + 32 * ks + 8 * gq);
            else {
#pragma unroll
                for (int e = 0; e < 8; ++e) qf[ks][e] = (h16)0.f;
            }
        }
        float m_run = -INFINITY, l_run = 0.f;
        f32x4 ctx[8];
#pragma unroll
        for (int nt = 0; nt < 8; ++nt) ctx[nt] = (f32x4){0.f, 0.f, 0.f, 0.f};
#pragma unroll 1
        for (int c = 0; c < 8; ++c) {
            const int j = 8 * qq + c;
            DSA_ISSUE(j + 3);
            asm volatile("s_waitcnt vmcnt(27)" ::: "memory");
            const unsigned char* sl = ring + (j & 3) * SLOT_BYTES;
            h16x8 af[2][4];
#pragma unroll
            for (int mt = 0; mt < 2; ++mt)
#pragma unroll
                for (int ks = 0; ks < 4; ++ks) af[mt][ks] = *(const h16x8*)(sl + (16 * mt + c16) * 256 + (((4 * ks + gq) ^ c16) * 16));
            fp16x4 rt[2]; ushort4 sv[2];
#pragma unroll
            for (int mt = 0; mt < 2; ++mt) {
                rt[mt] = __builtin_amdgcn_ds_read_tr16_b64_v4f16((LAS fp16x4*)(sl + 8192 + (16 * mt + 4 * gq + (c16 >> 2)) * 16 + 8 * (c16 & 3)));
                sv[mt] = *(const ushort4*)(selq + 32 * c + 16 * mt + 4 * gq);
            }
            fp16x4 tb[8][2];
            { const int rw0 = 4 * gq + (c16 >> 2), rw1 = 16 + rw0;
#pragma unroll
              for (int nt = 0; nt < 8; ++nt) { const int pc = 2 * nt + ((c16 >> 1) & 1);
                tb[nt][0] = __builtin_amdgcn_ds_read_tr16_b64_v4f16((LAS fp16x4*)(sl + rw0 * 256 + ((pc ^ (rw0 & 15)) * 16) + 8 * (c16 & 1)));
                tb[nt][1] = __builtin_amdgcn_ds_read_tr16_b64_v4f16((LAS fp16x4*)(sl + rw1 * 256 + ((pc ^ (rw1 & 15)) * 16) + 8 * (c16 & 1))); } }
            f32x4 s4[2];
#pragma unroll
            for (int mt = 0; mt < 2; ++mt) { s4[mt] = (f32x4){0.f, 0.f, 0.f, 0.f};
#pragma unroll
                for (int ks = 0; ks < 4; ++ks) s4[mt] = MFMA16(af[mt][ks], qf[ks], s4[mt]); }
            int dist[2][4]; int dmin = 127;
#pragma unroll
            for (int mt = 0; mt < 2; ++mt) { const int sarr[4] = {(int)sv[mt].x, (int)sv[mt].y, (int)sv[mt].z, (int)sv[mt].w};
#pragma unroll
                for (int r = 0; r < 4; ++r) { int d = tq - sarr[r]; d = d < 0 ? 0 : (d > 127 ? 127 : d); dist[mt][r] = d; dmin = d < dmin ? d : dmin; } }
            float bias[2][4];
            if (__all(dmin == 127)) {
#pragma unroll
                for (int mt = 0; mt < 2; ++mt)
#pragma unroll
                    for (int r = 0; r < 4; ++r) bias[mt][r] = b31;
            } else {
#pragma unroll
                for (int mt = 0; mt < 2; ++mt)
#pragma unroll
                    for (int r = 0; r < 4; ++r) bias[mt][r] = biasd[dist[mt][r] * 8 + (c16 & 7)];
            }
            float lg[2][4]; float mx = -INFINITY;
#pragma unroll
            for (int mt = 0; mt < 2; ++mt) { const h16x4 rr = __builtin_bit_cast(h16x4, rt[mt]);
#pragma unroll
                for (int r = 0; r < 4; ++r) {
                    const int kidx = 32 * c + 16 * mt + 4 * gq + r; const bool valid = hv && (kidx < ns);
                    const float v = valid ? s4[mt][r] * (float)rr[r] + bias[mt][r] : -INFINITY;
                    lg[mt][r] = v; mx = fmaxf(mx, v);
                } }
            {
                const unsigned u0 = __float_as_uint(mx);
                const auto p16 = __builtin_amdgcn_permlane16_swap(u0, u0, false, false);
                const float y = fmaxf(__uint_as_float(p16[0]), __uint_as_float(p16[1]));
                const unsigned u1 = __float_as_uint(y);
                const auto p32 = __builtin_amdgcn_permlane32_swap(u1, u1, false, false);
                mx = fmaxf(__uint_as_float(p32[0]), __uint_as_float(p32[1]));
            }
            const float m_new = fmaxf(m_run, mx);
            const float alpha = (hv && m_new > -INFINITY) ? __expf(m_run - m_new) : 1.f;
            float rs = 0.f; float pp[2][4];
#pragma unroll
            for (int mt = 0; mt < 2; ++mt)
#pragma unroll
                for (int r = 0; r < 4; ++r) { const float p = (hv && lg[mt][r] > -INFINITY) ? __expf(lg[mt][r] - m_new) : 0.f; pp[mt][r] = p; rs += p; }
            {
                const unsigned u0 = __float_as_uint(rs);
                const auto p16 = __builtin_amdgcn_permlane16_swap(u0, u0, false, false);
                const float y = __uint_as_float(p16[0]) + __uint_as_float(p16[1]);
                const unsigned u1 = __float_as_uint(y);
                const auto p32 = __builtin_amdgcn_permlane32_swap(u1, u1, false, false);
                rs = __uint_as_float(p32[0]) + __uint_as_float(p32[1]);
            }
            l_run = l_run * alpha + rs; m_run = m_new;
            h16x8 pa;
#pragma unroll
            for (int jx = 0; jx < 8; ++jx) pa[jx] = (h16)pp[jx >> 2][jx & 3];
            if (__any(alpha != 1.f)) {
                float ar[4];
#pragma unroll
                for (int r = 0; r < 4; ++r) ar[r] = __shfl(alpha, 4 * gq + r);
#pragma unroll
                for (int nt = 0; nt < 8; ++nt)
#pragma unroll
                    for (int r = 0; r < 4; ++r) ctx[nt][r] *= ar[r];
            }
#pragma unroll
            for (int nt = 0; nt < 8; ++nt) {
                const h16x4 b0 = __builtin_bit_cast(h16x4, tb[nt][0]), b1 = __builtin_bit_cast(h16x4, tb[nt][1]);
                h16x8 bf; bf[0] = b0[0]; bf[1] = b0[1]; bf[2] = b0[2]; bf[3] = b0[3]; bf[4] = b1[0]; bf[5] = b1[1]; bf[6] = b1[2]; bf[7] = b1[3];
                ctx[nt] = MFMA16(pa, bf, ctx[nt]);
            }
        }
        float li[4];
#pragma unroll
        for (int r = 0; r < 4; ++r) li[r] = 1.f / __shfl(l_run, (4 * gq + r) & 7);
        if (gq < 2) {
#pragma unroll
            for (int nt = 0; nt < 8; ++nt)
#pragma unroll
                for (int r = 0; r < 4; ++r) ctxb[(size_t)rowq * 1024 + (4 * gq + r) * 128 + 16 * nt + c16] = (h16)(ctx[nt][r] * li[r]);
        }
    }
    asm volatile("s_waitcnt vmcnt(0)" ::: "memory");
    }
#undef DSA_ISSUE
    WAVE_FENCE();
    TSEC_END(4);
}

__device__ __forceinline__ void phase3(const Params& P, int l, unsigned char* lds) {
    const int tid = opaque_tid(), lane = tid & 63, w = tid >> 6;
    float* biasd = (float*)(lds + 4 * WL_BYTES);
    __syncthreads();
    for (int i = tid; i < 1024; i += NTHREADS) biasd[i] = P.rel[(int)c_bucket[i >> 3] * 8 + (i & 7)];
    __syncthreads();
    { TSEC_BEGIN(10)
    for (int rep_ = 0; rep_ <= PROBE_SCAN2; ++rep_) for (int sw = blockIdx.x; sw < 8 * (8 / SNT); sw += gridDim.x) gdn_scan(P, sw, lds);
    TSEC_END(10); }
    __syncthreads();
    unsigned* ctr = (unsigned*)(P.ws + OFF_CTL) + 4608 + l * 128;
    unsigned char* wl = lds + w * WL_BYTES;
    const int x0 = (int)xb_xcc_id() & 7; int d = 0;
    for (;;) {
        int item = -1;
        if (lane == 0) {
            while (d < 8) {
                const int xc = (x0 + d) & 7; const int bb = xc >> 2, sub = xc & 3; const int cnt = (1026 - sub + 3) >> 2;
                const int pf = 230;
                const int t = (int)__hip_atomic_fetch_add(ctr + xc * 16, 1u, __ATOMIC_RELAXED, __HIP_MEMORY_SCOPE_AGENT);
                if (t < pf + 2 * (cnt - pf)) {
                    const int p = t < pf ? t : pf + ((t - pf) >> 1);
                    item = (bb * 1026 + 4 * (cnt - 1 - p) + sub) * 4 + (t < pf ? 0 : 1 + ((t - pf) & 1));
                    break;
                }
                ++d;
            }
        }
        d = __builtin_amdgcn_readfirstlane(d);
        item = __builtin_amdgcn_readfirstlane(item);
        if (item < 0) break;
        { const int hsel = item & 3; dsa_item(P, item >> 2, hsel == 2 ? 4 : 0, hsel == 1 ? 4 : 8, wl, biasd, lane); }
    }
}

__device__ __forceinline__ void phase4(const Params& P, int l, unsigned char* lds) {
    const int tid = opaque_tid(), lane = tid & 63, w = tid >> 6;
    (void)lds;
    if (l == 0 && (int)gridDim.x > 160 && (int)blockIdx.x >= 129) { prep_tiles(P, lds, 1, 129, (int)gridDim.x - 129); return; }
    TSEC_BEGIN(11)
    for (int it = blockIdx.x * 4 + w; it < (NT + 31) / 32; it += gridDim.x * 4) p4_item(P, l, it, lane);
    TSEC_END(11);
    if (l == 0 && (int)gridDim.x <= 160) { __syncthreads(); prep_tiles(P, lds, 1, 0, (int)gridDim.x); }
}

__device__ __forceinline__ void phase5(const Params& P, int l, unsigned char* lds) {
    h16* smem = (h16*)lds;
    const h16* W = (const h16*)(P.ws + OFF_WOT) + (size_t)l * 1024 * 1024;
    const h16* A = (const h16*)(P.ws + OFF_OMIX);
    float* sumsq_next = (float*)(P.ws + OFF_SUMSQ) + NTP;
    XcdQueue xq; xq.init((unsigned*)(P.ws + OFF_CTL) + 4352 + l * 128, 32, (int*)(lds + LDS_BYTES - 32));
    int xl, qi;
    while (xq.next(xl, qi)) {
        const int rb = 8 * xl + (qi & 7), tn = qi >> 3;
        EpiResBig ep; ep.layer = l; ep.row0 = rb * 256; ep.n0 = tn * 256; ep.meta = P.meta; ep.x = P.x; ep.metah = (float*)(P.ws + OFF_METAH); ep.out = P.out; ep.h16o = (h16*)(P.ws + OFF_H16); ep.sumsq_next = sumsq_next; ep.ss = 0.f; ep.nseg = 4;
        gemm_big(A + (size_t)rb * 256 * 1024, 1024, W + (size_t)tn * 256 * 1024, 1024, 1024, ep, smem);
    }
    __syncthreads();
    const int tid = opaque_tid();
    for (int it = blockIdx.x; it < 32; it += gridDim.x) {
        EpiResBig ep; ep.layer = l; ep.row0 = 16384; ep.n0 = it * 32; ep.meta = P.meta; ep.x = P.x; ep.metah = (float*)(P.ws + OFF_METAH); ep.out = P.out; ep.h16o = (h16*)(P.ws + OFF_H16); ep.sumsq_next = sumsq_next; ep.ss = 0.f; ep.nseg = 1;
        skinny_tile(A + (size_t)16384 * 1024, 1024, W + (size_t)it * 32 * 1024, 1024, 1024, ep, (float*)lds, tid);
    }
}

__global__ void __launch_bounds__(NTHREADS) hybrid_fwd(Params P) {
    extern __shared__ __attribute__((aligned(16))) unsigned char lds[];
    cg::grid_group grid = cg::this_grid();
    volatile LAS unsigned* bst = (volatile LAS unsigned*)(lds + LDS_BYTES - 16);
    if (threadIdx.x < 4) bst[threadIdx.x] = 0u;
    if (PROBE_TSEC && (threadIdx.x & 63) == 0) *tsec_slot() = 0ull;
    __syncthreads();
    XcdBarrier xbar = xcd_barrier_post((unsigned*)(P.ws + OFF_CTL) + 256, bst);
    if (PROBE_MFMA) {
        f32x16 pa[8]; h16x8 fa, fb;
#pragma unroll
        for (int e = 0; e < 8; ++e) { fa[e] = (h16)(0.001f * (threadIdx.x & 7)); fb[e] = (h16)0.5f; }
#pragma unroll
        for (int i = 0; i < 8; ++i)
#pragma unroll
            for (int r = 0; r < 16; ++r) pa[i][r] = 0.f;
        h16* lp = (h16*)lds + (threadIdx.x & 31) * 72 + 8 * ((threadIdx.x >> 5) & 1) + (threadIdx.x >> 6) * 2304;
#pragma unroll 1
        for (int it = 0; it < 256; ++it) {
            if (PROBE_MFMA == 2) {
                h16x8 t[8];
#pragma unroll
                for (int q = 0; q < 8; ++q) t[q] = *(const h16x8*)(lp + q * 32 * 72 + (it & 3) * 16);
#pragma unroll
                for (int q = 0; q < 4; ++q) *(h16x8*)(lp + 40000 + q * 32 * 72) = fb;
#pragma unroll
                for (int i = 0; i < 16; ++i) pa[i & 7] = MFMA32(t[i & 7], fb, pa[i & 7]);
#pragma unroll
                for (int q = 0; q < 12; ++q) { __builtin_amdgcn_sched_group_barrier(0x8, 1, 0); __builtin_amdgcn_sched_group_barrier(0x300, 1, 0); }
                __builtin_amdgcn_sched_group_barrier(0x8, 4, 0);
                __builtin_amdgcn_sched_barrier(0);
            } else {
#pragma unroll
                for (int i = 0; i < 16; ++i) pa[i & 7] = MFMA32(fa, fb, pa[i & 7]);
            }
        }
        float sacc = 0.f;
#pragma unroll
        for (int i = 0; i < 8; ++i) sacc += pa[i][0];
        if (sacc == 12345.678f) ((float*)(P.ws + OFF_CTL))[40] = sacc;
    }
    for (int ph = P.ph_lo; ph < P.ph_hi; ++ph) {
#ifndef ONLY
#define ONLY -1
#endif
        if (ph == 0) { TSEC_BEGIN(13) if (ONLY < 0 || ((ONLY >> 0) & 1)) for (int rep_ = 0; rep_ <= PROBE_P0X; ++rep_) phase_prep(P, lds); TSEC_END(13); }
        else {
            const int l = (ph - 1) / 5, s = (ph - 1) % 5;
            if (s == 0) { if (ONLY < 0 || ((ONLY >> 1) & 1)) for (int rep_ = 0; rep_ <= PROBE_P1X; ++rep_) phase_inproj(P, l, lds, rep_); }
            else if (s == 1) { if (ONLY < 0 || ((ONLY >> 2) & 1)) phase2(P, l, lds); }
            else if (s == 2) { if (ONLY < 0 || ((ONLY >> 3) & 1)) phase3(P, l, lds); }
            else if (s == 3) { if (ONLY < 0 || ((ONLY >> 4) & 1)) for (int rep_ = 0; rep_ <= PROBE_P4X; ++rep_) phase4(P, l, lds); }
            else { if (ONLY < 0 || ((ONLY >> 5) & 1)) for (int rep_ = 0; rep_ <= (l == 0 ? PROBE_P5L0X : 0); ++rep_) phase5(P, l, lds); }
        }
        if (ph + 1 < P.ph_hi) {
            if (P.ph_hi > 1000) grid.sync();
            { TSEC_BEGIN(20) if (PROBE_TSEC >= 20 && PROBE_TSEC - 20 == ph) t__20 = wall_clock64(); xcd_barrier(xbar); if (PROBE_TSEC >= 20 && PROBE_TSEC - 20 == ph) { const unsigned long long d__ = wall_clock64() - t__20; if ((threadIdx.x & 63) == 0) *tsec_slot() += d__; } }
            if (PROBE_SYNC) xcd_barrier(xbar);
        }
    }
    if (PROBE_TSEC) {
        unsigned long long* acc = (unsigned long long*)((unsigned*)(P.ws + OFF_CTL) + 32);
        __syncthreads();
        if ((threadIdx.x & 63) == 0) atomicAdd(acc, *tsec_slot());
        xcd_barrier(xbar);
        if (blockIdx.x == 0 && threadIdx.x == 0) {
            const unsigned long long tot = __hip_atomic_load(acc, __ATOMIC_RELAXED, __HIP_MEMORY_SCOPE_AGENT);
            const unsigned long long avg = tot / (gridDim.x * 4);
            const unsigned long long t0 = wall_clock64();
            while (wall_clock64() - t0 < avg) __builtin_amdgcn_s_sleep(4);
        }
    }
}

extern "C" void kernel_launch(void* const* d_in, const int* in_sizes, int n_in, void* d_out, int out_size, void* d_ws, size_t ws_size, hipStream_t stream) {
    static int grid_blocks = 0;
    if (grid_blocks == 0) {
        if (n_in != 17 || ws_size < WS_END) { fprintf(stderr, "kernel_launch: unexpected inputs (n_in %d, ws %zu < %zu)\n", n_in, ws_size, (size_t)WS_END); grid_blocks = -1; return; }
        int dev = 0, cus = 0, per_cu = 0;
        hipGetDevice(&dev);
        hipDeviceGetAttribute(&cus, hipDeviceAttributeMultiprocessorCount, dev);
        if (hipFuncSetAttribute((const void*)hybrid_fwd, hipFuncAttributeMaxDynamicSharedMemorySize, LDS_BYTES) != hipSuccess) { fprintf(stderr, "kernel_launch: hipFuncSetAttribute failed\n"); grid_blocks = -1; return; }
        hipOccupancyMaxActiveBlocksPerMultiprocessor(&per_cu, (const void*)hybrid_fwd, NTHREADS, LDS_BYTES);
        if (per_cu < 1) { fprintf(stderr, "kernel_launch: occupancy query says 0 blocks per CU\n"); grid_blocks = -1; return; }
        grid_blocks = cus * per_cu;
    }
    if (grid_blocks < 0) return;
    hipMemsetAsync((char*)d_ws + OFF_CTL, 0, 32768, stream);
    hipMemsetAsync((char*)d_ws + OFF_SUMSQ, 0, (size_t)2 * NTP * 4, stream);
    Params p{};
    p.x = (const float*)d_in[0]; p.meta = (const float*)d_in[1]; p.rel = (const float*)d_in[2]; p.norm_gain = (const float*)d_in[3];
    p.w_in = (const float*)d_in[4]; p.g_cq = (const float*)d_in[5]; p.g_ckv = (const float*)d_in[6]; p.w_uq = (const float*)d_in[7];
    p.w_ukv = (const float*)d_in[8]; p.w_qidx = (const float*)d_in[9]; p.g_qn = (const float*)d_in[10]; p.g_kn = (const float*)d_in[11];
    p.conv_w = (const float*)d_in[12]; p.a_log = (const float*)d_in[13]; p.dt_bias = (const float*)d_in[14]; p.g_out = (const float*)d_in[15];
    p.w_out = (const float*)d_in[16];
    p.out = (float*)d_out; p.ws = (unsigned char*)d_ws;
#if N_LAUNCH_MODE == 1
    p.ph_lo = 0; p.ph_hi = NPHASE;
    void* args[] = {&p};
    hipError_t e = hipLaunchCooperativeKernel((const void*)hybrid_fwd, dim3(grid_blocks), dim3(NTHREADS), args, LDS_BYTES, stream);
    if (e != hipSuccess) fprintf(stderr, "cooperative launch failed: %s (grid %d)\n", hipGetErrorString(e), grid_blocks);
#else
    for (int ph = 0; ph < NPHASE; ++ph) {
        p.ph_lo = ph; p.ph_hi = ph + 1;
        hipLaunchKernelGGL(hybrid_fwd, dim3(grid_blocks), dim3(NTHREADS), LDS_BYTES, stream, p);
    }
#endif
}
```

```cpp
#include <hip/hip_runtime.h>
#include <hip/hip_cooperative_groups.h>
#include <stdio.h>
#include <stdint.h>
namespace cg = cooperative_groups;

#define PROBE_TOPK2 0
#define PROBE_ATT2 0
#define PROBE_P1X 0
#define PROBE_P2X 0
#define PROBE_SCAN2 0
#define PROBE_P4X 0
#define PROBE_P0X 0
#define PROBE_P5L0X 0
#define PROBE_SYNC 0
#define PROBE_SWEEP 0
#define PROBE_P2C 0
#define PROBE_CHAIN 0
#define PROBE_MFMA 0
#define PROBE_TSEC 0
#define PROBE_S1 0
#define PROBE_S3 0
#define PROBE_S5 0
#ifndef N_LAUNCH_MODE
#define N_LAUNCH_MODE 1
#endif

typedef _Float16 h16;
typedef h16 h16x8 __attribute__((ext_vector_type(8)));
typedef h16 h16x4 __attribute__((ext_vector_type(4)));
typedef float f32x4 __attribute__((ext_vector_type(4)));
typedef float f32x16 __attribute__((ext_vector_type(16)));
typedef unsigned long long u64;
typedef __fp16 fp16x4 __attribute__((__vector_size__(4 * sizeof(__fp16))));

#define MFMA32(a, b, c) __builtin_amdgcn_mfma_f32_32x32x16_f16(a, b, c, 0, 0, 0)
#define MFMA16(a, b, c) __builtin_amdgcn_mfma_f32_16x16x32_f16(a, b, c, 0, 0, 0)
#define WAVE_FENCE() do { __builtin_amdgcn_fence(__ATOMIC_SEQ_CST, "wavefront"); __builtin_amdgcn_wave_barrier(); } while (0)

constexpr int T_ = 8208;
constexpr int NT = 16416;
constexpr int NTP = 16512;
constexpr int NRB = 129;
constexpr int NCH = 129;
constexpr int NGI = 8 * NCH;
constexpr int NKT = 257;
constexpr float EPS = 1e-6f;
constexpr int NTHREADS = 256;
constexpr int LDS_BYTES = 163840;
constexpr int NPHASE = 11;

constexpr size_t OFF_CTL = 0;
constexpr size_t OFF_W1T = 32768;
constexpr size_t OFF_WOT = OFF_W1T + (size_t)2 * 3072 * 1024 * 2;
constexpr size_t OFF_WQ2T = OFF_WOT + (size_t)2 * 1024 * 1024 * 2;
constexpr size_t OFF_WUKT = OFF_WQ2T + (size_t)2 * 768 * 256 * 2;
constexpr size_t OFF_WKABS = OFF_WUKT + (size_t)2 * 512 * 128 * 2;
constexpr size_t OFF_WUVT = OFF_WKABS + (size_t)2 * 8 * 128 * 64 * 2;
constexpr size_t OFF_SMALL = OFF_WUVT + (size_t)2 * 8 * 64 * 128 * 2;
constexpr size_t OFF_SZA = OFF_SMALL + (size_t)NTP * 16 * 4;
constexpr size_t OFF_SZG = OFF_SZA + (size_t)NTP * 512 * 2;
constexpr size_t OFF_PROJG = OFF_SZG + (size_t)NTP * 512 * 2;
constexpr size_t OFF_PROJA = OFF_PROJG + (size_t)NTP * 1536 * 2;
constexpr size_t OFF_QIDX = OFF_PROJA + (size_t)NTP * 512 * 2;
constexpr size_t OFF_QN = OFF_QIDX + (size_t)NTP * 256 * 2;
constexpr size_t OFF_QK = OFF_QN + (size_t)NTP * 512 * 2;
constexpr size_t OFF_KVROW = OFF_QK + (size_t)NTP * 1024 * 2;
constexpr size_t OFF_KFRAG = OFF_KVROW + (size_t)NTP * 136 * 2;
constexpr size_t OFF_U = OFF_KFRAG + (size_t)2 * NKT * 2048 * 2;
constexpr size_t OFF_WM = OFF_U + (size_t)NGI * 8192 * 2;
constexpr size_t OFF_QD = OFF_WM + (size_t)NGI * 8192 * 2;
constexpr size_t OFF_KDT = OFF_QD + (size_t)NGI * 8192 * 2;
constexpr size_t OFF_AQK = OFF_KDT + (size_t)NGI * 8192 * 2;
constexpr size_t OFF_CDEC = OFF_AQK + (size_t)NGI * 4096 * 2;
constexpr size_t OFF_METAH = OFF_CDEC + 8192;
constexpr size_t OFF_SUMSQ = OFF_METAH + (size_t)2 * 16 * 1024 * 4;
constexpr size_t WS_END = OFF_SUMSQ + (size_t)2 * NTP * 4;
constexpr size_t OFF_H16 = OFF_QK;
constexpr size_t OFF_CTX = OFF_PROJG;
constexpr size_t OFF_OMIX = OFF_PROJG + (size_t)NTP * 1024 * 2;

struct Params {
    const float* x; const float* meta; const float* rel; const float* norm_gain; const float* w_in;
    const float* g_cq; const float* g_ckv; const float* w_uq; const float* w_ukv; const float* w_qidx;
    const float* g_qn; const float* g_kn; const float* conv_w; const float* a_log; const float* dt_bias;
    const float* g_out; const float* w_out;
    float* out; unsigned char* ws;
    int ph_lo, ph_hi;
};

__constant__ unsigned char c_bucket[128] = {
    0, 1, 2, 3, 4, 5, 6, 7, 8, 9, 10, 11, 12, 13, 14, 15, 16, 16, 16, 17, 17, 18, 18, 18, 19, 19, 19, 20, 20, 20, 20, 21,
    21, 21, 21, 22, 22, 22, 22, 22, 23, 23, 23, 23, 23, 23, 24, 24, 24, 24, 24, 24, 25, 25, 25, 25, 25, 25, 25, 26, 26, 26, 26, 26,
    26, 26, 26, 27, 27, 27, 27, 27, 27, 27, 27, 27, 27, 28, 28, 28, 28, 28, 28, 28, 28, 28, 28, 29, 29, 29, 29, 29, 29, 29, 29, 29,
    29, 29, 29, 30, 30, 30, 30, 30, 30, 30, 30, 30, 30, 30, 30, 30, 30, 31, 31, 31, 31, 31, 31, 31, 31, 31, 31, 31, 31, 31, 31, 31};

__device__ __forceinline__ unsigned long long* tsec_slot() { extern __shared__ __attribute__((aligned(16))) unsigned char tsec_lds__[]; return (unsigned long long*)(tsec_lds__ + LDS_BYTES - 128) + (threadIdx.x >> 6); }
#define TSEC_BEGIN(id) unsigned long long t__##id = 0; if (PROBE_TSEC == (id)) t__##id = wall_clock64();
#define TSEC_END(id) do { if (PROBE_TSEC == (id)) { const unsigned long long d__ = wall_clock64() - t__##id; if ((threadIdx.x & 63) == 0) *tsec_slot() += d__; } } while (0)
__device__ __forceinline__ float silu_f(float x) { return x * __builtin_amdgcn_rcpf(1.f + __expf(-x)); }
__device__ __forceinline__ int lanes_below(u64 m) { return __builtin_amdgcn_mbcnt_hi((unsigned)(m >> 32), __builtin_amdgcn_mbcnt_lo((unsigned)m, 0)); }
__device__ __forceinline__ int lanes_below_from(u64 m, int base) { return __builtin_amdgcn_mbcnt_hi((unsigned)(m >> 32), __builtin_amdgcn_mbcnt_lo((unsigned)m, base)); }
__device__ __forceinline__ float relu1(float x) { const int i = __float_as_int(x); return __int_as_float(i > 0 ? i : 0); }
__device__ __forceinline__ unsigned ordkey(float f) { unsigned u = __float_as_uint(f); return (u & 0x80000000u) ? ~u : (u | 0x80000000u); }
__device__ __forceinline__ float ordinv(unsigned k) { unsigned u = (k & 0x80000000u) ? (k & 0x7fffffffu) : ~k; return __uint_as_float(u); }
__device__ __forceinline__ int opaque_tid() { int t = threadIdx.x; asm volatile("" : "+v"(t)); return t; }
__device__ __forceinline__ void lds_barrier() { asm volatile("s_waitcnt lgkmcnt(0)\n\ts_barrier" ::: "memory"); }

#define XB_TMO      128
#define XB_XCNT(j)  (256  + 64 * (j))
#define XB_XSUB(j)  (1280 + 64 * (j))
#define XB_XGEN(j)  (2304 + 64 * (j))
#define XB_TOP      3328
#define XB_TOPGEN   3392
#define XCD_BAR_WORDS 3456
#define XB_SPIN_CAP (1u << 22)
#define LAS __attribute__((address_space(3)))
__device__ __forceinline__ unsigned xb_ld(unsigned* p)              { return __hip_atomic_load(p, __ATOMIC_RELAXED, __HIP_MEMORY_SCOPE_AGENT); }
__device__ __forceinline__ unsigned xb_add(unsigned* p, unsigned v) { return __hip_atomic_fetch_add(p, v, __ATOMIC_RELAXED, __HIP_MEMORY_SCOPE_AGENT); }
__device__ __forceinline__ unsigned xb_xcc_id() { return (unsigned)__builtin_amdgcn_s_getreg((3 << 11) | 20) & 0xFu; }
#define XB_SPIN(cond, bar) do { unsigned _sp = 0; while (cond) { __builtin_amdgcn_s_sleep(1); \
    if ((++_sp & 255u) == 0u) { if (xb_ld(&(bar)[XB_TMO])) break; if (_sp > XB_SPIN_CAP) { atomicAdd(&(bar)[XB_TMO], 1u); break; } } } } while (0)
struct XcdBarrier { unsigned* bar; unsigned x; volatile LAS unsigned* st; };
__device__ __forceinline__ XcdBarrier xcd_barrier_post(unsigned* bar, volatile LAS unsigned* st) {
    XcdBarrier b; b.bar = bar; b.x = xb_xcc_id(); b.st = st;
    if (threadIdx.x == 0) (void)xb_add(&bar[XB_XCNT(b.x)], 1u);
    return b;
}
__device__ __forceinline__ void xcd_barrier_complete(unsigned* bar, unsigned x, unsigned& nloc, unsigned& nx) {
    const unsigned G = gridDim.x * gridDim.y * gridDim.z;
    unsigned sum, cnt, mine, sp = 0u;
    for (;;) {
        sum = 0u; cnt = 0u; mine = 0u;
#pragma unroll
        for (unsigned j = 0; j < 16; ++j) { const unsigned c = xb_ld(&bar[XB_XCNT(j)]); sum += c; cnt += (c > 0u) ? 1u : 0u; mine = (j == x) ? c : mine; }
        if (sum == G) break;
        __builtin_amdgcn_s_sleep(1);
        if ((++sp & 255u) == 0u) { if (xb_ld(&bar[XB_TMO])) break; if (sp > XB_SPIN_CAP) { atomicAdd(&bar[XB_TMO], 1u); break; } }
    }
    nloc = mine > 0u ? mine : 1u; nx = cnt > 0u ? cnt : 1u;
}
__device__ __forceinline__ void xcd_barrier(const XcdBarrier& b) {
    TSEC_BEGIN(5)
    asm volatile("s_waitcnt vmcnt(0)" ::: "memory");
    __syncthreads();
    if (threadIdx.x == 0) {
        unsigned* bar = b.bar;
        __builtin_amdgcn_s_waitcnt(0);
        unsigned nloc = b.st[0], nx = b.st[1];
        if (nloc == 0u) { xcd_barrier_complete(bar, b.x, nloc, nx); b.st[0] = nloc; b.st[1] = nx; }
        const unsigned old = xb_add(&bar[XB_XSUB(b.x)], 1u);
        const unsigned gen = old / nloc;
        if (old + 1u == (gen + 1u) * nloc) {
            __builtin_amdgcn_fence(__ATOMIC_RELEASE, "agent");
            asm volatile("s_waitcnt vmcnt(0)" ::: "memory");
            const unsigned og = xb_add(&bar[XB_TOP], 1u);
            const unsigned tg = og / nx;
            if (og + 1u == (tg + 1u) * nx) xb_add(&bar[XB_TOPGEN], 1u);
            else XB_SPIN(xb_ld(&bar[XB_TOPGEN]) == tg, bar);
            __builtin_amdgcn_fence(__ATOMIC_ACQUIRE, "agent");
            xb_add(&bar[XB_XGEN(b.x)], 1u);
            asm volatile("s_waitcnt vmcnt(0)" ::: "memory");
        } else {
            XB_SPIN(xb_ld(&bar[XB_XGEN(b.x)]) == gen, bar);
            __builtin_amdgcn_fence(__ATOMIC_ACQUIRE, "agent");
            asm volatile("s_waitcnt vmcnt(0)" ::: "memory");
        }
    }
    __syncthreads();
    TSEC_END(5);
}

struct XcdQueue {
    unsigned* ctr; int n_per; int x0; int d; int* slot;
    __device__ __forceinline__ void init(unsigned* c, int np, int* s) { ctr = c; n_per = np; x0 = (int)xb_xcc_id() & 7; d = 0; slot = s; }
    __device__ __forceinline__ bool next(int& xl, int& q) {
        __syncthreads();
        if (threadIdx.x == 0) {
            int res = -1;
            while (d < 8) {
                const int xc = (x0 + d) & 7;
                const unsigned t = __hip_atomic_fetch_add(ctr + xc * 16, 1u, __ATOMIC_RELAXED, __HIP_MEMORY_SCOPE_AGENT);
                if ((int)t < n_per) { res = xc * 65536 + (int)t; break; }
                ++d;
            }
            *slot = res;
        }
        __syncthreads();
        const int r = *slot;
        if (r < 0) return false;
        xl = r >> 16; q = r & 65535;
        return true;
    }
};

constexpr int GS = 72;

struct AF16 {
    const h16* p; int ld;
    __device__ __forceinline__ void init(int) {}
    __device__ __forceinline__ h16x8 load(int i, int row, int k) { return *(const h16x8*)(p + (size_t)row * ld + k); }
};

struct AH32 {
    const float* meta; const float* xs; int meta_bstride;
    const float* rp[4]; float ss[4];
    __device__ __forceinline__ const float* rowptr(int row) const {
        row = row < NT ? row : NT - 1;
        int b = row >= T_ ? 1 : 0; int t = row - b * T_;
        return t < 16 ? meta + (size_t)b * meta_bstride + (size_t)t * 1024 : xs + ((size_t)b * 8192 + (t - 16)) * 1024;
    }
    __device__ __forceinline__ h16x8 load(int i, int, int k) {
        const float4 v0 = *(const float4*)(rp[i] + k), v1 = *(const float4*)(rp[i] + k + 4);
        ss[i] += v0.x * v0.x + v0.y * v0.y + v0.z * v0.z + v0.w * v0.w + v1.x * v1.x + v1.y * v1.y + v1.z * v1.z + v1.w * v1.w;
        h16x8 r; r[0] = (h16)v0.x; r[1] = (h16)v0.y; r[2] = (h16)v0.z; r[3] = (h16)v0.w; r[4] = (h16)v1.x; r[5] = (h16)v1.y; r[6] = (h16)v1.z; r[7] = (h16)v1.w;
        return r;
    }
};

template <int BN, class AL, class EP>
__device__ __forceinline__ void gemm_tile(AL& al, int arow0, const h16* __restrict__ Bt, int ldb, int K, EP& ep, h16* smem) {
    const int tid = opaque_tid(), lane = tid & 63, w = tid >> 6, wm = w >> 1, wn = w & 1;
    constexpr int NTL = BN / 64;
    constexpr int NBG = BN / 32;
    constexpr int BUF = (128 + BN) * GS;
    f32x16 acc[2][NTL];
#pragma unroll
    for (int i = 0; i < 2; ++i)
#pragma unroll
        for (int j = 0; j < NTL; ++j)
#pragma unroll
            for (int r = 0; r < 16; ++r) acc[i][j][r] = 0.f;
    h16x8 ra[4], rb[NBG];
    const int nk = K >> 6;
#pragma unroll
    for (int i = 0; i < 4; ++i) { int g = tid + 256 * i; ra[i] = al.load(i, arow0 + (g >> 3), (g & 7) * 8); }
#pragma unroll
    for (int i = 0; i < NBG; ++i) { int g = tid + 256 * i; rb[i] = *(const h16x8*)(Bt + (size_t)(g >> 3) * ldb + (g & 7) * 8); }
    __syncthreads();
#pragma unroll
    for (int i = 0; i < 4; ++i) { int g = tid + 256 * i; *(h16x8*)(smem + (g >> 3) * GS + (g & 7) * 8) = ra[i]; }
#pragma unroll
    for (int i = 0; i < NBG; ++i) { int g = tid + 256 * i; *(h16x8*)(smem + 128 * GS + (g >> 3) * GS + (g & 7) * 8) = rb[i]; }
    __syncthreads();
    for (int kt = 0; kt < nk; ++kt) {
        const int cur = kt & 1;
        const h16* sA = smem + cur * BUF;
        const h16* sB = sA + 128 * GS;
        if (kt + 1 < nk) {
            const int k0 = (kt + 1) << 6;
#pragma unroll
            for (int i = 0; i < 4; ++i) { int g = tid + 256 * i; ra[i] = al.load(i, arow0 + (g >> 3), k0 + (g & 7) * 8); }
#pragma unroll
            for (int i = 0; i < NBG; ++i) { int g = tid + 256 * i; rb[i] = *(const h16x8*)(Bt + (size_t)(g >> 3) * ldb + k0 + (g & 7) * 8); }
        }
#pragma unroll
        for (int ks = 0; ks < 4; ++ks) {
            h16x8 af[2], bf[NTL];
#pragma unroll
            for (int mt = 0; mt < 2; ++mt) af[mt] = *(const h16x8*)(sA + (64 * wm + 32 * mt + (lane & 31)) * GS + 16 * ks + 8 * (lane >> 5));
#pragma unroll
            for (int nt = 0; nt < NTL; ++nt) bf[nt] = *(const h16x8*)(sB + ((BN / 2) * wn + 32 * nt + (lane & 31)) * GS + 16 * ks + 8 * (lane >> 5));
#pragma unroll
            for (int mt = 0; mt < 2; ++mt)
#pragma unroll
                for (int nt = 0; nt < NTL; ++nt) acc[mt][nt] = MFMA32(af[mt], bf[nt], acc[mt][nt]);
        }
        if (kt + 1 < nk) {
            h16* dA = smem + (cur ^ 1) * BUF;
            h16* dB = dA + 128 * GS;
#pragma unroll
            for (int i = 0; i < 4; ++i) { int g = tid + 256 * i; *(h16x8*)(dA + (g >> 3) * GS + (g & 7) * 8) = ra[i]; }
#pragma unroll
            for (int i = 0; i < NBG; ++i) { int g = tid + 256 * i; *(h16x8*)(dB + (g >> 3) * GS + (g & 7) * 8) = rb[i]; }
        }
        __syncthreads();
    }
    ep.pre(al);
    float* ft = (float*)smem;
#pragma unroll
    for (int mt = 0; mt < 2; ++mt)
#pragma unroll
        for (int nt = 0; nt < NTL; ++nt)
#pragma unroll
            for (int r = 0; r < 16; ++r) {
                const int rl = 64 * wm + 32 * mt + (r & 3) + 8 * (r >> 2) + 4 * (lane >> 5);
                const int cl = (BN / 2) * wn + 32 * nt + (lane & 31);
                ft[rl * (BN + 1) + cl] = acc[mt][nt][r];
            }
    __syncthreads();
    if (EP::kSweep) {
#pragma unroll 4
        for (int idx = tid; idx < 128 * BN; idx += NTHREADS) {
            const int rl = idx / BN, cl = idx % BN;
            float q = ep(rl, cl, ft[rl * (BN + 1) + cl]);
            if (EP::kRowSum) {
#pragma unroll
                for (int d = 1; d < 64; d <<= 1) q += __shfl_xor(q, d);
                if (lane == 0) ep.rowsum(rl, q);
            }
        }
    }
}

constexpr int GS2 = 72;
template <class EP>
__device__ __forceinline__ void gemm_big(const h16* __restrict__ A, int lda, const h16* __restrict__ Bt, int ldb, int K, EP& ep, h16* smem) {
    const int tid = opaque_tid(), lane = tid & 63, w = tid >> 6, wm = w >> 1, wn = w & 1;
    constexpr int BUF = 512 * GS2;
    f32x16 acc[4][4];
    float zero_ = 0.f; asm volatile("" : "+v"(zero_));
#pragma unroll
    for (int i = 0; i < 4; ++i)
#pragma unroll
        for (int j = 0; j < 4; ++j)
#pragma unroll
            for (int r = 0; r < 16; ++r) acc[i][j][r] = zero_;
    h16x8 ra[2][8], rb[2][8];
    const int nk = K >> 6;
    const h16* ap = A + (size_t)(tid >> 3) * lda + (tid & 7) * 8;
    const h16* bp = Bt + (size_t)(tid >> 3) * ldb + (tid & 7) * 8;
    const int soff = (tid >> 3) * GS2 + (tid & 7) * 8;
#pragma unroll
    for (int i = 0; i < 8; ++i) { ra[0][i] = *(const h16x8*)(ap + (size_t)(32 * i) * lda); rb[0][i] = *(const h16x8*)(bp + (size_t)(32 * i) * ldb); }
#pragma unroll
    for (int i = 0; i < 8; ++i) { ra[1][i] = *(const h16x8*)(ap + (size_t)(32 * i) * lda + 64); rb[1][i] = *(const h16x8*)(bp + (size_t)(32 * i) * ldb + 64); }
    __syncthreads();
#pragma unroll
    for (int i = 0; i < 8; ++i) { *(h16x8*)(smem + soff + 32 * i * GS2) = ra[0][i]; *(h16x8*)(smem + 256 * GS2 + soff + 32 * i * GS2) = rb[0][i]; }
    __syncthreads();
#define BIG_STEP(CUR, KT) do { \
        const h16* sA = smem + (CUR) * BUF + (128 * wm + (lane & 31)) * GS2 + 8 * (lane >> 5); \
        const h16* sB = smem + (CUR) * BUF + 256 * GS2 + (128 * wn + (lane & 31)) * GS2 + 8 * (lane >> 5); \
        h16* dW = smem + ((CUR) ^ 1) * BUF;     \
        int k0 = ((KT) + 2) << 6; k0 = k0 < K ? k0 : K - 64; \
        h16x8 af[2][4], bf[2][4]; \
        _Pragma("unroll") for (int t = 0; t < 4; ++t) { af[0][t] = *(const h16x8*)(sA + 32 * t * GS2); bf[0][t] = *(const h16x8*)(sB + 32 * t * GS2); } \
        __builtin_amdgcn_sched_barrier(0); \
        _Pragma("unroll") for (int ks = 0; ks < 4; ++ks) { \
            if (ks < 3) { _Pragma("unroll") for (int t = 0; t < 4; ++t) { af[(ks + 1) & 1][t] = *(const h16x8*)(sA + 32 * t * GS2 + 16 * (ks + 1)); bf[(ks + 1) & 1][t] = *(const h16x8*)(sB + 32 * t * GS2 + 16 * (ks + 1)); } } \
            _Pragma("unroll") for (int i = 2 * ks; i < 2 * ks + 2; ++i) { *(h16x8*)(dW + soff + 32 * i * GS2) = ra[(CUR) ^ 1][i]; *(h16x8*)(dW + 256 * GS2 + soff + 32 * i * GS2) = rb[(CUR) ^ 1][i]; } \
            _Pragma("unroll") for (int i = 2 * ks; i < 2 * ks + 2; ++i) { ra[CUR][i] = *(const h16x8*)(ap + (size_t)(32 * i) * lda + k0); rb[CUR][i] = *(const h16x8*)(bp + (size_t)(32 * i) * ldb + k0); } \
            _Pragma("unroll") for (int mt = 0; mt < 4; ++mt) _Pragma("unroll") for (int nt = 0; nt < 4; ++nt) acc[mt][nt] = MFMA32(af[ks & 1][mt], bf[ks & 1][nt], acc[mt][nt]); \
              \
            _Pragma("unroll") for (int q = 0; q < 4; ++q) { \
                __builtin_amdgcn_sched_group_barrier(0x8, 1, 0); __builtin_amdgcn_sched_group_barrier(0x100, 1, 0); \
                __builtin_amdgcn_sched_group_barrier(0x8, 1, 0); __builtin_amdgcn_sched_group_barrier(0x100, 1, 0); \
                __builtin_amdgcn_sched_group_barrier(0x8, 1, 0); __builtin_amdgcn_sched_group_barrier(0x200, 1, 0); \
                __builtin_amdgcn_sched_group_barrier(0x8, 1, 0); __builtin_amdgcn_sched_group_barrier(0x20, 1, 0); } \
            __builtin_amdgcn_sched_barrier(0); } \
        __syncthreads(); } while (0)
    TSEC_BEGIN(8)
    for (int kt = 0; kt < nk; kt += 2) { BIG_STEP(0, kt); BIG_STEP(1, kt + 1); }
    TSEC_END(8);
    TSEC_BEGIN(9)
#undef BIG_STEP
    float* st = (float*)smem + w * 1152;
    const int prow = lane >> 1, pc0 = (lane & 1) * 16;
    ep.template prefetch<0>(128 * wm + prow, 128 * wn + pc0);
#pragma unroll
    for (int mt = 0; mt < 4; ++mt) {
        if (mt == 0) ep.template prefetch<1>(128 * wm + 32 + prow, 128 * wn + pc0);
        if (mt == 1) ep.template prefetch<0>(128 * wm + 64 + prow, 128 * wn + pc0);
        if (mt == 2) ep.template prefetch<1>(128 * wm + 96 + prow, 128 * wn + pc0);
        ep.row_begin();
#pragma unroll
        for (int nt = 0; nt < 4; ++nt) {
#pragma unroll
            for (int r = 0; r < 16; ++r) st[((r & 3) + 8 * (r >> 2) + 4 * (lane >> 5)) * 36 + (lane & 31)] = acc[mt][nt][r];
            WAVE_FENCE();
            float v[16];
#pragma unroll
            for (int q = 0; q < 4; ++q) { const float4 t4 = *(const float4*)(st + prow * 36 + pc0 + 4 * q); v[4 * q] = t4.x; v[4 * q + 1] = t4.y; v[4 * q + 2] = t4.z; v[4 * q + 3] = t4.w; }
            WAVE_FENCE();
            if (mt & 1) ep.template store16<1>(nt, 128 * wm + 32 * mt + prow, 128 * wn + 32 * nt + pc0, v);
            else ep.template store16<0>(nt, 128 * wm + 32 * mt + prow, 128 * wn + 32 * nt + pc0, v);
        }
        ep.row_end(128 * wm + 32 * mt + prow, lane);
    }
    TSEC_END(9);
}

template <class EP>
__device__ __forceinline__ void skinny_tile(const h16* __restrict__ A, int lda, const h16* __restrict__ Bt, int ldb, int K, EP& ep, float* st, int tid) {
    const int lane = tid & 63, w = tid >> 6;
    f32x16 acc;
#pragma unroll
    for (int r = 0; r < 16; ++r) acc[r] = 0.f;
    const int kq = K >> 2;
    const h16* ap = A + (size_t)(lane & 31) * lda + 8 * (lane >> 5) + w * kq;
    const h16* bp = Bt + (size_t)(lane & 31) * ldb + 8 * (lane >> 5) + w * kq;
    if (w == 0) ep.template prefetch<0>(lane >> 1, (lane & 1) * 16);
    for (int k0 = 0; k0 < kq; k0 += 128) {
        h16x8 af[8], bf[8];
#pragma unroll
        for (int u = 0; u < 8; ++u) { af[u] = *(const h16x8*)(ap + k0 + 16 * u); bf[u] = *(const h16x8*)(bp + k0 + 16 * u); }
#pragma unroll
        for (int u = 0; u < 8; ++u) acc = MFMA32(af[u], bf[u], acc);
    }
    __syncthreads();
    float* my = st + w * 1152;
#pragma unroll
    for (int r = 0; r < 16; ++r) my[((r & 3) + 8 * (r >> 2) + 4 * (lane >> 5)) * 36 + (lane & 31)] = acc[r];
    __syncthreads();
    if (w == 0) {
        const int prow = lane >> 1, pc0 = (lane & 1) * 16;
        ep.row_begin();
        float v[16];
#pragma unroll
        for (int q = 0; q < 4; ++q) {
            float4 t4 = *(const float4*)(st + prow * 36 + pc0 + 4 * q);
#pragma unroll
            for (int ww = 1; ww < 4; ++ww) { const float4 u4 = *(const float4*)(st + ww * 1152 + prow * 36 + pc0 + 4 * q); t4.x += u4.x; t4.y += u4.y; t4.z += u4.z; t4.w += u4.w; }
            v[4 * q] = t4.x; v[4 * q + 1] = t4.y; v[4 * q + 2] = t4.z; v[4 * q + 3] = t4.w;
        }
        ep.template store16<0>(0, prow, pc0, v);
        ep.row_end(prow, lane);
    }
}

struct EpiInProj {
    static constexpr bool kSweep = true; static constexpr bool kRowSum = false;
    int row0, n0; const float* rstd; h16* projA; float* small; h16* sza; h16* szg; h16* projG;
    template <class AL_> __device__ __forceinline__ void pre(AL_&) {}
    __device__ __forceinline__ float operator()(int rl, int cl, float v) const {
        const int row = row0 + rl; const float y = v * rstd[rl]; const int c = n0 + cl;
        if (c < 512) { if (c < 448) projA[(size_t)row * 512 + c] = (h16)y; else if (c < 460) small[(size_t)row * 16 + (c - 448)] = y; }
        else if (c < 1024) sza[(size_t)row * 512 + (c - 512)] = (h16)silu_f(y);
        else if (c < 2560) projG[(size_t)row * 1536 + (c - 1024)] = (h16)y;
        else szg[(size_t)row * 512 + (c - 2560)] = (h16)silu_f(y);
        return 0.f;
    }
    __device__ __forceinline__ void rowsum(int, float) const {}
};
struct EpiIn2 : EpiInProj {
    float* rstd_w; int tid; const float* sumsq;
    template <class AL_> __device__ __forceinline__ void pre(AL_&) {
        if (tid < 128) rstd_w[tid] = rsqrtf(sumsq[row0 + tid] * (1.f / 1024.f) + EPS);
        __syncthreads();
    }
};
struct EpiTileF32 {
    static constexpr bool kSweep = false; static constexpr bool kRowSum = false;
    template <class AL_> __device__ __forceinline__ void pre(AL_&) {}
    __device__ __forceinline__ float operator()(int, int, float) const { return 0.f; }
    __device__ __forceinline__ void rowsum(int, float) const {}
};
struct EpiStoreH {
    static constexpr bool kSweep = true; static constexpr bool kRowSum = false;
    h16* dst; int ld; int row0; const float* rs;
    template <class AL_> __device__ __forceinline__ void pre(AL_&) {}
    __device__ __forceinline__ float operator()(int rl, int cl, float v) const { dst[(size_t)(row0 + rl) * ld + cl] = (h16)(rs ? v * rs[rl] : v); return 0.f; }
    __device__ __forceinline__ void rowsum(int, float) const {}
};
struct EpiGate {
    static constexpr bool kSweep = true; static constexpr bool kRowSum = false;
    h16* dst; const h16* gate; int row0; int c0;
    template <class AL_> __device__ __forceinline__ void pre(AL_&) {}
    __device__ __forceinline__ float operator()(int rl, int cl, float v) const {
        const size_t row = row0 + rl;
        dst[row * 1024 + c0 + cl] = (h16)(v * (float)gate[row * 512 + c0 + cl]);
        return 0.f;
    }
    __device__ __forceinline__ void rowsum(int, float) const {}
};
struct EpiResid {
    static constexpr bool kSweep = true; static constexpr bool kRowSum = true;
    int layer; int row0; int n0; const float* meta; const float* x; float* metah; float* out; h16* h16o; float* sumsq_next;
    template <class AL_> __device__ __forceinline__ void pre(AL_&) {}
    __device__ __forceinline__ float operator()(int rl, int cl, float v) const {
        const int row = row0 + rl; if (row >= NT) return 0.f;
        const int b = row >= T_ ? 1 : 0; const int t = row - b * T_; const int c = n0 + cl;
        if (layer == 0) {
            float hn;
            if (t < 16) { hn = meta[(size_t)t * 1024 + c] + v; metah[((size_t)b * 16 + t) * 1024 + c] = hn; }
            else { const size_t o = ((size_t)b * 8192 + (t - 16)) * 1024 + c; hn = x[o] + v; out[o] = hn; }
            h16o[(size_t)row * 1024 + c] = (h16)hn;
            return hn * hn;
        } else {
            if (t >= 16) { const size_t o = ((size_t)b * 8192 + (t - 16)) * 1024 + c; out[o] = out[o] + v; }
            return 0.f;
        }
    }
    __device__ __forceinline__ void rowsum(int rl, float q) const { if (layer == 0 && row0 + rl < NT) atomicAdd(sumsq_next + row0 + rl, q); }
};

__device__ __forceinline__ void store16h(h16* dst, const float* v) {
    h16x8 a, b;
#pragma unroll
    for (int e = 0; e < 8; ++e) { a[e] = (h16)v[e]; b[e] = (h16)v[8 + e]; }
    *(h16x8*)dst = a; *(h16x8*)(dst + 8) = b;
}
struct EpiInBig {
    int row0, n0; const float* sumsq; h16* projA; float* small; h16* sza; h16* szg; h16* projG;
    float ssq[2];
    __device__ __forceinline__ void row_begin() {}
    __device__ __forceinline__ void row_end(int, int) {}
    template <int B> __device__ __forceinline__ void prefetch(int rl, int) { ssq[B] = sumsq[row0 + rl]; }
    template <int B> __device__ __forceinline__ void store16(int, int rl, int cl, const float* v) const {
        const int row = row0 + rl; const int c = n0 + cl;
        const float rs = rsqrtf(ssq[B] * (1.f / 1024.f) + EPS);
        float y[16];
#pragma unroll
        for (int e = 0; e < 16; ++e) y[e] = v[e] * rs;
        if (c < 512) {
            if (c < 448) store16h(projA + (size_t)row * 512 + c, y);
            else if (c == 448) {
#pragma unroll
                for (int e = 0; e < 12; ++e) small[(size_t)row * 16 + e] = y[e];
            }
        } else if (c < 1024) {
#pragma unroll
            for (int e = 0; e < 16; ++e) y[e] = silu_f(y[e]);
            store16h(sza + (size_t)row * 512 + (c - 512), y);
        } else if (c < 2560) store16h(projG + (size_t)row * 1536 + (c - 1024), y);
        else {
#pragma unroll
            for (int e = 0; e < 16; ++e) y[e] = silu_f(y[e]);
            store16h(szg + (size_t)row * 512 + (c - 2560), y);
        }
    }
};
struct EpiResBig {
    int layer, row0, n0; const float* meta; const float* x; float* metah; float* out; h16* h16o; float* sumsq_next; float ss; int nseg;
    float4 pf[2][4][4];
    __device__ __forceinline__ void row_begin() { ss = 0.f; }
    __device__ __forceinline__ void row_end(int rl, int lane) {
        if (layer == 0) { float q = ss; q += __shfl_xor(q, 1); if ((lane & 1) == 0) atomicAdd(sumsq_next + row0 + rl, q); }
    }
    __device__ __forceinline__ const float* srcp(int row, int c) const {
        const int b = row >= T_ ? 1 : 0; const int t = row - b * T_;
        if (layer == 0) return t < 16 ? meta + (size_t)t * 1024 + c : x + ((size_t)b * 8192 + (t - 16)) * 1024 + c;
        return out + ((size_t)b * 8192 + (t < 16 ? 0 : t - 16)) * 1024 + c;
    }
    template <int B> __device__ __forceinline__ void prefetch(int rl, int cl) {
        const float* src = srcp(row0 + rl, n0 + cl);
#pragma unroll
        for (int nt = 0; nt < 4; ++nt)
            if (nt < nseg) {
#pragma unroll
                for (int q = 0; q < 4; ++q) pf[B][nt][q] = *(const float4*)(src + 32 * nt + 4 * q);
            }
    }
    template <int B> __device__ __forceinline__ void store16(int nt, int rl, int cl, const float* v) {
        const int row = row0 + rl; const int c = n0 + cl;
        const int b = row >= T_ ? 1 : 0; const int t = row - b * T_;
        float* dst;
        if (layer == 0) dst = t < 16 ? metah + ((size_t)b * 16 + t) * 1024 + c : out + ((size_t)b * 8192 + (t - 16)) * 1024 + c;
        else { if (t < 16) return; dst = out + ((size_t)b * 8192 + (t - 16)) * 1024 + c; }
        float hn[16];
#pragma unroll
        for (int q = 0; q < 4; ++q) {
            const float4 hv = pf[B][nt][q];
            float4 o4; o4.x = hv.x + v[4 * q]; o4.y = hv.y + v[4 * q + 1]; o4.z = hv.z + v[4 * q + 2]; o4.w = hv.w + v[4 * q + 3];
            *(float4*)(dst + 4 * q) = o4;
            hn[4 * q] = o4.x; hn[4 * q + 1] = o4.y; hn[4 * q + 2] = o4.z; hn[4 * q + 3] = o4.w;
        }
        if (layer == 0) {
            store16h(h16o + (size_t)row * 1024 + c, hn);
#pragma unroll
            for (int e = 0; e < 16; ++e) ss += hn[e] * hn[e];
        }
    }
};

__device__ __forceinline__ int in_src_col(int n) {
    if (n < 452) return n;
    if (n < 456) return 3012 + (n - 452);
    if (n < 460) return 3016 + (n - 456);
    if (n < 512) return -1;
    if (n < 1024) return 452 + (n - 512);
    if (n < 2560) return 964 + (n - 1024);
    return 2500 + (n - 2560);
}
__device__ __forceinline__ float prep_get(const Params& P, int l, int job, int h, int n, int k) {
    switch (job) {
        case 0: { const int s = in_src_col(n); if (s < 0) return 0.f; return P.norm_gain[l * 1024 + k] * P.w_in[((size_t)l * 1024 + k) * 3020 + s]; }
        case 1: return P.w_out[((size_t)l * 1024 + k) * 1024 + n];
        case 2: return P.g_cq[l * 256 + k] * (n < 512 ? P.w_uq[((size_t)l * 256 + k) * 512 + n] : P.w_qidx[((size_t)l * 256 + k) * 256 + (n - 512)]);
        case 3: return P.g_ckv[l * 128 + k] * P.w_ukv[((size_t)l * 128 + k) * 1024 + n];
        case 4: { const int kk = k >> 4, hf = (k >> 3) & 1, j = k & 7; const int d = 16 * kk + 8 * (j >> 2) + 4 * hf + (j & 3);
                  return P.w_ukv[((size_t)l * 128 + n) * 1024 + h * 64 + d] * P.g_kn[l * 64 + d] * P.g_qn[l * 64 + d] * 0.125f; }
        default: return P.w_ukv[((size_t)l * 128 + k) * 1024 + 512 + h * 64 + n];
    }
}
__device__ __forceinline__ void prep_tiles(const Params& P, unsigned char* lds, int l, int first_wg, int nwg);
__device__ __forceinline__ void phase_prep(const Params& P, unsigned char* lds) {
    float* tile = (float*)lds;
    const int tid = opaque_tid();
    {
        h16* h16o = (h16*)(P.ws + OFF_H16); float* sumsq = (float*)(P.ws + OFF_SUMSQ);
        const int lane = tid & 63, w = tid >> 6;
        for (int row = blockIdx.x * 4 + w; row < NT; row += gridDim.x * 4) {
            const int b = row >= T_ ? 1 : 0; const int t = row - b * T_;
            const float* src = t < 16 ? P.meta + (size_t)t * 1024 : P.x + ((size_t)b * 8192 + (t - 16)) * 1024;
            float ss = 0.f;
#pragma unroll
            for (int q = 0; q < 2; ++q) {
                const float4 a = *(const float4*)(src + q * 512 + lane * 8), c4 = *(const float4*)(src + q * 512 + lane * 8 + 4);
                ss += a.x * a.x + a.y * a.y + a.z * a.z + a.w * a.w + c4.x * c4.x + c4.y * c4.y + c4.z * c4.z + c4.w * c4.w;
                h16x8 o; o[0] = (h16)a.x; o[1] = (h16)a.y; o[2] = (h16)a.z; o[3] = (h16)a.w; o[4] = (h16)c4.x; o[5] = (h16)c4.y; o[6] = (h16)c4.z; o[7] = (h16)c4.w;
                *(h16x8*)(h16o + (size_t)row * 1024 + q * 512 + lane * 8) = o;
            }
#pragma unroll
            for (int d = 1; d < 64; d <<= 1) ss += __shfl_xor(ss, d);
            if (lane == 0) sumsq[row] = ss;
        }
    }
    prep_tiles(P, lds, 0, 0, (int)gridDim.x);
}
__device__ __forceinline__ void prep_tiles(const Params& P, unsigned char* lds, int l, int first_wg, int nwg) {
    float* tile = (float*)lds;
    const int tid = opaque_tid();
    for (int it = (int)blockIdx.x - first_wg; it >= 0 && it < 1120; it += nwg) {
        int r = it;
        int job, h = 0, N, K, tn, tk; h16* dst;
        if (r < 768) { job = 0; N = 3072; K = 1024; tn = r / 16; tk = r % 16; dst = (h16*)(P.ws + OFF_W1T) + (size_t)l * 3072 * 1024; }
        else if ((r -= 768) < 256) { job = 1; N = 1024; K = 1024; tn = r / 16; tk = r % 16; dst = (h16*)(P.ws + OFF_WOT) + (size_t)l * 1024 * 1024; }
        else if ((r -= 256) < 48) { job = 2; N = 768; K = 256; tn = r / 4; tk = r % 4; dst = (h16*)(P.ws + OFF_WQ2T) + (size_t)l * 768 * 256; }
        else if ((r -= 48) < 16) { job = 3; N = 512; K = 128; tn = r / 2; tk = r % 2; dst = (h16*)(P.ws + OFF_WUKT) + (size_t)l * 512 * 128; }
        else if ((r -= 16) < 16) { job = 4; N = 128; K = 64; h = r / 2; tn = r % 2; tk = 0; dst = (h16*)(P.ws + OFF_WKABS) + ((size_t)l * 8 + h) * 128 * 64; }
        else { r -= 16; job = 5; N = 64; K = 128; h = r / 2; tn = 0; tk = r % 2; dst = (h16*)(P.ws + OFF_WUVT) + ((size_t)l * 8 + h) * 64 * 128; }
        (void)N;
        const int n0 = tn * 64, k0 = tk * 64;
        __syncthreads();
#pragma unroll 4
        for (int q = 0; q < 16; ++q) { const int kk = q * 4 + (tid >> 6), nn = tid & 63; tile[kk * 65 + nn] = prep_get(P, l, job, h, n0 + nn, k0 + kk); }
        __syncthreads();
#pragma unroll 4
        for (int q = 0; q < 16; ++q) { const int nn = q * 4 + (tid >> 6), kk = tid & 63; dst[(size_t)(n0 + nn) * K + k0 + kk] = (h16)tile[kk * 65 + nn]; }
    }
}

__device__ __forceinline__ void phase_inproj(const Params& P, int l, unsigned char* lds, int rep_p1 = 0) {
    h16* smem = (h16*)lds;
    float* rstd = (float*)(lds + 73728);
    const int tid = opaque_tid();
    const h16* W = (const h16*)(P.ws + OFF_W1T) + (size_t)l * 3072 * 1024;
    const h16* A = (const h16*)(P.ws + OFF_H16);
    const float* sumsq = (const float*)(P.ws + OFF_SUMSQ) + (size_t)l * NTP;
    XcdQueue xq; xq.init((unsigned*)(P.ws + OFF_CTL) + 4096 + l * 128 + 2048 * rep_p1, 96, (int*)(lds + LDS_BYTES - 32));
    int xl, qi;
    while (xq.next(xl, qi)) {
        const int rb = 8 * xl + (qi & 7), tn = 4 * (qi >> 5) + ((qi >> 3) & 3);
        EpiInBig ep{rb * 256, tn * 256, sumsq, (h16*)(P.ws + OFF_PROJA), (float*)(P.ws + OFF_SMALL), (h16*)(P.ws + OFF_SZA), (h16*)(P.ws + OFF_SZG), (h16*)(P.ws + OFF_PROJG), {0.f, 0.f}};
        gemm_big(A + (size_t)rb * 256 * 1024, 1024, W + (size_t)tn * 256 * 1024, 1024, 1024, ep, smem);
    }
    __syncthreads();
    for (int it = blockIdx.x; it < 96; it += gridDim.x) {
        EpiInBig ep{16384, it * 32, sumsq, (h16*)(P.ws + OFF_PROJA), (float*)(P.ws + OFF_SMALL), (h16*)(P.ws + OFF_SZA), (h16*)(P.ws + OFF_SZG), (h16*)(P.ws + OFF_PROJG), {0.f, 0.f}};
        skinny_tile(A + (size_t)16384 * 1024, 1024, W + (size_t)it * 32 * 1024, 1024, 1024, ep, (float*)lds, tid);
    }
    (void)rstd;
}

__device__ __forceinline__ void p2a_item(const Params& P, int l, int rb, int j, unsigned char* lds) {
    h16* smem = (h16*)lds;
    float* ft = (float*)lds;
    float* rstdq = (float*)(lds + 73728);
    const int tid = opaque_tid(); const int row0 = rb * 128;
    const h16* projA = (const h16*)(P.ws + OFF_PROJA);
    __syncthreads();
    {
        const int row = row0 + (tid >> 1), hf = tid & 1; float s = 0.f;
#pragma unroll 4
        for (int q = 0; q < 16; ++q) { const h16x8 v = *(const h16x8*)(projA + (size_t)row * 512 + hf * 128 + q * 8);
#pragma unroll
            for (int e = 0; e < 8; ++e) { const float f = (float)v[e]; s += f * f; } }
        s += __shfl_xor(s, 1);
        if (hf == 0) rstdq[tid >> 1] = rsqrtf(s * (1.f / 256.f) + EPS);
    }
    __syncthreads();
    const h16* Wq2 = (const h16*)(P.ws + OFF_WQ2T) + (size_t)l * 768 * 256;
    AF16 al{projA, 512};
    if (j >= 4) {
        EpiStoreH ep{(h16*)(P.ws + OFF_QIDX) + (j - 4) * 128, 256, row0, rstdq};
        gemm_tile<128>(al, row0, Wq2 + (size_t)j * 128 * 256, 256, 256, ep, smem);
        return;
    }
    EpiTileF32 ep;
    gemm_tile<128>(al, row0, Wq2 + (size_t)j * 128 * 256, 256, 256, ep, smem);
    __syncthreads();
    h16* qn = (h16*)(P.ws + OFF_QN);
    {
        const int rl = tid >> 1, hh = tid & 1; float s = 0.f;
        const float rq = rstdq[rl];
        for (int d = 0; d < 64; ++d) { const float f = ft[rl * 129 + hh * 64 + d] * rq; s += f * f; }
        const float rs = rsqrtf(s * (1.f / 64.f) + EPS) * rq;
        h16* dst = qn + (size_t)(row0 + rl) * 512 + (2 * j + hh) * 64;
        const float* gq = P.g_qn + l * 64;
        for (int d = 0; d < 64; d += 8) { h16x8 o;
#pragma unroll
            for (int e = 0; e < 8; ++e) o[e] = (h16)(ft[rl * 129 + hh * 64 + d + e] * rs * gq[d + e]);
            *(h16x8*)(dst + d) = o; }
    }
    __threadfence_block();
    __syncthreads();
    for (int hh = 0; hh < 2; ++hh) {
        const int head = 2 * j + hh;
        AF16 al2{qn + head * 64, 512};
        EpiStoreH ep2{(h16*)(P.ws + OFF_QK) + head * 128, 1024, row0, nullptr};
        gemm_tile<128>(al2, row0, (const h16*)(P.ws + OFF_WKABS) + ((size_t)l * 8 + head) * 128 * 64, 64, 64, ep2, smem);
    }
}

__device__ __forceinline__ void p2b_item(const Params& P, int l, int rb, unsigned char* lds) {
    h16* smem = (h16*)lds;
    float* ft = (float*)lds;
    const int tid = opaque_tid(); const int row0 = rb * 128;
    const h16* projA = (const h16*)(P.ws + OFF_PROJA);
    h16* kvrow = (h16*)(P.ws + OFF_KVROW);
    __syncthreads();
    {
        const int row = row0 + (tid >> 1), hf = tid & 1; float s = 0.f; h16x8 v[8];
#pragma unroll
        for (int q = 0; q < 8; ++q) { v[q] = *(const h16x8*)(projA + (size_t)row * 512 + 256 + hf * 64 + q * 8);
#pragma unroll
            for (int e = 0; e < 8; ++e) { const float f = (float)v[q][e]; s += f * f; } }
        s += __shfl_xor(s, 1);
        const float rs = rsqrtf(s * (1.f / 128.f) + EPS);
        const float* g = P.g_ckv + l * 128 + hf * 64;
#pragma unroll
        for (int q = 0; q < 8; ++q) { h16x8 o;
#pragma unroll
            for (int e = 0; e < 8; ++e) o[e] = (h16)((float)v[q][e] * rs * g[q * 8 + e]);
            *(h16x8*)(kvrow + (size_t)row * 136 + hf * 64 + q * 8) = o; }
    }
    {
        h16* kfrag = (h16*)(P.ws + OFF_KFRAG);
#pragma unroll
        for (int q = 0; q < 4; ++q) {
            const int g = tid + 256 * q; const int row = row0 + (g >> 3), g8 = g & 7;
            if (row < NT) {
                const int b = row >= T_ ? 1 : 0; const int t = row - b * T_;
                const h16x8 v = *(const h16x8*)(projA + (size_t)row * 512 + 384 + g8 * 8);
                const int tile = t >> 5, ks = g8 >> 1, hh = g8 & 1;
                *(h16x8*)(kfrag + ((size_t)(b * NKT + tile) * 4 + ks) * 512 + (hh * 32 + (t & 31)) * 8) = v;
            }
        }
    }
    __threadfence_block();
    __syncthreads();
    const h16* Wuk = (const h16*)(P.ws + OFF_WUKT) + (size_t)l * 512 * 128;
    for (int tn = 0; tn < 4; ++tn) {
        AF16 al{kvrow, 136};
        EpiTileF32 ep;
        gemm_tile<128>(al, row0, Wuk + (size_t)tn * 128 * 128, 128, 128, ep, smem);
        __syncthreads();
        const int rl = tid >> 1, hh = tid & 1; float s = 0.f;
        for (int d = 0; d < 64; ++d) { const float f = ft[rl * 129 + hh * 64 + d]; s += f * f; }
        kvrow[(size_t)(row0 + rl) * 136 + 128 + 2 * tn + hh] = (h16)rsqrtf(s * (1.f / 64.f) + EPS);
        __syncthreads();
    }
}

__device__ __forceinline__ void p2c_item(const Params& P, int l, int item, unsigned char* lds) {
    h16* qh = (h16*)lds;
    h16* kh = (h16*)(lds + 17408);
    float* kf = (float*)(lds + 34816);
    float* vf = (float*)(lds + 67584);
    float* Lm = (float*)(lds + 100352);
    float* beta = (float*)(lds + 116736);
    float* dec = beta + 64;
    float* edec = dec + 64;
    const int tid = opaque_tid(), lane = tid & 63, w = tid >> 6;
    const int chain = item / NCH, n = item % NCH, b = chain >> 2, h = chain & 3;
    const h16* projG = (const h16*)(P.ws + OFF_PROJG);
    const float* small = (const float*)(P.ws + OFF_SMALL);
    const float* cw = P.conv_w + (size_t)l * 4 * 1536;
    __syncthreads();
#ifndef P2C
#define P2C 15
#endif
    float* cwl = (float*)(lds + 117504);
    for (int e = tid; e < 1536; e += NTHREADS) { const int m = e >> 9, jj = (e >> 7) & 3, c = e & 127; cwl[e] = cw[jj * 1536 + m * 512 + h * 128 + c]; }
    __syncthreads();
    for (int rs1_ = 0; rs1_ <= PROBE_S1; ++rs1_) if (P2C & 1) {
        const int i = tid >> 2, part = tid & 3;
        const int t = 64 * n + i - 48; const bool valid = t >= 0;
        const size_t row = (size_t)b * T_ + (valid ? t : 0);
        h16x8 rv[3][4][4];
#define CONV_LOAD(m_) do { _Pragma("unroll") for (int jj = 0; jj < 4; ++jj) { int tt = t - 3 + jj; tt = tt < 0 ? 0 : tt; \
            const h16* rp = projG + ((size_t)b * T_ + tt) * 1536 + (m_) * 512 + h * 128 + part * 32; \
            _Pragma("unroll") for (int c8 = 0; c8 < 4; ++c8) rv[m_][jj][c8] = *(const h16x8*)(rp + c8 * 8); } } while (0)
        CONV_LOAD(0); CONV_LOAD(1);
        float bl = 0.f, al = 0.f;
        if (part == 0) { bl = small[row * 16 + 4 + h]; al = small[row * 16 + 8 + h]; }
        float vals[32];
#pragma unroll
        for (int m = 0; m < 3; ++m) {
            if (m == 1) { CONV_LOAD(2); }
            __builtin_amdgcn_sched_barrier(0);
#pragma unroll
            for (int c = 0; c < 32; ++c) vals[c] = 0.f;
#pragma unroll
            for (int jj = 0; jj < 4; ++jj) {
                const float msk = (valid && (t - 3 + jj) >= 0) ? 1.f : 0.f;
                const float* wp = cwl + (m * 4 + jj) * 128 + part * 32;
#pragma unroll
                for (int c8 = 0; c8 < 4; ++c8) {
                    const float4 w0 = *(const float4*)(wp + c8 * 8), w1 = *(const float4*)(wp + c8 * 8 + 4);
                    const float wv[8] = {w0.x, w0.y, w0.z, w0.w, w1.x, w1.y, w1.z, w1.w};
#pragma unroll
                    for (int e = 0; e < 8; ++e) vals[c8 * 8 + e] += wv[e] * msk * (float)rv[m][jj][c8][e];
                }
            }
            float ss = 0.f;
#pragma unroll
            for (int c = 0; c < 32; ++c) { vals[c] = silu_f(vals[c]); ss += vals[c] * vals[c]; }
            if (m < 2) {
                ss += __shfl_xor(ss, 1); ss += __shfl_xor(ss, 2);
                const float rs = valid ? rsqrtf(ss + EPS) : 0.f;
                h16* dsth = (m == 0 ? qh : kh) + i * 136 + part * 32;
#pragma unroll
                for (int c8 = 0; c8 < 4; ++c8) { h16x8 o;
#pragma unroll
                    for (int e = 0; e < 8; ++e) o[e] = (h16)(vals[c8 * 8 + e] * rs);
                    *(h16x8*)(dsth + c8 * 8) = o; }
                if (m == 1) {
#pragma unroll
                    for (int c4 = 0; c4 < 8; ++c4) *(float4*)(kf + i * 128 + part * 32 + c4 * 4) = make_float4(vals[4 * c4] * rs, vals[4 * c4 + 1] * rs, vals[4 * c4 + 2] * rs, vals[4 * c4 + 3] * rs);
                }
            } else {
#pragma unroll
                for (int c4 = 0; c4 < 8; ++c4) *(float4*)(vf + i * 128 + part * 32 + c4 * 4) = valid ? make_float4(vals[4 * c4], vals[4 * c4 + 1], vals[4 * c4 + 2], vals[4 * c4 + 3]) : make_float4(0.f, 0.f, 0.f, 0.f);
            }
        }
#undef CONV_LOAD
        if (part == 0) {
            float bt = 0.f, g = 0.f;
            if (valid) {
                bt = 1.f / (1.f + __expf(-bl));
                const float xx = al + P.dt_bias[l * 4 + h];
                const float sp = xx > 20.f ? xx : log1pf(__expf(xx));
                g = -__expf(P.a_log[l * 4 + h]) * sp;
            }
            beta[i] = bt; dec[i] = g;
        }
    }
    __syncthreads();
    if (w == 0) {
        float v = dec[lane];
#pragma unroll
        for (int d = 1; d < 64; d <<= 1) { const float o = __shfl_up(v, d); if (lane >= d) v += o; }
        dec[lane] = v; edec[lane] = __expf(v);
    }
    __syncthreads();
    for (int rs3_ = 0; rs3_ <= PROBE_S3; ++rs3_) if (P2C & 2) {
        const int gq = lane >> 4, c16 = lane & 15;
        h16* aqk = (h16*)(P.ws + OFF_AQK) + (size_t)item * 4096;
        h16x8 ak[4], aq[4];
#pragma unroll
        for (int ks = 0; ks < 4; ++ks) { ak[ks] = *(const h16x8*)(kh + (16 * w + c16) * 136 + 32 * ks + 8 * gq); aq[ks] = *(const h16x8*)(qh + (16 * w + c16) * 136 + 32 * ks + 8 * gq); }
#pragma unroll
        for (int nt = 0; nt < 4; ++nt) {
            f32x4 kk = {0.f, 0.f, 0.f, 0.f}, qk = {0.f, 0.f, 0.f, 0.f};
#pragma unroll
            for (int ks = 0; ks < 4; ++ks) { const h16x8 bb = *(const h16x8*)(kh + (16 * nt + c16) * 136 + 32 * ks + 8 * gq); kk = MFMA16(ak[ks], bb, kk); qk = MFMA16(aq[ks], bb, qk); }
            const int jc = 16 * nt + c16; const float dj = dec[jc];
#pragma unroll
            for (int r = 0; r < 4; ++r) {
                const int ir = 16 * w + 4 * gq + r; const float gm = __expf(fminf(dec[ir] - dj, 0.f));
                Lm[ir * 64 + jc] = ir > jc ? beta[ir] * kk[r] * gm : 0.f;
                aqk[ir * 64 + jc] = (h16)(ir >= jc ? qk[r] * gm : 0.f);
            }
        }
    }
    __syncthreads();
    for (int rs5_ = 0; rs5_ <= PROBE_S5; ++rs5_) if (P2C & 8) {
        h16* qd = (h16*)(P.ws + OFF_QD) + (size_t)item * 8192;
        const int i = tid >> 2, part = tid & 3; const float ed = edec[i];
#pragma unroll
        for (int c8 = 0; c8 < 4; ++c8) { const h16x8 v = *(const h16x8*)(qh + i * 136 + part * 32 + c8 * 8); h16x8 o;
#pragma unroll
            for (int e = 0; e < 8; ++e) o[e] = (h16)((float)v[e] * ed);
            *(h16x8*)(qd + i * 128 + part * 32 + c8 * 8) = o; }
        h16* kdt = (h16*)(P.ws + OFF_KDT) + (size_t)item * 8192;
        const int d = tid & 127, ih = tid >> 7; const float dl = dec[63];
#pragma unroll
        for (int i8 = 0; i8 < 4; ++i8) { h16x8 o;
#pragma unroll
            for (int e = 0; e < 8; ++e) { const int ii = ih * 32 + i8 * 8 + e; o[e] = (h16)(kf[ii * 128 + d] * __expf(dl - dec[ii])); }
            *(h16x8*)(kdt + d * 64 + ih * 32 + i8 * 8) = o; }
        if (tid == 0) ((float*)(P.ws + OFF_CDEC))[item] = __expf(dl);
    }
    __syncthreads();
    if (P2C & 4) {
        float* scl = cwl;
        if (tid < 128) { const int i = tid & 63; scl[tid] = tid < 64 ? beta[i] : beta[i] * edec[i]; }
        __syncthreads();
        const int c = tid; const bool isu = c < 128; float* col = isu ? (vf + c) : (kf + (c - 128));
        const float* sc = scl + (isu ? 0 : 64);
        h16* dst = (h16*)(P.ws + (isu ? OFF_U : OFF_WM)) + (size_t)item * 8192 + (isu ? c : c - 128);
#pragma unroll 1
        for (int bi = 0; bi < 8; ++bi) {
            float sv[8];
            { const float4 s0 = *(const float4*)(sc + 8 * bi), s1 = *(const float4*)(sc + 8 * bi + 4);
              const float ss_[8] = {s0.x, s0.y, s0.z, s0.w, s1.x, s1.y, s1.z, s1.w};
#pragma unroll
              for (int r = 0; r < 8; ++r) sv[r] = col[(8 * bi + r) * 128] * ss_[r]; }
#pragma unroll 2
            for (int j4 = 0; j4 < 2 * bi; ++j4) {
                const float x0 = col[(4 * j4 + 0) * 128], x1 = col[(4 * j4 + 1) * 128], x2 = col[(4 * j4 + 2) * 128], x3 = col[(4 * j4 + 3) * 128];
#pragma unroll
                for (int r = 0; r < 8; ++r) { const float4 lv = *(const float4*)(Lm + (8 * bi + r) * 64 + 4 * j4); sv[r] -= lv.x * x0; sv[r] -= lv.y * x1; sv[r] -= lv.z * x2; sv[r] -= lv.w * x3; }
            }
            float4 la[8], lb[8];
#pragma unroll
            for (int r = 1; r < 8; ++r) { la[r] = *(const float4*)(Lm + (8 * bi + r) * 64 + 8 * bi); lb[r] = *(const float4*)(Lm + (8 * bi + r) * 64 + 8 * bi + 4); }
#pragma unroll
            for (int r = 1; r < 8; ++r) {
                const float lv[8] = {la[r].x, la[r].y, la[r].z, la[r].w, lb[r].x, lb[r].y, lb[r].z, lb[r].w};
#pragma unroll
                for (int q = 0; q < r; ++q) sv[r] -= lv[q] * sv[q];
            }
#pragma unroll
            for (int r = 0; r < 8; ++r) { col[(8 * bi + r) * 128] = sv[r]; dst[(8 * bi + r) * 128] = (h16)sv[r]; }
        }
    }
}

__device__ __forceinline__ float half_sum(float x) {
    const unsigned u = __float_as_uint(x); const auto p = __builtin_amdgcn_permlane32_swap(u, u, false, false);
    return __uint_as_float(p[0]) + __uint_as_float(p[1]);
}
__device__ __forceinline__ void store_tile_T(const f32x16& acc, float scale, float* st, h16* dst_row_lane  , bool ok, int lane) {
#pragma unroll
    for (int r = 0; r < 16; ++r) st[(lane & 31) * 33 + (r & 3) + 8 * (r >> 2) + 4 * (lane >> 5)] = acc[r] * scale;
    WAVE_FENCE();
    float v[16];
#pragma unroll
    for (int q = 0; q < 16; ++q) v[q] = st[(lane >> 1) * 33 + (lane & 1) * 16 + q];
    WAVE_FENCE();
    if (ok) store16h(dst_row_lane, v);
}

__device__ __forceinline__ void chain_item(const Params& P, int l, int item, float* st, int lane) {
    const int r0 = item * 32; const int tok = lane & 31, hf = lane >> 5;
    const int row = r0 + tok; const int rowc = row < NT ? row : NT - 1;
    const h16* projA = (const h16*)(P.ws + OFF_PROJA);
    const h16* Wq2 = (const h16*)(P.ws + OFF_WQ2T) + (size_t)l * 768 * 256;
    const h16* Wka = (const h16*)(P.ws + OFF_WKABS) + (size_t)l * 8 * 128 * 64;
    const h16* Wuk = (const h16*)(P.ws + OFF_WUKT) + (size_t)l * 512 * 128;
    h16* qidx = (h16*)(P.ws + OFF_QIDX); h16* qk = (h16*)(P.ws + OFF_QK); h16* kvrow = (h16*)(P.ws + OFF_KVROW);
    const int srow = r0 + (lane >> 1); const bool sok = srow < NT; const size_t srowc = sok ? srow : NT - 1;
    h16x8 bq[16]; float ss = 0.f;
#pragma unroll
    for (int ks = 0; ks < 16; ++ks) { bq[ks] = *(const h16x8*)(projA + (size_t)rowc * 512 + 16 * ks + 8 * hf);
#pragma unroll
        for (int e = 0; e < 8; ++e) { const float f = (float)bq[ks][e]; ss += f * f; } }
    ss = half_sum(ss);
    const float rstd_q = rsqrtf(ss * (1.f / 256.f) + EPS);
#pragma unroll 1
    for (int h = 0; h < 8; ++h) {
        f32x16 aq[2];
#pragma unroll
        for (int mt = 0; mt < 2; ++mt)
#pragma unroll
            for (int r = 0; r < 16; ++r) aq[mt][r] = 0.f;
        const h16* wp = Wq2 + (size_t)(64 * h + tok) * 256 + 8 * hf;
#pragma unroll
        for (int ks = 0; ks < 16; ++ks) {
            const h16x8 a0 = *(const h16x8*)(wp + 16 * ks), a1 = *(const h16x8*)(wp + 32 * 256 + 16 * ks);
            aq[0] = MFMA32(a0, bq[ks], aq[0]); aq[1] = MFMA32(a1, bq[ks], aq[1]);
        }
        __builtin_amdgcn_sched_group_barrier(0x20, 8, 0);
#pragma unroll
        for (int q = 0; q < 12; ++q) { __builtin_amdgcn_sched_group_barrier(0x8, 2, 0); __builtin_amdgcn_sched_group_barrier(0x20, 2, 0); }
        __builtin_amdgcn_sched_group_barrier(0x8, 8, 0);
        __builtin_amdgcn_sched_barrier(0);
        float sq = 0.f;
#pragma unroll
        for (int mt = 0; mt < 2; ++mt)
#pragma unroll
            for (int r = 0; r < 16; ++r) sq += aq[mt][r] * aq[mt][r];
        sq = half_sum(sq) * rstd_q * rstd_q;
        const float rsq = rsqrtf(sq * (1.f / 64.f) + EPS) * rstd_q;
        h16x8 qb[4];
#pragma unroll
        for (int kk = 0; kk < 4; ++kk)
#pragma unroll
            for (int j = 0; j < 8; ++j) qb[kk][j] = (h16)(aq[kk >> 1][8 * (kk & 1) + j] * rsq);
        const h16* kp = Wka + (size_t)h * 128 * 64 + (size_t)tok * 64 + 8 * hf;
#pragma unroll
        for (int ct = 0; ct < 4; ++ct) {
            f32x16 ak;
#pragma unroll
            for (int r = 0; r < 16; ++r) ak[r] = 0.f;
#pragma unroll
            for (int kk = 0; kk < 4; ++kk) { const h16x8 a = *(const h16x8*)(kp + (size_t)(32 * ct) * 64 + 16 * kk); ak = MFMA32(a, qb[kk], ak); }
            store_tile_T(ak, 1.f, st, qk + srowc * 1024 + h * 128 + 32 * ct + 16 * (lane & 1), sok, lane);
        }
    }
#pragma unroll 1
    for (int nt = 0; nt < 8; ++nt) {
        f32x16 ai;
#pragma unroll
        for (int r = 0; r < 16; ++r) ai[r] = 0.f;
        const h16* wp = Wq2 + (size_t)(512 + 32 * nt + tok) * 256 + 8 * hf;
#pragma unroll
        for (int ks = 0; ks < 16; ++ks) { const h16x8 a = *(const h16x8*)(wp + 16 * ks); ai = MFMA32(a, bq[ks], ai); }
#pragma unroll
        for (int r = 0; r < 16; ++r) ai[r] *= rstd_q;
        store_tile_T(ai, 1.f, st, qidx + srowc * 256 + 32 * nt + 16 * (lane & 1), sok, lane);
    }
    h16x8 bk[8]; float sk = 0.f;
#pragma unroll
    for (int ks = 0; ks < 8; ++ks) { bk[ks] = *(const h16x8*)(projA + (size_t)rowc * 512 + 256 + 16 * ks + 8 * hf);
#pragma unroll
        for (int e = 0; e < 8; ++e) { const float f = (float)bk[ks][e]; sk += f * f; } }
    sk = half_sum(sk);
    const float rstd_kv = rsqrtf(sk * (1.f / 128.f) + EPS);
    if (row < NT) {
        const float* g = P.g_ckv + l * 128;
#pragma unroll
        for (int ks = 0; ks < 8; ++ks) { h16x8 o;
#pragma unroll
            for (int e = 0; e < 8; ++e) o[e] = (h16)((float)bk[ks][e] * rstd_kv * g[16 * ks + 8 * hf + e]);
            *(h16x8*)(kvrow + (size_t)row * 136 + 16 * ks + 8 * hf) = o; }
    }
#pragma unroll 1
    for (int h = 0; h < 8; ++h) {
        f32x16 ak[2];
#pragma unroll
        for (int mt = 0; mt < 2; ++mt)
#pragma unroll
            for (int r = 0; r < 16; ++r) ak[mt][r] = 0.f;
        const h16* wp = Wuk + (size_t)(64 * h + tok) * 128 + 8 * hf;
#pragma unroll
        for (int ks = 0; ks < 8; ++ks) {
            const h16x8 a0 = *(const h16x8*)(wp + 16 * ks), a1 = *(const h16x8*)(wp + 32 * 128 + 16 * ks);
            ak[0] = MFMA32(a0, bk[ks], ak[0]); ak[1] = MFMA32(a1, bk[ks], ak[1]);
        }
        float sq = 0.f;
#pragma unroll
        for (int mt = 0; mt < 2; ++mt)
#pragma unroll
            for (int r = 0; r < 16; ++r) sq += ak[mt][r] * ak[mt][r];
        sq = half_sum(sq) * rstd_kv * rstd_kv;
        if (row < NT && hf == 0) kvrow[(size_t)row * 136 + 128 + h] = (h16)rsqrtf(sq * (1.f / 64.f) + EPS);
    }
    if (row < NT) {
        h16* kfrag = (h16*)(P.ws + OFF_KFRAG);
        const int b = row >= T_ ? 1 : 0; const int t = row - b * T_; const int tile = t >> 5;
#pragma unroll
        for (int q = 0; q < 4; ++q) {
            const int g8 = 2 * q + hf;
            const h16x8 v = *(const h16x8*)(projA + (size_t)row * 512 + 384 + g8 * 8);
            *(h16x8*)(kfrag + ((size_t)(b * NKT + tile) * 4 + (g8 >> 1)) * 512 + ((g8 & 1) * 32 + (t & 31)) * 8) = v;
        }
    }
}

__device__ __forceinline__ void p4_item(const Params& P, int l, int item, int lane) {
    const int r0 = item * 32; const int tok = lane & 31, hf = lane >> 5;
    const int row = r0 + tok; const bool ok = row < NT; const size_t rowc = ok ? row : NT - 1;
    const h16* ctx = (const h16*)(P.ws + OFF_CTX); const h16* Wuv = (const h16*)(P.ws + OFF_WUVT) + (size_t)l * 8 * 64 * 128;
    const h16* sza = (const h16*)(P.ws + OFF_SZA); const h16* szg = (const h16*)(P.ws + OFF_SZG); const h16* og = (const h16*)(P.ws + OFF_QN);
    h16* omix = (h16*)(P.ws + OFF_OMIX);
#pragma unroll 1
    for (int h = 0; h < 8; ++h) {
        h16x8 bc[8];
#pragma unroll
        for (int ks = 0; ks < 8; ++ks) bc[ks] = *(const h16x8*)(ctx + rowc * 1024 + h * 128 + 16 * ks + 8 * hf);
        f32x16 ao[2];
#pragma unroll
        for (int mt = 0; mt < 2; ++mt)
#pragma unroll
            for (int r = 0; r < 16; ++r) ao[mt][r] = 0.f;
        const h16* wp = Wuv + (size_t)h * 64 * 128 + (size_t)tok * 128 + 8 * hf;
#pragma unroll
        for (int ks = 0; ks < 8; ++ks) {
            const h16x8 a0 = *(const h16x8*)(wp + 16 * ks), a1 = *(const h16x8*)(wp + 32 * 128 + 16 * ks);
            ao[0] = MFMA32(a0, bc[ks], ao[0]); ao[1] = MFMA32(a1, bc[ks], ao[1]);
        }
        if (ok) {
#pragma unroll
            for (int mt = 0; mt < 2; ++mt)
#pragma unroll
                for (int g = 0; g < 4; ++g) {
                    const int d0 = h * 64 + 32 * mt + 8 * g + 4 * hf;
                    const h16x4 z = *(const h16x4*)(sza + (size_t)row * 512 + d0);
                    h16x4 o;
#pragma unroll
                    for (int e = 0; e < 4; ++e) o[e] = (h16)(ao[mt][4 * g + e] * (float)z[e]);
                    *(h16x4*)(omix + (size_t)row * 1024 + d0) = o;
                }
        }
    }
    const float* go = P.g_out + l * 128;
#pragma unroll 1
    for (int h = 0; h < 4; ++h) {
        h16x8 v[8]; float ss = 0.f;
#pragma unroll
        for (int q = 0; q < 8; ++q) { v[q] = *(const h16x8*)(og + rowc * 512 + h * 128 + 64 * hf + 8 * q);
#pragma unroll
            for (int e = 0; e < 8; ++e) { const float f = (float)v[q][e]; ss += f * f; } }
        ss = half_sum(ss);
        const float rs = rsqrtf(ss * (1.f / 128.f) + EPS);
        if (ok) {
#pragma unroll
            for (int q = 0; q < 8; ++q) { const h16x8 z = *(const h16x8*)(szg + (size_t)row * 512 + h * 128 + 64 * hf + 8 * q); h16x8 o;
#pragma unroll
                for (int e = 0; e < 8; ++e) o[e] = (h16)((float)v[q][e] * rs * go[64 * hf + 8 * q + e] * (float)z[e]);
                *(h16x8*)(omix + (size_t)row * 1024 + 512 + h * 128 + 64 * hf + 8 * q) = o; }
        }
    }
}

__device__ __forceinline__ void phase2(const Params& P, int l, unsigned char* lds) {
    const int tid = opaque_tid(), lane = tid & 63, w = tid >> 6;
    unsigned* ctr = (unsigned*)(P.ws + OFF_CTL) + 16 + l;
    int* slot = (int*)(lds + LDS_BYTES - 32);
    for (int rep_ = 0; rep_ <= (PROBE_P2C | PROBE_CHAIN | PROBE_P2X); ++rep_) {
    for (;;) {
        __syncthreads();
        if (tid == 0) *slot = (int)__hip_atomic_fetch_add(ctr + 4 * rep_, 1u, __ATOMIC_RELAXED, __HIP_MEMORY_SCOPE_AGENT);
        __syncthreads();
        const int it = *slot;
        if (it >= NGI + 129) break;
        if (it >= 129) { if (!PROBE_CHAIN || rep_ == 0) { TSEC_BEGIN(6) p2c_item(P, l, it - 129, lds); TSEC_END(6); } }
        else if (!PROBE_P2C || rep_ == 0) {
            const int ci = it * 4 + w;
            __syncthreads();
            TSEC_BEGIN(7)
            if (ci < (NT + 31) / 32) chain_item(P, l, ci, (float*)lds + w * 1152, lane);
            TSEC_END(7);
        }
    }
    }
}

constexpr int SNT = 2;
__device__ __forceinline__ void gdn_scan(const Params& P, int sw, unsigned char* lds) {
    h16* St = (h16*)lds;
    h16* Vt = (h16*)(lds + 16 * SNT * 272);
    const int tid = opaque_tid(), lane = tid & 63, w = tid >> 6, gq = lane >> 4, c16 = lane & 15;
    const int chain = sw / (8 / SNT), e0 = (sw % (8 / SNT)) * 16 * SNT, b = chain >> 2, h = chain & 3;
    const h16* Ub = (const h16*)(P.ws + OFF_U); const h16* Wb = (const h16*)(P.ws + OFF_WM);
    const h16* Qb = (const h16*)(P.ws + OFF_QD); const h16* Kb = (const h16*)(P.ws + OFF_KDT);
    const h16* Ab = (const h16*)(P.ws + OFF_AQK); const float* cdec = (const float*)(P.ws + OFF_CDEC);
    h16* og = (h16*)(P.ws + OFF_QN);
    __syncthreads();
    for (int i = tid; i < 16 * SNT * 136; i += NTHREADS) St[i] = (h16)0.f;
    f32x4 S[2][SNT];
#pragma unroll
    for (int m2 = 0; m2 < 2; ++m2)
#pragma unroll
        for (int nt = 0; nt < SNT; ++nt) S[m2][nt] = (f32x4){0.f, 0.f, 0.f, 0.f};
    __syncthreads();
    h16x8 wf[2][4], qf[2][4], af[2][2], kf_[2][2][2]; h16 uv[2][SNT][4]; float cd[2];
#define SCAN_LOAD(S_, n_) do { const int nn_ = (n_) < NCH ? (n_) : NCH - 1; const size_t itm = (size_t)chain * NCH + nn_; \
        _Pragma("unroll") for (int ks = 0; ks < 4; ++ks) { wf[S_][ks] = *(const h16x8*)(Wb + itm * 8192 + (16 * w + c16) * 128 + 32 * ks + 8 * gq); qf[S_][ks] = *(const h16x8*)(Qb + itm * 8192 + (16 * w + c16) * 128 + 32 * ks + 8 * gq); } \
        _Pragma("unroll") for (int ks = 0; ks < 2; ++ks) { af[S_][ks] = *(const h16x8*)(Ab + itm * 4096 + (16 * w + c16) * 64 + 32 * ks + 8 * gq); \
            _Pragma("unroll") for (int m2 = 0; m2 < 2; ++m2) kf_[S_][m2][ks] = *(const h16x8*)(Kb + itm * 8192 + (16 * (2 * w + m2) + c16) * 64 + 32 * ks + 8 * gq); } \
        _Pragma("unroll") for (int nt = 0; nt < SNT; ++nt) _Pragma("unroll") for (int r = 0; r < 4; ++r) uv[S_][nt][r] = Ub[itm * 8192 + (16 * w + 4 * gq + r) * 128 + e0 + 16 * nt + c16]; \
        cd[S_] = cdec[itm]; } while (0)
#define SCAN_STEP(S_, n_) do { \
        h16x8 cwf[4], cqf[4], caf[2], ckf[2][2]; float cu[SNT][4]; const float ccd = cd[S_]; \
        _Pragma("unroll") for (int ks = 0; ks < 4; ++ks) { cwf[ks] = wf[S_][ks]; cqf[ks] = qf[S_][ks]; } \
        _Pragma("unroll") for (int ks = 0; ks < 2; ++ks) { caf[ks] = af[S_][ks]; ckf[0][ks] = kf_[S_][0][ks]; ckf[1][ks] = kf_[S_][1][ks]; } \
        _Pragma("unroll") for (int nt = 0; nt < SNT; ++nt) _Pragma("unroll") for (int r = 0; r < 4; ++r) cu[nt][r] = (float)uv[S_][nt][r]; \
        SCAN_LOAD(S_, (n_) + 2); \
        f32x4 Pm[SNT], O[SNT]; \
        _Pragma("unroll") for (int nt = 0; nt < SNT; ++nt) { Pm[nt] = (f32x4){0.f, 0.f, 0.f, 0.f}; O[nt] = (f32x4){0.f, 0.f, 0.f, 0.f}; \
            _Pragma("unroll") for (int ks = 0; ks < 4; ++ks) { const h16x8 bs = *(const h16x8*)(St + (16 * nt + c16) * 136 + 32 * ks + 8 * gq); Pm[nt] = MFMA16(cwf[ks], bs, Pm[nt]); O[nt] = MFMA16(cqf[ks], bs, O[nt]); } \
            h16x4 vn; \
            _Pragma("unroll") for (int r = 0; r < 4; ++r) vn[r] = (h16)(cu[nt][r] - Pm[nt][r]); \
            *(h16x4*)(Vt + (16 * nt + c16) * 72 + 16 * w + 4 * gq) = vn; } \
        lds_barrier(); \
        _Pragma("unroll") for (int nt = 0; nt < SNT; ++nt) { \
            _Pragma("unroll") for (int m2 = 0; m2 < 2; ++m2) _Pragma("unroll") for (int r = 0; r < 4; ++r) S[m2][nt][r] *= ccd; \
            _Pragma("unroll") for (int ks = 0; ks < 2; ++ks) { const h16x8 bv = *(const h16x8*)(Vt + (16 * nt + c16) * 72 + 32 * ks + 8 * gq); O[nt] = MFMA16(caf[ks], bv, O[nt]); S[0][nt] = MFMA16(ckf[0][ks], bv, S[0][nt]); S[1][nt] = MFMA16(ckf[1][ks], bv, S[1][nt]); } \
            _Pragma("unroll") for (int r = 0; r < 4; ++r) { const int t = 64 * (n_) + 16 * w + 4 * gq + r - 48; if (t >= 0) og[((size_t)b * T_ + t) * 512 + h * 128 + e0 + 16 * nt + c16] = (h16)(O[nt][r] * 0.08838834764831845f); } \
            _Pragma("unroll") for (int m2 = 0; m2 < 2; ++m2) { h16x4 sv; \
                _Pragma("unroll") for (int r = 0; r < 4; ++r) sv[r] = (h16)S[m2][nt][r]; \
                *(h16x4*)(St + (16 * nt + c16) * 136 + 16 * (2 * w + m2) + 4 * gq) = sv; } } \
        lds_barrier(); } while (0)
    SCAN_LOAD(0, 0); SCAN_LOAD(1, 1);
    for (int n = 0; n + 1 < NCH; n += 2) { SCAN_STEP(0, n); SCAN_STEP(1, n + 1); }
    SCAN_STEP(0, NCH - 1);
#undef SCAN_STEP
#undef SCAN_LOAD
}

constexpr int CAP = 704;
__device__ __forceinline__ void dma16_asm(const void* gptr, unsigned lds_addr) {
    unsigned sv; lds_addr = (unsigned)__builtin_amdgcn_readfirstlane((int)lds_addr);
    asm volatile("s_mov_b32 %0, m0\n\ts_mov_b32 m0, %2\n\ts_nop 0\n\tglobal_load_lds_dwordx4 %1, off\n\ts_mov_b32 m0, %0" : "=&s"(sv) : "v"(gptr), "s"(lds_addr) : "memory");
}
__device__ __forceinline__ int dpp_scan_incl(int x) {
    x += __builtin_amdgcn_update_dpp(0, x, 0x111, 0xf, 0xf, false);
    x += __builtin_amdgcn_update_dpp(0, x, 0x112, 0xf, 0xf, false);
    x += __builtin_amdgcn_update_dpp(0, x, 0x114, 0xf, 0xf, false);
    x += __builtin_amdgcn_update_dpp(0, x, 0x118, 0xf, 0xf, false);
    x += __builtin_amdgcn_update_dpp(0, x, 0x142, 0xa, 0xf, false);
    x += __builtin_amdgcn_update_dpp(0, x, 0x143, 0xc, 0xf, false);
    return x;
}

__device__ __forceinline__ int topk_prune(float* sc, unsigned short* ix, unsigned* hist, int c, int lane, int K, int limit, float& theta, float& theta_next) {
    constexpr int NE = (CAP + 63) / 64;
    unsigned key[NE]; unsigned short idx[NE]; float val[NE];
#pragma unroll
    for (int it = 0; it < NE; ++it) { const int i = lane + 64 * it; const bool v = i < c; const float f = v ? sc[i] : 0.f; val[it] = f; idx[it] = v ? ix[i] : (unsigned short)0; key[it] = v ? ordkey(f) : 0u; }
    unsigned prefix = 0; int need = K; int binpop = 0; bool exact = true; int sh = 0;
    const unsigned tb0 = (unsigned)__builtin_amdgcn_readfirstlane((int)(key[0] >> 24));
    bool same = true;
#pragma unroll
    for (int it = 0; it < NE; ++it) same = same && (key[it] == 0u || (key[it] >> 24) == tb0);
    const bool skip0 = __all(same);
    if (skip0) prefix = tb0 << 24;
#pragma unroll
    for (int r = 0; r < 4; ++r) {
        if (r == 0 && skip0) continue;
        const int shift = 24 - 8 * r;
        ((uint4*)hist)[lane] = make_uint4(0u, 0u, 0u, 0u);
        WAVE_FENCE();
#pragma unroll
        for (int it = 0; it < NE; ++it) {
            const bool m = (key[it] != 0u) && (r == 0 || ((key[it] ^ prefix) >> ((shift + 8) & 31)) == 0u);
            if (m) atomicAdd(&hist[(key[it] >> shift) & 255u], 1u);
        }
        WAVE_FENCE();
        const uint4 h4 = ((const uint4*)hist)[63 - lane];
        WAVE_FENCE();
        const int loc = (int)(h4.x + h4.y + h4.z + h4.w);
        const int incl = dpp_scan_incl(loc);
        const int c3 = incl - loc, c2 = c3 + (int)h4.w, c1 = c2 + (int)h4.z, c0 = c1 + (int)h4.y;
        int dsel = -1, cab = 0, hb = 0;
        if (c3 < need && need <= c3 + (int)h4.w) { dsel = 3; cab = c3; hb = (int)h4.w; }
        else if (c2 < need && need <= c2 + (int)h4.z) { dsel = 2; cab = c2; hb = (int)h4.z; }
        else if (c1 < need && need <= c1 + (int)h4.y) { dsel = 1; cab = c1; hb = (int)h4.y; }
        else if (c0 < need && need <= c0 + (int)h4.x) { dsel = 0; cab = c0; hb = (int)h4.x; }
        const u64 fm = __ballot(dsel >= 0);
        const int src = __builtin_amdgcn_readfirstlane(__ffsll((long long)fm) - 1);
        const int digit = __builtin_amdgcn_readlane(4 * (63 - lane) + dsel, src);
        const int cabv = __builtin_amdgcn_readlane(cab, src);
        binpop = __builtin_amdgcn_readlane(hb, src);
        need -= cabv; prefix |= (unsigned)digit << shift; sh = shift;
        if (r < 3 && (K - need) + binpop <= limit) { exact = false; break; }
    }
    (void)sh;
    const unsigned thr = prefix; int out = 0, tb = 0;
#pragma unroll
    for (int it = 0; it < NE; ++it) {
        const bool v = key[it] != 0u; const bool gt = v && key[it] > thr; const bool eq = v && key[it] == thr;
        bool keep;
        if (exact && K == 256) { const u64 meq = __ballot(eq); const int tr = tb + lanes_below(meq); keep = gt || (eq && tr < need); tb += __popcll(meq); }
        else keep = gt || eq;
        const u64 mk = __ballot(keep); const int slot = out + lanes_below(mk);
        if (keep) { sc[slot] = val[it]; ix[slot] = idx[it]; }
        out += __popcll(mk);
    }
    WAVE_FENCE();
    theta = ordinv(thr); theta_next = ordinv(thr + 1u);
    return out;
}

constexpr int WL_SC = 0;
constexpr int WL_IX = 8 * CAP * 4;
constexpr int WL_RING = 0;
constexpr int SLOT_BYTES = 8704;
constexpr int WL_SEL = 34816;
constexpr int WL_NSEL = 38912;
constexpr int WL_BYTES = 38944;
static_assert(WL_IX + 8 * CAP * 2 <= WL_SEL && 4 * SLOT_BYTES <= WL_SEL, "DSA LDS map");

__device__ __forceinline__ void dsa_item(const Params& P, int item, int qlo, int qhi, unsigned char* wl, const float* biasd, int lane) {
    float* sc = (float*)(wl + WL_SC);
    unsigned short* ix = (unsigned short*)(wl + WL_IX);
    unsigned* hist = (unsigned*)(wl + WL_SEL);
    unsigned short* sel = (unsigned short*)(wl + WL_SEL);
    int* nselL = (int*)(wl + WL_NSEL);
    unsigned char* ring = wl + WL_RING;
    const h16* qidx = (const h16*)(P.ws + OFF_QIDX);
    const float* small = (const float*)(P.ws + OFF_SMALL);
    const h16* kvrow = (const h16*)(P.ws + OFF_KVROW);
    const h16* qk = (const h16*)(P.ws + OFF_QK);
    h16* ctxb = (h16*)(P.ws + OFF_CTX);
    const int row0 = item * 8; const int b = row0 >= T_ ? 1 : 0; const int t0 = row0 - b * T_;
    const int half = lane >> 5, kl = lane & 31;
    const unsigned wl_a = (unsigned)(size_t)(LAS unsigned char*)wl;
    WAVE_FENCE();
    TSEC_BEGIN(3)
    for (int rep_ = 0; rep_ <= (PROBE_TOPK2 | PROBE_SWEEP); ++rep_) {
        const bool dummy_ = PROBE_SWEEP && rep_ == 0;
        h16x8 afr[4];
        { const int qq = kl >> 2, hd = kl & 3; const h16* p = qidx + (size_t)(row0 + qq) * 256 + hd * 64 + 8 * half;
#pragma unroll
          for (int ks = 0; ks < 4; ++ks) afr[ks] = *(const h16x8*)(p + 16 * ks); }
        float wq[4][4]; float thq[8]; int cntq[8];
#pragma unroll
        for (int g = 0; g < 4; ++g) { const float* sp = small + (size_t)(row0 + 2 * g + half) * 16;
#pragma unroll
            for (int hh = 0; hh < 4; ++hh) wq[g][hh] = sp[hh]; }
#pragma unroll
        for (int qq = 0; qq < 8; ++qq) { thq[qq] = (dummy_ || qq < qlo || qq >= qhi) ? INFINITY : -INFINITY; cntq[qq] = 0; }
        const int ntiles = ((t0 + 7) >> 5) + 1;
        bool safe_ = false;
      redo_sweep:
        const h16* kfp = (const h16*)(P.ws + OFF_KFRAG) + (size_t)b * NKT * 2048 + lane * 8;
        h16x8 bt[8][4];
#pragma unroll
        for (int u = 0; u < 8; ++u) { const int tl = u < ntiles ? u : ntiles - 1;
#pragma unroll
            for (int ks = 0; ks < 4; ++ks) bt[u][ks] = *(const h16x8*)(kfp + (size_t)tl * 2048 + ks * 512); }
        const int ngroups = (ntiles + 3) >> 2;
#define SWEEP_GROUP(PAR) \
                f32x16 acc[4]; \
                _Pragma("unroll") for (int u = 0; u < 4; ++u) { \
                    _Pragma("unroll") for (int r = 0; r < 16; ++r) acc[u][r] = 0.f; \
                    _Pragma("unroll") for (int ks = 0; ks < 4; ++ks) acc[u] = MFMA32(afr[ks], bt[4 * (PAR) + u][ks], acc[u]); \
                    const int tn = tile0 + u + 8 < ntiles ? tile0 + u + 8 : ntiles - 1;     \
                    _Pragma("unroll") for (int ks = 0; ks < 4; ++ks) bt[4 * (PAR) + u][ks] = *(const h16x8*)(kfp + (size_t)tn * 2048 + ks * 512); } \
                _Pragma("unroll") for (int q = 0; q < 16; ++q) { __builtin_amdgcn_sched_group_barrier(0x8, 1, 0); __builtin_amdgcn_sched_group_barrier(0x20, 1, 0); }     \
                __builtin_amdgcn_sched_barrier(0);
        for (int grp = 0; grp <= ngroups; ++grp) {
            const bool last = grp == ngroups;
            if (!last) {
                const int tile0 = grp * 4;
                f32x16 accs[4];
                if (grp & 1) { SWEEP_GROUP(1) _Pragma("unroll") for (int u = 0; u < 4; ++u) accs[u] = acc[u]; }
                else { SWEEP_GROUP(0) _Pragma("unroll") for (int u = 0; u < 4; ++u) accs[u] = acc[u]; }
#pragma unroll
                for (int p = 0; p < 2; ++p) {
                    const int key = (tile0 + 2 * p) * 32 + lane;
#define APPEND_CELL(QQ, SV) do { const float sv_ = (SV); u64 mge_; asm("v_cmp_ge_f32 %0, %1, %2" : "=s"(mge_) : "v"(sv_), "v"(thq[QQ])); \
                        const u64 m_ = __builtin_amdgcn_ballot_w64(key <= t0 + (QQ)) & mge_; \
                        const int slot_ = lanes_below_from(m_, cntq[QQ]); \
                        const unsigned a1_ = wl_a + 4u * (unsigned)slot_, a2_ = wl_a + 2u * (unsigned)slot_; u64 ex_; \
                        asm volatile("s_and_saveexec_b64 %0, %1\n\tds_write_b32 %2, %3 offset:%6\n\tds_write_b16 %4, %5 offset:%7\n\ts_mov_b64 exec, %0" \
                            : "=&s"(ex_) : "s"(m_), "v"(a1_), "v"(sv_), "v"(a2_), "v"(key), "n"(WL_SC + (QQ) * CAP * 4), "n"(WL_IX + (QQ) * CAP * 2) : "memory"); \
                        cntq[QQ] += __builtin_popcountll(m_); } while (0)
#define APPEND_PAIR(G) do { float sa = 0.f, sb = 0.f; \
                        _Pragma("unroll") for (int hh = 0; hh < 4; ++hh) { sa = fmaf(wq[G][hh], relu1(accs[2 * p][4 * (G) + hh]), sa); sb = fmaf(wq[G][hh], relu1(accs[2 * p + 1][4 * (G) + hh]), sb); } \
                        const auto sw = __builtin_amdgcn_permlane32_swap(__float_as_uint(sa), __float_as_uint(sb), false, false);     \
                        APPEND_CELL(2 * (G), __uint_as_float(sw[0])); APPEND_CELL(2 * (G) + 1, __uint_as_float(sw[1])); } while (0)
                    APPEND_PAIR(0); APPEND_PAIR(1); APPEND_PAIR(2); APPEND_PAIR(3);
#undef APPEND_PAIR
#undef APPEND_CELL
                }
            }
            const int lim = last ? 256 : CAP - 128;
            int cmax = cntq[0];
#pragma unroll
            for (int qq = 1; qq < 8; ++qq) cmax = cntq[qq] > cmax ? cntq[qq] : cmax;
            if (cmax > lim) {
                WAVE_FENCE();
#pragma unroll 1
                for (int qq = 0; qq < 8; ++qq) {
                    int c = cntq[0];
#pragma unroll
                    for (int j = 1; j < 8; ++j) c = qq == j ? cntq[j] : c;
                    c = __builtin_amdgcn_readfirstlane(c);
                    if (c > lim) {
                        float nth, nthn;
                        const int nall = t0 + qq + 1; int nseen = (grp + 1) * 128; nseen = nseen < nall ? nseen : nall;
                        int K = 256;
                        if (!last && !safe_) { K = (int)(448.f * (float)nseen / (float)nall) + 16; K = K < 48 ? 48 : (K > 256 ? 256 : K); }
                        TSEC_BEGIN(1) TSEC_BEGIN(2)
                        const int nc = topk_prune(sc + qq * CAP, ix + qq * CAP, hist, c, lane, K, last ? 256 : K + 64, nth, nthn);
                        if (!last) TSEC_END(1); else TSEC_END(2);
                        float nv = K == 256 ? nthn : nth;
                        int ncf = nc;
                        if (K < 256 && nc > lim) {
                            ncf = topk_prune(sc + qq * CAP, ix + qq * CAP, hist, nc, lane, 256, 320, nth, nthn); nv = nthn;
                        }
#pragma unroll
                        for (int j = 0; j < 8; ++j) if (j == qq) { cntq[j] = ncf; thq[j] = nv; }
                    }
                }
            }
        }
        {
            bool okq = true;
#pragma unroll
            for (int qq = 0; qq < 8; ++qq) okq = okq && (qq < qlo || qq >= qhi || cntq[qq] >= 256 || cntq[qq] >= t0 + qq + 1);
            if (!okq && !safe_ && !dummy_) {
                safe_ = true;
#pragma unroll
                for (int qq = 0; qq < 8; ++qq) { thq[qq] = (qq < qlo || qq >= qhi) ? INFINITY : -INFINITY; cntq[qq] = 0; }
                WAVE_FENCE();
                goto redo_sweep;
            }
        }
#undef SWEEP_GROUP
        WAVE_FENCE();
#pragma unroll 1
        for (int qq = qlo; qq < (dummy_ ? 0 : qhi); ++qq) {
            int c = cntq[0];
#pragma unroll
            for (int j = 1; j < 8; ++j) c = qq == j ? cntq[j] : c;
            c = __builtin_amdgcn_readfirstlane(c);
            if (lane == 0) nselL[qq] = c;
#pragma unroll
            for (int i4 = 0; i4 < 4; ++i4) { const int i = lane + 64 * i4; sel[qq * 256 + i] = i < c ? ix[qq * CAP + i] : (unsigned short)0; }
        }
        WAVE_FENCE();
    }
    TSEC_END(3);
    TSEC_BEGIN(4)
    const int gq = lane >> 4, c16 = lane & 15; const bool hv = c16 < 8;
    const unsigned ring_a = (unsigned)(size_t)(LAS unsigned char*)ring;
    const h16* kvb = kvrow + (size_t)b * T_ * 136;
    int poff[4];
#pragma unroll
    for (int i = 0; i < 4; ++i) poff[i] = (c16 ^ ((4 * i + gq) & 15)) * 8;
    const float b31 = biasd[127 * 8 + (c16 & 7)];
#define DSA_ISSUE(J_) do { const int jj_ = (J_) < 8 * qhi ? (J_) : 8 * qhi - 1; const unsigned short* sp_ = sel + (jj_ >> 3) * 256 + 32 * (jj_ & 7); \
        const h16* a_[8]; \
        _Pragma("unroll") for (int i = 0; i < 8; ++i) a_[i] = kvb + (size_t)sp_[4 * i + gq] * 136 + poff[i & 3]; \
        const h16* ar_ = kvb + (size_t)sp_[lane & 31] * 136 + 128; \
        const unsigned la_ = (unsigned)__builtin_amdgcn_readfirstlane((int)(ring_a + ((J_) & 3) * SLOT_BYTES)); unsigned sv_; unsigned long long ex_; \
        asm volatile("s_mov_b32 %0, m0\n\ts_mov_b32 m0, %2\n\ts_nop 0\n\t" \
            "global_load_lds_dwordx4 %3, off\n\ts_add_u32 m0, m0, 0x400\n\ts_nop 0\n\t" "global_load_lds_dwordx4 %4, off\n\ts_add_u32 m0, m0, 0x400\n\ts_nop 0\n\t" \
            "global_load_lds_dwordx4 %5, off\n\ts_add_u32 m0, m0, 0x400\n\ts_nop 0\n\t" "global_load_lds_dwordx4 %6, off\n\ts_add_u32 m0, m0, 0x400\n\ts_nop 0\n\t" \
            "global_load_lds_dwordx4 %7, off\n\ts_add_u32 m0, m0, 0x400\n\ts_nop 0\n\t" "global_load_lds_dwordx4 %8, off\n\ts_add_u32 m0, m0, 0x400\n\ts_nop 0\n\t" \
            "global_load_lds_dwordx4 %9, off\n\ts_add_u32 m0, m0, 0x400\n\ts_nop 0\n\t" "global_load_lds_dwordx4 %10, off\n\ts_add_u32 m0, m0, 0x400\n\ts_nop 0\n\t" \
            "s_mov_b64 %1, exec\n\ts_mov_b64 exec, 0xffffffff\n\tglobal_load_lds_dwordx4 %11, off\n\ts_mov_b64 exec, %1\n\ts_mov_b32 m0, %0" \
            : "=&s"(sv_), "=&s"(ex_) : "s"(la_), "v"(a_[0]), "v"(a_[1]), "v"(a_[2]), "v"(a_[3]), "v"(a_[4]), "v"(a_[5]), "v"(a_[6]), "v"(a_[7]), "v"(ar_) : "memory"); } while (0)
    for (int rep_ = 0; rep_ <= PROBE_ATT2; ++rep_) {
    asm volatile("s_waitcnt vmcnt(0) lgkmcnt(0)" ::: "memory");
    DSA_ISSUE(8 * qlo); DSA_ISSUE(8 * qlo + 1); DSA_ISSUE(8 * qlo + 2);
#pragma unroll 1
    for (int qq = qlo; qq < qhi; ++qq) {
        const int rowq = row0 + qq, tq = t0 + qq, ns = nselL[qq];
        const unsigned short* selq = sel + qq * 256;
        h16x8 qf[4];
#pragma unroll
        for (int ks = 0; ks < 4; ++ks) {
            if (hv) qf[ks] = *(const h16x8*)(qk + (size_t)rowq * 1024 + c16 * 128 + 32 * ks + 8 * gq);
            else {
#pragma unroll
                for (int e = 0; e < 8; ++e) qf[ks][e] = (h16)0.f;
            }
        }
        float m_run = -INFINITY, l_run = 0.f;
        f32x4 ctx[8];
#pragma unroll
        for (int nt = 0; nt < 8; ++nt) ctx[nt] = (f32x4){0.f, 0.f, 0.f, 0.f};
#pragma unroll 1
        for (int c = 0; c < 8; ++c) {
            const int j = 8 * qq + c;
            DSA_ISSUE(j + 3);
            asm volatile("s_waitcnt vmcnt(27)" ::: "memory");
            const unsigned char* sl = ring + (j & 3) * SLOT_BYTES;
            h16x8 af[2][4];
#pragma unroll
            for (int mt = 0; mt < 2; ++mt)
#pragma unroll
                for (int ks = 0; ks < 4; ++ks) af[mt][ks] = *(const h16x8*)(sl + (16 * mt + c16) * 256 + (((4 * ks + gq) ^ c16) * 16));
            fp16x4 rt[2]; ushort4 sv[2];
#pragma unroll
            for (int mt = 0; mt < 2; ++mt) {
                rt[mt] = __builtin_amdgcn_ds_read_tr16_b64_v4f16((LAS fp16x4*)(sl + 8192 + (16 * mt + 4 * gq + (c16 >> 2)) * 16 + 8 * (c16 & 3)));
                sv[mt] = *(const ushort4*)(selq + 32 * c + 16 * mt + 4 * gq);
            }
            fp16x4 tb[8][2];
            { const int rw0 = 4 * gq + (c16 >> 2), rw1 = 16 + rw0;
#pragma unroll
              for (int nt = 0; nt < 8; ++nt) { const int pc = 2 * nt + ((c16 >> 1) & 1);
                tb[nt][0] = __builtin_amdgcn_ds_read_tr16_b64_v4f16((LAS fp16x4*)(sl + rw0 * 256 + ((pc ^ (rw0 & 15)) * 16) + 8 * (c16 & 1)));
                tb[nt][1] = __builtin_amdgcn_ds_read_tr16_b64_v4f16((LAS fp16x4*)(sl + rw1 * 256 + ((pc ^ (rw1 & 15)) * 16) + 8 * (c16 & 1))); } }
            f32x4 s4[2];
#pragma unroll
            for (int mt = 0; mt < 2; ++mt) { s4[mt] = (f32x4){0.f, 0.f, 0.f, 0.f};
#pragma unroll
                for (int ks = 0; ks < 4; ++ks) s4[mt] = MFMA16(af[mt][ks], qf[ks], s4[mt]); }
            int dist[2][4]; int dmin = 127;
#pragma unroll
            for (int mt = 0; mt < 2; ++mt) { const int sarr[4] = {(int)sv[mt].x, (int)sv[mt].y, (int)sv[mt].z, (int)sv[mt].w};
#pragma unroll
                for (int r = 0; r < 4; ++r) { int d = tq - sarr[r]; d = d < 0 ? 0 : (d > 127 ? 127 : d); dist[mt][r] = d; dmin = d < dmin ? d : dmin; } }
            float bias[2][4];
            if (__all(dmin == 127)) {
#pragma unroll
                for (int mt = 0; mt < 2; ++mt)
#pragma unroll
                    for (int r = 0; r < 4; ++r) bias[mt][r] = b31;
            } else {
#pragma unroll
                for (int mt = 0; mt < 2; ++mt)
#pragma unroll
                    for (int r = 0; r < 4; ++r) bias[mt][r] = biasd[dist[mt][r] * 8 + (c16 & 7)];
            }
            float lg[2][4]; float mx = -INFINITY;
#pragma unroll
            for (int mt = 0; mt < 2; ++mt) { const h16x4 rr = __builtin_bit_cast(h16x4, rt[mt]);
#pragma unroll
                for (int r = 0; r < 4; ++r) {
                    const int kidx = 32 * c + 16 * mt + 4 * gq + r; const bool valid = hv && (kidx < ns);
                    const float v = valid ? s4[mt][r] * (float)rr[r] + bias[mt][r] : -INFINITY;
                    lg[mt][r] = v; mx = fmaxf(mx, v);
                } }
            {
                const unsigned u0 = __float_as_uint(mx);
                const auto p16 = __builtin_amdgcn_permlane16_swap(u0, u0, false, false);
                const float y = fmaxf(__uint_as_float(p16[0]), __uint_as_float(p16[1]));
                const unsigned u1 = __float_as_uint(y);
                const auto p32 = __builtin_amdgcn_permlane32_swap(u1, u1, false, false);
                mx = fmaxf(__uint_as_float(p32[0]), __uint_as_float(p32[1]));
            }
            const float m_new = fmaxf(m_run, mx);
            const float alpha = (hv && m_new > -INFINITY) ? __expf(m_run - m_new) : 1.f;
            float rs = 0.f; float pp[2][4];
#pragma unroll
            for (int mt = 0; mt < 2; ++mt)
#pragma unroll
                for (int r = 0; r < 4; ++r) { const float p = (hv && lg[mt][r] > -INFINITY) ? __expf(lg[mt][r] - m_new) : 0.f; pp[mt][r] = p; rs += p; }
            {
                const unsigned u0 = __float_as_uint(rs);
                const auto p16 = __builtin_amdgcn_permlane16_swap(u0, u0, false, false);
                const float y = __uint_as_float(p16[0]) + __uint_as_float(p16[1]);
                const unsigned u1 = __float_as_uint(y);
                const auto p32 = __builtin_amdgcn_permlane32_swap(u1, u1, false, false);
                rs = __uint_as_float(p32[0]) + __uint_as_float(p32[1]);
            }
            l_run = l_run * alpha + rs; m_run = m_new;
            h16x8 pa;
#pragma unroll
            for (int jx = 0; jx < 8; ++jx) pa[jx] = (h16)pp[jx >> 2][jx & 3];
            if (__any(alpha != 1.f)) {
                float ar[4];
#pragma unroll
                for (int r = 0; r < 4; ++r) ar[r] = __shfl(alpha, 4 * gq + r);
#pragma unroll
                for (int nt = 0; nt < 8; ++nt)
#pragma unroll
                    for (int r = 0; r < 4; ++r) ctx[nt][r] *= ar[r];
            }
#pragma unroll
            for (int nt = 0; nt < 8; ++nt) {
                const h16x4 b0 = __builtin_bit_cast(h16x4, tb[nt][0]), b1 = __builtin_bit_cast(h16x4, tb[nt][1]);
                h16x8 bf; bf[0] = b0[0]; bf[1] = b0[1]; bf[2] = b0[2]; bf[3] = b0[3]; bf[4] = b1[0]; bf[5] = b1[1]; bf[6] = b1[2]; bf[7] = b1[3];
                ctx[nt] = MFMA16(pa, bf, ctx[nt]);
            }
        }
        float li[4];
#pragma unroll
        for (int r = 0; r < 4; ++r) li[r] = 1.f / __shfl(l_run, (4 * gq + r) & 7);
        if (gq < 2) {
#pragma unroll
            for (int nt = 0; nt < 8; ++nt)
#pragma unroll
                for (int r = 0; r < 4; ++r) ctxb[(size_t)rowq * 1024 + (4 * gq + r) * 128 + 16 * nt + c16] = (h16)(ctx[nt][r] * li[r]);
        }
    }
    asm volatile("s_waitcnt vmcnt(0)" ::: "memory");
    }
#undef DSA_ISSUE
    WAVE_FENCE();
    TSEC_END(4);
}

__device__ __forceinline__ void phase3(const Params& P, int l, unsigned char* lds) {
    const int tid = opaque_tid(), lane = tid & 63, w = tid >> 6;
    float* biasd = (float*)(lds + 4 * WL_BYTES);
    __syncthreads();
    for (int i = tid; i < 1024; i += NTHREADS) biasd[i] = P.rel[(int)c_bucket[i >> 3] * 8 + (i & 7)];
    __syncthreads();
    { TSEC_BEGIN(10)
    for (int rep_ = 0; rep_ <= PROBE_SCAN2; ++rep_) for (int sw = blockIdx.x; sw < 8 * (8 / SNT); sw += gridDim.x) gdn_scan(P, sw, lds);
    TSEC_END(10); }
    __syncthreads();
    unsigned* ctr = (unsigned*)(P.ws + OFF_CTL) + 4608 + l * 128;
    unsigned char* wl = lds + w * WL_BYTES;
    const int x0 = (int)xb_xcc_id() & 7; int d = 0;
    for (;;) {
        int item = -1;
        if (lane == 0) {
            while (d < 8) {
                const int xc = (x0 + d) & 7; const int bb = xc >> 2, sub = xc & 3; const int cnt = (1026 - sub + 3) >> 2;
                const int pf = 230;
                const int t = (int)__hip_atomic_fetch_add(ctr + xc * 16, 1u, __ATOMIC_RELAXED, __HIP_MEMORY_SCOPE_AGENT);
                if (t < pf + 2 * (cnt - pf)) {
                    const int p = t < pf ? t : pf + ((t - pf) >> 1);
                    item = (bb * 1026 + 4 * (cnt - 1 - p) + sub) * 4 + (t < pf ? 0 : 1 + ((t - pf) & 1));
                    break;
                }
                ++d;
            }
        }
        d = __builtin_amdgcn_readfirstlane(d);
        item = __builtin_amdgcn_readfirstlane(item);
        if (item < 0) break;
        { const int hsel = item & 3; dsa_item(P, item >> 2, hsel == 2 ? 4 : 0, hsel == 1 ? 4 : 8, wl, biasd, lane); }
    }
}

__device__ __forceinline__ void phase4(const Params& P, int l, unsigned char* lds) {
    const int tid = opaque_tid(), lane = tid & 63, w = tid >> 6;
    (void)lds;
    if (l == 0 && (int)gridDim.x > 160 && (int)blockIdx.x >= 129) { prep_tiles(P, lds, 1, 129, (int)gridDim.x - 129); return; }
    TSEC_BEGIN(11)
    for (int it = blockIdx.x * 4 + w; it < (NT + 31) / 32; it += gridDim.x * 4) p4_item(P, l, it, lane);
    TSEC_END(11);
    if (l == 0 && (int)gridDim.x <= 160) { __syncthreads(); prep_tiles(P, lds, 1, 0, (int)gridDim.x); }
}

__device__ __forceinline__ void phase5(const Params& P, int l, unsigned char* lds) {
    h16* smem = (h16*)lds;
    const h16* W = (const h16*)(P.ws + OFF_WOT) + (size_t)l * 1024 * 1024;
    const h16* A = (const h16*)(P.ws + OFF_OMIX);
    float* sumsq_next = (float*)(P.ws + OFF_SUMSQ) + NTP;
    XcdQueue xq; xq.init((unsigned*)(P.ws + OFF_CTL) + 4352 + l * 128, 32, (int*)(lds + LDS_BYTES - 32));
    int xl, qi;
    while (xq.next(xl, qi)) {
        const int rb = 8 * xl + (qi & 7), tn = qi >> 3;
        EpiResBig ep; ep.layer = l; ep.row0 = rb * 256; ep.n0 = tn * 256; ep.meta = P.meta; ep.x = P.x; ep.metah = (float*)(P.ws + OFF_METAH); ep.out = P.out; ep.h16o = (h16*)(P.ws + OFF_H16); ep.sumsq_next = sumsq_next; ep.ss = 0.f; ep.nseg = 4;
        gemm_big(A + (size_t)rb * 256 * 1024, 1024, W + (size_t)tn * 256 * 1024, 1024, 1024, ep, smem);
    }
    __syncthreads();
    const int tid = opaque_tid();
    for (int it = blockIdx.x; it < 32; it += gridDim.x) {
        EpiResBig ep; ep.layer = l; ep.row0 = 16384; ep.n0 = it * 32; ep.meta = P.meta; ep.x = P.x; ep.metah = (float*)(P.ws + OFF_METAH); ep.out = P.out; ep.h16o = (h16*)(P.ws + OFF_H16); ep.sumsq_next = sumsq_next; ep.ss = 0.f; ep.nseg = 1;
        skinny_tile(A + (size_t)16384 * 1024, 1024, W + (size_t)it * 32 * 1024, 1024, 1024, ep, (float*)lds, tid);
    }
}

__global__ void __launch_bounds__(NTHREADS) hybrid_fwd(Params P) {
    extern __shared__ __attribute__((aligned(16))) unsigned char lds[];
    cg::grid_group grid = cg::this_grid();
    volatile LAS unsigned* bst = (volatile LAS unsigned*)(lds + LDS_BYTES - 16);
    if (threadIdx.x < 4) bst[threadIdx.x] = 0u;
    if (PROBE_TSEC && (threadIdx.x & 63) == 0) *tsec_slot() = 0ull;
    __syncthreads();
    XcdBarrier xbar = xcd_barrier_post((unsigned*)(P.ws + OFF_CTL) + 256, bst);
    if (PROBE_MFMA) {
        f32x16 pa[8]; h16x8 fa, fb;
#pragma unroll
        for (int e = 0; e < 8; ++e) { fa[e] = (h16)(0.001f * (threadIdx.x & 7)); fb[e] = (h16)0.5f; }
#pragma unroll
        for (int i = 0; i < 8; ++i)
#pragma unroll
            for (int r = 0; r < 16; ++r) pa[i][r] = 0.f;
        h16* lp = (h16*)lds + (threadIdx.x & 31) * 72 + 8 * ((threadIdx.x >> 5) & 1) + (threadIdx.x >> 6) * 2304;
#pragma unroll 1
        for (int it = 0; it < 256; ++it) {
            if (PROBE_MFMA == 2) {
                h16x8 t[8];
#pragma unroll
                for (int q = 0; q < 8; ++q) t[q] = *(const h16x8*)(lp + q * 32 * 72 + (it & 3) * 16);
#pragma unroll
                for (int q = 0; q < 4; ++q) *(h16x8*)(lp + 40000 + q * 32 * 72) = fb;
#pragma unroll
                for (int i = 0; i < 16; ++i) pa[i & 7] = MFMA32(t[i & 7], fb, pa[i & 7]);
#pragma unroll
                for (int q = 0; q < 12; ++q) { __builtin_amdgcn_sched_group_barrier(0x8, 1, 0); __builtin_amdgcn_sched_group_barrier(0x300, 1, 0); }
                __builtin_amdgcn_sched_group_barrier(0x8, 4, 0);
                __builtin_amdgcn_sched_barrier(0);
            } else {
#pragma unroll
                for (int i = 0; i < 16; ++i) pa[i & 7] = MFMA32(fa, fb, pa[i & 7]);
            }
        }
        float sacc = 0.f;
#pragma unroll
        for (int i = 0; i < 8; ++i) sacc += pa[i][0];
        if (sacc == 12345.678f) ((float*)(P.ws + OFF_CTL))[40] = sacc;
    }
    for (int ph = P.ph_lo; ph < P.ph_hi; ++ph) {
#ifndef ONLY
#define ONLY -1
#endif
        if (ph == 0) { TSEC_BEGIN(13) if (ONLY < 0 || ((ONLY >> 0) & 1)) for (int rep_ = 0; rep_ <= PROBE_P0X; ++rep_) phase_prep(P, lds); TSEC_END(13); }
        else {
            const int l = (ph - 1) / 5, s = (ph - 1) % 5;
            if (s == 0) { if (ONLY < 0 || ((ONLY >> 1) & 1)) for (int rep_ = 0; rep_ <= PROBE_P1X; ++rep_) phase_inproj(P, l, lds, rep_); }
            else if (s == 1) { if (ONLY < 0 || ((ONLY >> 2) & 1)) phase2(P, l, lds); }
            else if (s == 2) { if (ONLY < 0 || ((ONLY >> 3) & 1)) phase3(P, l, lds); }
            else if (s == 3) { if (ONLY < 0 || ((ONLY >> 4) & 1)) for (int rep_ = 0; rep_ <= PROBE_P4X; ++rep_) phase4(P, l, lds); }
            else { if (ONLY < 0 || ((ONLY >> 5) & 1)) for (int rep_ = 0; rep_ <= (l == 0 ? PROBE_P5L0X : 0); ++rep_) phase5(P, l, lds); }
        }
        if (ph + 1 < P.ph_hi) {
            if (P.ph_hi > 1000) grid.sync();
            { TSEC_BEGIN(20) if (PROBE_TSEC >= 20 && PROBE_TSEC - 20 == ph) t__20 = wall_clock64(); xcd_barrier(xbar); if (PROBE_TSEC >= 20 && PROBE_TSEC - 20 == ph) { const unsigned long long d__ = wall_clock64() - t__20; if ((threadIdx.x & 63) == 0) *tsec_slot() += d__; } }
            if (PROBE_SYNC) xcd_barrier(xbar);
        }
    }
    if (PROBE_TSEC) {
        unsigned long long* acc = (unsigned long long*)((unsigned*)(P.ws + OFF_CTL) + 32);
        __syncthreads();
        if ((threadIdx.x & 63) == 0) atomicAdd(acc, *tsec_slot());
        xcd_barrier(xbar);
        if (blockIdx.x == 0 && threadIdx.x == 0) {
            const unsigned long long tot = __hip_atomic_load(acc, __ATOMIC_RELAXED, __HIP_MEMORY_SCOPE_AGENT);
            const unsigned long long avg = tot / (gridDim.x * 4);
            const unsigned long long t0 = wall_clock64();
            while (wall_clock64() - t0 < avg) __builtin_amdgcn_s_sleep(4);
        }
    }
}

extern "C" void kernel_launch(void* const* d_in, const int* in_sizes, int n_in, void* d_out, int out_size, void* d_ws, size_t ws_size, hipStream_t stream) {
    static int grid_blocks = 0;
    if (grid_blocks == 0) {
        if (n_in != 17 || ws_size < WS_END) { fprintf(stderr, "kernel_launch: unexpected inputs (n_in %d, ws %zu < %zu)\n", n_in, ws_size, (size_t)WS_END); grid_blocks = -1; return; }
        int dev = 0, cus = 0, per_cu = 0;
        hipGetDevice(&dev);
        hipDeviceGetAttribute(&cus, hipDeviceAttributeMultiprocessorCount, dev);
        if (hipFuncSetAttribute((const void*)hybrid_fwd, hipFuncAttributeMaxDynamicSharedMemorySize, LDS_BYTES) != hipSuccess) { fprintf(stderr, "kernel_launch: hipFuncSetAttribute failed\n"); grid_blocks = -1; return; }
        hipOccupancyMaxActiveBlocksPerMultiprocessor(&per_cu, (const void*)hybrid_fwd, NTHREADS, LDS_BYTES);
        if (per_cu < 1) { fprintf(stderr, "kernel_launch: occupancy query says 0 blocks per CU\n"); grid_blocks = -1; return; }
        grid_blocks = cus * per_cu;
    }
    if (grid_blocks < 0) return;
    hipMemsetAsync((char*)d_ws + OFF_CTL, 0, 32768, stream);
    hipMemsetAsync((char*)d_ws + OFF_SUMSQ, 0, (size_t)2 * NTP * 4, stream);
    Params p{};
    p.x = (const float*)d_in[0]; p.meta = (const float*)d_in[1]; p.rel = (const float*)d_in[2]; p.norm_gain = (const float*)d_in[3];
    p.w_in = (const float*)d_in[4]; p.g_cq = (const float*)d_in[5]; p.g_ckv = (const float*)d_in[6]; p.w_uq = (const float*)d_in[7];
    p.w_ukv = (const float*)d_in[8]; p.w_qidx = (const float*)d_in[9]; p.g_qn = (const float*)d_in[10]; p.g_kn = (const float*)d_in[11];
    p.conv_w = (const float*)d_in[12]; p.a_log = (const float*)d_in[13]; p.dt_bias = (const float*)d_in[14]; p.g_out = (const float*)d_in[15];
    p.w_out = (const float*)d_in[16];
    p.out = (float*)d_out; p.ws = (unsigned char*)d_ws;
#if N_LAUNCH_MODE == 1
    p.ph_lo = 0; p.ph_hi = NPHASE;
    void* args[] = {&p};
    hipError_t e = hipLaunchCooperativeKernel((const void*)hybrid_fwd, dim3(grid_blocks), dim3(NTHREADS), args, LDS_BYTES, stream);
    if (e != hipSuccess) fprintf(stderr, "cooperative launch failed: %s (grid %d)\n", hipGetErrorString(e), grid_blocks);
#else
    for (int ph = 0; ph < NPHASE; ++ph) {
        p.ph_lo = ph; p.ph_hi = ph + 1;
        hipLaunchKernelGGL(hybrid_fwd, dim3(grid_blocks), dim3(NTHREADS), LDS_BYTES, stream, p);
    }
#endif
}
```

```cpp
#include <hip/hip_runtime.h>
#include <hip/hip_cooperative_groups.h>
#include <stdio.h>
#include <stdint.h>
namespace cg = cooperative_groups;

#define PROBE_TOPK2 0
#define PROBE_ATT2 0
#define PROBE_P1X 0
#define PROBE_P2X 0
#define PROBE_SCAN2 0
#define PROBE_P4X 0
#define PROBE_P0X 0
#define PROBE_P5L0X 0
#define PROBE_SYNC 0
#define PROBE_SWEEP 0
#define PROBE_P2C 0
#define PROBE_CHAIN 0
#define PROBE_MFMA 0
#define PROBE_TSEC 0
#define PROBE_S1 0
#define PROBE_S3 0
#define PROBE_S5 0
#ifndef N_LAUNCH_MODE
#define N_LAUNCH_MODE 1
#endif

typedef _Float16 h16;
typedef h16 h16x8 __attribute__((ext_vector_type(8)));
typedef h16 h16x4 __attribute__((ext_vector_type(4)));
typedef float f32x4 __attribute__((ext_vector_type(4)));
typedef float f32x16 __attribute__((ext_vector_type(16)));
typedef unsigned long long u64;
typedef __fp16 fp16x4 __attribute__((__vector_size__(4 * sizeof(__fp16))));

#define MFMA32(a, b, c) __builtin_amdgcn_mfma_f32_32x32x16_f16(a, b, c, 0, 0, 0)
#define MFMA16(a, b, c) __builtin_amdgcn_mfma_f32_16x16x32_f16(a, b, c, 0, 0, 0)
#define WAVE_FENCE() do { __builtin_amdgcn_fence(__ATOMIC_SEQ_CST, "wavefront"); __builtin_amdgcn_wave_barrier(); } while (0)

constexpr int T_ = 8208;
constexpr int NT = 16416;
constexpr int NTP = 16512;
constexpr int NRB = 129;
constexpr int NCH = 129;
constexpr int NGI = 8 * NCH;
constexpr int NKT = 257;
constexpr float EPS = 1e-6f;
constexpr int NTHREADS = 256;
constexpr int LDS_BYTES = 163840;
constexpr int NPHASE = 11;

constexpr size_t OFF_CTL = 0;
constexpr size_t OFF_W1T = 32768;
constexpr size_t OFF_WOT = OFF_W1T + (size_t)2 * 3072 * 1024 * 2;
constexpr size_t OFF_WQ2T = OFF_WOT + (size_t)2 * 1024 * 1024 * 2;
constexpr size_t OFF_WUKT = OFF_WQ2T + (size_t)2 * 768 * 256 * 2;
constexpr size_t OFF_WKABS = OFF_WUKT + (size_t)2 * 512 * 128 * 2;
constexpr size_t OFF_WUVT = OFF_WKABS + (size_t)2 * 8 * 128 * 64 * 2;
constexpr size_t OFF_SMALL = OFF_WUVT + (size_t)2 * 8 * 64 * 128 * 2;
constexpr size_t OFF_SZA = OFF_SMALL + (size_t)NTP * 16 * 4;
constexpr size_t OFF_SZG = OFF_SZA + (size_t)NTP * 512 * 2;
constexpr size_t OFF_PROJG = OFF_SZG + (size_t)NTP * 512 * 2;
constexpr size_t OFF_PROJA = OFF_PROJG + (size_t)NTP * 1536 * 2;
constexpr size_t OFF_QIDX = OFF_PROJA + (size_t)NTP * 512 * 2;
constexpr size_t OFF_QN = OFF_QIDX + (size_t)NTP * 256 * 2;
constexpr size_t OFF_QK = OFF_QN + (size_t)NTP * 512 * 2;
constexpr size_t OFF_KVROW = OFF_QK + (size_t)NTP * 1024 * 2;
constexpr size_t OFF_KFRAG = OFF_KVROW + (size_t)NTP * 136 * 2;
constexpr size_t OFF_U = OFF_KFRAG + (size_t)2 * NKT * 2048 * 2;
constexpr size_t OFF_WM = OFF_U + (size_t)NGI * 8192 * 2;
constexpr size_t OFF_QD = OFF_WM + (size_t)NGI * 8192 * 2;
constexpr size_t OFF_KDT = OFF_QD + (size_t)NGI * 8192 * 2;
constexpr size_t OFF_AQK = OFF_KDT + (size_t)NGI * 8192 * 2;
constexpr size_t OFF_CDEC = OFF_AQK + (size_t)NGI * 4096 * 2;
constexpr size_t OFF_METAH = OFF_CDEC + 8192;
constexpr size_t OFF_SUMSQ = OFF_METAH + (size_t)2 * 16 * 1024 * 4;
constexpr size_t WS_END = OFF_SUMSQ + (size_t)2 * NTP * 4;
constexpr size_t OFF_H16 = OFF_QK;
constexpr size_t OFF_CTX = OFF_PROJG;
constexpr size_t OFF_OMIX = OFF_PROJG + (size_t)NTP * 1024 * 2;

struct Params {
    const float* x; const float* meta; const float* rel; const float* norm_gain; const float* w_in;
    const float* g_cq; const float* g_ckv; const float* w_uq; const float* w_ukv; const float* w_qidx;
    const float* g_qn; const float* g_kn; const float* conv_w; const float* a_log; const float* dt_bias;
    const float* g_out; const float* w_out;
    float* out; unsigned char* ws;
    int ph_lo, ph_hi;
};

__constant__ unsigned char c_bucket[128] = {
    0, 1, 2, 3, 4, 5, 6, 7, 8, 9, 10, 11, 12, 13, 14, 15, 16, 16, 16, 17, 17, 18, 18, 18, 19, 19, 19, 20, 20, 20, 20, 21,
    21, 21, 21, 22, 22, 22, 22, 22, 23, 23, 23, 23, 23, 23, 24, 24, 24, 24, 24, 24, 25, 25, 25, 25, 25, 25, 25, 26, 26, 26, 26, 26,
    26, 26, 26, 27, 27, 27, 27, 27, 27, 27, 27, 27, 27, 28, 28, 28, 28, 28, 28, 28, 28, 28, 28, 29, 29, 29, 29, 29, 29, 29, 29, 29,
    29, 29, 29, 30, 30, 30, 30, 30, 30, 30, 30, 30, 30, 30, 30, 30, 30, 31, 31, 31, 31, 31, 31, 31, 31, 31, 31, 31, 31, 31, 31, 31};

__device__ __forceinline__ unsigned long long* tsec_slot() { extern __shared__ __attribute__((aligned(16))) unsigned char tsec_lds__[]; return (unsigned long long*)(tsec_lds__ + LDS_BYTES - 128) + (threadIdx.x >> 6); }
#define TSEC_BEGIN(id) unsigned long long t__##id = 0; if (PROBE_TSEC == (id)) t__##id = wall_clock64();
#define TSEC_END(id) do { if (PROBE_TSEC == (id)) { const unsigned long long d__ = wall_clock64() - t__##id; if ((threadIdx.x & 63) == 0) *tsec_slot() += d__; } } while (0)
__device__ __forceinline__ float silu_f(float x) { return x * __builtin_amdgcn_rcpf(1.f + __expf(-x)); }
__device__ __forceinline__ int lanes_below(u64 m) { return __builtin_amdgcn_mbcnt_hi((unsigned)(m >> 32), __builtin_amdgcn_mbcnt_lo((unsigned)m, 0)); }
__device__ __forceinline__ int lanes_below_from(u64 m, int base) { return __builtin_amdgcn_mbcnt_hi((unsigned)(m >> 32), __builtin_amdgcn_mbcnt_lo((unsigned)m, base)); }
__device__ __forceinline__ float relu1(float x) { const int i = __float_as_int(x); return __int_as_float(i > 0 ? i : 0); }
__device__ __forceinline__ unsigned ordkey(float f) { unsigned u = __float_as_uint(f); return (u & 0x80000000u) ? ~u : (u | 0x80000000u); }
__device__ __forceinline__ float ordinv(unsigned k) { unsigned u = (k & 0x80000000u) ? (k & 0x7fffffffu) : ~k; return __uint_as_float(u); }
__device__ __forceinline__ int opaque_tid() { int t = threadIdx.x; asm volatile("" : "+v"(t)); return t; }
__device__ __forceinline__ void lds_barrier() { asm volatile("s_waitcnt lgkmcnt(0)\n\ts_barrier" ::: "memory"); }

#define XB_TMO      128
#define XB_XCNT(j)  (256  + 64 * (j))
#define XB_XSUB(j)  (1280 + 64 * (j))
#define XB_XGEN(j)  (2304 + 64 * (j))
#define XB_TOP      3328
#define XB_TOPGEN   3392
#define XCD_BAR_WORDS 3456
#define XB_SPIN_CAP (1u << 22)
#define LAS __attribute__((address_space(3)))
__device__ __forceinline__ unsigned xb_ld(unsigned* p)              { return __hip_atomic_load(p, __ATOMIC_RELAXED, __HIP_MEMORY_SCOPE_AGENT); }
__device__ __forceinline__ unsigned xb_add(unsigned* p, unsigned v) { return __hip_atomic_fetch_add(p, v, __ATOMIC_RELAXED, __HIP_MEMORY_SCOPE_AGENT); }
__device__ __forceinline__ unsigned xb_xcc_id() { return (unsigned)__builtin_amdgcn_s_getreg((3 << 11) | 20) & 0xFu; }
#define XB_SPIN(cond, bar) do { unsigned _sp = 0; while (cond) { __builtin_amdgcn_s_sleep(1); \
    if ((++_sp & 255u) == 0u) { if (xb_ld(&(bar)[XB_TMO])) break; if (_sp > XB_SPIN_CAP) { atomicAdd(&(bar)[XB_TMO], 1u); break; } } } } while (0)
struct XcdBarrier { unsigned* bar; unsigned x; volatile LAS unsigned* st; };
__device__ __forceinline__ XcdBarrier xcd_barrier_post(unsigned* bar, volatile LAS unsigned* st) {
    XcdBarrier b; b.bar = bar; b.x = xb_xcc_id(); b.st = st;
    if (threadIdx.x == 0) (void)xb_add(&bar[XB_XCNT(b.x)], 1u);
    return b;
}
__device__ __forceinline__ void xcd_barrier_complete(unsigned* bar, unsigned x, unsigned& nloc, unsigned& nx) {
    const unsigned G = gridDim.x * gridDim.y * gridDim.z;
    unsigned sum, cnt, mine, sp = 0u;
    for (;;) {
        sum = 0u; cnt = 0u; mine = 0u;
#pragma unroll
        for (unsigned j = 0; j < 16; ++j) { const unsigned c = xb_ld(&bar[XB_XCNT(j)]); sum += c; cnt += (c > 0u) ? 1u : 0u; mine = (j == x) ? c : mine; }
        if (sum == G) break;
        __builtin_amdgcn_s_sleep(1);
        if ((++sp & 255u) == 0u) { if (xb_ld(&bar[XB_TMO])) break; if (sp > XB_SPIN_CAP) { atomicAdd(&bar[XB_TMO], 1u); break; } }
    }
    nloc = mine > 0u ? mine : 1u; nx = cnt > 0u ? cnt : 1u;
}
__device__ __forceinline__ void xcd_barrier(const XcdBarrier& b) {
    TSEC_BEGIN(5)
    asm volatile("s_waitcnt vmcnt(0)" ::: "memory");
    __syncthreads();
    if (threadIdx.x == 0) {
        unsigned* bar = b.bar;
        __builtin_amdgcn_s_waitcnt(0);
        unsigned nloc = b.st[0], nx = b.st[1];
        if (nloc == 0u) { xcd_barrier_complete(bar, b.x, nloc, nx); b.st[0] = nloc; b.st[1] = nx; }
        const unsigned old = xb_add(&bar[XB_XSUB(b.x)], 1u);
        const unsigned gen = old / nloc;
        if (old + 1u == (gen + 1u) * nloc) {
            __builtin_amdgcn_fence(__ATOMIC_RELEASE, "agent");
            asm volatile("s_waitcnt vmcnt(0)" ::: "memory");
            const unsigned og = xb_add(&bar[XB_TOP], 1u);
            const unsigned tg = og / nx;
            if (og + 1u == (tg + 1u) * nx) xb_add(&bar[XB_TOPGEN], 1u);
            else XB_SPIN(xb_ld(&bar[XB_TOPGEN]) == tg, bar);
            __builtin_amdgcn_fence(__ATOMIC_ACQUIRE, "agent");
            xb_add(&bar[XB_XGEN(b.x)], 1u);
            asm volatile("s_waitcnt vmcnt(0)" ::: "memory");
        } else {
            XB_SPIN(xb_ld(&bar[XB_XGEN(b.x)]) == gen, bar);
            __builtin_amdgcn_fence(__ATOMIC_ACQUIRE, "agent");
            asm volatile("s_waitcnt vmcnt(0)" ::: "memory");
        }
    }
    __syncthreads();
    TSEC_END(5);
}

struct XcdQueue {
    unsigned* ctr; int n_per; int x0; int d; int* slot;
    __device__ __forceinline__ void init(unsigned* c, int np, int* s) { ctr = c; n_per = np; x0 = (int)xb_xcc_id() & 7; d = 0; slot = s; }
    __device__ __forceinline__ bool next(int& xl, int& q) {
        __syncthreads();
        if (threadIdx.x == 0) {
            int res = -1;
            while (d < 8) {
                const int xc = (x0 + d) & 7;
                const unsigned t = __hip_atomic_fetch_add(ctr + xc * 16, 1u, __ATOMIC_RELAXED, __HIP_MEMORY_SCOPE_AGENT);
                if ((int)t < n_per) { res = xc * 65536 + (int)t; break; }
                ++d;
            }
            *slot = res;
        }
        __syncthreads();
        const int r = *slot;
        if (r < 0) return false;
        xl = r >> 16; q = r & 65535;
        return true;
    }
};

constexpr int GS = 72;

struct AF16 {
    const h16* p; int ld;
    __device__ __forceinline__ void init(int) {}
    __device__ __forceinline__ h16x8 load(int i, int row, int k) { return *(const h16x8*)(p + (size_t)row * ld + k); }
};

struct AH32 {
    const float* meta; const float* xs; int meta_bstride;
    const float* rp[4]; float ss[4];
    __device__ __forceinline__ const float* rowptr(int row) const {
        row = row < NT ? row : NT - 1;
        int b = row >= T_ ? 1 : 0; int t = row - b * T_;
        return t < 16 ? meta + (size_t)b * meta_bstride + (size_t)t * 1024 : xs + ((size_t)b * 8192 + (t - 16)) * 1024;
    }
    __device__ __forceinline__ h16x8 load(int i, int, int k) {
        const float4 v0 = *(const float4*)(rp[i] + k), v1 = *(const float4*)(rp[i] + k + 4);
        ss[i] += v0.x * v0.x + v0.y * v0.y + v0.z * v0.z + v0.w * v0.w + v1.x * v1.x + v1.y * v1.y + v1.z * v1.z + v1.w * v1.w;
        h16x8 r; r[0] = (h16)v0.x; r[1] = (h16)v0.y; r[2] = (h16)v0.z; r[3] = (h16)v0.w; r[4] = (h16)v1.x; r[5] = (h16)v1.y; r[6] = (h16)v1.z; r[7] = (h16)v1.w;
        return r;
    }
};

template <int BN, class AL, class EP>
__device__ __forceinline__ void gemm_tile(AL& al, int arow0, const h16* __restrict__ Bt, int ldb, int K, EP& ep, h16* smem) {
    const int tid = opaque_tid(), lane = tid & 63, w = tid >> 6, wm = w >> 1, wn = w & 1;
    constexpr int NTL = BN / 64;
    constexpr int NBG = BN / 32;
    constexpr int BUF = (128 + BN) * GS;
    f32x16 acc[2][NTL];
#pragma unroll
    for (int i = 0; i < 2; ++i)
#pragma unroll
        for (int j = 0; j < NTL; ++j)
#pragma unroll
            for (int r = 0; r < 16; ++r) acc[i][j][r] = 0.f;
    h16x8 ra[4], rb[NBG];
    const int nk = K >> 6;
#pragma unroll
    for (int i = 0; i < 4; ++i) { int g = tid + 256 * i; ra[i] = al.load(i, arow0 + (g >> 3), (g & 7) * 8); }
#pragma unroll
    for (int i = 0; i < NBG; ++i) { int g = tid + 256 * i; rb[i] = *(const h16x8*)(Bt + (size_t)(g >> 3) * ldb + (g & 7) * 8); }
    __syncthreads();
#pragma unroll
    for (int i = 0; i < 4; ++i) { int g = tid + 256 * i; *(h16x8*)(smem + (g >> 3) * GS + (g & 7) * 8) = ra[i]; }
#pragma unroll
    for (int i = 0; i < NBG; ++i) { int g = tid + 256 * i; *(h16x8*)(smem + 128 * GS + (g >> 3) * GS + (g & 7) * 8) = rb[i]; }
    __syncthreads();
    for (int kt = 0; kt < nk; ++kt) {
        const int cur = kt & 1;
        const h16* sA = smem + cur * BUF;
        const h16* sB = sA + 128 * GS;
        if (kt + 1 < nk) {
            const int k0 = (kt + 1) << 6;
#pragma unroll
            for (int i = 0; i < 4; ++i) { int g = tid + 256 * i; ra[i] = al.load(i, arow0 + (g >> 3), k0 + (g & 7) * 8); }
#pragma unroll
            for (int i = 0; i < NBG; ++i) { int g = tid + 256 * i; rb[i] = *(const h16x8*)(Bt + (size_t)(g >> 3) * ldb + k0 + (g & 7) * 8); }
        }
#pragma unroll
        for (int ks = 0; ks < 4; ++ks) {
            h16x8 af[2], bf[NTL];
#pragma unroll
            for (int mt = 0; mt < 2; ++mt) af[mt] = *(const h16x8*)(sA + (64 * wm + 32 * mt + (lane & 31)) * GS + 16 * ks + 8 * (lane >> 5));
#pragma unroll
            for (int nt = 0; nt < NTL; ++nt) bf[nt] = *(const h16x8*)(sB + ((BN / 2) * wn + 32 * nt + (lane & 31)) * GS + 16 * ks + 8 * (lane >> 5));
#pragma unroll
            for (int mt = 0; mt < 2; ++mt)
#pragma unroll
                for (int nt = 0; nt < NTL; ++nt) acc[mt][nt] = MFMA32(af[mt], bf[nt], acc[mt][nt]);
        }
        if (kt + 1 < nk) {
            h16* dA = smem + (cur ^ 1) * BUF;
            h16* dB = dA + 128 * GS;
#pragma unroll
            for (int i = 0; i < 4; ++i) { int g = tid + 256 * i; *(h16x8*)(dA + (g >> 3) * GS + (g & 7) * 8) = ra[i]; }
#pragma unroll
            for (int i = 0; i < NBG; ++i) { int g = tid + 256 * i; *(h16x8*)(dB + (g >> 3) * GS + (g & 7) * 8) = rb[i]; }
        }
        __syncthreads();
    }
    ep.pre(al);
    float* ft = (float*)smem;
#pragma unroll
    for (int mt = 0; mt < 2; ++mt)
#pragma unroll
        for (int nt = 0; nt < NTL; ++nt)
#pragma unroll
            for (int r = 0; r < 16; ++r) {
                const int rl = 64 * wm + 32 * mt + (r & 3) + 8 * (r >> 2) + 4 * (lane >> 5);
                const int cl = (BN / 2) * wn + 32 * nt + (lane & 31);
                ft[rl * (BN + 1) + cl] = acc[mt][nt][r];
            }
    __syncthreads();
    if (EP::kSweep) {
#pragma unroll 4
        for (int idx = tid; idx < 128 * BN; idx += NTHREADS) {
            const int rl = idx / BN, cl = idx % BN;
            float q = ep(rl, cl, ft[rl * (BN + 1) + cl]);
            if (EP::kRowSum) {
#pragma unroll
                for (int d = 1; d < 64; d <<= 1) q += __shfl_xor(q, d);
                if (lane == 0) ep.rowsum(rl, q);
            }
        }
    }
}

constexpr int GS2 = 72;
template <class EP>
__device__ __forceinline__ void gemm_big(const h16* __restrict__ A, int lda, const h16* __restrict__ Bt, int ldb, int K, EP& ep, h16* smem) {
    const int tid = opaque_tid(), lane = tid & 63, w = tid >> 6, wm = w >> 1, wn = w & 1;
    constexpr int BUF = 512 * GS2;
    f32x16 acc[4][4];
    float zero_ = 0.f; asm volatile("" : "+v"(zero_));
#pragma unroll
    for (int i = 0; i < 4; ++i)
#pragma unroll
        for (int j = 0; j < 4; ++j)
#pragma unroll
            for (int r = 0; r < 16; ++r) acc[i][j][r] = zero_;
    h16x8 ra[2][8], rb[2][8];
    const int nk = K >> 6;
    const h16* ap = A + (size_t)(tid >> 3) * lda + (tid & 7) * 8;
    const h16* bp = Bt + (size_t)(tid >> 3) * ldb + (tid & 7) * 8;
    const int soff = (tid >> 3) * GS2 + (tid & 7) * 8;
#pragma unroll
    for (int i = 0; i < 8; ++i) { ra[0][i] = *(const h16x8*)(ap + (size_t)(32 * i) * lda); rb[0][i] = *(const h16x8*)(bp + (size_t)(32 * i) * ldb); }
#pragma unroll
    for (int i = 0; i < 8; ++i) { ra[1][i] = *(const h16x8*)(ap + (size_t)(32 * i) * lda + 64); rb[1][i] = *(const h16x8*)(bp + (size_t)(32 * i) * ldb + 64); }
    __syncthreads();
#pragma unroll
    for (int i = 0; i < 8; ++i) { *(h16x8*)(smem + soff + 32 * i * GS2) = ra[0][i]; *(h16x8*)(smem + 256 * GS2 + soff + 32 * i * GS2) = rb[0][i]; }
    __syncthreads();
#define BIG_STEP(CUR, KT) do { \
        const h16* sA = smem + (CUR) * BUF + (128 * wm + (lane & 31)) * GS2 + 8 * (lane >> 5); \
        const h16* sB = smem + (CUR) * BUF + 256 * GS2 + (128 * wn + (lane & 31)) * GS2 + 8 * (lane >> 5); \
        h16* dW = smem + ((CUR) ^ 1) * BUF;     \
        int k0 = ((KT) + 2) << 6; k0 = k0 < K ? k0 : K - 64; \
        h16x8 af[2][4], bf[2][4]; \
        _Pragma("unroll") for (int t = 0; t < 4; ++t) { af[0][t] = *(const h16x8*)(sA + 32 * t * GS2); bf[0][t] = *(const h16x8*)(sB + 32 * t * GS2); } \
        __builtin_amdgcn_sched_barrier(0); \
        _Pragma("unroll") for (int ks = 0; ks < 4; ++ks) { \
            if (ks < 3) { _Pragma("unroll") for (int t = 0; t < 4; ++t) { af[(ks + 1) & 1][t] = *(const h16x8*)(sA + 32 * t * GS2 + 16 * (ks + 1)); bf[(ks + 1) & 1][t] = *(const h16x8*)(sB + 32 * t * GS2 + 16 * (ks + 1)); } } \
            _Pragma("unroll") for (int i = 2 * ks; i < 2 * ks + 2; ++i) { *(h16x8*)(dW + soff + 32 * i * GS2) = ra[(CUR) ^ 1][i]; *(h16x8*)(dW + 256 * GS2 + soff + 32 * i * GS2) = rb[(CUR) ^ 1][i]; } \
            _Pragma("unroll") for (int i = 2 * ks; i < 2 * ks + 2; ++i) { ra[CUR][i] = *(const h16x8*)(ap + (size_t)(32 * i) * lda + k0); rb[CUR][i] = *(const h16x8*)(bp + (size_t)(32 * i) * ldb + k0); } \
            _Pragma("unroll") for (int mt = 0; mt < 4; ++mt) _Pragma("unroll") for (int nt = 0; nt < 4; ++nt) acc[mt][nt] = MFMA32(af[ks & 1][mt], bf[ks & 1][nt], acc[mt][nt]); \
              \
            _Pragma("unroll") for (int q = 0; q < 4; ++q) { \
                __builtin_amdgcn_sched_group_barrier(0x8, 1, 0); __builtin_amdgcn_sched_group_barrier(0x100, 1, 0); \
                __builtin_amdgcn_sched_group_barrier(0x8, 1, 0); __builtin_amdgcn_sched_group_barrier(0x100, 1, 0); \
                __builtin_amdgcn_sched_group_barrier(0x8, 1, 0); __builtin_amdgcn_sched_group_barrier(0x200, 1, 0); \
                __builtin_amdgcn_sched_group_barrier(0x8, 1, 0); __builtin_amdgcn_sched_group_barrier(0x20, 1, 0); } \
            __builtin_amdgcn_sched_barrier(0); } \
        __syncthreads(); } while (0)
    TSEC_BEGIN(8)
    for (int kt = 0; kt < nk; kt += 2) { BIG_STEP(0, kt); BIG_STEP(1, kt + 1); }
    TSEC_END(8);
    TSEC_BEGIN(9)
#undef BIG_STEP
    float* st = (float*)smem + w * 1152;
    const int prow = lane >> 1, pc0 = (lane & 1) * 16;
    ep.template prefetch<0>(128 * wm + prow, 128 * wn + pc0);
#pragma unroll
    for (int mt = 0; mt < 4; ++mt) {
        if (mt == 0) ep.template prefetch<1>(128 * wm + 32 + prow, 128 * wn + pc0);
        if (mt == 1) ep.template prefetch<0>(128 * wm + 64 + prow, 128 * wn + pc0);
        if (mt == 2) ep.template prefetch<1>(128 * wm + 96 + prow, 128 * wn + pc0);
        ep.row_begin();
#pragma unroll
        for (int nt = 0; nt < 4; ++nt) {
#pragma unroll
            for (int r = 0; r < 16; ++r) st[((r & 3) + 8 * (r >> 2) + 4 * (lane >> 5)) * 36 + (lane & 31)] = acc[mt][nt][r];
            WAVE_FENCE();
            float v[16];
#pragma unroll
            for (int q = 0; q < 4; ++q) { const float4 t4 = *(const float4*)(st + prow * 36 + pc0 + 4 * q); v[4 * q] = t4.x; v[4 * q + 1] = t4.y; v[4 * q + 2] = t4.z; v[4 * q + 3] = t4.w; }
            WAVE_FENCE();
            if (mt & 1) ep.template store16<1>(nt, 128 * wm + 32 * mt + prow, 128 * wn + 32 * nt + pc0, v);
            else ep.template store16<0>(nt, 128 * wm + 32 * mt + prow, 128 * wn + 32 * nt + pc0, v);
        }
        ep.row_end(128 * wm + 32 * mt + prow, lane);
    }
    TSEC_END(9);
}

template <class EP>
__device__ __forceinline__ void skinny_tile(const h16* __restrict__ A, int lda, const h16* __restrict__ Bt, int ldb, int K, EP& ep, float* st, int tid) {
    const int lane = tid & 63, w = tid >> 6;
    f32x16 acc;
#pragma unroll
    for (int r = 0; r < 16; ++r) acc[r] = 0.f;
    const int kq = K >> 2;
    const h16* ap = A + (size_t)(lane & 31) * lda + 8 * (lane >> 5) + w * kq;
    const h16* bp = Bt + (size_t)(lane & 31) * ldb + 8 * (lane >> 5) + w * kq;
    if (w == 0) ep.template prefetch<0>(lane >> 1, (lane & 1) * 16);
    for (int k0 = 0; k0 < kq; k0 += 128) {
        h16x8 af[8], bf[8];
#pragma unroll
        for (int u = 0; u < 8; ++u) { af[u] = *(const h16x8*)(ap + k0 + 16 * u); bf[u] = *(const h16x8*)(bp + k0 + 16 * u); }
#pragma unroll
        for (int u = 0; u < 8; ++u) acc = MFMA32(af[u], bf[u], acc);
    }
    __syncthreads();
    float* my = st + w * 1152;
#pragma unroll
    for (int r = 0; r < 16; ++r) my[((r & 3) + 8 * (r >> 2) + 4 * (lane >> 5)) * 36 + (lane & 31)] = acc[r];
    __syncthreads();
    if (w == 0) {
        const int prow = lane >> 1, pc0 = (lane & 1) * 16;
        ep.row_begin();
        float v[16];
#pragma unroll
        for (int q = 0; q < 4; ++q) {
            float4 t4 = *(const float4*)(st + prow * 36 + pc0 + 4 * q);
#pragma unroll
            for (int ww = 1; ww < 4; ++ww) { const float4 u4 = *(const float4*)(st + ww * 1152 + prow * 36 + pc0 + 4 * q); t4.x += u4.x; t4.y += u4.y; t4.z += u4.z; t4.w += u4.w; }
            v[4 * q] = t4.x; v[4 * q + 1] = t4.y; v[4 * q + 2] = t4.z; v[4 * q + 3] = t4.w;
        }
        ep.template store16<0>(0, prow, pc0, v);
        ep.row_end(prow, lane);
    }
}

struct EpiInProj {
    static constexpr bool kSweep = true; static constexpr bool kRowSum = false;
    int row0, n0; const float* rstd; h16* projA; float* small; h16* sza; h16* szg; h16* projG;
    template <class AL_> __device__ __forceinline__ void pre(AL_&) {}
    __device__ __forceinline__ float operator()(int rl, int cl, float v) const {
        const int row = row0 + rl; const float y = v * rstd[rl]; const int c = n0 + cl;
        if (c < 512) { if (c < 448) projA[(size_t)row * 512 + c] = (h16)y; else if (c < 460) small[(size_t)row * 16 + (c - 448)] = y; }
        else if (c < 1024) sza[(size_t)row * 512 + (c - 512)] = (h16)silu_f(y);
        else if (c < 2560) projG[(size_t)row * 1536 + (c - 1024)] = (h16)y;
        else szg[(size_t)row * 512 + (c - 2560)] = (h16)silu_f(y);
        return 0.f;
    }
    __device__ __forceinline__ void rowsum(int, float) const {}
};
struct EpiIn2 : EpiInProj {
    float* rstd_w; int tid; const float* sumsq;
    template <class AL_> __device__ __forceinline__ void pre(AL_&) {
        if (tid < 128) rstd_w[tid] = rsqrtf(sumsq[row0 + tid] * (1.f / 1024.f) + EPS);
        __syncthreads();
    }
};
struct EpiTileF32 {
    static constexpr bool kSweep = false; static constexpr bool kRowSum = false;
    template <class AL_> __device__ __forceinline__ void pre(AL_&) {}
    __device__ __forceinline__ float operator()(int, int, float) const { return 0.f; }
    __device__ __forceinline__ void rowsum(int, float) const {}
};
struct EpiStoreH {
    static constexpr bool kSweep = true; static constexpr bool kRowSum = false;
    h16* dst; int ld; int row0; const float* rs;
    template <class AL_> __device__ __forceinline__ void pre(AL_&) {}
    __device__ __forceinline__ float operator()(int rl, int cl, float v) const { dst[(size_t)(row0 + rl) * ld + cl] = (h16)(rs ? v * rs[rl] : v); return 0.f; }
    __device__ __forceinline__ void rowsum(int, float) const {}
};
struct EpiGate {
    static constexpr bool kSweep = true; static constexpr bool kRowSum = false;
    h16* dst; const h16* gate; int row0; int c0;
    template <class AL_> __device__ __forceinline__ void pre(AL_&) {}
    __device__ __forceinline__ float operator()(int rl, int cl, float v) const {
        const size_t row = row0 + rl;
        dst[row * 1024 + c0 + cl] = (h16)(v * (float)gate[row * 512 + c0 + cl]);
        return 0.f;
    }
    __device__ __forceinline__ void rowsum(int, float) const {}
};
struct EpiResid {
    static constexpr bool kSweep = true; static constexpr bool kRowSum = true;
    int layer; int row0; int n0; const float* meta; const float* x; float* metah; float* out; h16* h16o; float* sumsq_next;
    template <class AL_> __device__ __forceinline__ void pre(AL_&) {}
    __device__ __forceinline__ float operator()(int rl, int cl, float v) const {
        const int row = row0 + rl; if (row >= NT) return 0.f;
        const int b = row >= T_ ? 1 : 0; const int t = row - b * T_; const int c = n0 + cl;
        if (layer == 0) {
            float hn;
            if (t < 16) { hn = meta[(size_t)t * 1024 + c] + v; metah[((size_t)b * 16 + t) * 1024 + c] = hn; }
            else { const size_t o = ((size_t)b * 8192 + (t - 16)) * 1024 + c; hn = x[o] + v; out[o] = hn; }
            h16o[(size_t)row * 1024 + c] = (h16)hn;
            return hn * hn;
        } else {
            if (t >= 16) { const size_t o = ((size_t)b * 8192 + (t - 16)) * 1024 + c; out[o] = out[o] + v; }
            return 0.f;
        }
    }
    __device__ __forceinline__ void rowsum(int rl, float q) const { if (layer == 0 && row0 + rl < NT) atomicAdd(sumsq_next + row0 + rl, q); }
};

__device__ __forceinline__ void store16h(h16* dst, const float* v) {
    h16x8 a, b;
#pragma unroll
    for (int e = 0; e < 8; ++e) { a[e] = (h16)v[e]; b[e] = (h16)v[8 + e]; }
    *(h16x8*)dst = a; *(h16x8*)(dst + 8) = b;
}
struct EpiInBig {
    int row0, n0; const float* sumsq; h16* projA; float* small; h16* sza; h16* szg; h16* projG;
    float ssq[2];
    __device__ __forceinline__ void row_begin() {}
    __device__ __forceinline__ void row_end(int, int) {}
    template <int B> __device__ __forceinline__ void prefetch(int rl, int) { ssq[B] = sumsq[row0 + rl]; }
    template <int B> __device__ __forceinline__ void store16(int, int rl, int cl, const float* v) const {
        const int row = row0 + rl; const int c = n0 + cl;
        const float rs = rsqrtf(ssq[B] * (1.f / 1024.f) + EPS);
        float y[16];
#pragma unroll
        for (int e = 0; e < 16; ++e) y[e] = v[e] * rs;
        if (c < 512) {
            if (c < 448) store16h(projA + (size_t)row * 512 + c, y);
            else if (c == 448) {
#pragma unroll
                for (int e = 0; e < 12; ++e) small[(size_t)row * 16 + e] = y[e];
            }
        } else if (c < 1024) {
#pragma unroll
            for (int e = 0; e < 16; ++e) y[e] = silu_f(y[e]);
            store16h(sza + (size_t)row * 512 + (c - 512), y);
        } else if (c < 2560) store16h(projG + (size_t)row * 1536 + (c - 1024), y);
        else {
#pragma unroll
            for (int e = 0; e < 16; ++e) y[e] = silu_f(y[e]);
            store16h(szg + (size_t)row * 512 + (c - 2560), y);
        }
    }
};
struct EpiResBig {
    int layer, row0, n0; const float* meta; const float* x; float* metah; float* out; h16* h16o; float* sumsq_next; float ss; int nseg;
    float4 pf[2][4][4];
    __device__ __forceinline__ void row_begin() { ss = 0.f; }
    __device__ __forceinline__ void row_end(int rl, int lane) {
        if (layer == 0) { float q = ss; q += __shfl_xor(q, 1); if ((lane & 1) == 0) atomicAdd(sumsq_next + row0 + rl, q); }
    }
    __device__ __forceinline__ const float* srcp(int row, int c) const {
        const int b = row >= T_ ? 1 : 0; const int t = row - b * T_;
        if (layer == 0) return t < 16 ? meta + (size_t)t * 1024 + c : x + ((size_t)b * 8192 + (t - 16)) * 1024 + c;
        return out + ((size_t)b * 8192 + (t < 16 ? 0 : t - 16)) * 1024 + c;
    }
    template <int B> __device__ __forceinline__ void prefetch(int rl, int cl) {
        const float* src = srcp(row0 + rl, n0 + cl);
#pragma unroll
        for (int nt = 0; nt < 4; ++nt)
            if (nt < nseg) {
#pragma unroll
                for (int q = 0; q < 4; ++q) pf[B][nt][q] = *(const float4*)(src + 32 * nt + 4 * q);
            }
    }
    template <int B> __device__ __forceinline__ void store16(int nt, int rl, int cl, const float* v) {
        const int row = row0 + rl; const int c = n0 + cl;
        const int b = row >= T_ ? 1 : 0; const int t = row - b * T_;
        float* dst;
        if (layer == 0) dst = t < 16 ? metah + ((size_t)b * 16 + t) * 1024 + c : out + ((size_t)b * 8192 + (t - 16)) * 1024 + c;
        else { if (t < 16) return; dst = out + ((size_t)b * 8192 + (t - 16)) * 1024 + c; }
        float hn[16];
#pragma unroll
        for (int q = 0; q < 4; ++q) {
            const float4 hv = pf[B][nt][q];
            float4 o4; o4.x = hv.x + v[4 * q]; o4.y = hv.y + v[4 * q + 1]; o4.z = hv.z + v[4 * q + 2]; o4.w = hv.w + v[4 * q + 3];
            *(float4*)(dst + 4 * q) = o4;
            hn[4 * q] = o4.x; hn[4 * q + 1] = o4.y; hn[4 * q + 2] = o4.z; hn[4 * q + 3] = o4.w;
        }
        if (layer == 0) {
            store16h(h16o + (size_t)row * 1024 + c, hn);
#pragma unroll
            for (int e = 0; e < 16; ++e) ss += hn[e] * hn[e];
        }
    }
};

__device__ __forceinline__ int in_src_col(int n) {
    if (n < 452) return n;
    if (n < 456) return 3012 + (n - 452);
    if (n < 460) return 3016 + (n - 456);
    if (n < 512) return -1;
    if (n < 1024) return 452 + (n - 512);
    if (n < 2560) return 964 + (n - 1024);
    return 2500 + (n - 2560);
}
__device__ __forceinline__ float prep_get(const Params& P, int l, int job, int h, int n, int k) {
    switch (job) {
        case 0: { const int s = in_src_col(n); if (s < 0) return 0.f; return P.norm_gain[l * 1024 + k] * P.w_in[((size_t)l * 1024 + k) * 3020 + s]; }
        case 1: return P.w_out[((size_t)l * 1024 + k) * 1024 + n];
        case 2: return P.g_cq[l * 256 + k] * (n < 512 ? P.w_uq[((size_t)l * 256 + k) * 512 + n] : P.w_qidx[((size_t)l * 256 + k) * 256 + (n - 512)]);
        case 3: return P.g_ckv[l * 128 + k] * P.w_ukv[((size_t)l * 128 + k) * 1024 + n];
        case 4: { const int kk = k >> 4, hf = (k >> 3) & 1, j = k & 7; const int d = 16 * kk + 8 * (j >> 2) + 4 * hf + (j & 3);
                  return P.w_ukv[((size_t)l * 128 + n) * 1024 + h * 64 + d] * P.g_kn[l * 64 + d] * P.g_qn[l * 64 + d] * 0.125f; }
        default: return P.w_ukv[((size_t)l * 128 + k) * 1024 + 512 + h * 64 + n];
    }
}
__device__ __forceinline__ void prep_tiles(const Params& P, unsigned char* lds, int l, int first_wg, int nwg);
__device__ __forceinline__ void phase_prep(const Params& P, unsigned char* lds) {
    float* tile = (float*)lds;
    const int tid = opaque_tid();
    {
        h16* h16o = (h16*)(P.ws + OFF_H16); float* sumsq = (float*)(P.ws + OFF_SUMSQ);
        const int lane = tid & 63, w = tid >> 6;
        for (int row = blockIdx.x * 4 + w; row < NT; row += gridDim.x * 4) {
            const int b = row >= T_ ? 1 : 0; const int t = row - b * T_;
            const float* src = t < 16 ? P.meta + (size_t)t * 1024 : P.x + ((size_t)b * 8192 + (t - 16)) * 1024;
            float ss = 0.f;
#pragma unroll
            for (int q = 0; q < 2; ++q) {
                const float4 a = *(const float4*)(src + q * 512 + lane * 8), c4 = *(const float4*)(src + q * 512 + lane * 8 + 4);
                ss += a.x * a.x + a.y * a.y + a.z * a.z + a.w * a.w + c4.x * c4.x + c4.y * c4.y + c4.z * c4.z + c4.w * c4.w;
                h16x8 o; o[0] = (h16)a.x; o[1] = (h16)a.y; o[2] = (h16)a.z; o[3] = (h16)a.w; o[4] = (h16)c4.x; o[5] = (h16)c4.y; o[6] = (h16)c4.z; o[7] = (h16)c4.w;
                *(h16x8*)(h16o + (size_t)row * 1024 + q * 512 + lane * 8) = o;
            }
#pragma unroll
            for (int d = 1; d < 64; d <<= 1) ss += __shfl_xor(ss, d);
            if (lane == 0) sumsq[row] = ss;
        }
    }
    prep_tiles(P, lds, 0, 0, (int)gridDim.x);
}
__device__ __forceinline__ void prep_tiles(const Params& P, unsigned char* lds, int l, int first_wg, int nwg) {
    float* tile = (float*)lds;
    const int tid = opaque_tid();
    for (int it = (int)blockIdx.x - first_wg; it >= 0 && it < 1120; it += nwg) {
        int r = it;
        int job, h = 0, N, K, tn, tk; h16* dst;
        if (r < 768) { job = 0; N = 3072; K = 1024; tn = r / 16; tk = r % 16; dst = (h16*)(P.ws + OFF_W1T) + (size_t)l * 3072 * 1024; }
        else if ((r -= 768) < 256) { job = 1; N = 1024; K = 1024; tn = r / 16; tk = r % 16; dst = (h16*)(P.ws + OFF_WOT) + (size_t)l * 1024 * 1024; }
        else if ((r -= 256) < 48) { job = 2; N = 768; K = 256; tn = r / 4; tk = r % 4; dst = (h16*)(P.ws + OFF_WQ2T) + (size_t)l * 768 * 256; }
        else if ((r -= 48) < 16) { job = 3; N = 512; K = 128; tn = r / 2; tk = r % 2; dst = (h16*)(P.ws + OFF_WUKT) + (size_t)l * 512 * 128; }
        else if ((r -= 16) < 16) { job = 4; N = 128; K = 64; h = r / 2; tn = r % 2; tk = 0; dst = (h16*)(P.ws + OFF_WKABS) + ((size_t)l * 8 + h) * 128 * 64; }
        else { r -= 16; job = 5; N = 64; K = 128; h = r / 2; tn = 0; tk = r % 2; dst = (h16*)(P.ws + OFF_WUVT) + ((size_t)l * 8 + h) * 64 * 128; }
        (void)N;
        const int n0 = tn * 64, k0 = tk * 64;
        __syncthreads();
#pragma unroll 4
        for (int q = 0; q < 16; ++q) { const int kk = q * 4 + (tid >> 6), nn = tid & 63; tile[kk * 65 + nn] = prep_get(P, l, job, h, n0 + nn, k0 + kk); }
        __syncthreads();
#pragma unroll 4
        for (int q = 0; q < 16; ++q) { const int nn = q * 4 + (tid >> 6), kk = tid & 63; dst[(size_t)(n0 + nn) * K + k0 + kk] = (h16)tile[kk * 65 + nn]; }
    }
}

__device__ __forceinline__ void phase_inproj(const Params& P, int l, unsigned char* lds, int rep_p1 = 0) {
    h16* smem = (h16*)lds;
    float* rstd = (float*)(lds + 73728);
    const int tid = opaque_tid();
    const h16* W = (const h16*)(P.ws + OFF_W1T) + (size_t)l * 3072 * 1024;
    const h16* A = (const h16*)(P.ws + OFF_H16);
    const float* sumsq = (const float*)(P.ws + OFF_SUMSQ) + (size_t)l * NTP;
    XcdQueue xq; xq.init((unsigned*)(P.ws + OFF_CTL) + 4096 + l * 128 + 2048 * rep_p1, 96, (int*)(lds + LDS_BYTES - 32));
    int xl, qi;
    while (xq.next(xl, qi)) {
        const int rb = 8 * xl + (qi & 7), tn = 4 * (qi >> 5) + ((qi >> 3) & 3);
        EpiInBig ep{rb * 256, tn * 256, sumsq, (h16*)(P.ws + OFF_PROJA), (float*)(P.ws + OFF_SMALL), (h16*)(P.ws + OFF_SZA), (h16*)(P.ws + OFF_SZG), (h16*)(P.ws + OFF_PROJG), {0.f, 0.f}};
        gemm_big(A + (size_t)rb * 256 * 1024, 1024, W + (size_t)tn * 256 * 1024, 1024, 1024, ep, smem);
    }
    __syncthreads();
    for (int it = blockIdx.x; it < 96; it += gridDim.x) {
        EpiInBig ep{16384, it * 32, sumsq, (h16*)(P.ws + OFF_PROJA), (float*)(P.ws + OFF_SMALL), (h16*)(P.ws + OFF_SZA), (h16*)(P.ws + OFF_SZG), (h16*)(P.ws + OFF_PROJG), {0.f, 0.f}};
        skinny_tile(A + (size_t)16384 * 1024, 1024, W + (size_t)it * 32 * 1024, 1024, 1024, ep, (float*)lds, tid);
    }
    (void)rstd;
}

__device__ __forceinline__ void p2a_item(const Params& P, int l, int rb, int j, unsigned char* lds) {
    h16* smem = (h16*)lds;
    float* ft = (float*)lds;
    float* rstdq = (float*)(lds + 73728);
    const int tid = opaque_tid(); const int row0 = rb * 128;
    const h16* projA = (const h16*)(P.ws + OFF_PROJA);
    __syncthreads();
    {
        const int row = row0 + (tid >> 1), hf = tid & 1; float s = 0.f;
#pragma unroll 4
        for (int q = 0; q < 16; ++q) { const h16x8 v = *(const h16x8*)(projA + (size_t)row * 512 + hf * 128 + q * 8);
#pragma unroll
            for (int e = 0; e < 8; ++e) { const float f = (float)v[e]; s += f * f; } }
        s += __shfl_xor(s, 1);
        if (hf == 0) rstdq[tid >> 1] = rsqrtf(s * (1.f / 256.f) + EPS);
    }
    __syncthreads();
    const h16* Wq2 = (const h16*)(P.ws + OFF_WQ2T) + (size_t)l * 768 * 256;
    AF16 al{projA, 512};
    if (j >= 4) {
        EpiStoreH ep{(h16*)(P.ws + OFF_QIDX) + (j - 4) * 128, 256, row0, rstdq};
        gemm_tile<128>(al, row0, Wq2 + (size_t)j * 128 * 256, 256, 256, ep, smem);
        return;
    }
    EpiTileF32 ep;
    gemm_tile<128>(al, row0, Wq2 + (size_t)j * 128 * 256, 256, 256, ep, smem);
    __syncthreads();
    h16* qn = (h16*)(P.ws + OFF_QN);
    {
        const int rl = tid >> 1, hh = tid & 1; float s = 0.f;
        const float rq = rstdq[rl];
        for (int d = 0; d < 64; ++d) { const float f = ft[rl * 129 + hh * 64 + d] * rq; s += f * f; }
        const float rs = rsqrtf(s * (1.f / 64.f) + EPS) * rq;
        h16* dst = qn + (size_t)(row0 + rl) * 512 + (2 * j + hh) * 64;
        const float* gq = P.g_qn + l * 64;
        for (int d = 0; d < 64; d += 8) { h16x8 o;
#pragma unroll
            for (int e = 0; e < 8; ++e) o[e] = (h16)(ft[rl * 129 + hh * 64 + d + e] * rs * gq[d + e]);
            *(h16x8*)(dst + d) = o; }
    }
    __threadfence_block();
    __syncthreads();
    for (int hh = 0; hh < 2; ++hh) {
        const int head = 2 * j + hh;
        AF16 al2{qn + head * 64, 512};
        EpiStoreH ep2{(h16*)(P.ws + OFF_QK) + head * 128, 1024, row0, nullptr};
        gemm_tile<128>(al2, row0, (const h16*)(P.ws + OFF_WKABS) + ((size_t)l * 8 + head) * 128 * 64, 64, 64, ep2, smem);
    }
}

__device__ __forceinline__ void p2b_item(const Params& P, int l, int rb, unsigned char* lds) {
    h16* smem = (h16*)lds;
    float* ft = (float*)lds;
    const int tid = opaque_tid(); const int row0 = rb * 128;
    const h16* projA = (const h16*)(P.ws + OFF_PROJA);
    h16* kvrow = (h16*)(P.ws + OFF_KVROW);
    __syncthreads();
    {
        const int row = row0 + (tid >> 1), hf = tid & 1; float s = 0.f; h16x8 v[8];
#pragma unroll
        for (int q = 0; q < 8; ++q) { v[q] = *(const h16x8*)(projA + (size_t)row * 512 + 256 + hf * 64 + q * 8);
#pragma unroll
            for (int e = 0; e < 8; ++e) { const float f = (float)v[q][e]; s += f * f; } }
        s += __shfl_xor(s, 1);
        const float rs = rsqrtf(s * (1.f / 128.f) + EPS);
        const float* g = P.g_ckv + l * 128 + hf * 64;
#pragma unroll
        for (int q = 0; q < 8; ++q) { h16x8 o;
#pragma unroll
            for (int e = 0; e < 8; ++e) o[e] = (h16)((float)v[q][e] * rs * g[q * 8 + e]);
            *(h16x8*)(kvrow + (size_t)row * 136 + hf * 64 + q * 8) = o; }
    }
    {
        h16* kfrag = (h16*)(P.ws + OFF_KFRAG);
#pragma unroll
        for (int q = 0; q < 4; ++q) {
            const int g = tid + 256 * q; const int row = row0 + (g >> 3), g8 = g & 7;
            if (row < NT) {
                const int b = row >= T_ ? 1 : 0; const int t = row - b * T_;
                const h16x8 v = *(const h16x8*)(projA + (size_t)row * 512 + 384 + g8 * 8);
                const int tile = t >> 5, ks = g8 >> 1, hh = g8 & 1;
                *(h16x8*)(kfrag + ((size_t)(b * NKT + tile) * 4 + ks) * 512 + (hh * 32 + (t & 31)) * 8) = v;
            }
        }
    }
    __threadfence_block();
    __syncthreads();
    const h16* Wuk = (const h16*)(P.ws + OFF_WUKT) + (size_t)l * 512 * 128;
    for (int tn = 0; tn < 4; ++tn) {
        AF16 al{kvrow, 136};
        EpiTileF32 ep;
        gemm_tile<128>(al, row0, Wuk + (size_t)tn * 128 * 128, 128, 128, ep, smem);
        __syncthreads();
        const int rl = tid >> 1, hh = tid & 1; float s = 0.f;
        for (int d = 0; d < 64; ++d) { const float f = ft[rl * 129 + hh * 64 + d]; s += f * f; }
        kvrow[(size_t)(row0 + rl) * 136 + 128 + 2 * tn + hh] = (h16)rsqrtf(s * (1.f / 64.f) + EPS);
        __syncthreads();
    }
}

__device__ __forceinline__ void p2c_item(const Params& P, int l, int item, unsigned char* lds) {
    h16* qh = (h16*)lds;
    h16* kh = (h16*)(lds + 17408);
    float* kf = (float*)(lds + 34816);
    float* vf = (float*)(lds + 67584);
    float* Lm = (float*)(lds + 100352);
    float* beta = (float*)(lds + 116736);
    float* dec = beta + 64;
    float* edec = dec + 64;
    const int tid = opaque_tid(), lane = tid & 63, w = tid >> 6;
    const int chain = item / NCH, n = item % NCH, b = chain >> 2, h = chain & 3;
    const h16* projG = (const h16*)(P.ws + OFF_PROJG);
    const float* small = (const float*)(P.ws + OFF_SMALL);
    const float* cw = P.conv_w + (size_t)l * 4 * 1536;
    __syncthreads();
#ifndef P2C
#define P2C 15
#endif
    float* cwl = (float*)(lds + 117504);
    for (int e = tid; e < 1536; e += NTHREADS) { const int m = e >> 9, jj = (e >> 7) & 3, c = e & 127; cwl[e] = cw[jj * 1536 + m * 512 + h * 128 + c]; }
    __syncthreads();
    for (int rs1_ = 0; rs1_ <= PROBE_S1; ++rs1_) if (P2C & 1) {
        const int i = tid >> 2, part = tid & 3;
        const int t = 64 * n + i - 48; const bool valid = t >= 0;
        const size_t row = (size_t)b * T_ + (valid ? t : 0);
        h16x8 rv[3][4][4];
#define CONV_LOAD(m_) do { _Pragma("unroll") for (int jj = 0; jj < 4; ++jj) { int tt = t - 3 + jj; tt = tt < 0 ? 0 : tt; \
            const h16* rp = projG + ((size_t)b * T_ + tt) * 1536 + (m_) * 512 + h * 128 + part * 32; \
            _Pragma("unroll") for (int c8 = 0; c8 < 4; ++c8) rv[m_][jj][c8] = *(const h16x8*)(rp + c8 * 8); } } while (0)
        CONV_LOAD(0); CONV_LOAD(1);
        float bl = 0.f, al = 0.f;
        if (part == 0) { bl = small[row * 16 + 4 + h]; al = small[row * 16 + 8 + h]; }
        float vals[32];
#pragma unroll
        for (int m = 0; m < 3; ++m) {
            if (m == 1) { CONV_LOAD(2); }
            __builtin_amdgcn_sched_barrier(0);
#pragma unroll
            for (int c = 0; c < 32; ++c) vals[c] = 0.f;
#pragma unroll
            for (int jj = 0; jj < 4; ++jj) {
                const float msk = (valid && (t - 3 + jj) >= 0) ? 1.f : 0.f;
                const float* wp = cwl + (m * 4 + jj) * 128 + part * 32;
#pragma unroll
                for (int c8 = 0; c8 < 4; ++c8) {
                    const float4 w0 = *(const float4*)(wp + c8 * 8), w1 = *(const float4*)(wp + c8 * 8 + 4);
                    const float wv[8] = {w0.x, w0.y, w0.z, w0.w, w1.x, w1.y, w1.z, w1.w};
#pragma unroll
                    for (int e = 0; e < 8; ++e) vals[c8 * 8 + e] += wv[e] * msk * (float)rv[m][jj][c8][e];
                }
            }
            float ss = 0.f;
#pragma unroll
            for (int c = 0; c < 32; ++c) { vals[c] = silu_f(vals[c]); ss += vals[c] * vals[c]; }
            if (m < 2) {
                ss += __shfl_xor(ss, 1); ss += __shfl_xor(ss, 2);
                const float rs = valid ? rsqrtf(ss + EPS) : 0.f;
                h16* dsth = (m == 0 ? qh : kh) + i * 136 + part * 32;
#pragma unroll
                for (int c8 = 0; c8 < 4; ++c8) { h16x8 o;
#pragma unroll
                    for (int e = 0; e < 8; ++e) o[e] = (h16)(vals[c8 * 8 + e] * rs);
                    *(h16x8*)(dsth + c8 * 8) = o; }
                if (m == 1) {
#pragma unroll
                    for (int c4 = 0; c4 < 8; ++c4) *(float4*)(kf + i * 128 + part * 32 + c4 * 4) = make_float4(vals[4 * c4] * rs, vals[4 * c4 + 1] * rs, vals[4 * c4 + 2] * rs, vals[4 * c4 + 3] * rs);
                }
            } else {
#pragma unroll
                for (int c4 = 0; c4 < 8; ++c4) *(float4*)(vf + i * 128 + part * 32 + c4 * 4) = valid ? make_float4(vals[4 * c4], vals[4 * c4 + 1], vals[4 * c4 + 2], vals[4 * c4 + 3]) : make_float4(0.f, 0.f, 0.f, 0.f);
            }
        }
#undef CONV_LOAD
        if (part == 0) {
            float bt = 0.f, g = 0.f;
            if (valid) {
                bt = 1.f / (1.f + __expf(-bl));
                const float xx = al + P.dt_bias[l * 4 + h];
                const float sp = xx > 20.f ? xx : log1pf(__expf(xx));
                g = -__expf(P.a_log[l * 4 + h]) * sp;
            }
            beta[i] = bt; dec[i] = g;
        }
    }
    __syncthreads();
    if (w == 0) {
        float v = dec[lane];
#pragma unroll
        for (int d = 1; d < 64; d <<= 1) { const float o = __shfl_up(v, d); if (lane >= d) v += o; }
        dec[lane] = v; edec[lane] = __expf(v);
    }
    __syncthreads();
    for (int rs3_ = 0; rs3_ <= PROBE_S3; ++rs3_) if (P2C & 2) {
        const int gq = lane >> 4, c16 = lane & 15;
        h16* aqk = (h16*)(P.ws + OFF_AQK) + (size_t)item * 4096;
        h16x8 ak[4], aq[4];
#pragma unroll
        for (int ks = 0; ks < 4; ++ks) { ak[ks] = *(const h16x8*)(kh + (16 * w + c16) * 136 + 32 * ks + 8 * gq); aq[ks] = *(const h16x8*)(qh + (16 * w + c16) * 136 + 32 * ks + 8 * gq); }
#pragma unroll
        for (int nt = 0; nt < 4; ++nt) {
            f32x4 kk = {0.f, 0.f, 0.f, 0.f}, qk = {0.f, 0.f, 0.f, 0.f};
#pragma unroll
            for (int ks = 0; ks < 4; ++ks) { const h16x8 bb = *(const h16x8*)(kh + (16 * nt + c16) * 136 + 32 * ks + 8 * gq); kk = MFMA16(ak[ks], bb, kk); qk = MFMA16(aq[ks], bb, qk); }
            const int jc = 16 * nt + c16; const float dj = dec[jc];
#pragma unroll
            for (int r = 0; r < 4; ++r) {
                const int ir = 16 * w + 4 * gq + r; const float gm = __expf(fminf(dec[ir] - dj, 0.f));
                Lm[ir * 64 + jc] = ir > jc ? beta[ir] * kk[r] * gm : 0.f;
                aqk[ir * 64 + jc] = (h16)(ir >= jc ? qk[r] * gm : 0.f);
            }
        }
    }
    __syncthreads();
    for (int rs5_ = 0; rs5_ <= PROBE_S5; ++rs5_) if (P2C & 8) {
        h16* qd = (h16*)(P.ws + OFF_QD) + (size_t)item * 8192;
        const int i = tid >> 2, part = tid & 3; const float ed = edec[i];
#pragma unroll
        for (int c8 = 0; c8 < 4; ++c8) { const h16x8 v = *(const h16x8*)(qh + i * 136 + part * 32 + c8 * 8); h16x8 o;
#pragma unroll
            for (int e = 0; e < 8; ++e) o[e] = (h16)((float)v[e] * ed);
            *(h16x8*)(qd + i * 128 + part * 32 + c8 * 8) = o; }
        h16* kdt = (h16*)(P.ws + OFF_KDT) + (size_t)item * 8192;
        const int d = tid & 127, ih = tid >> 7; const float dl = dec[63];
#pragma unroll
        for (int i8 = 0; i8 < 4; ++i8) { h16x8 o;
#pragma unroll
            for (int e = 0; e < 8; ++e) { const int ii = ih * 32 + i8 * 8 + e; o[e] = (h16)(kf[ii * 128 + d] * __expf(dl - dec[ii])); }
            *(h16x8*)(kdt + d * 64 + ih * 32 + i8 * 8) = o; }
        if (tid == 0) ((float*)(P.ws + OFF_CDEC))[item] = __expf(dl);
    }
    __syncthreads();
    if (P2C & 4) {
        float* scl = cwl;
        if (tid < 128) { const int i = tid & 63; scl[tid] = tid < 64 ? beta[i] : beta[i] * edec[i]; }
        __syncthreads();
        const int c = tid; const bool isu = c < 128; float* col = isu ? (vf + c) : (kf + (c - 128));
        const float* sc = scl + (isu ? 0 : 64);
        h16* dst = (h16*)(P.ws + (isu ? OFF_U : OFF_WM)) + (size_t)item * 8192 + (isu ? c : c - 128);
#pragma unroll 1
        for (int bi = 0; bi < 8; ++bi) {
            float sv[8];
            { const float4 s0 = *(const float4*)(sc + 8 * bi), s1 = *(const float4*)(sc + 8 * bi + 4);
              const float ss_[8] = {s0.x, s0.y, s0.z, s0.w, s1.x, s1.y, s1.z, s1.w};
#pragma unroll
              for (int r = 0; r < 8; ++r) sv[r] = col[(8 * bi + r) * 128] * ss_[r]; }
#pragma unroll 2
            for (int j4 = 0; j4 < 2 * bi; ++j4) {
                const float x0 = col[(4 * j4 + 0) * 128], x1 = col[(4 * j4 + 1) * 128], x2 = col[(4 * j4 + 2) * 128], x3 = col[(4 * j4 + 3) * 128];
#pragma unroll
                for (int r = 0; r < 8; ++r) { const float4 lv = *(const float4*)(Lm + (8 * bi + r) * 64 + 4 * j4); sv[r] -= lv.x * x0; sv[r] -= lv.y * x1; sv[r] -= lv.z * x2; sv[r] -= lv.w * x3; }
            }
            float4 la[8], lb[8];
#pragma unroll
            for (int r = 1; r < 8; ++r) { la[r] = *(const float4*)(Lm + (8 * bi + r) * 64 + 8 * bi); lb[r] = *(const float4*)(Lm + (8 * bi + r) * 64 + 8 * bi + 4); }
#pragma unroll
            for (int r = 1; r < 8; ++r) {
                const float lv[8] = {la[r].x, la[r].y, la[r].z, la[r].w, lb[r].x, lb[r].y, lb[r].z, lb[r].w};
#pragma unroll
                for (int q = 0; q < r; ++q) sv[r] -= lv[q] * sv[q];
            }
#pragma unroll
            for (int r = 0; r < 8; ++r) { col[(8 * bi + r) * 128] = sv[r]; dst[(8 * bi + r) * 128] = (h16)sv[r]; }
        }
    }
}

__device__ __forceinline__ float half_sum(float x) {
    const unsigned u = __float_as_uint(x); const auto p = __builtin_amdgcn_permlane32_swap(u, u, false, false);
    return __uint_as_float(p[0]) + __uint_as_float(p[1]);
}
__device__ __forceinline__ void store_tile_T(const f32x16& acc, float scale, float* st, h16* dst_row_lane  , bool ok, int lane) {
#pragma unroll
    for (int r = 0; r < 16; ++r) st[(lane & 31) * 33 + (r & 3) + 8 * (r >> 2) + 4 * (lane >> 5)] = acc[r] * scale;
    WAVE_FENCE();
    float v[16];
#pragma unroll
    for (int q = 0; q < 16; ++q) v[q] = st[(lane >> 1) * 33 + (lane & 1) * 16 + q];
    WAVE_FENCE();
    if (ok) store16h(dst_row_lane, v);
}

__device__ __forceinline__ void chain_item(const Params& P, int l, int item, float* st, int lane) {
    const int r0 = item * 32; const int tok = lane & 31, hf = lane >> 5;
    const int row = r0 + tok; const int rowc = row < NT ? row : NT - 1;
    const h16* projA = (const h16*)(P.ws + OFF_PROJA);
    const h16* Wq2 = (const h16*)(P.ws + OFF_WQ2T) + (size_t)l * 768 * 256;
    const h16* Wka = (const h16*)(P.ws + OFF_WKABS) + (size_t)l * 8 * 128 * 64;
    const h16* Wuk = (const h16*)(P.ws + OFF_WUKT) + (size_t)l * 512 * 128;
    h16* qidx = (h16*)(P.ws + OFF_QIDX); h16* qk = (h16*)(P.ws + OFF_QK); h16* kvrow = (h16*)(P.ws + OFF_KVROW);
    const int srow = r0 + (lane >> 1); const bool sok = srow < NT; const size_t srowc = sok ? srow : NT - 1;
    h16x8 bq[16]; float ss = 0.f;
#pragma unroll
    for (int ks = 0; ks < 16; ++ks) { bq[ks] = *(const h16x8*)(projA + (size_t)rowc * 512 + 16 * ks + 8 * hf);
#pragma unroll
        for (int e = 0; e < 8; ++e) { const float f = (float)bq[ks][e]; ss += f * f; } }
    ss = half_sum(ss);
    const float rstd_q = rsqrtf(ss * (1.f / 256.f) + EPS);
#pragma unroll 1
    for (int h = 0; h < 8; ++h) {
        f32x16 aq[2];
#pragma unroll
        for (int mt = 0; mt < 2; ++mt)
#pragma unroll
            for (int r = 0; r < 16; ++r) aq[mt][r] = 0.f;
        const h16* wp = Wq2 + (size_t)(64 * h + tok) * 256 + 8 * hf;
#pragma unroll
        for (int ks = 0; ks < 16; ++ks) {
            const h16x8 a0 = *(const h16x8*)(wp + 16 * ks), a1 = *(const h16x8*)(wp + 32 * 256 + 16 * ks);
            aq[0] = MFMA32(a0, bq[ks], aq[0]); aq[1] = MFMA32(a1, bq[ks], aq[1]);
        }
        __builtin_amdgcn_sched_group_barrier(0x20, 8, 0);
#pragma unroll
        for (int q = 0; q < 12; ++q) { __builtin_amdgcn_sched_group_barrier(0x8, 2, 0); __builtin_amdgcn_sched_group_barrier(0x20, 2, 0); }
        __builtin_amdgcn_sched_group_barrier(0x8, 8, 0);
        __builtin_amdgcn_sched_barrier(0);
        float sq = 0.f;
#pragma unroll
        for (int mt = 0; mt < 2; ++mt)
#pragma unroll
            for (int r = 0; r < 16; ++r) sq += aq[mt][r] * aq[mt][r];
        sq = half_sum(sq) * rstd_q * rstd_q;
        const float rsq = rsqrtf(sq * (1.f / 64.f) + EPS) * rstd_q;
        h16x8 qb[4];
#pragma unroll
        for (int kk = 0; kk < 4; ++kk)
#pragma unroll
            for (int j = 0; j < 8; ++j) qb[kk][j] = (h16)(aq[kk >> 1][8 * (kk & 1) + j] * rsq);
        const h16* kp = Wka + (size_t)h * 128 * 64 + (size_t)tok * 64 + 8 * hf;
#pragma unroll
        for (int ct = 0; ct < 4; ++ct) {
            f32x16 ak;
#pragma unroll
            for (int r = 0; r < 16; ++r) ak[r] = 0.f;
#pragma unroll
            for (int kk = 0; kk < 4; ++kk) { const h16x8 a = *(const h16x8*)(kp + (size_t)(32 * ct) * 64 + 16 * kk); ak = MFMA32(a, qb[kk], ak); }
            store_tile_T(ak, 1.f, st, qk + srowc * 1024 + h * 128 + 32 * ct + 16 * (lane & 1), sok, lane);
        }
    }
#pragma unroll 1
    for (int nt = 0; nt < 8; ++nt) {
        f32x16 ai;
#pragma unroll
        for (int r = 0; r < 16; ++r) ai[r] = 0.f;
        const h16* wp = Wq2 + (size_t)(512 + 32 * nt + tok) * 256 + 8 * hf;
#pragma unroll
        for (int ks = 0; ks < 16; ++ks) { const h16x8 a = *(const h16x8*)(wp + 16 * ks); ai = MFMA32(a, bq[ks], ai); }
#pragma unroll
        for (int r = 0; r < 16; ++r) ai[r] *= rstd_q;
        store_tile_T(ai, 1.f, st, qidx + srowc * 256 + 32 * nt + 16 * (lane & 1), sok, lane);
    }
    h16x8 bk[8]; float sk = 0.f;
#pragma unroll
    for (int ks = 0; ks < 8; ++ks) { bk[ks] = *(const h16x8*)(projA + (size_t)rowc * 512 + 256 + 16 * ks + 8 * hf);
#pragma unroll
        for (int e = 0; e < 8; ++e) { const float f = (float)bk[ks][e]; sk += f * f; } }
    sk = half_sum(sk);
    const float rstd_kv = rsqrtf(sk * (1.f / 128.f) + EPS);
    if (row < NT) {
        const float* g = P.g_ckv + l * 128;
#pragma unroll
        for (int ks = 0; ks < 8; ++ks) { h16x8 o;
#pragma unroll
            for (int e = 0; e < 8; ++e) o[e] = (h16)((float)bk[ks][e] * rstd_kv * g[16 * ks + 8 * hf + e]);
            *(h16x8*)(kvrow + (size_t)row * 136 + 16 * ks + 8 * hf) = o; }
    }
#pragma unroll 1
    for (int h = 0; h < 8; ++h) {
        f32x16 ak[2];
#pragma unroll
        for (int mt = 0; mt < 2; ++mt)
#pragma unroll
            for (int r = 0; r < 16; ++r) ak[mt][r] = 0.f;
        const h16* wp = Wuk + (size_t)(64 * h + tok) * 128 + 8 * hf;
#pragma unroll
        for (int ks = 0; ks < 8; ++ks) {
            const h16x8 a0 = *(const h16x8*)(wp + 16 * ks), a1 = *(const h16x8*)(wp + 32 * 128 + 16 * ks);
            ak[0] = MFMA32(a0, bk[ks], ak[0]); ak[1] = MFMA32(a1, bk[ks], ak[1]);
        }
        float sq = 0.f;
#pragma unroll
        for (int mt = 0; mt < 2; ++mt)
#pragma unroll
            for (int r = 0; r < 16; ++r) sq += ak[mt][r] * ak[mt][r];
        sq = half_sum(sq) * rstd_kv * rstd_kv;
        if (row < NT && hf == 0) kvrow[(size_t)row * 136 + 128 + h] = (h16)rsqrtf(sq * (1.f / 64.f) + EPS);
    }
    if (row < NT) {
        h16* kfrag = (h16*)(P.ws + OFF_KFRAG);
        const int b = row >= T_ ? 1 : 0; const int t = row - b * T_; const int tile = t >> 5;
#pragma unroll
        for (int q = 0; q < 4; ++q) {
            const int g8 = 2 * q + hf;
            const h16x8 v = *(const h16x8*)(projA + (size_t)row * 512 + 384 + g8 * 8);
            *(h16x8*)(kfrag + ((size_t)(b * NKT + tile) * 4 + (g8 >> 1)) * 512 + ((g8 & 1) * 32 + (t & 31)) * 8) = v;
        }
    }
}

__device__ __forceinline__ void p4_item(const Params& P, int l, int item, int lane) {
    const int r0 = item * 32; const int tok = lane & 31, hf = lane >> 5;
    const int row = r0 + tok; const bool ok = row < NT; const size_t rowc = ok ? row : NT - 1;
    const h16* ctx = (const h16*)(P.ws + OFF_CTX); const h16* Wuv = (const h16*)(P.ws + OFF_WUVT) + (size_t)l * 8 * 64 * 128;
    const h16* sza = (const h16*)(P.ws + OFF_SZA); const h16* szg = (const h16*)(P.ws + OFF_SZG); const h16* og = (const h16*)(P.ws + OFF_QN);
    h16* omix = (h16*)(P.ws + OFF_OMIX);
#pragma unroll 1
    for (int h = 0; h < 8; ++h) {
        h16x8 bc[8];
#pragma unroll
        for (int ks = 0; ks < 8; ++ks) bc[ks] = *(const h16x8*)(ctx + rowc * 1024 + h * 128 + 16 * ks + 8 * hf);
        f32x16 ao[2];
#pragma unroll
        for (int mt = 0; mt < 2; ++mt)
#pragma unroll
            for (int r = 0; r < 16; ++r) ao[mt][r] = 0.f;
        const h16* wp = Wuv + (size_t)h * 64 * 128 + (size_t)tok * 128 + 8 * hf;
#pragma unroll
        for (int ks = 0; ks < 8; ++ks) {
            const h16x8 a0 = *(const h16x8*)(wp + 16 * ks), a1 = *(const h16x8*)(wp + 32 * 128 + 16 * ks);
            ao[0] = MFMA32(a0, bc[ks], ao[0]); ao[1] = MFMA32(a1, bc[ks], ao[1]);
        }
        if (ok) {
#pragma unroll
            for (int mt = 0; mt < 2; ++mt)
#pragma unroll
                for (int g = 0; g < 4; ++g) {
                    const int d0 = h * 64 + 32 * mt + 8 * g + 4 * hf;
                    const h16x4 z = *(const h16x4*)(sza + (size_t)row * 512 + d0);
                    h16x4 o;
#pragma unroll
                    for (int e = 0; e < 4; ++e) o[e] = (h16)(ao[mt][4 * g + e] * (float)z[e]);
                    *(h16x4*)(omix + (size_t)row * 1024 + d0) = o;
                }
        }
    }
    const float* go = P.g_out + l * 128;
#pragma unroll 1
    for (int h = 0; h < 4; ++h) {
        h16x8 v[8]; float ss = 0.f;
#pragma unroll
        for (int q = 0; q < 8; ++q) { v[q] = *(const h16x8*)(og + rowc * 512 + h * 128 + 64 * hf + 8 * q);
#pragma unroll
            for (int e = 0; e < 8; ++e) { const float f = (float)v[q][e]; ss += f * f; } }
        ss = half_sum(ss);
        const float rs = rsqrtf(ss * (1.f / 128.f) + EPS);
        if (ok) {
#pragma unroll
            for (int q = 0; q < 8; ++q) { const h16x8 z = *(const h16x8*)(szg + (size_t)row * 512 + h * 128 + 64 * hf + 8 * q); h16x8 o;
#pragma unroll
                for (int e = 0; e < 8; ++e) o[e] = (h16)((float)v[q][e] * rs * go[64 * hf + 8 * q + e] * (float)z[e]);
                *(h16x8*)(omix + (size_t)row * 1024 + 512 + h * 128 + 64 * hf + 8 * q) = o; }
        }
    }
}

__device__ __forceinline__ void phase2(const Params& P, int l, unsigned char* lds) {
    const int tid = opaque_tid(), lane = tid & 63, w = tid >> 6;
    unsigned* ctr = (unsigned*)(P.ws + OFF_CTL) + 16 + l;
    int* slot = (int*)(lds + LDS_BYTES - 32);
    for (int rep_ = 0; rep_ <= (PROBE_P2C | PROBE_CHAIN | PROBE_P2X); ++rep_) {
    for (;;) {
        __syncthreads();
        if (tid == 0) *slot = (int)__hip_atomic_fetch_add(ctr + 4 * rep_, 1u, __ATOMIC_RELAXED, __HIP_MEMORY_SCOPE_AGENT);
        __syncthreads();
        const int it = *slot;
        if (it >= NGI + 129) break;
        if (it >= 129) { if (!PROBE_CHAIN || rep_ == 0) { TSEC_BEGIN(6) p2c_item(P, l, it - 129, lds); TSEC_END(6); } }
        else if (!PROBE_P2C || rep_ == 0) {
            const int ci = it * 4 + w;
            __syncthreads();
            TSEC_BEGIN(7)
            if (ci < (NT + 31) / 32) chain_item(P, l, ci, (float*)lds + w * 1152, lane);
            TSEC_END(7);
        }
    }
    }
}

constexpr int SNT = 2;
__device__ __forceinline__ void gdn_scan(const Params& P, int sw, unsigned char* lds) {
    h16* St = (h16*)lds;
    h16* Vt = (h16*)(lds + 16 * SNT * 272);
    const int tid = opaque_tid(), lane = tid & 63, w = tid >> 6, gq = lane >> 4, c16 = lane & 15;
    const int chain = sw / (8 / SNT), e0 = (sw % (8 / SNT)) * 16 * SNT, b = chain >> 2, h = chain & 3;
    const h16* Ub = (const h16*)(P.ws + OFF_U); const h16* Wb = (const h16*)(P.ws + OFF_WM);
    const h16* Qb = (const h16*)(P.ws + OFF_QD); const h16* Kb = (const h16*)(P.ws + OFF_KDT);
    const h16* Ab = (const h16*)(P.ws + OFF_AQK); const float* cdec = (const float*)(P.ws + OFF_CDEC);
    h16* og = (h16*)(P.ws + OFF_QN);
    __syncthreads();
    for (int i = tid; i < 16 * SNT * 136; i += NTHREADS) St[i] = (h16)0.f;
    f32x4 S[2][SNT];
#pragma unroll
    for (int m2 = 0; m2 < 2; ++m2)
#pragma unroll
        for (int nt = 0; nt < SNT; ++nt) S[m2][nt] = (f32x4){0.f, 0.f, 0.f, 0.f};
    __syncthreads();
    h16x8 wf[2][4], qf[2][4], af[2][2], kf_[2][2][2]; h16 uv[2][SNT][4]; float cd[2];
#define SCAN_LOAD(S_, n_) do { const int nn_ = (n_) < NCH ? (n_) : NCH - 1; const size_t itm = (size_t)chain * NCH + nn_; \
        _Pragma("unroll") for (int ks = 0; ks < 4; ++ks) { wf[S_][ks] = *(const h16x8*)(Wb + itm * 8192 + (16 * w + c16) * 128 + 32 * ks + 8 * gq); qf[S_][ks] = *(const h16x8*)(Qb + itm * 8192 + (16 * w + c16) * 128 + 32 * ks + 8 * gq); } \
        _Pragma("unroll") for (int ks = 0; ks < 2; ++ks) { af[S_][ks] = *(const h16x8*)(Ab + itm * 4096 + (16 * w + c16) * 64 + 32 * ks + 8 * gq); \
            _Pragma("unroll") for (int m2 = 0; m2 < 2; ++m2) kf_[S_][m2][ks] = *(const h16x8*)(Kb + itm * 8192 + (16 * (2 * w + m2) + c16) * 64 + 32 * ks + 8 * gq); } \
        _Pragma("unroll") for (int nt = 0; nt < SNT; ++nt) _Pragma("unroll") for (int r = 0; r < 4; ++r) uv[S_][nt][r] = Ub[itm * 8192 + (16 * w + 4 * gq + r) * 128 + e0 + 16 * nt + c16]; \
        cd[S_] = cdec[itm]; } while (0)
#define SCAN_STEP(S_, n_) do { \
        h16x8 cwf[4], cqf[4], caf[2], ckf[2][2]; float cu[SNT][4]; const float ccd = cd[S_]; \
        _Pragma("unroll") for (int ks = 0; ks < 4; ++ks) { cwf[ks] = wf[S_][ks]; cqf[ks] = qf[S_][ks]; } \
        _Pragma("unroll") for (int ks = 0; ks < 2; ++ks) { caf[ks] = af[S_][ks]; ckf[0][ks] = kf_[S_][0][ks]; ckf[1][ks] = kf_[S_][1][ks]; } \
        _Pragma("unroll") for (int nt = 0; nt < SNT; ++nt) _Pragma("unroll") for (int r = 0; r < 4; ++r) cu[nt][r] = (float)uv[S_][nt][r]; \
        SCAN_LOAD(S_, (n_) + 2); \
        f32x4 Pm[SNT], O[SNT]; \
        _Pragma("unroll") for (int nt = 0; nt < SNT; ++nt) { Pm[nt] = (f32x4){0.f, 0.f, 0.f, 0.f}; O[nt] = (f32x4){0.f, 0.f, 0.f, 0.f}; \
            _Pragma("unroll") for (int ks = 0; ks < 4; ++ks) { const h16x8 bs = *(const h16x8*)(St + (16 * nt + c16) * 136 + 32 * ks + 8 * gq); Pm[nt] = MFMA16(cwf[ks], bs, Pm[nt]); O[nt] = MFMA16(cqf[ks], bs, O[nt]); } \
            h16x4 vn; \
            _Pragma("unroll") for (int r = 0; r < 4; ++r) vn[r] = (h16)(cu[nt][r] - Pm[nt][r]); \
            *(h16x4*)(Vt + (16 * nt + c16) * 72 + 16 * w + 4 * gq) = vn; } \
        lds_barrier(); \
        _Pragma("unroll") for (int nt = 0; nt < SNT; ++nt) { \
            _Pragma("unroll") for (int m2 = 0; m2 < 2; ++m2) _Pragma("unroll") for (int r = 0; r < 4; ++r) S[m2][nt][r] *= ccd; \
            _Pragma("unroll") for (int ks = 0; ks < 2; ++ks) { const h16x8 bv = *(const h16x8*)(Vt + (16 * nt + c16) * 72 + 32 * ks + 8 * gq); O[nt] = MFMA16(caf[ks], bv, O[nt]); S[0][nt] = MFMA16(ckf[0][ks], bv, S[0][nt]); S[1][nt] = MFMA16(ckf[1][ks], bv, S[1][nt]); } \
            _Pragma("unroll") for (int r = 0; r < 4; ++r) { const int t = 64 * (n_) + 16 * w + 4 * gq + r - 48; if (t >= 0) og[((size_t)b * T_ + t) * 512 + h * 128 + e0 + 16 * nt + c16] = (h16)(O[nt][r] * 0.08838834764831845f); } \
            _Pragma("unroll") for (int m2 = 0; m2 < 2; ++m2) { h16x4 sv; \
                _Pragma("unroll") for (int r = 0; r < 4; ++r) sv[r] = (h16)S[m2][nt][r]; \
                *(h16x4*)(St + (16 * nt + c16) * 136 + 16 * (2 * w + m2) + 4 * gq) = sv; } } \
        lds_barrier(); } while (0)
    SCAN_LOAD(0, 0); SCAN_LOAD(1, 1);
    for (int n = 0; n + 1 < NCH; n += 2) { SCAN_STEP(0, n); SCAN_STEP(1, n + 1); }
    SCAN_STEP(0, NCH - 1);
#undef SCAN_STEP
#undef SCAN_LOAD
}

constexpr int CAP = 704;
__device__ __forceinline__ void dma16_asm(const void* gptr, unsigned lds_addr) {
    unsigned sv; lds_addr = (unsigned)__builtin_amdgcn_readfirstlane((int)lds_addr);
    asm volatile("s_mov_b32 %0, m0\n\ts_mov_b32 m0, %2\n\ts_nop 0\n\tglobal_load_lds_dwordx4 %1, off\n\ts_mov_b32 m0, %0" : "=&s"(sv) : "v"(gptr), "s"(lds_addr) : "memory");
}
__device__ __forceinline__ int dpp_scan_incl(int x) {
    x += __builtin_amdgcn_update_dpp(0, x, 0x111, 0xf, 0xf, false);
    x += __builtin_amdgcn_update_dpp(0, x, 0x112, 0xf, 0xf, false);
    x += __builtin_amdgcn_update_dpp(0, x, 0x114, 0xf, 0xf, false);
    x += __builtin_amdgcn_update_dpp(0, x, 0x118, 0xf, 0xf, false);
    x += __builtin_amdgcn_update_dpp(0, x, 0x142, 0xa, 0xf, false);
    x += __builtin_amdgcn_update_dpp(0, x, 0x143, 0xc, 0xf, false);
    return x;
}

__device__ __forceinline__ int topk_prune(float* sc, unsigned short* ix, unsigned* hist, int c, int lane, int K, int limit, float& theta, float& theta_next) {
    constexpr int NE = (CAP + 63) / 64;
    unsigned key[NE]; unsigned short idx[NE]; float val[NE];
#pragma unroll
    for (int it = 0; it < NE; ++it) { const int i = lane + 64 * it; const bool v = i < c; const float f = v ? sc[i] : 0.f; val[it] = f; idx[it] = v ? ix[i] : (unsigned short)0; key[it] = v ? ordkey(f) : 0u; }
    unsigned prefix = 0; int need = K; int binpop = 0; bool exact = true; int sh = 0;
    const unsigned tb0 = (unsigned)__builtin_amdgcn_readfirstlane((int)(key[0] >> 24));
    bool same = true;
#pragma unroll
    for (int it = 0; it < NE; ++it) same = same && (key[it] == 0u || (key[it] >> 24) == tb0);
    const bool skip0 = __all(same);
    if (skip0) prefix = tb0 << 24;
#pragma unroll
    for (int r = 0; r < 4; ++r) {
        if (r == 0 && skip0) continue;
        const int shift = 24 - 8 * r;
        ((uint4*)hist)[lane] = make_uint4(0u, 0u, 0u, 0u);
        WAVE_FENCE();
#pragma unroll
        for (int it = 0; it < NE; ++it) {
            const bool m = (key[it] != 0u) && (r == 0 || ((key[it] ^ prefix) >> ((shift + 8) & 31)) == 0u);
            if (m) atomicAdd(&hist[(key[it] >> shift) & 255u], 1u);
        }
        WAVE_FENCE();
        const uint4 h4 = ((const uint4*)hist)[63 - lane];
        WAVE_FENCE();
        const int loc = (int)(h4.x + h4.y + h4.z + h4.w);
        const int incl = dpp_scan_incl(loc);
        const int c3 = incl - loc, c2 = c3 + (int)h4.w, c1 = c2 + (int)h4.z, c0 = c1 + (int)h4.y;
        int dsel = -1, cab = 0, hb = 0;
        if (c3 < need && need <= c3 + (int)h4.w) { dsel = 3; cab = c3; hb = (int)h4.w; }
        else if (c2 < need && need <= c2 + (int)h4.z) { dsel = 2; cab = c2; hb = (int)h4.z; }
        else if (c1 < need && need <= c1 + (int)h4.y) { dsel = 1; cab = c1; hb = (int)h4.y; }
        else if (c0 < need && need <= c0 + (int)h4.x) { dsel = 0; cab = c0; hb = (int)h4.x; }
        const u64 fm = __ballot(dsel >= 0);
        const int src = __builtin_amdgcn_readfirstlane(__ffsll((long long)fm) - 1);
        const int digit = __builtin_amdgcn_readlane(4 * (63 - lane) + dsel, src);
        const int cabv = __builtin_amdgcn_readlane(cab, src);
        binpop = __builtin_amdgcn_readlane(hb, src);
        need -= cabv; prefix |= (unsigned)digit << shift; sh = shift;
        if (r < 3 && (K - need) + binpop <= limit) { exact = false; break; }
    }
    (void)sh;
    const unsigned thr = prefix; int out = 0, tb = 0;
#pragma unroll
    for (int it = 0; it < NE; ++it) {
        const bool v = key[it] != 0u; const bool gt = v && key[it] > thr; const bool eq = v && key[it] == thr;
        bool keep;
        if (exact && K == 256) { const u64 meq = __ballot(eq); const int tr = tb + lanes_below(meq); keep = gt || (eq && tr < need); tb += __popcll(meq); }
        else keep = gt || eq;
        const u64 mk = __ballot(keep); const int slot = out + lanes_below(mk);
        if (keep) { sc[slot] = val[it]; ix[slot] = idx[it]; }
        out += __popcll(mk);
    }
    WAVE_FENCE();
    theta = ordinv(thr); theta_next = ordinv(thr + 1u);
    return out;
}

constexpr int WL_SC = 0;
constexpr int WL_IX = 8 * CAP * 4;
constexpr int WL_RING = 0;
constexpr int SLOT_BYTES = 8704;
constexpr int WL_SEL = 34816;
constexpr int WL_NSEL = 38912;
constexpr int WL_BYTES = 38944;
static_assert(WL_IX + 8 * CAP * 2 <= WL_SEL && 4 * SLOT_BYTES <= WL_SEL, "DSA LDS map");

__device__ __forceinline__ void dsa_item(const Params& P, int item, int qlo, int qhi, unsigned char* wl, const float* biasd, int lane) {
    float* sc = (float*)(wl + WL_SC);
    unsigned short* ix = (unsigned short*)(wl + WL_IX);
    unsigned* hist = (unsigned*)(wl + WL_SEL);
    unsigned short* sel = (unsigned short*)(wl + WL_SEL);
    int* nselL = (int*)(wl + WL_NSEL);
    unsigned char* ring = wl + WL_RING;
    const h16* qidx = (const h16*)(P.ws + OFF_QIDX);
    const float* small = (const float*)(P.ws + OFF_SMALL);
    const h16* kvrow = (const h16*)(P.ws + OFF_KVROW);
    const h16* qk = (const h16*)(P.ws + OFF_QK);
    h16* ctxb = (h16*)(P.ws + OFF_CTX);
    const int row0 = item * 8; const int b = row0 >= T_ ? 1 : 0; const int t0 = row0 - b * T_;
    const int half = lane >> 5, kl = lane & 31;
    const unsigned wl_a = (unsigned)(size_t)(LAS unsigned char*)wl;
    WAVE_FENCE();
    TSEC_BEGIN(3)
    for (int rep_ = 0; rep_ <= (PROBE_TOPK2 | PROBE_SWEEP); ++rep_) {
        const bool dummy_ = PROBE_SWEEP && rep_ == 0;
        h16x8 afr[4];
        { const int qq = kl >> 2, hd = kl & 3; const h16* p = qidx + (size_t)(row0 + qq) * 256 + hd * 64 + 8 * half;
#pragma unroll
          for (int ks = 0; ks < 4; ++ks) afr[ks] = *(const h16x8*)(p + 16 * ks); }
        float wq[4][4]; float thq[8]; int cntq[8];
#pragma unroll
        for (int g = 0; g < 4; ++g) { const float* sp = small + (size_t)(row0 + 2 * g + half) * 16;
#pragma unroll
            for (int hh = 0; hh < 4; ++hh) wq[g][hh] = sp[hh]; }
#pragma unroll
        for (int qq = 0; qq < 8; ++qq) { thq[qq] = (dummy_ || qq < qlo || qq >= qhi) ? INFINITY : -INFINITY; cntq[qq] = 0; }
        const int ntiles = ((t0 + 7) >> 5) + 1;
        bool safe_ = false;
      redo_sweep:
        const h16* kfp = (const h16*)(P.ws + OFF_KFRAG) + (size_t)b * NKT * 2048 + lane * 8;
        h16x8 bt[4][4];
#pragma unroll
        for (int u = 0; u < 4; ++u) { const int tl = u < ntiles ? u : ntiles - 1;
#pragma unroll
            for (int ks = 0; ks < 4; ++ks) bt[u][ks] = *(const h16x8*)(kfp + (size_t)tl * 2048 + ks * 512); }
        const int ngroups = (ntiles + 3) >> 2;
#define SWEEP_GROUP() \
                f32x16 acc[4]; \
                _Pragma("unroll") for (int u = 0; u < 4; ++u) { \
                    _Pragma("unroll") for (int r = 0; r < 16; ++r) acc[u][r] = 0.f; \
                    _Pragma("unroll") for (int ks = 0; ks < 4; ++ks) acc[u] = MFMA32(afr[ks], bt[u][ks], acc[u]); \
                    const int tn = tile0 + u + 4 < ntiles ? tile0 + u + 4 : ntiles - 1;     \
                    _Pragma("unroll") for (int ks = 0; ks < 4; ++ks) bt[u][ks] = *(const h16x8*)(kfp + (size_t)tn * 2048 + ks * 512); } \
                _Pragma("unroll") for (int q = 0; q < 16; ++q) { __builtin_amdgcn_sched_group_barrier(0x8, 1, 0); __builtin_amdgcn_sched_group_barrier(0x20, 1, 0); }     \
                __builtin_amdgcn_sched_barrier(0);
        for (int grp = 0; grp <= ngroups; ++grp) {
            const bool last = grp == ngroups;
            if (!last) {
                const int tile0 = grp * 4;
                f32x16 accs[4];
                { SWEEP_GROUP() _Pragma("unroll") for (int u = 0; u < 4; ++u) accs[u] = acc[u]; }
#pragma unroll
                for (int p = 0; p < 2; ++p) {
                    const int key = (tile0 + 2 * p) * 32 + lane;
#define APPEND_CELL(QQ, SV) do { const float sv_ = (SV); u64 mge_; asm("v_cmp_ge_f32 %0, %1, %2" : "=s"(mge_) : "v"(sv_), "v"(thq[QQ])); \
                        const u64 m_ = __builtin_amdgcn_ballot_w64(key <= t0 + (QQ)) & mge_; \
                        const int slot_ = lanes_below_from(m_, cntq[QQ]); \
                        const unsigned a1_ = wl_a + 4u * (unsigned)slot_, a2_ = wl_a + 2u * (unsigned)slot_; u64 ex_; \
                        asm volatile("s_and_saveexec_b64 %0, %1\n\tds_write_b32 %2, %3 offset:%6\n\tds_write_b16 %4, %5 offset:%7\n\ts_mov_b64 exec, %0" \
                            : "=&s"(ex_) : "s"(m_), "v"(a1_), "v"(sv_), "v"(a2_), "v"(key), "n"(WL_SC + (QQ) * CAP * 4), "n"(WL_IX + (QQ) * CAP * 2) : "memory"); \
                        cntq[QQ] += __builtin_popcountll(m_); } while (0)
#define APPEND_PAIR(G) do { float sa = 0.f, sb = 0.f; \
                        _Pragma("unroll") for (int hh = 0; hh < 4; ++hh) { sa = fmaf(wq[G][hh], relu1(accs[2 * p][4 * (G) + hh]), sa); sb = fmaf(wq[G][hh], relu1(accs[2 * p + 1][4 * (G) + hh]), sb); } \
                        const auto sw = __builtin_amdgcn_permlane32_swap(__float_as_uint(sa), __float_as_uint(sb), false, false);     \
                        APPEND_CELL(2 * (G), __uint_as_float(sw[0])); APPEND_CELL(2 * (G) + 1, __uint_as_float(sw[1])); } while (0)
                    APPEND_PAIR(0); APPEND_PAIR(1); APPEND_PAIR(2); APPEND_PAIR(3);
#undef APPEND_PAIR
#undef APPEND_CELL
                }
            }
            const int lim = last ? 256 : CAP - 128;
            int cmax = cntq[0];
#pragma unroll
            for (int qq = 1; qq < 8; ++qq) cmax = cntq[qq] > cmax ? cntq[qq] : cmax;
            if (cmax > lim) {
                WAVE_FENCE();
#pragma unroll 1
                for (int qq = 0; qq < 8; ++qq) {
                    int c = cntq[0];
#pragma unroll
                    for (int j = 1; j < 8; ++j) c = qq == j ? cntq[j] : c;
                    c = __builtin_amdgcn_readfirstlane(c);
                    if (c > lim) {
                        float nth, nthn;
                        const int nall = t0 + qq + 1; int nseen = (grp + 1) * 128; nseen = nseen < nall ? nseen : nall;
                        int K = 256;
                        if (!last && !safe_) { K = (int)(448.f * (float)nseen / (float)nall) + 16; K = K < 48 ? 48 : (K > 256 ? 256 : K); }
                        TSEC_BEGIN(1) TSEC_BEGIN(2)
                        const int nc = topk_prune(sc + qq * CAP, ix + qq * CAP, hist, c, lane, K, last ? 256 : K + 64, nth, nthn);
                        if (!last) TSEC_END(1); else TSEC_END(2);
                        float nv = K == 256 ? nthn : nth;
                        int ncf = nc;
                        if (K < 256 && nc > lim) {
                            ncf = topk_prune(sc + qq * CAP, ix + qq * CAP, hist, nc, lane, 256, 320, nth, nthn); nv = nthn;
                        }
#pragma unroll
                        for (int j = 0; j < 8; ++j) if (j == qq) { cntq[j] = ncf; thq[j] = nv; }
                    }
                }
            }
        }
        {
            bool okq = true;
#pragma unroll
            for (int qq = 0; qq < 8; ++qq) okq = okq && (qq < qlo || qq >= qhi || cntq[qq] >= 256 || cntq[qq] >= t0 + qq + 1);
            if (!okq && !safe_ && !dummy_) {
                safe_ = true;
#pragma unroll
                for (int qq = 0; qq < 8; ++qq) { thq[qq] = (qq < qlo || qq >= qhi) ? INFINITY : -INFINITY; cntq[qq] = 0; }
                WAVE_FENCE();
                goto redo_sweep;
            }
        }
#undef SWEEP_GROUP
        WAVE_FENCE();
#pragma unroll 1
        for (int qq = qlo; qq < (dummy_ ? 0 : qhi); ++qq) {
            int c = cntq[0];
#pragma unroll
            for (int j = 1; j < 8; ++j) c = qq == j ? cntq[j] : c;
            c = __builtin_amdgcn_readfirstlane(c);
            if (lane == 0) nselL[qq] = c;
#pragma unroll
            for (int i4 = 0; i4 < 4; ++i4) { const int i = lane + 64 * i4; sel[qq * 256 + i] = i < c ? ix[qq * CAP + i] : (unsigned short)0; }
        }
        WAVE_FENCE();
    }
    TSEC_END(3);
    TSEC_BEGIN(4)
    const int gq = lane >> 4, c16 = lane & 15; const bool hv = c16 < 8;
    const unsigned ring_a = (unsigned)(size_t)(LAS unsigned char*)ring;
    const h16* kvb = kvrow + (size_t)b * T_ * 136;
    int poff[4];
#pragma unroll
    for (int i = 0; i < 4; ++i) poff[i] = (c16 ^ ((4 * i + gq) & 15)) * 8;
    const float b31 = biasd[127 * 8 + (c16 & 7)];
#define DSA_ISSUE(J_) do { const int jj_ = (J_) < 8 * qhi ? (J_) : 8 * qhi - 1; const unsigned short* sp_ = sel + (jj_ >> 3) * 256 + 32 * (jj_ & 7); \
        const h16* a_[8]; \
        _Pragma("unroll") for (int i = 0; i < 8; ++i) a_[i] = kvb + (size_t)sp_[4 * i + gq] * 136 + poff[i & 3]; \
        const h16* ar_ = kvb + (size_t)sp_[lane & 31] * 136 + 128; \
        const unsigned la_ = (unsigned)__builtin_amdgcn_readfirstlane((int)(ring_a + ((J_) & 3) * SLOT_BYTES)); unsigned sv_; unsigned long long ex_; \
        asm volatile("s_mov_b32 %0, m0\n\ts_mov_b32 m0, %2\n\ts_nop 0\n\t" \
            "global_load_lds_dwordx4 %3, off\n\ts_add_u32 m0, m0, 0x400\n\ts_nop 0\n\t" "global_load_lds_dwordx4 %4, off\n\ts_add_u32 m0, m0, 0x400\n\ts_nop 0\n\t" \
            "global_load_lds_dwordx4 %5, off\n\ts_add_u32 m0, m0, 0x400\n\ts_nop 0\n\t" "global_load_lds_dwordx4 %6, off\n\ts_add_u32 m0, m0, 0x400\n\ts_nop 0\n\t" \
            "global_load_lds_dwordx4 %7, off\n\ts_add_u32 m0, m0, 0x400\n\ts_nop 0\n\t" "global_load_lds_dwordx4 %8, off\n\ts_add_u32 m0, m0, 0x400\n\ts_nop 0\n\t" \
            "global_load_lds_dwordx4 %9, off\n\ts_add_u32 m0, m0, 0x400\n\ts_nop 0\n\t" "global_load_lds_dwordx4 %10, off\n\ts_add_u32 m0, m0, 0x400\n\ts_nop 0\n\t" \
            "s_mov_b64 %1, exec\n\ts_mov_b64 exec, 0xffffffff\n\tglobal_load_lds_dwordx4 %11, off\n\ts_mov_b64 exec, %1\n\ts_mov_b32 m0, %0" \
            : "=&s"(sv_), "=&s"(ex_) : "s"(la_), "v"(a_[0]), "v"(a_[1]), "v"(a_[2]), "v"(a_[3]), "v"(a_[4]), "v"(a_[5]), "v"(a_[6]), "v"(a_[7]), "v"(ar_) : "memory"); } while (0)
    for (int rep_ = 0; rep_ <= PROBE_ATT2; ++rep_) {
    asm volatile("s_waitcnt vmcnt(0) lgkmcnt(0)" ::: "memory");
    DSA_ISSUE(8 * qlo); DSA_ISSUE(8 * qlo + 1); DSA_ISSUE(8 * qlo + 2);
#pragma unroll 1
    for (int qq = qlo; qq < qhi; ++qq) {
        const int rowq = row0 + qq, tq = t0 + qq, ns = nselL[qq];
        const unsigned short* selq = sel + qq * 256;
        h16x8 qf[4];
#pragma unroll
        for (int ks = 0; ks < 4; ++ks) {
            if (hv) qf[ks] = *(const h16x8*)(qk + (size_t)rowq * 1024 + c16 * 128 + 32 * ks + 8 * gq);
            else {
#pragma unroll
                for (int e = 0; e < 8; ++e) qf[ks][e] = (h16)0.f;
            }
        }
        float m_run = -INFINITY, l_run = 0.f;
        f32x4 ctx[8];
#pragma unroll
        for (int nt = 0; nt < 8; ++nt) ctx[nt] = (f32x4){0.f, 0.f, 0.f, 0.f};
#pragma unroll 1
        for (int c = 0; c < 8; ++c) {
            const int j = 8 * qq + c;
            DSA_ISSUE(j + 3);
            asm volatile("s_waitcnt vmcnt(27)" ::: "memory");
            const unsigned char* sl = ring + (j & 3) * SLOT_BYTES;
            h16x8 af[2][4];
#pragma unroll
            for (int mt = 0; mt < 2; ++mt)
#pragma unroll
                for (int ks = 0; ks < 4; ++ks) af[mt][ks] = *(const h16x8*)(sl + (16 * mt + c16) * 256 + (((4 * ks + gq) ^ c16) * 16));
            fp16x4 rt[2]; ushort4 sv[2];
#pragma unroll
            for (int mt = 0; mt < 2; ++mt) {
                rt[mt] = __builtin_amdgcn_ds_read_tr16_b64_v4f16((LAS fp16x4*)(sl + 8192 + (16 * mt + 4 * gq + (c16 >> 2)) * 16 + 8 * (c16 & 3)));
                sv[mt] = *(const ushort4*)(selq + 32 * c + 16 * mt + 4 * gq);
            }
            fp16x4 tb[8][2];
            { const int rw0 = 4 * gq + (c16 >> 2), rw1 = 16 + rw0;
#pragma unroll
              for (int nt = 0; nt < 8; ++nt) { const int pc = 2 * nt + ((c16 >> 1) & 1);
                tb[nt][0] = __builtin_amdgcn_ds_read_tr16_b64_v4f16((LAS fp16x4*)(sl + rw0 * 256 + ((pc ^ (rw0 & 15)) * 16) + 8 * (c16 & 1)));
                tb[nt][1] = __builtin_amdgcn_ds_read_tr16_b64_v4f16((LAS fp16x4*)(sl + rw1 * 256 + ((pc ^ (rw1 & 15)) * 16) + 8 * (c16 & 1))); } }
            f32x4 s4[2];
#pragma unroll
            for (int mt = 0; mt < 2; ++mt) { s4[mt] = (f32x4){0.f, 0.f, 0.f, 0.f};
#pragma unroll
                for (int ks = 0; ks < 4; ++ks) s4[mt] = MFMA16(af[mt][ks], qf[ks], s4[mt]); }
            int dist[2][4]; int dmin = 127;
#pragma unroll
            for (int mt = 0; mt < 2; ++mt) { const int sarr[4] = {(int)sv[mt].x, (int)sv[mt].y, (int)sv[mt].z, (int)sv[mt].w};
#pragma unroll
                for (int r = 0; r < 4; ++r) { int d = tq - sarr[r]; d = d < 0 ? 0 : (d > 127 ? 127 : d); dist[mt][r] = d; dmin = d < dmin ? d : dmin; } }
            float bias[2][4];
            if (__all(dmin == 127)) {
#pragma unroll
                for (int mt = 0; mt < 2; ++mt)
#pragma unroll
                    for (int r = 0; r < 4; ++r) bias[mt][r] = b31;
            } else {
#pragma unroll
                for (int mt = 0; mt < 2; ++mt)
#pragma unroll
                    for (int r = 0; r < 4; ++r) bias[mt][r] = biasd[dist[mt][r] * 8 + (c16 & 7)];
            }
            float lg[2][4]; float mx = -INFINITY;
#pragma unroll
            for (int mt = 0; mt < 2; ++mt) { const h16x4 rr = __builtin_bit_cast(h16x4, rt[mt]);
#pragma unroll
                for (int r = 0; r < 4; ++r) {
                    const int kidx = 32 * c + 16 * mt + 4 * gq + r; const bool valid = hv && (kidx < ns);
                    const float v = valid ? s4[mt][r] * (float)rr[r] + bias[mt][r] : -INFINITY;
                    lg[mt][r] = v; mx = fmaxf(mx, v);
                } }
            {
                const unsigned u0 = __float_as_uint(mx);
                const auto p16 = __builtin_amdgcn_permlane16_swap(u0, u0, false, false);
                const float y = fmaxf(__uint_as_float(p16[0]), __uint_as_float(p16[1]));
                const unsigned u1 = __float_as_uint(y);
                const auto p32 = __builtin_amdgcn_permlane32_swap(u1, u1, false, false);
                mx = fmaxf(__uint_as_float(p32[0]), __uint_as_float(p32[1]));
            }
            const float m_new = fmaxf(m_run, mx);
            const float alpha = (hv && m_new > -INFINITY) ? __expf(m_run - m_new) : 1.f;
            float rs = 0.f; float pp[2][4];
#pragma unroll
            for (int mt = 0; mt < 2; ++mt)
#pragma unroll
                for (int r = 0; r < 4; ++r) { const float p = (hv && lg[mt][r] > -INFINITY) ? __expf(lg[mt][r] - m_new) : 0.f; pp[mt][r] = p; rs += p; }
            {
                const unsigned u0 = __float_as_uint(rs);
                const auto p16 = __builtin_amdgcn_permlane16_swap(u0, u0, false, false);
                const float y = __uint_as_float(p16[0]) + __uint_as_float(p16[1]);
                const unsigned u1 = __float_as_uint(y);
                const auto p32 = __builtin_amdgcn_permlane32_swap(u1, u1, false, false);
                rs = __uint_as_float(p32[0]) + __uint_as_float(p32[1]);
            }
            l_run = l_run * alpha + rs; m_run = m_new;
            h16x8 pa;
#pragma unroll
            for (int jx = 0; jx < 8; ++jx) pa[jx] = (h16)pp[jx >> 2][jx & 3];
            if (__any(alpha != 1.f)) {
                float ar[4];
#pragma unroll
                for (int r = 0; r < 4; ++r) ar[r] = __shfl(alpha, 4 * gq + r);
#pragma unroll
                for (int nt = 0; nt < 8; ++nt)
#pragma unroll
                    for (int r = 0; r < 4; ++r) ctx[nt][r] *= ar[r];
            }
#pragma unroll
            for (int nt = 0; nt < 8; ++nt) {
                const h16x4 b0 = __builtin_bit_cast(h16x4, tb[nt][0]), b1 = __builtin_bit_cast(h16x4, tb[nt][1]);
                h16x8 bf; bf[0] = b0[0]; bf[1] = b0[1]; bf[2] = b0[2]; bf[3] = b0[3]; bf[4] = b1[0]; bf[5] = b1[1]; bf[6] = b1[2]; bf[7] = b1[3];
                ctx[nt] = MFMA16(pa, bf, ctx[nt]);
            }
        }
        float li[4];
#pragma unroll
        for (int r = 0; r < 4; ++r) li[r] = 1.f / __shfl(l_run, (4 * gq + r) & 7);
        if (gq < 2) {
#pragma unroll
            for (int nt = 0; nt < 8; ++nt)
#pragma unroll
                for (int r = 0; r < 4; ++r) ctxb[(size_t)rowq * 1024 + (4 * gq + r) * 128 + 16 * nt + c16] = (h16)(ctx[nt][r] * li[r]);
        }
    }
    asm volatile("s_waitcnt vmcnt(0)" ::: "memory");
    }
#undef DSA_ISSUE
    WAVE_FENCE();
    TSEC_END(4);
}

__device__ __forceinline__ void phase3(const Params& P, int l, unsigned char* lds) {
    const int tid = opaque_tid(), lane = tid & 63, w = tid >> 6;
    float* biasd = (float*)(lds + 4 * WL_BYTES);
    __syncthreads();
    for (int i = tid; i < 1024; i += NTHREADS) biasd[i] = P.rel[(int)c_bucket[i >> 3] * 8 + (i & 7)];
    __syncthreads();
    { TSEC_BEGIN(10)
    for (int rep_ = 0; rep_ <= PROBE_SCAN2; ++rep_) for (int sw = blockIdx.x; sw < 8 * (8 / SNT); sw += gridDim.x) gdn_scan(P, sw, lds);
    TSEC_END(10); }
    __syncthreads();
    unsigned* ctr = (unsigned*)(P.ws + OFF_CTL) + 4608 + l * 128;
    unsigned char* wl = lds + w * WL_BYTES;
    const int x0 = (int)xb_xcc_id() & 7; int d = 0;
    for (;;) {
        int item = -1;
        if (lane == 0) {
            while (d < 8) {
                const int xc = (x0 + d) & 7; const int bb = xc >> 2, sub = xc & 3; const int cnt = (1026 - sub + 3) >> 2;
                const int pf = 230;
                const int t = (int)__hip_atomic_fetch_add(ctr + xc * 16, 1u, __ATOMIC_RELAXED, __HIP_MEMORY_SCOPE_AGENT);
                if (t < pf + 2 * (cnt - pf)) {
                    const int p = t < pf ? t : pf + ((t - pf) >> 1);
                    item = (bb * 1026 + 4 * (cnt - 1 - p) + sub) * 4 + (t < pf ? 0 : 1 + ((t - pf) & 1));
                    break;
                }
                ++d;
            }
        }
        d = __builtin_amdgcn_readfirstlane(d);
        item = __builtin_amdgcn_readfirstlane(item);
        if (item < 0) break;
        { const int hsel = item & 3; dsa_item(P, item >> 2, hsel == 2 ? 4 : 0, hsel == 1 ? 4 : 8, wl, biasd, lane); }
    }
}

__device__ __forceinline__ void phase4(const Params& P, int l, unsigned char* lds) {
    const int tid = opaque_tid(), lane = tid & 63, w = tid >> 6;
    (void)lds;
    if (l == 0 && (int)gridDim.x > 160 && (int)blockIdx.x >= 129) { prep_tiles(P, lds, 1, 129, (int)gridDim.x - 129); return; }
    TSEC_BEGIN(11)
    for (int it = blockIdx.x * 4 + w; it < (NT + 31) / 32; it += gridDim.x * 4) p4_item(P, l, it, lane);
    TSEC_END(11);
    if (l == 0 && (int)gridDim.x <= 160) { __syncthreads(); prep_tiles(P, lds, 1, 0, (int)gridDim.x); }
}

__device__ __forceinline__ void phase5(const Params& P, int l, unsigned char* lds) {
    h16* smem = (h16*)lds;
    const h16* W = (const h16*)(P.ws + OFF_WOT) + (size_t)l * 1024 * 1024;
    const h16* A = (const h16*)(P.ws + OFF_OMIX);
    float* sumsq_next = (float*)(P.ws + OFF_SUMSQ) + NTP;
    XcdQueue xq; xq.init((unsigned*)(P.ws + OFF_CTL) + 4352 + l * 128, 32, (int*)(lds + LDS_BYTES - 32));
    int xl, qi;
    while (xq.next(xl, qi)) {
        const int rb = 8 * xl + (qi & 7), tn = qi >> 3;
        EpiResBig ep; ep.layer = l; ep.row0 = rb * 256; ep.n0 = tn * 256; ep.meta = P.meta; ep.x = P.x; ep.metah = (float*)(P.ws + OFF_METAH); ep.out = P.out; ep.h16o = (h16*)(P.ws + OFF_H16); ep.sumsq_next = sumsq_next; ep.ss = 0.f; ep.nseg = 4;
        gemm_big(A + (size_t)rb * 256 * 1024, 1024, W + (size_t)tn * 256 * 1024, 1024, 1024, ep, smem);
    }
    __syncthreads();
    const int tid = opaque_tid();
    for (int it = blockIdx.x; it < 32; it += gridDim.x) {
        EpiResBig ep; ep.layer = l; ep.row0 = 16384; ep.n0 = it * 32; ep.meta = P.meta; ep.x = P.x; ep.metah = (float*)(P.ws + OFF_METAH); ep.out = P.out; ep.h16o = (h16*)(P.ws + OFF_H16); ep.sumsq_next = sumsq_next; ep.ss = 0.f; ep.nseg = 1;
        skinny_tile(A + (size_t)16384 * 1024, 1024, W + (size_t)it * 32 * 1024, 1024, 1024, ep, (float*)lds, tid);
    }
}

__global__ void __launch_bounds__(NTHREADS) hybrid_fwd(Params P) {
    extern __shared__ __attribute__((aligned(16))) unsigned char lds[];
    cg::grid_group grid = cg::this_grid();
    volatile LAS unsigned* bst = (volatile LAS unsigned*)(lds + LDS_BYTES - 16);
    if (threadIdx.x < 4) bst[threadIdx.x] = 0u;
    if (PROBE_TSEC && (threadIdx.x & 63) == 0) *tsec_slot() = 0ull;
    __syncthreads();
    XcdBarrier xbar = xcd_barrier_post((unsigned*)(P.ws + OFF_CTL) + 256, bst);
    if (PROBE_MFMA) {
        f32x16 pa[8]; h16x8 fa, fb;
#pragma unroll
        for (int e = 0; e < 8; ++e) { fa[e] = (h16)(0.001f * (threadIdx.x & 7)); fb[e] = (h16)0.5f; }
#pragma unroll
        for (int i = 0; i < 8; ++i)
#pragma unroll
            for (int r = 0; r < 16; ++r) pa[i][r] = 0.f;
        h16* lp = (h16*)lds + (threadIdx.x & 31) * 72 + 8 * ((threadIdx.x >> 5) & 1) + (threadIdx.x >> 6) * 2304;
#pragma unroll 1
        for (int it = 0; it < 256; ++it) {
            if (PROBE_MFMA == 2) {
                h16x8 t[8];
#pragma unroll
                for (int q = 0; q < 8; ++q) t[q] = *(const h16x8*)(lp + q * 32 * 72 + (it & 3) * 16);
#pragma unroll
                for (int q = 0; q < 4; ++q) *(h16x8*)(lp + 40000 + q * 32 * 72) = fb;
#pragma unroll
                for (int i = 0; i < 16; ++i) pa[i & 7] = MFMA32(t[i & 7], fb, pa[i & 7]);
#pragma unroll
                for (int q = 0; q < 12; ++q) { __builtin_amdgcn_sched_group_barrier(0x8, 1, 0); __builtin_amdgcn_sched_group_barrier(0x300, 1, 0); }
                __builtin_amdgcn_sched_group_barrier(0x8, 4, 0);
                __builtin_amdgcn_sched_barrier(0);
            } else {
#pragma unroll
                for (int i = 0; i < 16; ++i) pa[i & 7] = MFMA32(fa, fb, pa[i & 7]);
            }
        }
        float sacc = 0.f;
#pragma unroll
        for (int i = 0; i < 8; ++i) sacc += pa[i][0];
        if (sacc == 12345.678f) ((float*)(P.ws + OFF_CTL))[40] = sacc;
    }
    for (int ph = P.ph_lo; ph < P.ph_hi; ++ph) {
#ifndef ONLY
#define ONLY -1
#endif
        if (ph == 0) { TSEC_BEGIN(13) if (ONLY < 0 || ((ONLY >> 0) & 1)) for (int rep_ = 0; rep_ <= PROBE_P0X; ++rep_) phase_prep(P, lds); TSEC_END(13); }
        else {
            const int l = (ph - 1) / 5, s = (ph - 1) % 5;
            if (s == 0) { if (ONLY < 0 || ((ONLY >> 1) & 1)) for (int rep_ = 0; rep_ <= PROBE_P1X; ++rep_) phase_inproj(P, l, lds, rep_); }
            else if (s == 1) { if (ONLY < 0 || ((ONLY >> 2) & 1)) phase2(P, l, lds); }
            else if (s == 2) { if (ONLY < 0 || ((ONLY >> 3) & 1)) phase3(P, l, lds); }
            else if (s == 3) { if (ONLY < 0 || ((ONLY >> 4) & 1)) for (int rep_ = 0; rep_ <= PROBE_P4X; ++rep_) phase4(P, l, lds); }
            else { if (ONLY < 0 || ((ONLY >> 5) & 1)) for (int rep_ = 0; rep_ <= (l == 0 ? PROBE_P5L0X : 0); ++rep_) phase5(P, l, lds); }
        }
        if (ph + 1 < P.ph_hi) {
            if (P.ph_hi > 1000) grid.sync();
            { TSEC_BEGIN(20) if (PROBE_TSEC >= 20 && PROBE_TSEC - 20 == ph) t__20 = wall_clock64(); xcd_barrier(xbar); if (PROBE_TSEC >= 20 && PROBE_TSEC - 20 == ph) { const unsigned long long d__ = wall_clock64() - t__20; if ((threadIdx.x & 63) == 0) *tsec_slot() += d__; } }
            if (PROBE_SYNC) xcd_barrier(xbar);
        }
    }
    if (PROBE_TSEC) {
        unsigned long long* acc = (unsigned long long*)((unsigned*)(P.ws + OFF_CTL) + 32);
        __syncthreads();
        if ((threadIdx.x & 63) == 0) atomicAdd(acc, *tsec_slot());
        xcd_barrier(xbar);
        if (blockIdx.x == 0 && threadIdx.x == 0) {
            const unsigned long long tot = __hip_atomic_load(acc, __ATOMIC_RELAXED, __HIP_MEMORY_SCOPE_AGENT);
            const unsigned long long avg = tot / (gridDim.x * 4);
            const unsigned long long t0 = wall_clock64();
            while (wall_clock64() - t0 < avg) __builtin_amdgcn_s_sleep(4);
        }
    }
}

extern "C" void kernel_launch(void* const* d_in, const int* in_sizes, int n_in, void* d_out, int out_size, void* d_ws, size_t ws_size, hipStream_t stream) {
    static int grid_blocks = 0;
    if (grid_blocks == 0) {
        if (n_in != 17 || ws_size < WS_END) { fprintf(stderr, "kernel_launch: unexpected inputs (n_in %d, ws %zu < %zu)\n", n_in, ws_size, (size_t)WS_END); grid_blocks = -1; return; }
        int dev = 0, cus = 0, per_cu = 0;
        hipGetDevice(&dev);
        hipDeviceGetAttribute(&cus, hipDeviceAttributeMultiprocessorCount, dev);
        if (hipFuncSetAttribute((const void*)hybrid_fwd, hipFuncAttributeMaxDynamicSharedMemorySize, LDS_BYTES) != hipSuccess) { fprintf(stderr, "kernel_launch: hipFuncSetAttribute failed\n"); grid_blocks = -1; return; }
        hipOccupancyMaxActiveBlocksPerMultiprocessor(&per_cu, (const void*)hybrid_fwd, NTHREADS, LDS_BYTES);
        if (per_cu < 1) { fprintf(stderr, "kernel_launch: occupancy query says 0 blocks per CU\n"); grid_blocks = -1; return; }
        grid_blocks = cus * per_cu;
    }
    if (grid_blocks < 0) return;
    hipMemsetAsync((char*)d_ws + OFF_CTL, 0, 32768, stream);
    hipMemsetAsync((char*)d_ws + OFF_SUMSQ, 0, (size_t)2 * NTP * 4, stream);
    Params p{};
    p.x = (const float*)d_in[0]; p.meta = (const float*)d_in[1]; p.rel = (const float*)d_in[2]; p.norm_gain = (const float*)d_in[3];
    p.w_in = (const float*)d_in[4]; p.g_cq = (const float*)d_in[5]; p.g_ckv = (const float*)d_in[6]; p.w_uq = (const float*)d_in[7];
    p.w_ukv = (const float*)d_in[8]; p.w_qidx = (const float*)d_in[9]; p.g_qn = (const float*)d_in[10]; p.g_kn = (const float*)d_in[11];
    p.conv_w = (const float*)d_in[12]; p.a_log = (const float*)d_in[13]; p.dt_bias = (const float*)d_in[14]; p.g_out = (const float*)d_in[15];
    p.w_out = (const float*)d_in[16];
    p.out = (float*)d_out; p.ws = (unsigned char*)d_ws;
#if N_LAUNCH_MODE == 1
    p.ph_lo = 0; p.ph_hi = NPHASE;
    void* args[] = {&p};
    hipError_t e = hipLaunchCooperativeKernel((const void*)hybrid_fwd, dim3(grid_blocks), dim3(NTHREADS), args, LDS_BYTES, stream);
    if (e != hipSuccess) fprintf(stderr, "cooperative launch failed: %s (grid %d)\n", hipGetErrorString(e), grid_blocks);
#else
    for (int ph = 0; ph < NPHASE; ++ph) {
        p.ph_lo = ph; p.ph_hi = ph + 1;
        hipLaunchKernelGGL(hybrid_fwd, dim3(grid_blocks), dim3(NTHREADS), LDS_BYTES, stream, p);
    }
#endif
}
```

```cpp
#include <hip/hip_runtime.h>
#include <hip/hip_cooperative_groups.h>
#include <stdio.h>
#include <stdint.h>
namespace cg = cooperative_groups;

#define PROBE_TOPK2 0
#define PROBE_ATT2 0
#define PROBE_P1X 0
#define PROBE_P2X 0
#define PROBE_SCAN2 0
#define PROBE_P4X 0
#define PROBE_P0X 0
#define PROBE_P5L0X 0
#define PROBE_SYNC 0
#define PROBE_SWEEP 0
#define PROBE_P2C 0
#define PROBE_CHAIN 0
#define PROBE_MFMA 0
#define PROBE_TSEC 0
#define PROBE_S1 0
#define PROBE_S3 0
#define PROBE_S5 0
#ifndef N_LAUNCH_MODE
#define N_LAUNCH_MODE 1
#endif

typedef _Float16 h16;
typedef h16 h16x8 __attribute__((ext_vector_type(8)));
typedef h16 h16x4 __attribute__((ext_vector_type(4)));
typedef float f32x4 __attribute__((ext_vector_type(4)));
typedef float f32x16 __attribute__((ext_vector_type(16)));
typedef unsigned long long u64;
typedef __fp16 fp16x4 __attribute__((__vector_size__(4 * sizeof(__fp16))));

#define MFMA32(a, b, c) __builtin_amdgcn_mfma_f32_32x32x16_f16(a, b, c, 0, 0, 0)
#define MFMA16(a, b, c) __builtin_amdgcn_mfma_f32_16x16x32_f16(a, b, c, 0, 0, 0)
#define WAVE_FENCE() do { __builtin_amdgcn_fence(__ATOMIC_SEQ_CST, "wavefront"); __builtin_amdgcn_wave_barrier(); } while (0)

constexpr int T_ = 8208;
constexpr int NT = 16416;
constexpr int NTP = 16512;
constexpr int NRB = 129;
constexpr int NCH = 129;
constexpr int NGI = 8 * NCH;
constexpr int NKT = 257;
constexpr float EPS = 1e-6f;
constexpr int NTHREADS = 256;
constexpr int LDS_BYTES = 163840;
constexpr int NPHASE = 11;

constexpr size_t OFF_CTL = 0;
constexpr size_t OFF_W1T = 32768;
constexpr size_t OFF_WOT = OFF_W1T + (size_t)2 * 3072 * 1024 * 2;
constexpr size_t OFF_WQ2T = OFF_WOT + (size_t)2 * 1024 * 1024 * 2;
constexpr size_t OFF_WUKT = OFF_WQ2T + (size_t)2 * 768 * 256 * 2;
constexpr size_t OFF_WKABS = OFF_WUKT + (size_t)2 * 512 * 128 * 2;
constexpr size_t OFF_WUVT = OFF_WKABS + (size_t)2 * 8 * 128 * 64 * 2;
constexpr size_t OFF_SMALL = OFF_WUVT + (size_t)2 * 8 * 64 * 128 * 2;
constexpr size_t OFF_SZA = OFF_SMALL + (size_t)NTP * 16 * 4;
constexpr size_t OFF_SZG = OFF_SZA + (size_t)NTP * 512 * 2;
constexpr size_t OFF_PROJG = OFF_SZG + (size_t)NTP * 512 * 2;
constexpr size_t OFF_PROJA = OFF_PROJG + (size_t)NTP * 1536 * 2;
constexpr size_t OFF_QIDX = OFF_PROJA + (size_t)NTP * 512 * 2;
constexpr size_t OFF_QN = OFF_QIDX + (size_t)NTP * 256 * 2;
constexpr size_t OFF_QK = OFF_QN + (size_t)NTP * 512 * 2;
constexpr size_t OFF_KVROW = OFF_QK + (size_t)NTP * 1024 * 2;
constexpr size_t OFF_KFRAG = OFF_KVROW + (size_t)NTP * 136 * 2;
constexpr size_t OFF_U = OFF_KFRAG + (size_t)2 * NKT * 2048 * 2;
constexpr size_t OFF_WM = OFF_U + (size_t)NGI * 8192 * 2;
constexpr size_t OFF_QD = OFF_WM + (size_t)NGI * 8192 * 2;
constexpr size_t OFF_KDT = OFF_QD + (size_t)NGI * 8192 * 2;
constexpr size_t OFF_AQK = OFF_KDT + (size_t)NGI * 8192 * 2;
constexpr size_t OFF_CDEC = OFF_AQK + (size_t)NGI * 4096 * 2;
constexpr size_t OFF_METAH = OFF_CDEC + 8192;
constexpr size_t OFF_SUMSQ = OFF_METAH + (size_t)2 * 16 * 1024 * 4;
constexpr size_t WS_END = OFF_SUMSQ + (size_t)2 * NTP * 4;
constexpr size_t OFF_H16 = OFF_QK;
constexpr size_t OFF_CTX = OFF_PROJG;
constexpr size_t OFF_OMIX = OFF_PROJG + (size_t)NTP * 1024 * 2;

struct Params {
    const float* x; const float* meta; const float* rel; const float* norm_gain; const float* w_in;
    const float* g_cq; const float* g_ckv; const float* w_uq; const float* w_ukv; const float* w_qidx;
    const float* g_qn; const float* g_kn; const float* conv_w; const float* a_log; const float* dt_bias;
    const float* g_out; const float* w_out;
    float* out; unsigned char* ws;
    int ph_lo, ph_hi;
};

__constant__ unsigned char c_bucket[128] = {
    0, 1, 2, 3, 4, 5, 6, 7, 8, 9, 10, 11, 12, 13, 14, 15, 16, 16, 16, 17, 17, 18, 18, 18, 19, 19, 19, 20, 20, 20, 20, 21,
    21, 21, 21, 22, 22, 22, 22, 22, 23, 23, 23, 23, 23, 23, 24, 24, 24, 24, 24, 24, 25, 25, 25, 25, 25, 25, 25, 26, 26, 26, 26, 26,
    26, 26, 26, 27, 27, 27, 27, 27, 27, 27, 27, 27, 27, 28, 28, 28, 28, 28, 28, 28, 28, 28, 28, 29, 29, 29, 29, 29, 29, 29, 29, 29,
    29, 29, 29, 30, 30, 30, 30, 30, 30, 30, 30, 30, 30, 30, 30, 30, 30, 31, 31, 31, 31, 31, 31, 31, 31, 31, 31, 31, 31, 31, 31, 31};

__device__ __forceinline__ unsigned long long* tsec_slot() { extern __shared__ __attribute__((aligned(16))) unsigned char tsec_lds__[]; return (unsigned long long*)(tsec_lds__ + LDS_BYTES - 128) + (threadIdx.x >> 6); }
#define TSEC_BEGIN(id) unsigned long long t__##id = 0; if (PROBE_TSEC == (id)) t__##id = wall_clock64();
#define TSEC_END(id) do { if (PROBE_TSEC == (id)) { const unsigned long long d__ = wall_clock64() - t__##id; if ((threadIdx.x & 63) == 0) *tsec_slot() += d__; } } while (0)
__device__ __forceinline__ float silu_f(float x) { return x * __builtin_amdgcn_rcpf(1.f + __expf(-x)); }
__device__ __forceinline__ int lanes_below(u64 m) { return __builtin_amdgcn_mbcnt_hi((unsigned)(m >> 32), __builtin_amdgcn_mbcnt_lo((unsigned)m, 0)); }
__device__ __forceinline__ int lanes_below_from(u64 m, int base) { return __builtin_amdgcn_mbcnt_hi((unsigned)(m >> 32), __builtin_amdgcn_mbcnt_lo((unsigned)m, base)); }
__device__ __forceinline__ float relu1(float x) { const int i = __float_as_int(x); return __int_as_float(i > 0 ? i : 0); }
__device__ __forceinline__ unsigned ordkey(float f) { unsigned u = __float_as_uint(f); return (u & 0x80000000u) ? ~u : (u | 0x80000000u); }
__device__ __forceinline__ float ordinv(unsigned k) { unsigned u = (k & 0x80000000u) ? (k & 0x7fffffffu) : ~k; return __uint_as_float(u); }
__device__ __forceinline__ int opaque_tid() { int t = threadIdx.x; asm volatile("" : "+v"(t)); return t; }
__device__ __forceinline__ void lds_barrier() { asm volatile("s_waitcnt lgkmcnt(0)\n\ts_barrier" ::: "memory"); }

#define XB_TMO      128
#define XB_XCNT(j)  (256  + 64 * (j))
#define XB_XSUB(j)  (1280 + 64 * (j))
#define XB_XGEN(j)  (2304 + 64 * (j))
#define XB_TOP      3328
#define XB_TOPGEN   3392
#define XCD_BAR_WORDS 3456
#define XB_SPIN_CAP (1u << 22)
#define LAS __attribute__((address_space(3)))
__device__ __forceinline__ unsigned xb_ld(unsigned* p)              { return __hip_atomic_load(p, __ATOMIC_RELAXED, __HIP_MEMORY_SCOPE_AGENT); }
__device__ __forceinline__ unsigned xb_add(unsigned* p, unsigned v) { return __hip_atomic_fetch_add(p, v, __ATOMIC_RELAXED, __HIP_MEMORY_SCOPE_AGENT); }
__device__ __forceinline__ unsigned xb_xcc_id() { return (unsigned)__builtin_amdgcn_s_getreg((3 << 11) | 20) & 0xFu; }
#define XB_SPIN(cond, bar) do { unsigned _sp = 0; while (cond) { __builtin_amdgcn_s_sleep(1); \
    if ((++_sp & 255u) == 0u) { if (xb_ld(&(bar)[XB_TMO])) break; if (_sp > XB_SPIN_CAP) { atomicAdd(&(bar)[XB_TMO], 1u); break; } } } } while (0)
struct XcdBarrier { unsigned* bar; unsigned x; volatile LAS unsigned* st; };
__device__ __forceinline__ XcdBarrier xcd_barrier_post(unsigned* bar, volatile LAS unsigned* st) {
    XcdBarrier b; b.bar = bar; b.x = xb_xcc_id(); b.st = st;
    if (threadIdx.x == 0) (void)xb_add(&bar[XB_XCNT(b.x)], 1u);
    return b;
}
__device__ __forceinline__ void xcd_barrier_complete(unsigned* bar, unsigned x, unsigned& nloc, unsigned& nx) {
    const unsigned G = gridDim.x * gridDim.y * gridDim.z;
    unsigned sum, cnt, mine, sp = 0u;
    for (;;) {
        sum = 0u; cnt = 0u; mine = 0u;
#pragma unroll
        for (unsigned j = 0; j < 16; ++j) { const unsigned c = xb_ld(&bar[XB_XCNT(j)]); sum += c; cnt += (c > 0u) ? 1u : 0u; mine = (j == x) ? c : mine; }
        if (sum == G) break;
        __builtin_amdgcn_s_sleep(1);
        if ((++sp & 255u) == 0u) { if (xb_ld(&bar[XB_TMO])) break; if (sp > XB_SPIN_CAP) { atomicAdd(&bar[XB_TMO], 1u); break; } }
    }
    nloc = mine > 0u ? mine : 1u; nx = cnt > 0u ? cnt : 1u;
}
__device__ __forceinline__ void xcd_barrier(const XcdBarrier& b) {
    TSEC_BEGIN(5)
    asm volatile("s_waitcnt vmcnt(0)" ::: "memory");
    __syncthreads();
    if (threadIdx.x == 0) {
        unsigned* bar = b.bar;
        __builtin_amdgcn_s_waitcnt(0);
        unsigned nloc = b.st[0], nx = b.st[1];
        if (nloc == 0u) { xcd_barrier_complete(bar, b.x, nloc, nx); b.st[0] = nloc; b.st[1] = nx; }
        const unsigned old = xb_add(&bar[XB_XSUB(b.x)], 1u);
        const unsigned gen = old / nloc;
        if (old + 1u == (gen + 1u) * nloc) {
            __builtin_amdgcn_fence(__ATOMIC_RELEASE, "agent");
            asm volatile("s_waitcnt vmcnt(0)" ::: "memory");
            const unsigned og = xb_add(&bar[XB_TOP], 1u);
            const unsigned tg = og / nx;
            if (og + 1u == (tg + 1u) * nx) xb_add(&bar[XB_TOPGEN], 1u);
            else XB_SPIN(xb_ld(&bar[XB_TOPGEN]) == tg, bar);
            __builtin_amdgcn_fence(__ATOMIC_ACQUIRE, "agent");
            xb_add(&bar[XB_XGEN(b.x)], 1u);
            asm volatile("s_waitcnt vmcnt(0)" ::: "memory");
        } else {
            XB_SPIN(xb_ld(&bar[XB_XGEN(b.x)]) == gen, bar);
            __builtin_amdgcn_fence(__ATOMIC_ACQUIRE, "agent");
            asm volatile("s_waitcnt vmcnt(0)" ::: "memory");
        }
    }
    __syncthreads();
    TSEC_END(5);
}

struct XcdQueue {
    unsigned* ctr; int n_per; int x0; int d; int* slot;
    __device__ __forceinline__ void init(unsigned* c, int np, int* s) { ctr = c; n_per = np; x0 = (int)xb_xcc_id() & 7; d = 0; slot = s; }
    __device__ __forceinline__ bool next(int& xl, int& q) {
        __syncthreads();
        if (threadIdx.x == 0) {
            int res = -1;
            while (d < 8) {
                const int xc = (x0 + d) & 7;
                const unsigned t = __hip_atomic_fetch_add(ctr + xc * 16, 1u, __ATOMIC_RELAXED, __HIP_MEMORY_SCOPE_AGENT);
                if ((int)t < n_per) { res = xc * 65536 + (int)t; break; }
                ++d;
            }
            *slot = res;
        }
        __syncthreads();
        const int r = *slot;
        if (r < 0) return false;
        xl = r >> 16; q = r & 65535;
        return true;
    }
};

constexpr int GS = 72;

struct AF16 {
    const h16* p; int ld;
    __device__ __forceinline__ void init(int) {}
    __device__ __forceinline__ h16x8 load(int i, int row, int k) { return *(const h16x8*)(p + (size_t)row * ld + k); }
};

struct AH32 {
    const float* meta; const float* xs; int meta_bstride;
    const float* rp[4]; float ss[4];
    __device__ __forceinline__ const float* rowptr(int row) const {
        row = row < NT ? row : NT - 1;
        int b = row >= T_ ? 1 : 0; int t = row - b * T_;
        return t < 16 ? meta + (size_t)b * meta_bstride + (size_t)t * 1024 : xs + ((size_t)b * 8192 + (t - 16)) * 1024;
    }
    __device__ __forceinline__ h16x8 load(int i, int, int k) {
        const float4 v0 = *(const float4*)(rp[i] + k), v1 = *(const float4*)(rp[i] + k + 4);
        ss[i] += v0.x * v0.x + v0.y * v0.y + v0.z * v0.z + v0.w * v0.w + v1.x * v1.x + v1.y * v1.y + v1.z * v1.z + v1.w * v1.w;
        h16x8 r; r[0] = (h16)v0.x; r[1] = (h16)v0.y; r[2] = (h16)v0.z; r[3] = (h16)v0.w; r[4] = (h16)v1.x; r[5] = (h16)v1.y; r[6] = (h16)v1.z; r[7] = (h16)v1.w;
        return r;
    }
};

template <int BN, class AL, class EP>
__device__ __forceinline__ void gemm_tile(AL& al, int arow0, const h16* __restrict__ Bt, int ldb, int K, EP& ep, h16* smem) {
    const int tid = opaque_tid(), lane = tid & 63, w = tid >> 6, wm = w >> 1, wn = w & 1;
    constexpr int NTL = BN / 64;
    constexpr int NBG = BN / 32;
    constexpr int BUF = (128 + BN) * GS;
    f32x16 acc[2][NTL];
#pragma unroll
    for (int i = 0; i < 2; ++i)
#pragma unroll
        for (int j = 0; j < NTL; ++j)
#pragma unroll
            for (int r = 0; r < 16; ++r) acc[i][j][r] = 0.f;
    h16x8 ra[4], rb[NBG];
    const int nk = K >> 6;
#pragma unroll
    for (int i = 0; i < 4; ++i) { int g = tid + 256 * i; ra[i] = al.load(i, arow0 + (g >> 3), (g & 7) * 8); }
#pragma unroll
    for (int i = 0; i < NBG; ++i) { int g = tid + 256 * i; rb[i] = *(const h16x8*)(Bt + (size_t)(g >> 3) * ldb + (g & 7) * 8); }
    __syncthreads();
#pragma unroll
    for (int i = 0; i < 4; ++i) { int g = tid + 256 * i; *(h16x8*)(smem + (g >> 3) * GS + (g & 7) * 8) = ra[i]; }
#pragma unroll
    for (int i = 0; i < NBG; ++i) { int g = tid + 256 * i; *(h16x8*)(smem + 128 * GS + (g >> 3) * GS + (g & 7) * 8) = rb[i]; }
    __syncthreads();
    for (int kt = 0; kt < nk; ++kt) {
        const int cur = kt & 1;
        const h16* sA = smem + cur * BUF;
        const h16* sB = sA + 128 * GS;
        if (kt + 1 < nk) {
            const int k0 = (kt + 1) << 6;
#pragma unroll
            for (int i = 0; i < 4; ++i) { int g = tid + 256 * i; ra[i] = al.load(i, arow0 + (g >> 3), k0 + (g & 7) * 8); }
#pragma unroll
            for (int i = 0; i < NBG; ++i) { int g = tid + 256 * i; rb[i] = *(const h16x8*)(Bt + (size_t)(g >> 3) * ldb + k0 + (g & 7) * 8); }
        }
#pragma unroll
        for (int ks = 0; ks < 4; ++ks) {
            h16x8 af[2], bf[NTL];
#pragma unroll
            for (int mt = 0; mt < 2; ++mt) af[mt] = *(const h16x8*)(sA + (64 * wm + 32 * mt + (lane & 31)) * GS + 16 * ks + 8 * (lane >> 5));
#pragma unroll
            for (int nt = 0; nt < NTL; ++nt) bf[nt] = *(const h16x8*)(sB + ((BN / 2) * wn + 32 * nt + (lane & 31)) * GS + 16 * ks + 8 * (lane >> 5));
#pragma unroll
            for (int mt = 0; mt < 2; ++mt)
#pragma unroll
                for (int nt = 0; nt < NTL; ++nt) acc[mt][nt] = MFMA32(af[mt], bf[nt], acc[mt][nt]);
        }
        if (kt + 1 < nk) {
            h16* dA = smem + (cur ^ 1) * BUF;
            h16* dB = dA + 128 * GS;
#pragma unroll
            for (int i = 0; i < 4; ++i) { int g = tid + 256 * i; *(h16x8*)(dA + (g >> 3) * GS + (g & 7) * 8) = ra[i]; }
#pragma unroll
            for (int i = 0; i < NBG; ++i) { int g = tid + 256 * i; *(h16x8*)(dB + (g >> 3) * GS + (g & 7) * 8) = rb[i]; }
        }
        __syncthreads();
    }
    ep.pre(al);
    float* ft = (float*)smem;
#pragma unroll
    for (int mt = 0; mt < 2; ++mt)
#pragma unroll
        for (int nt = 0; nt < NTL; ++nt)
#pragma unroll
            for (int r = 0; r < 16; ++r) {
                const int rl = 64 * wm + 32 * mt + (r & 3) + 8 * (r >> 2) + 4 * (lane >> 5);
                const int cl = (BN / 2) * wn + 32 * nt + (lane & 31);
                ft[rl * (BN + 1) + cl] = acc[mt][nt][r];
            }
    __syncthreads();
    if (EP::kSweep) {
#pragma unroll 4
        for (int idx = tid; idx < 128 * BN; idx += NTHREADS) {
            const int rl = idx / BN, cl = idx % BN;
            float q = ep(rl, cl, ft[rl * (BN + 1) + cl]);
            if (EP::kRowSum) {
#pragma unroll
                for (int d = 1; d < 64; d <<= 1) q += __shfl_xor(q, d);
                if (lane == 0) ep.rowsum(rl, q);
            }
        }
    }
}

constexpr int GS2 = 72;
template <class EP>
__device__ __forceinline__ void gemm_big(const h16* __restrict__ A, int lda, const h16* __restrict__ Bt, int ldb, int K, EP& ep, h16* smem) {
    const int tid = opaque_tid(), lane = tid & 63, w = tid >> 6, wm = w >> 1, wn = w & 1;
    constexpr int BUF = 512 * GS2;
    f32x16 acc[4][4];
    float zero_ = 0.f; asm volatile("" : "+v"(zero_));
#pragma unroll
    for (int i = 0; i < 4; ++i)
#pragma unroll
        for (int j = 0; j < 4; ++j)
#pragma unroll
            for (int r = 0; r < 16; ++r) acc[i][j][r] = zero_;
    h16x8 ra[2][8], rb[2][8];
    const int nk = K >> 6;
    const h16* ap = A + (size_t)(tid >> 3) * lda + (tid & 7) * 8;
    const h16* bp = Bt + (size_t)(tid >> 3) * ldb + (tid & 7) * 8;
    const int soff = (tid >> 3) * GS2 + (tid & 7) * 8;
#pragma unroll
    for (int i = 0; i < 8; ++i) { ra[0][i] = *(const h16x8*)(ap + (size_t)(32 * i) * lda); rb[0][i] = *(const h16x8*)(bp + (size_t)(32 * i) * ldb); }
#pragma unroll
    for (int i = 0; i < 8; ++i) { ra[1][i] = *(const h16x8*)(ap + (size_t)(32 * i) * lda + 64); rb[1][i] = *(const h16x8*)(bp + (size_t)(32 * i) * ldb + 64); }
    __syncthreads();
#pragma unroll
    for (int i = 0; i < 8; ++i) { *(h16x8*)(smem + soff + 32 * i * GS2) = ra[0][i]; *(h16x8*)(smem + 256 * GS2 + soff + 32 * i * GS2) = rb[0][i]; }
    __syncthreads();
#define BIG_STEP(CUR, KT) do { \
        const h16* sA = smem + (CUR) * BUF + (128 * wm + (lane & 31)) * GS2 + 8 * (lane >> 5); \
        const h16* sB = smem + (CUR) * BUF + 256 * GS2 + (128 * wn + (lane & 31)) * GS2 + 8 * (lane >> 5); \
        h16* dW = smem + ((CUR) ^ 1) * BUF;     \
        int k0 = ((KT) + 2) << 6; k0 = k0 < K ? k0 : K - 64; \
        h16x8 af[2][4], bf[2][4]; \
        _Pragma("unroll") for (int t = 0; t < 4; ++t) { af[0][t] = *(const h16x8*)(sA + 32 * t * GS2); bf[0][t] = *(const h16x8*)(sB + 32 * t * GS2); } \
        __builtin_amdgcn_sched_barrier(0); \
        _Pragma("unroll") for (int ks = 0; ks < 4; ++ks) { \
            if (ks < 3) { _Pragma("unroll") for (int t = 0; t < 4; ++t) { af[(ks + 1) & 1][t] = *(const h16x8*)(sA + 32 * t * GS2 + 16 * (ks + 1)); bf[(ks + 1) & 1][t] = *(const h16x8*)(sB + 32 * t * GS2 + 16 * (ks + 1)); } } \
            _Pragma("unroll") for (int i = 2 * ks; i < 2 * ks + 2; ++i) { *(h16x8*)(dW + soff + 32 * i * GS2) = ra[(CUR) ^ 1][i]; *(h16x8*)(dW + 256 * GS2 + soff + 32 * i * GS2) = rb[(CUR) ^ 1][i]; } \
            _Pragma("unroll") for (int i = 2 * ks; i < 2 * ks + 2; ++i) { ra[CUR][i] = *(const h16x8*)(ap + (size_t)(32 * i) * lda + k0); rb[CUR][i] = *(const h16x8*)(bp + (size_t)(32 * i) * ldb + k0); } \
            _Pragma("unroll") for (int mt = 0; mt < 4; ++mt) _Pragma("unroll") for (int nt = 0; nt < 4; ++nt) acc[mt][nt] = MFMA32(af[ks & 1][mt], bf[ks & 1][nt], acc[mt][nt]); \
              \
            _Pragma("unroll") for (int q = 0; q < 4; ++q) { \
                __builtin_amdgcn_sched_group_barrier(0x8, 1, 0); __builtin_amdgcn_sched_group_barrier(0x100, 1, 0); \
                __builtin_amdgcn_sched_group_barrier(0x8, 1, 0); __builtin_amdgcn_sched_group_barrier(0x100, 1, 0); \
                __builtin_amdgcn_sched_group_barrier(0x8, 1, 0); __builtin_amdgcn_sched_group_barrier(0x200, 1, 0); \
                __builtin_amdgcn_sched_group_barrier(0x8, 1, 0); __builtin_amdgcn_sched_group_barrier(0x20, 1, 0); } \
            __builtin_amdgcn_sched_barrier(0); } \
        __syncthreads(); } while (0)
    TSEC_BEGIN(8)
    for (int kt = 0; kt < nk; kt += 2) { BIG_STEP(0, kt); BIG_STEP(1, kt + 1); }
    TSEC_END(8);
    TSEC_BEGIN(9)
#undef BIG_STEP
    float* st = (float*)smem + w * 1152;
    const int prow = lane >> 1, pc0 = (lane & 1) * 16;
    ep.template prefetch<0>(128 * wm + prow, 128 * wn + pc0);
#pragma unroll
    for (int mt = 0; mt < 4; ++mt) {
        if (mt == 0) ep.template prefetch<1>(128 * wm + 32 + prow, 128 * wn + pc0);
        if (mt == 1) ep.template prefetch<0>(128 * wm + 64 + prow, 128 * wn + pc0);
        if (mt == 2) ep.template prefetch<1>(128 * wm + 96 + prow, 128 * wn + pc0);
        ep.row_begin();
#pragma unroll
        for (int nt = 0; nt < 4; ++nt) {
#pragma unroll
            for (int r = 0; r < 16; ++r) st[((r & 3) + 8 * (r >> 2) + 4 * (lane >> 5)) * 36 + (lane & 31)] = acc[mt][nt][r];
            WAVE_FENCE();
            float v[16];
#pragma unroll
            for (int q = 0; q < 4; ++q) { const float4 t4 = *(const float4*)(st + prow * 36 + pc0 + 4 * q); v[4 * q] = t4.x; v[4 * q + 1] = t4.y; v[4 * q + 2] = t4.z; v[4 * q + 3] = t4.w; }
            WAVE_FENCE();
            if (mt & 1) ep.template store16<1>(nt, 128 * wm + 32 * mt + prow, 128 * wn + 32 * nt + pc0, v);
            else ep.template store16<0>(nt, 128 * wm + 32 * mt + prow, 128 * wn + 32 * nt + pc0, v);
        }
        ep.row_end(128 * wm + 32 * mt + prow, lane);
    }
    TSEC_END(9);
}

template <class EP>
__device__ __forceinline__ void skinny_tile(const h16* __restrict__ A, int lda, const h16* __restrict__ Bt, int ldb, int K, EP& ep, float* st, int tid) {
    const int lane = tid & 63, w = tid >> 6;
    f32x16 acc;
#pragma unroll
    for (int r = 0; r < 16; ++r) acc[r] = 0.f;
    const int kq = K >> 2;
    const h16* ap = A + (size_t)(lane & 31) * lda + 8 * (lane >> 5) + w * kq;
    const h16* bp = Bt + (size_t)(lane & 31) * ldb + 8 * (lane >> 5) + w * kq;
    if (w == 0) ep.template prefetch<0>(lane >> 1, (lane & 1) * 16);
    for (int k0 = 0; k0 < kq; k0 += 128) {
        h16x8 af[8], bf[8];
#pragma unroll
        for (int u = 0; u < 8; ++u) { af[u] = *(const h16x8*)(ap + k0 + 16 * u); bf[u] = *(const h16x8*)(bp + k0 + 16 * u); }
#pragma unroll
        for (int u = 0; u < 8; ++u) acc = MFMA32(af[u], bf[u], acc);
    }
    __syncthreads();
    float* my = st + w * 1152;
#pragma unroll
    for (int r = 0; r < 16; ++r) my[((r & 3) + 8 * (r >> 2) + 4 * (lane >> 5)) * 36 + (lane & 31)] = acc[r];
    __syncthreads();
    if (w == 0) {
        const int prow = lane >> 1, pc0 = (lane & 1) * 16;
        ep.row_begin();
        float v[16];
#pragma unroll
        for (int q = 0; q < 4; ++q) {
            float4 t4 = *(const float4*)(st + prow * 36 + pc0 + 4 * q);
#pragma unroll
            for (int ww = 1; ww < 4; ++ww) { const float4 u4 = *(const float4*)(st + ww * 1152 + prow * 36 + pc0 + 4 * q); t4.x += u4.x; t4.y += u4.y; t4.z += u4.z; t4.w += u4.w; }
            v[4 * q] = t4.x; v[4 * q + 1] = t4.y; v[4 * q + 2] = t4.z; v[4 * q + 3] = t4.w;
        }
        ep.template store16<0>(0, prow, pc0, v);
        ep.row_end(prow, lane);
    }
}

struct EpiInProj {
    static constexpr bool kSweep = true; static constexpr bool kRowSum = false;
    int row0, n0; const float* rstd; h16* projA; float* small; h16* sza; h16* szg; h16* projG;
    template <class AL_> __device__ __forceinline__ void pre(AL_&) {}
    __device__ __forceinline__ float operator()(int rl, int cl, float v) const {
        const int row = row0 + rl; const float y = v * rstd[rl]; const int c = n0 + cl;
        if (c < 512) { if (c < 448) projA[(size_t)row * 512 + c] = (h16)y; else if (c < 460) small[(size_t)row * 16 + (c - 448)] = y; }
        else if (c < 1024) sza[(size_t)row * 512 + (c - 512)] = (h16)silu_f(y);
        else if (c < 2560) projG[(size_t)row * 1536 + (c - 1024)] = (h16)y;
        else szg[(size_t)row * 512 + (c - 2560)] = (h16)silu_f(y);
        return 0.f;
    }
    __device__ __forceinline__ void rowsum(int, float) const {}
};
struct EpiIn2 : EpiInProj {
    float* rstd_w; int tid; const float* sumsq;
    template <class AL_> __device__ __forceinline__ void pre(AL_&) {
        if (tid < 128) rstd_w[tid] = rsqrtf(sumsq[row0 + tid] * (1.f / 1024.f) + EPS);
        __syncthreads();
    }
};
struct EpiTileF32 {
    static constexpr bool kSweep = false; static constexpr bool kRowSum = false;
    template <class AL_> __device__ __forceinline__ void pre(AL_&) {}
    __device__ __forceinline__ float operator()(int, int, float) const { return 0.f; }
    __device__ __forceinline__ void rowsum(int, float) const {}
};
struct EpiStoreH {
    static constexpr bool kSweep = true; static constexpr bool kRowSum = false;
    h16* dst; int ld; int row0; const float* rs;
    template <class AL_> __device__ __forceinline__ void pre(AL_&) {}
    __device__ __forceinline__ float operator()(int rl, int cl, float v) const { dst[(size_t)(row0 + rl) * ld + cl] = (h16)(rs ? v * rs[rl] : v); return 0.f; }
    __device__ __forceinline__ void rowsum(int, float) const {}
};
struct EpiGate {
    static constexpr bool kSweep = true; static constexpr bool kRowSum = false;
    h16* dst; const h16* gate; int row0; int c0;
    template <class AL_> __device__ __forceinline__ void pre(AL_&) {}
    __device__ __forceinline__ float operator()(int rl, int cl, float v) const {
        const size_t row = row0 + rl;
        dst[row * 1024 + c0 + cl] = (h16)(v * (float)gate[row * 512 + c0 + cl]);
        return 0.f;
    }
    __device__ __forceinline__ void rowsum(int, float) const {}
};
struct EpiResid {
    static constexpr bool kSweep = true; static constexpr bool kRowSum = true;
    int layer; int row0; int n0; const float* meta; const float* x; float* metah; float* out; h16* h16o; float* sumsq_next;
    template <class AL_> __device__ __forceinline__ void pre(AL_&) {}
    __device__ __forceinline__ float operator()(int rl, int cl, float v) const {
        const int row = row0 + rl; if (row >= NT) return 0.f;
        const int b = row >= T_ ? 1 : 0; const int t = row - b * T_; const int c = n0 + cl;
        if (layer == 0) {
            float hn;
            if (t < 16) { hn = meta[(size_t)t * 1024 + c] + v; metah[((size_t)b * 16 + t) * 1024 + c] = hn; }
            else { const size_t o = ((size_t)b * 8192 + (t - 16)) * 1024 + c; hn = x[o] + v; out[o] = hn; }
            h16o[(size_t)row * 1024 + c] = (h16)hn;
            return hn * hn;
        } else {
            if (t >= 16) { const size_t o = ((size_t)b * 8192 + (t - 16)) * 1024 + c; out[o] = out[o] + v; }
            return 0.f;
        }
    }
    __device__ __forceinline__ void rowsum(int rl, float q) const { if (layer == 0 && row0 + rl < NT) atomicAdd(sumsq_next + row0 + rl, q); }
};

__device__ __forceinline__ void store16h(h16* dst, const float* v) {
    h16x8 a, b;
#pragma unroll
    for (int e = 0; e < 8; ++e) { a[e] = (h16)v[e]; b[e] = (h16)v[8 + e]; }
    *(h16x8*)dst = a; *(h16x8*)(dst + 8) = b;
}
struct EpiInBig {
    int row0, n0; const float* sumsq; h16* projA; float* small; h16* sza; h16* szg; h16* projG;
    float ssq[2];
    __device__ __forceinline__ void row_begin() {}
    __device__ __forceinline__ void row_end(int, int) {}
    template <int B> __device__ __forceinline__ void prefetch(int rl, int) { ssq[B] = sumsq[row0 + rl]; }
    template <int B> __device__ __forceinline__ void store16(int, int rl, int cl, const float* v) const {
        const int row = row0 + rl; const int c = n0 + cl;
        const float rs = rsqrtf(ssq[B] * (1.f / 1024.f) + EPS);
        float y[16];
#pragma unroll
        for (int e = 0; e < 16; ++e) y[e] = v[e] * rs;
        if (c < 512) {
            if (c < 448) store16h(projA + (size_t)row * 512 + c, y);
            else if (c == 448) {
#pragma unroll
                for (int e = 0; e < 12; ++e) small[(size_t)row * 16 + e] = y[e];
            }
        } else if (c < 1024) {
#pragma unroll
            for (int e = 0; e < 16; ++e) y[e] = silu_f(y[e]);
            store16h(sza + (size_t)row * 512 + (c - 512), y);
        } else if (c < 2560) store16h(projG + (size_t)row * 1536 + (c - 1024), y);
        else {
#pragma unroll
            for (int e = 0; e < 16; ++e) y[e] = silu_f(y[e]);
            store16h(szg + (size_t)row * 512 + (c - 2560), y);
        }
    }
};
struct EpiResBig {
    int layer, row0, n0; const float* meta; const float* x; float* metah; float* out; h16* h16o; float* sumsq_next; float ss; int nseg;
    float4 pf[2][4][4];
    __device__ __forceinline__ void row_begin() { ss = 0.f; }
    __device__ __forceinline__ void row_end(int rl, int lane) {
        if (layer == 0) { float q = ss; q += __shfl_xor(q, 1); if ((lane & 1) == 0) atomicAdd(sumsq_next + row0 + rl, q); }
    }
    __device__ __forceinline__ const float* srcp(int row, int c) const {
        const int b = row >= T_ ? 1 : 0; const int t = row - b * T_;
        if (layer == 0) return t < 16 ? meta + (size_t)t * 1024 + c : x + ((size_t)b * 8192 + (t - 16)) * 1024 + c;
        return out + ((size_t)b * 8192 + (t < 16 ? 0 : t - 16)) * 1024 + c;
    }
    template <int B> __device__ __forceinline__ void prefetch(int rl, int cl) {
        const float* src = srcp(row0 + rl, n0 + cl);
#pragma unroll
        for (int nt = 0; nt < 4; ++nt)
            if (nt < nseg) {
#pragma unroll
                for (int q = 0; q < 4; ++q) pf[B][nt][q] = *(const float4*)(src + 32 * nt + 4 * q);
            }
    }
    template <int B> __device__ __forceinline__ void store16(int nt, int rl, int cl, const float* v) {
        const int row = row0 + rl; const int c = n0 + cl;
        const int b = row >= T_ ? 1 : 0; const int t = row - b * T_;
        float* dst;
        if (layer == 0) dst = t < 16 ? metah + ((size_t)b * 16 + t) * 1024 + c : out + ((size_t)b * 8192 + (t - 16)) * 1024 + c;
        else { if (t < 16) return; dst = out + ((size_t)b * 8192 + (t - 16)) * 1024 + c; }
        float hn[16];
#pragma unroll
        for (int q = 0; q < 4; ++q) {
            const float4 hv = pf[B][nt][q];
            float4 o4; o4.x = hv.x + v[4 * q]; o4.y = hv.y + v[4 * q + 1]; o4.z = hv.z + v[4 * q + 2]; o4.w = hv.w + v[4 * q + 3];
            *(float4*)(dst + 4 * q) = o4;
            hn[4 * q] = o4.x; hn[4 * q + 1] = o4.y; hn[4 * q + 2] = o4.z; hn[4 * q + 3] = o4.w;
        }
        if (layer == 0) {
            store16h(h16o + (size_t)row * 1024 + c, hn);
#pragma unroll
            for (int e = 0; e < 16; ++e) ss += hn[e] * hn[e];
        }
    }
};

__device__ __forceinline__ int in_src_col(int n) {
    if (n < 452) return n;
    if (n < 456) return 3012 + (n - 452);
    if (n < 460) return 3016 + (n - 456);
    if (n < 512) return -1;
    if (n < 1024) return 452 + (n - 512);
    if (n < 2560) return 964 + (n - 1024);
    return 2500 + (n - 2560);
}
__device__ __forceinline__ float prep_get(const Params& P, int l, int job, int h, int n, int k) {
    switch (job) {
        case 0: { const int s = in_src_col(n); if (s < 0) return 0.f; return P.norm_gain[l * 1024 + k] * P.w_in[((size_t)l * 1024 + k) * 3020 + s]; }
        case 1: return P.w_out[((size_t)l * 1024 + k) * 1024 + n];
        case 2: return P.g_cq[l * 256 + k] * (n < 512 ? P.w_uq[((size_t)l * 256 + k) * 512 + n] : P.w_qidx[((size_t)l * 256 + k) * 256 + (n - 512)]);
        case 3: return P.g_ckv[l * 128 + k] * P.w_ukv[((size_t)l * 128 + k) * 1024 + n];
        case 4: { const int kk = k >> 4, hf = (k >> 3) & 1, j = k & 7; const int d = 16 * kk + 8 * (j >> 2) + 4 * hf + (j & 3);
                  return P.w_ukv[((size_t)l * 128 + n) * 1024 + h * 64 + d] * P.g_kn[l * 64 + d] * P.g_qn[l * 64 + d] * 0.125f; }
        default: return P.w_ukv[((size_t)l * 128 + k) * 1024 + 512 + h * 64 + n];
    }
}
__device__ __forceinline__ void prep_tiles(const Params& P, unsigned char* lds, int l, int first_wg, int nwg);
__device__ __forceinline__ void phase_prep(const Params& P, unsigned char* lds) {
    float* tile = (float*)lds;
    const int tid = opaque_tid();
    {
        h16* h16o = (h16*)(P.ws + OFF_H16); float* sumsq = (float*)(P.ws + OFF_SUMSQ);
        const int lane = tid & 63, w = tid >> 6;
        for (int row = blockIdx.x * 4 + w; row < NT; row += gridDim.x * 4) {
            const int b = row >= T_ ? 1 : 0; const int t = row - b * T_;
            const float* src = t < 16 ? P.meta + (size_t)t * 1024 : P.x + ((size_t)b * 8192 + (t - 16)) * 1024;
            float ss = 0.f;
#pragma unroll
            for (int q = 0; q < 2; ++q) {
                const float4 a = *(const float4*)(src + q * 512 + lane * 8), c4 = *(const float4*)(src + q * 512 + lane * 8 + 4);
                ss += a.x * a.x + a.y * a.y + a.z * a.z + a.w * a.w + c4.x * c4.x + c4.y * c4.y + c4.z * c4.z + c4.w * c4.w;
                h16x8 o; o[0] = (h16)a.x; o[1] = (h16)a.y; o[2] = (h16)a.z; o[3] = (h16)a.w; o[4] = (h16)c4.x; o[5] = (h16)c4.y; o[6] = (h16)c4.z; o[7] = (h16)c4.w;
                *(h16x8*)(h16o + (size_t)row * 1024 + q * 512 + lane * 8) = o;
            }
#pragma unroll
            for (int d = 1; d < 64; d <<= 1) ss += __shfl_xor(ss, d);
            if (lane == 0) sumsq[row] = ss;
        }
    }
    prep_tiles(P, lds, 0, 0, (int)gridDim.x);
}
__device__ __forceinline__ void prep_tiles(const Params& P, unsigned char* lds, int l, int first_wg, int nwg) {
    float* tile = (float*)lds;
    const int tid = opaque_tid();
    for (int it = (int)blockIdx.x - first_wg; it >= 0 && it < 1120; it += nwg) {
        int r = it;
        int job, h = 0, N, K, tn, tk; h16* dst;
        if (r < 768) { job = 0; N = 3072; K = 1024; tn = r / 16; tk = r % 16; dst = (h16*)(P.ws + OFF_W1T) + (size_t)l * 3072 * 1024; }
        else if ((r -= 768) < 256) { job = 1; N = 1024; K = 1024; tn = r / 16; tk = r % 16; dst = (h16*)(P.ws + OFF_WOT) + (size_t)l * 1024 * 1024; }
        else if ((r -= 256) < 48) { job = 2; N = 768; K = 256; tn = r / 4; tk = r % 4; dst = (h16*)(P.ws + OFF_WQ2T) + (size_t)l * 768 * 256; }
        else if ((r -= 48) < 16) { job = 3; N = 512; K = 128; tn = r / 2; tk = r % 2; dst = (h16*)(P.ws + OFF_WUKT) + (size_t)l * 512 * 128; }
        else if ((r -= 16) < 16) { job = 4; N = 128; K = 64; h = r / 2; tn = r % 2; tk = 0; dst = (h16*)(P.ws + OFF_WKABS) + ((size_t)l * 8 + h) * 128 * 64; }
        else { r -= 16; job = 5; N = 64; K = 128; h = r / 2; tn = 0; tk = r % 2; dst = (h16*)(P.ws + OFF_WUVT) + ((size_t)l * 8 + h) * 64 * 128; }
        (void)N;
        const int n0 = tn * 64, k0 = tk * 64;
        __syncthreads();
#pragma unroll 4
        for (int q = 0; q < 16; ++q) { const int kk = q * 4 + (tid >> 6), nn = tid & 63; tile[kk * 65 + nn] = prep_get(P, l, job, h, n0 + nn, k0 + kk); }
        __syncthreads();
#pragma unroll 4
        for (int q = 0; q < 16; ++q) { const int nn = q * 4 + (tid >> 6), kk = tid & 63; dst[(size_t)(n0 + nn) * K + k0 + kk] = (h16)tile[kk * 65 + nn]; }
    }
}

__device__ __forceinline__ void phase_inproj(const Params& P, int l, unsigned char* lds, int rep_p1 = 0) {
    h16* smem = (h16*)lds;
    float* rstd = (float*)(lds + 73728);
    const int tid = opaque_tid();
    const h16* W = (const h16*)(P.ws + OFF_W1T) + (size_t)l * 3072 * 1024;
    const h16* A = (const h16*)(P.ws + OFF_H16);
    const float* sumsq = (const float*)(P.ws + OFF_SUMSQ) + (size_t)l * NTP;
    XcdQueue xq; xq.init((unsigned*)(P.ws + OFF_CTL) + 4096 + l * 128 + 2048 * rep_p1, 96, (int*)(lds + LDS_BYTES - 32));
    int xl, qi;
    while (xq.next(xl, qi)) {
        const int rb = 8 * xl + (qi & 7), tn = 4 * (qi >> 5) + ((qi >> 3) & 3);
        EpiInBig ep{rb * 256, tn * 256, sumsq, (h16*)(P.ws + OFF_PROJA), (float*)(P.ws + OFF_SMALL), (h16*)(P.ws + OFF_SZA), (h16*)(P.ws + OFF_SZG), (h16*)(P.ws + OFF_PROJG), {0.f, 0.f}};
        gemm_big(A + (size_t)rb * 256 * 1024, 1024, W + (size_t)tn * 256 * 1024, 1024, 1024, ep, smem);
    }
    __syncthreads();
    for (int it = blockIdx.x; it < 96; it += gridDim.x) {
        EpiInBig ep{16384, it * 32, sumsq, (h16*)(P.ws + OFF_PROJA), (float*)(P.ws + OFF_SMALL), (h16*)(P.ws + OFF_SZA), (h16*)(P.ws + OFF_SZG), (h16*)(P.ws + OFF_PROJG), {0.f, 0.f}};
        skinny_tile(A + (size_t)16384 * 1024, 1024, W + (size_t)it * 32 * 1024, 1024, 1024, ep, (float*)lds, tid);
    }
    (void)rstd;
}

__device__ __forceinline__ void p2a_item(const Params& P, int l, int rb, int j, unsigned char* lds) {
    h16* smem = (h16*)lds;
    float* ft = (float*)lds;
    float* rstdq = (float*)(lds + 73728);
    const int tid = opaque_tid(); const int row0 = rb * 128;
    const h16* projA = (const h16*)(P.ws + OFF_PROJA);
    __syncthreads();
    {
        const int row = row0 + (tid >> 1), hf = tid & 1; float s = 0.f;
#pragma unroll 4
        for (int q = 0; q < 16; ++q) { const h16x8 v = *(const h16x8*)(projA + (size_t)row * 512 + hf * 128 + q * 8);
#pragma unroll
            for (int e = 0; e < 8; ++e) { const float f = (float)v[e]; s += f * f; } }
        s += __shfl_xor(s, 1);
        if (hf == 0) rstdq[tid >> 1] = rsqrtf(s * (1.f / 256.f) + EPS);
    }
    __syncthreads();
    const h16* Wq2 = (const h16*)(P.ws + OFF_WQ2T) + (size_t)l * 768 * 256;
    AF16 al{projA, 512};
    if (j >= 4) {
        EpiStoreH ep{(h16*)(P.ws + OFF_QIDX) + (j - 4) * 128, 256, row0, rstdq};
        gemm_tile<128>(al, row0, Wq2 + (size_t)j * 128 * 256, 256, 256, ep, smem);
        return;
    }
    EpiTileF32 ep;
    gemm_tile<128>(al, row0, Wq2 + (size_t)j * 128 * 256, 256, 256, ep, smem);
    __syncthreads();
    h16* qn = (h16*)(P.ws + OFF_QN);
    {
        const int rl = tid >> 1, hh = tid & 1; float s = 0.f;
        const float rq = rstdq[rl];
        for (int d = 0; d < 64; ++d) { const float f = ft[rl * 129 + hh * 64 + d] * rq; s += f * f; }
        const float rs = rsqrtf(s * (1.f / 64.f) + EPS) * rq;
        h16* dst = qn + (size_t)(row0 + rl) * 512 + (2 * j + hh) * 64;
        const float* gq = P.g_qn + l * 64;
        for (int d = 0; d < 64; d += 8) { h16x8 o;
#pragma unroll
            for (int e = 0; e < 8; ++e) o[e] = (h16)(ft[rl * 129 + hh * 64 + d + e] * rs * gq[d + e]);
            *(h16x8*)(dst + d) = o; }
    }
    __threadfence_block();
    __syncthreads();
    for (int hh = 0; hh < 2; ++hh) {
        const int head = 2 * j + hh;
        AF16 al2{qn + head * 64, 512};
        EpiStoreH ep2{(h16*)(P.ws + OFF_QK) + head * 128, 1024, row0, nullptr};
        gemm_tile<128>(al2, row0, (const h16*)(P.ws + OFF_WKABS) + ((size_t)l * 8 + head) * 128 * 64, 64, 64, ep2, smem);
    }
}

__device__ __forceinline__ void p2b_item(const Params& P, int l, int rb, unsigned char* lds) {
    h16* smem = (h16*)lds;
    float* ft = (float*)lds;
    const int tid = opaque_tid(); const int row0 = rb * 128;
    const h16* projA = (const h16*)(P.ws + OFF_PROJA);
    h16* kvrow = (h16*)(P.ws + OFF_KVROW);
    __syncthreads();
    {
        const int row = row0 + (tid >> 1), hf = tid & 1; float s = 0.f; h16x8 v[8];
#pragma unroll
        for (int q = 0; q < 8; ++q) { v[q] = *(const h16x8*)(projA + (size_t)row * 512 + 256 + hf * 64 + q * 8);
#pragma unroll
            for (int e = 0; e < 8; ++e) { const float f = (float)v[q][e]; s += f * f; } }
        s += __shfl_xor(s, 1);
        const float rs = rsqrtf(s * (1.f / 128.f) + EPS);
        const float* g = P.g_ckv + l * 128 + hf * 64;
#pragma unroll
        for (int q = 0; q < 8; ++q) { h16x8 o;
#pragma unroll
            for (int e = 0; e < 8; ++e) o[e] = (h16)((float)v[q][e] * rs * g[q * 8 + e]);
            *(h16x8*)(kvrow + (size_t)row * 136 + hf * 64 + q * 8) = o; }
    }
    {
        h16* kfrag = (h16*)(P.ws + OFF_KFRAG);
#pragma unroll
        for (int q = 0; q < 4; ++q) {
            const int g = tid + 256 * q; const int row = row0 + (g >> 3), g8 = g & 7;
            if (row < NT) {
                const int b = row >= T_ ? 1 : 0; const int t = row - b * T_;
                const h16x8 v = *(const h16x8*)(projA + (size_t)row * 512 + 384 + g8 * 8);
                const int tile = t >> 5, ks = g8 >> 1, hh = g8 & 1;
                *(h16x8*)(kfrag + ((size_t)(b * NKT + tile) * 4 + ks) * 512 + (hh * 32 + (t & 31)) * 8) = v;
            }
        }
    }
    __threadfence_block();
    __syncthreads();
    const h16* Wuk = (const h16*)(P.ws + OFF_WUKT) + (size_t)l * 512 * 128;
    for (int tn = 0; tn < 4; ++tn) {
        AF16 al{kvrow, 136};
        EpiTileF32 ep;
        gemm_tile<128>(al, row0, Wuk + (size_t)tn * 128 * 128, 128, 128, ep, smem);
        __syncthreads();
        const int rl = tid >> 1, hh = tid & 1; float s = 0.f;
        for (int d = 0; d < 64; ++d) { const float f = ft[rl * 129 + hh * 64 + d]; s += f * f; }
        kvrow[(size_t)(row0 + rl) * 136 + 128 + 2 * tn + hh] = (h16)rsqrtf(s * (1.f / 64.f) + EPS);
        __syncthreads();
    }
}

__device__ __forceinline__ void p2c_item(const Params& P, int l, int item, unsigned char* lds) {
    h16* qh = (h16*)lds;
    h16* kh = (h16*)(lds + 17408);
    float* kf = (float*)(lds + 34816);
    float* vf = (float*)(lds + 67584);
    float* Lm = (float*)(lds + 100352);
    float* beta = (float*)(lds + 116736);
    float* dec = beta + 64;
    float* edec = dec + 64;
    const int tid = opaque_tid(), lane = tid & 63, w = tid >> 6;
    const int chain = item / NCH, n = item % NCH, b = chain >> 2, h = chain & 3;
    const h16* projG = (const h16*)(P.ws + OFF_PROJG);
    const float* small = (const float*)(P.ws + OFF_SMALL);
    const float* cw = P.conv_w + (size_t)l * 4 * 1536;
    __syncthreads();
#ifndef P2C
#define P2C 15
#endif
    float* cwl = (float*)(lds + 117504);
    for (int e = tid; e < 1536; e += NTHREADS) { const int m = e >> 9, jj = (e >> 7) & 3, c = e & 127; cwl[e] = cw[jj * 1536 + m * 512 + h * 128 + c]; }
    __syncthreads();
    for (int rs1_ = 0; rs1_ <= PROBE_S1; ++rs1_) if (P2C & 1) {
        const int i = tid >> 2, part = tid & 3;
        const int t = 64 * n + i - 48; const bool valid = t >= 0;
        const size_t row = (size_t)b * T_ + (valid ? t : 0);
        h16x8 rv[3][4][4];
#define CONV_LOAD(m_) do { _Pragma("unroll") for (int jj = 0; jj < 4; ++jj) { int tt = t - 3 + jj; tt = tt < 0 ? 0 : tt; \
            const h16* rp = projG + ((size_t)b * T_ + tt) * 1536 + (m_) * 512 + h * 128 + part * 32; \
            _Pragma("unroll") for (int c8 = 0; c8 < 4; ++c8) rv[m_][jj][c8] = *(const h16x8*)(rp + c8 * 8); } } while (0)
        CONV_LOAD(0); CONV_LOAD(1);
        float bl = 0.f, al = 0.f;
        if (part == 0) { bl = small[row * 16 + 4 + h]; al = small[row * 16 + 8 + h]; }
        float vals[32];
#pragma unroll
        for (int m = 0; m < 3; ++m) {
            if (m == 1) { CONV_LOAD(2); }
            __builtin_amdgcn_sched_barrier(0);
#pragma unroll
            for (int c = 0; c < 32; ++c) vals[c] = 0.f;
#pragma unroll
            for (int jj = 0; jj < 4; ++jj) {
                const float msk = (valid && (t - 3 + jj) >= 0) ? 1.f : 0.f;
                const float* wp = cwl + (m * 4 + jj) * 128 + part * 32;
#pragma unroll
                for (int c8 = 0; c8 < 4; ++c8) {
                    const float4 w0 = *(const float4*)(wp + c8 * 8), w1 = *(const float4*)(wp + c8 * 8 + 4);
                    const float wv[8] = {w0.x, w0.y, w0.z, w0.w, w1.x, w1.y, w1.z, w1.w};
#pragma unroll
                    for (int e = 0; e < 8; ++e) vals[c8 * 8 + e] += wv[e] * msk * (float)rv[m][jj][c8][e];
                }
            }
            float ss = 0.f;
#pragma unroll
            for (int c = 0; c < 32; ++c) { vals[c] = silu_f(vals[c]); ss += vals[c] * vals[c]; }
            if (m < 2) {
                ss += __shfl_xor(ss, 1); ss += __shfl_xor(ss, 2);
                const float rs = valid ? rsqrtf(ss + EPS) : 0.f;
                h16* dsth = (m == 0 ? qh : kh) + i * 136 + part * 32;
#pragma unroll
                for (int c8 = 0; c8 < 4; ++c8) { h16x8 o;
#pragma unroll
                    for (int e = 0; e < 8; ++e) o[e] = (h16)(vals[c8 * 8 + e] * rs);
                    *(h16x8*)(dsth + c8 * 8) = o; }
                if (m == 1) {
#pragma unroll
                    for (int c4 = 0; c4 < 8; ++c4) *(float4*)(kf + i * 128 + part * 32 + c4 * 4) = make_float4(vals[4 * c4] * rs, vals[4 * c4 + 1] * rs, vals[4 * c4 + 2] * rs, vals[4 * c4 + 3] * rs);
                }
            } else {
#pragma unroll
                for (int c4 = 0; c4 < 8; ++c4) *(float4*)(vf + i * 128 + part * 32 + c4 * 4) = valid ? make_float4(vals[4 * c4], vals[4 * c4 + 1], vals[4 * c4 + 2], vals[4 * c4 + 3]) : make_float4(0.f, 0.f, 0.f, 0.f);
            }
        }
#undef CONV_LOAD
        if (part == 0) {
            float bt = 0.f, g = 0.f;
            if (valid) {
                bt = 1.f / (1.f + __expf(-bl));
                const float xx = al + P.dt_bias[l * 4 + h];
                const float sp = xx > 20.f ? xx : log1pf(__expf(xx));
                g = -__expf(P.a_log[l * 4 + h]) * sp;
            }
            beta[i] = bt; dec[i] = g;
        }
    }
    __syncthreads();
    if (w == 0) {
        float v = dec[lane];
#pragma unroll
        for (int d = 1; d < 64; d <<= 1) { const float o = __shfl_up(v, d); if (lane >= d) v += o; }
        dec[lane] = v; edec[lane] = __expf(v);
    }
    __syncthreads();
    for (int rs3_ = 0; rs3_ <= PROBE_S3; ++rs3_) if (P2C & 2) {
        const int gq = lane >> 4, c16 = lane & 15;
        h16* aqk = (h16*)(P.ws + OFF_AQK) + (size_t)item * 4096;
        h16x8 ak[4], aq[4];
#pragma unroll
        for (int ks = 0; ks < 4; ++ks) { ak[ks] = *(const h16x8*)(kh + (16 * w + c16) * 136 + 32 * ks + 8 * gq); aq[ks] = *(const h16x8*)(qh + (16 * w + c16) * 136 + 32 * ks + 8 * gq); }
#pragma unroll
        for (int nt = 0; nt < 4; ++nt) {
            f32x4 kk = {0.f, 0.f, 0.f, 0.f}, qk = {0.f, 0.f, 0.f, 0.f};
#pragma unroll
            for (int ks = 0; ks < 4; ++ks) { const h16x8 bb = *(const h16x8*)(kh + (16 * nt + c16) * 136 + 32 * ks + 8 * gq); kk = MFMA16(ak[ks], bb, kk); qk = MFMA16(aq[ks], bb, qk); }
            const int jc = 16 * nt + c16; const float dj = dec[jc];
#pragma unroll
            for (int r = 0; r < 4; ++r) {
                const int ir = 16 * w + 4 * gq + r; const float gm = __expf(fminf(dec[ir] - dj, 0.f));
                Lm[ir * 64 + jc] = ir > jc ? beta[ir] * kk[r] * gm : 0.f;
                aqk[ir * 64 + jc] = (h16)(ir >= jc ? qk[r] * gm : 0.f);
            }
        }
    }
    __syncthreads();
    for (int rs5_ = 0; rs5_ <= PROBE_S5; ++rs5_) if (P2C & 8) {
        h16* qd = (h16*)(P.ws + OFF_QD) + (size_t)item * 8192;
        const int i = tid >> 2, part = tid & 3; const float ed = edec[i];
#pragma unroll
        for (int c8 = 0; c8 < 4; ++c8) { const h16x8 v = *(const h16x8*)(qh + i * 136 + part * 32 + c8 * 8); h16x8 o;
#pragma unroll
            for (int e = 0; e < 8; ++e) o[e] = (h16)((float)v[e] * ed);
            *(h16x8*)(qd + i * 128 + part * 32 + c8 * 8) = o; }
        h16* kdt = (h16*)(P.ws + OFF_KDT) + (size_t)item * 8192;
        const int d = tid & 127, ih = tid >> 7; const float dl = dec[63];
#pragma unroll
        for (int i8 = 0; i8 < 4; ++i8) { h16x8 o;
#pragma unroll
            for (int e = 0; e < 8; ++e) { const int ii = ih * 32 + i8 * 8 + e; o[e] = (h16)(kf[ii * 128 + d] * __expf(dl - dec[ii])); }
            *(h16x8*)(kdt + d * 64 + ih * 32 + i8 * 8) = o; }
        if (tid == 0) ((float*)(P.ws + OFF_CDEC))[item] = __expf(dl);
    }
    __syncthreads();
    if (P2C & 4) {
        float* scl = cwl;
        if (tid < 128) { const int i = tid & 63; scl[tid] = tid < 64 ? beta[i] : beta[i] * edec[i]; }
        __syncthreads();
        const int c = tid; const bool isu = c < 128; float* col = isu ? (vf + c) : (kf + (c - 128));
        const float* sc = scl + (isu ? 0 : 64);
        h16* dst = (h16*)(P.ws + (isu ? OFF_U : OFF_WM)) + (size_t)item * 8192 + (isu ? c : c - 128);
#pragma unroll 1
        for (int bi = 0; bi < 8; ++bi) {
            float sv[8];
            { const float4 s0 = *(const float4*)(sc + 8 * bi), s1 = *(const float4*)(sc + 8 * bi + 4);
              const float ss_[8] = {s0.x, s0.y, s0.z, s0.w, s1.x, s1.y, s1.z, s1.w};
#pragma unroll
              for (int r = 0; r < 8; ++r) sv[r] = col[(8 * bi + r) * 128] * ss_[r]; }
#pragma unroll 2
            for (int j4 = 0; j4 < 2 * bi; ++j4) {
                const float x0 = col[(4 * j4 + 0) * 128], x1 = col[(4 * j4 + 1) * 128], x2 = col[(4 * j4 + 2) * 128], x3 = col[(4 * j4 + 3) * 128];
#pragma unroll
                for (int r = 0; r < 8; ++r) { const float4 lv = *(const float4*)(Lm + (8 * bi + r) * 64 + 4 * j4); sv[r] -= lv.x * x0; sv[r] -= lv.y * x1; sv[r] -= lv.z * x2; sv[r] -= lv.w * x3; }
            }
            float4 la[8], lb[8];
#pragma unroll
            for (int r = 1; r < 8; ++r) { la[r] = *(const float4*)(Lm + (8 * bi + r) * 64 + 8 * bi); lb[r] = *(const float4*)(Lm + (8 * bi + r) * 64 + 8 * bi + 4); }
#pragma unroll
            for (int r = 1; r < 8; ++r) {
                const float lv[8] = {la[r].x, la[r].y, la[r].z, la[r].w, lb[r].x, lb[r].y, lb[r].z, lb[r].w};
#pragma unroll
                for (int q = 0; q < r; ++q) sv[r] -= lv[q] * sv[q];
            }
#pragma unroll
            for (int r = 0; r < 8; ++r) { col[(8 * bi + r) * 128] = sv[r]; dst[(8 * bi + r) * 128] = (h16)sv[r]; }
        }
    }
}

__device__ __forceinline__ float half_sum(float x) {
    const unsigned u = __float_as_uint(x); const auto p = __builtin_amdgcn_permlane32_swap(u, u, false, false);
    return __uint_as_float(p[0]) + __uint_as_float(p[1]);
}
__device__ __forceinline__ void store_tile_T(const f32x16& acc, float scale, float* st, h16* dst_row_lane  , bool ok, int lane) {
#pragma unroll
    for (int r = 0; r < 16; ++r) st[(lane & 31) * 33 + (r & 3) + 8 * (r >> 2) + 4 * (lane >> 5)] = acc[r] * scale;
    WAVE_FENCE();
    float v[16];
#pragma unroll
    for (int q = 0; q < 16; ++q) v[q] = st[(lane >> 1) * 33 + (lane & 1) * 16 + q];
    WAVE_FENCE();
    if (ok) store16h(dst_row_lane, v);
}

__device__ __forceinline__ void chain_item(const Params& P, int l, int item, float* st, int lane) {
    const int r0 = item * 32; const int tok = lane & 31, hf = lane >> 5;
    const int row = r0 + tok; const int rowc = row < NT ? row : NT - 1;
    const h16* projA = (const h16*)(P.ws + OFF_PROJA);
    const h16* Wq2 = (const h16*)(P.ws + OFF_WQ2T) + (size_t)l * 768 * 256;
    const h16* Wka = (const h16*)(P.ws + OFF_WKABS) + (size_t)l * 8 * 128 * 64;
    const h16* Wuk = (const h16*)(P.ws + OFF_WUKT) + (size_t)l * 512 * 128;
    h16* qidx = (h16*)(P.ws + OFF_QIDX); h16* qk = (h16*)(P.ws + OFF_QK); h16* kvrow = (h16*)(P.ws + OFF_KVROW);
    const int srow = r0 + (lane >> 1); const bool sok = srow < NT; const size_t srowc = sok ? srow : NT - 1;
    h16x8 bq[16]; float ss = 0.f;
#pragma unroll
    for (int ks = 0; ks < 16; ++ks) { bq[ks] = *(const h16x8*)(projA + (size_t)rowc * 512 + 16 * ks + 8 * hf);
#pragma unroll
        for (int e = 0; e < 8; ++e) { const float f = (float)bq[ks][e]; ss += f * f; } }
    ss = half_sum(ss);
    const float rstd_q = rsqrtf(ss * (1.f / 256.f) + EPS);
#pragma unroll 1
    for (int h = 0; h < 8; ++h) {
        f32x16 aq[2];
#pragma unroll
        for (int mt = 0; mt < 2; ++mt)
#pragma unroll
            for (int r = 0; r < 16; ++r) aq[mt][r] = 0.f;
        const h16* wp = Wq2 + (size_t)(64 * h + tok) * 256 + 8 * hf;
#pragma unroll
        for (int ks = 0; ks < 16; ++ks) {
            const h16x8 a0 = *(const h16x8*)(wp + 16 * ks), a1 = *(const h16x8*)(wp + 32 * 256 + 16 * ks);
            aq[0] = MFMA32(a0, bq[ks], aq[0]); aq[1] = MFMA32(a1, bq[ks], aq[1]);
        }
        __builtin_amdgcn_sched_group_barrier(0x20, 8, 0);
#pragma unroll
        for (int q = 0; q < 12; ++q) { __builtin_amdgcn_sched_group_barrier(0x8, 2, 0); __builtin_amdgcn_sched_group_barrier(0x20, 2, 0); }
        __builtin_amdgcn_sched_group_barrier(0x8, 8, 0);
        __builtin_amdgcn_sched_barrier(0);
        float sq = 0.f;
#pragma unroll
        for (int mt = 0; mt < 2; ++mt)
#pragma unroll
            for (int r = 0; r < 16; ++r) sq += aq[mt][r] * aq[mt][r];
        sq = half_sum(sq) * rstd_q * rstd_q;
        const float rsq = rsqrtf(sq * (1.f / 64.f) + EPS) * rstd_q;
        h16x8 qb[4];
#pragma unroll
        for (int kk = 0; kk < 4; ++kk)
#pragma unroll
            for (int j = 0; j < 8; ++j) qb[kk][j] = (h16)(aq[kk >> 1][8 * (kk & 1) + j] * rsq);
        const h16* kp = Wka + (size_t)h * 128 * 64 + (size_t)tok * 64 + 8 * hf;
#pragma unroll
        for (int ct = 0; ct < 4; ++ct) {
            f32x16 ak;
#pragma unroll
            for (int r = 0; r < 16; ++r) ak[r] = 0.f;
#pragma unroll
            for (int kk = 0; kk < 4; ++kk) { const h16x8 a = *(const h16x8*)(kp + (size_t)(32 * ct) * 64 + 16 * kk); ak = MFMA32(a, qb[kk], ak); }
            store_tile_T(ak, 1.f, st, qk + srowc * 1024 + h * 128 + 32 * ct + 16 * (lane & 1), sok, lane);
        }
    }
#pragma unroll 1
    for (int nt = 0; nt < 8; ++nt) {
        f32x16 ai;
#pragma unroll
        for (int r = 0; r < 16; ++r) ai[r] = 0.f;
        const h16* wp = Wq2 + (size_t)(512 + 32 * nt + tok) * 256 + 8 * hf;
#pragma unroll
        for (int ks = 0; ks < 16; ++ks) { const h16x8 a = *(const h16x8*)(wp + 16 * ks); ai = MFMA32(a, bq[ks], ai); }
#pragma unroll
        for (int r = 0; r < 16; ++r) ai[r] *= rstd_q;
        store_tile_T(ai, 1.f, st, qidx + srowc * 256 + 32 * nt + 16 * (lane & 1), sok, lane);
    }
    h16x8 bk[8]; float sk = 0.f;
#pragma unroll
    for (int ks = 0; ks < 8; ++ks) { bk[ks] = *(const h16x8*)(projA + (size_t)rowc * 512 + 256 + 16 * ks + 8 * hf);
#pragma unroll
        for (int e = 0; e < 8; ++e) { const float f = (float)bk[ks][e]; sk += f * f; } }
    sk = half_sum(sk);
    const float rstd_kv = rsqrtf(sk * (1.f / 128.f) + EPS);
    if (row < NT) {
        const float* g = P.g_ckv + l * 128;
#pragma unroll
        for (int ks = 0; ks < 8; ++ks) { h16x8 o;
#pragma unroll
            for (int e = 0; e < 8; ++e) o[e] = (h16)((float)bk[ks][e] * rstd_kv * g[16 * ks + 8 * hf + e]);
            *(h16x8*)(kvrow + (size_t)row * 136 + 16 * ks + 8 * hf) = o; }
    }
#pragma unroll 1
    for (int h = 0; h < 8; ++h) {
        f32x16 ak[2];
#pragma unroll
        for (int mt = 0; mt < 2; ++mt)
#pragma unroll
            for (int r = 0; r < 16; ++r) ak[mt][r] = 0.f;
        const h16* wp = Wuk + (size_t)(64 * h + tok) * 128 + 8 * hf;
#pragma unroll
        for (int ks = 0; ks < 8; ++ks) {
            const h16x8 a0 = *(const h16x8*)(wp + 16 * ks), a1 = *(const h16x8*)(wp + 32 * 128 + 16 * ks);
            ak[0] = MFMA32(a0, bk[ks], ak[0]); ak[1] = MFMA32(a1, bk[ks], ak[1]);
        }
        float sq = 0.f;
#pragma unroll
        for (int mt = 0; mt < 2; ++mt)
#pragma unroll
            for (int r = 0; r < 16; ++r) sq += ak[mt][r] * ak[mt][r];
        sq = half_sum(sq) * rstd_kv * rstd_kv;
        if (row < NT && hf == 0) kvrow[(size_t)row * 136 + 128 + h] = (h16)rsqrtf(sq * (1.f / 64.f) + EPS);
    }
    if (row < NT) {
        h16* kfrag = (h16*)(P.ws + OFF_KFRAG);
        const int b = row >= T_ ? 1 : 0; const int t = row - b * T_; const int tile = t >> 5;
#pragma unroll
        for (int q = 0; q < 4; ++q) {
            const int g8 = 2 * q + hf;
            const h16x8 v = *(const h16x8*)(projA + (size_t)row * 512 + 384 + g8 * 8);
            *(h16x8*)(kfrag + ((size_t)(b * NKT + tile) * 4 + (g8 >> 1)) * 512 + ((g8 & 1) * 32 + (t & 31)) * 8) = v;
        }
    }
}

__device__ __forceinline__ void p4_item(const Params& P, int l, int item, int lane) {
    const int r0 = item * 32; const int tok = lane & 31, hf = lane >> 5;
    const int row = r0 + tok; const bool ok = row < NT; const size_t rowc = ok ? row : NT - 1;
    const h16* ctx = (const h16*)(P.ws + OFF_CTX); const h16* Wuv = (const h16*)(P.ws + OFF_WUVT) + (size_t)l * 8 * 64 * 128;
    const h16* sza = (const h16*)(P.ws + OFF_SZA); const h16* szg = (const h16*)(P.ws + OFF_SZG); const h16* og = (const h16*)(P.ws + OFF_QN);
    h16* omix = (h16*)(P.ws + OFF_OMIX);
#pragma unroll 1
    for (int h = 0; h < 8; ++h) {
        h16x8 bc[8];
#pragma unroll
        for (int ks = 0; ks < 8; ++ks) bc[ks] = *(const h16x8*)(ctx + rowc * 1024 + h * 128 + 16 * ks + 8 * hf);
        f32x16 ao[2];
#pragma unroll
        for (int mt = 0; mt < 2; ++mt)
#pragma unroll
            for (int r = 0; r < 16; ++r) ao[mt][r] = 0.f;
        const h16* wp = Wuv + (size_t)h * 64 * 128 + (size_t)tok * 128 + 8 * hf;
#pragma unroll
        for (int ks = 0; ks < 8; ++ks) {
            const h16x8 a0 = *(const h16x8*)(wp + 16 * ks), a1 = *(const h16x8*)(wp + 32 * 128 + 16 * ks);
            ao[0] = MFMA32(a0, bc[ks], ao[0]); ao[1] = MFMA32(a1, bc[ks], ao[1]);
        }
        if (ok) {
#pragma unroll
            for (int mt = 0; mt < 2; ++mt)
#pragma unroll
                for (int g = 0; g < 4; ++g) {
                    const int d0 = h * 64 + 32 * mt + 8 * g + 4 * hf;
                    const h16x4 z = *(const h16x4*)(sza + (size_t)row * 512 + d0);
                    h16x4 o;
#pragma unroll
                    for (int e = 0; e < 4; ++e) o[e] = (h16)(ao[mt][4 * g + e] * (float)z[e]);
                    *(h16x4*)(omix + (size_t)row * 1024 + d0) = o;
                }
        }
    }
    const float* go = P.g_out + l * 128;
#pragma unroll 1
    for (int h = 0; h < 4; ++h) {
        h16x8 v[8]; float ss = 0.f;
#pragma unroll
        for (int q = 0; q < 8; ++q) { v[q] = *(const h16x8*)(og + rowc * 512 + h * 128 + 64 * hf + 8 * q);
#pragma unroll
            for (int e = 0; e < 8; ++e) { const float f = (float)v[q][e]; ss += f * f; } }
        ss = half_sum(ss);
        const float rs = rsqrtf(ss * (1.f / 128.f) + EPS);
        if (ok) {
#pragma unroll
            for (int q = 0; q < 8; ++q) { const h16x8 z = *(const h16x8*)(szg + (size_t)row * 512 + h * 128 + 64 * hf + 8 * q); h16x8 o;
#pragma unroll
                for (int e = 0; e < 8; ++e) o[e] = (h16)((float)v[q][e] * rs * go[64 * hf + 8 * q + e] * (float)z[e]);
                *(h16x8*)(omix + (size_t)row * 1024 + 512 + h * 128 + 64 * hf + 8 * q) = o; }
        }
    }
}

__device__ __forceinline__ void phase2(const Params& P, int l, unsigned char* lds) {
    const int tid = opaque_tid(), lane = tid & 63, w = tid >> 6;
    unsigned* ctr = (unsigned*)(P.ws + OFF_CTL) + 16 + l;
    int* slot = (int*)(lds + LDS_BYTES - 32);
    for (int rep_ = 0; rep_ <= (PROBE_P2C | PROBE_CHAIN | PROBE_P2X); ++rep_) {
    for (;;) {
        __syncthreads();
        if (tid == 0) *slot = (int)__hip_atomic_fetch_add(ctr + 4 * rep_, 1u, __ATOMIC_RELAXED, __HIP_MEMORY_SCOPE_AGENT);
        __syncthreads();
        const int it = *slot;
        if (it >= NGI + 129) break;
        if (it >= 129) { if (!PROBE_CHAIN || rep_ == 0) { TSEC_BEGIN(6) p2c_item(P, l, it - 129, lds); TSEC_END(6); } }
        else if (!PROBE_P2C || rep_ == 0) {
            const int ci = it * 4 + w;
            __syncthreads();
            TSEC_BEGIN(7)
            if (ci < (NT + 31) / 32) chain_item(P, l, ci, (float*)lds + w * 1152, lane);
            TSEC_END(7);
        }
    }
    }
}

constexpr int SNT = 2;
__device__ __forceinline__ void gdn_scan(const Params& P, int sw, unsigned char* lds) {
    h16* St = (h16*)lds;
    h16* Vt = (h16*)(lds + 16 * SNT * 272);
    const int tid = opaque_tid(), lane = tid & 63, w = tid >> 6, gq = lane >> 4, c16 = lane & 15;
    const int chain = sw / (8 / SNT), e0 = (sw % (8 / SNT)) * 16 * SNT, b = chain >> 2, h = chain & 3;
    const h16* Ub = (const h16*)(P.ws + OFF_U); const h16* Wb = (const h16*)(P.ws + OFF_WM);
    const h16* Qb = (const h16*)(P.ws + OFF_QD); const h16* Kb = (const h16*)(P.ws + OFF_KDT);
    const h16* Ab = (const h16*)(P.ws + OFF_AQK); const float* cdec = (const float*)(P.ws + OFF_CDEC);
    h16* og = (h16*)(P.ws + OFF_QN);
    __syncthreads();
    for (int i = tid; i < 16 * SNT * 136; i += NTHREADS) St[i] = (h16)0.f;
    f32x4 S[2][SNT];
#pragma unroll
    for (int m2 = 0; m2 < 2; ++m2)
#pragma unroll
        for (int nt = 0; nt < SNT; ++nt) S[m2][nt] = (f32x4){0.f, 0.f, 0.f, 0.f};
    __syncthreads();
    h16x8 wf[2][4], qf[2][4], af[2][2], kf_[2][2][2]; h16 uv[2][SNT][4]; float cd[2];
#define SCAN_LOAD(S_, n_) do { const int nn_ = (n_) < NCH ? (n_) : NCH - 1; const size_t itm = (size_t)chain * NCH + nn_; \
        _Pragma("unroll") for (int ks = 0; ks < 4; ++ks) { wf[S_][ks] = *(const h16x8*)(Wb + itm * 8192 + (16 * w + c16) * 128 + 32 * ks + 8 * gq); qf[S_][ks] = *(const h16x8*)(Qb + itm * 8192 + (16 * w + c16) * 128 + 32 * ks + 8 * gq); } \
        _Pragma("unroll") for (int ks = 0; ks < 2; ++ks) { af[S_][ks] = *(const h16x8*)(Ab + itm * 4096 + (16 * w + c16) * 64 + 32 * ks + 8 * gq); \
            _Pragma("unroll") for (int m2 = 0; m2 < 2; ++m2) kf_[S_][m2][ks] = *(const h16x8*)(Kb + itm * 8192 + (16 * (2 * w + m2) + c16) * 64 + 32 * ks + 8 * gq); } \
        _Pragma("unroll") for (int nt = 0; nt < SNT; ++nt) _Pragma("unroll") for (int r = 0; r < 4; ++r) uv[S_][nt][r] = Ub[itm * 8192 + (16 * w + 4 * gq + r) * 128 + e0 + 16 * nt + c16]; \
        cd[S_] = cdec[itm]; } while (0)
#define SCAN_STEP(S_, n_) do { \
        h16x8 cwf[4], cqf[4], caf[2], ckf[2][2]; float cu[SNT][4]; const float ccd = cd[S_]; \
        _Pragma("unroll") for (int ks = 0; ks < 4; ++ks) { cwf[ks] = wf[S_][ks]; cqf[ks] = qf[S_][ks]; } \
        _Pragma("unroll") for (int ks = 0; ks < 2; ++ks) { caf[ks] = af[S_][ks]; ckf[0][ks] = kf_[S_][0][ks]; ckf[1][ks] = kf_[S_][1][ks]; } \
        _Pragma("unroll") for (int nt = 0; nt < SNT; ++nt) _Pragma("unroll") for (int r = 0; r < 4; ++r) cu[nt][r] = (float)uv[S_][nt][r]; \
        SCAN_LOAD(S_, (n_) + 2); \
        f32x4 Pm[SNT], O[SNT]; \
        _Pragma("unroll") for (int nt = 0; nt < SNT; ++nt) { Pm[nt] = (f32x4){0.f, 0.f, 0.f, 0.f}; O[nt] = (f32x4){0.f, 0.f, 0.f, 0.f}; \
            _Pragma("unroll") for (int ks = 0; ks < 4; ++ks) { const h16x8 bs = *(const h16x8*)(St + (16 * nt + c16) * 136 + 32 * ks + 8 * gq); Pm[nt] = MFMA16(cwf[ks], bs, Pm[nt]); O[nt] = MFMA16(cqf[ks], bs, O[nt]); } \
            h16x4 vn; \
            _Pragma("unroll") for (int r = 0; r < 4; ++r) vn[r] = (h16)(cu[nt][r] - Pm[nt][r]); \
            *(h16x4*)(Vt + (16 * nt + c16) * 72 + 16 * w + 4 * gq) = vn; } \
        lds_barrier(); \
        _Pragma("unroll") for (int nt = 0; nt < SNT; ++nt) { \
            _Pragma("unroll") for (int m2 = 0; m2 < 2; ++m2) _Pragma("unroll") for (int r = 0; r < 4; ++r) S[m2][nt][r] *= ccd; \
            _Pragma("unroll") for (int ks = 0; ks < 2; ++ks) { const h16x8 bv = *(const h16x8*)(Vt + (16 * nt + c16) * 72 + 32 * ks + 8 * gq); O[nt] = MFMA16(caf[ks], bv, O[nt]); S[0][nt] = MFMA16(ckf[0][ks], bv, S[0][nt]); S[1][nt] = MFMA16(ckf[1][ks], bv, S[1][nt]); } \
            _Pragma("unroll") for (int r = 0; r < 4; ++r) { const int t = 64 * (n_) + 16 * w + 4 * gq + r - 48; if (t >= 0) og[((size_t)b * T_ + t) * 512 + h * 128 + e0 + 16 * nt + c16] = (h16)(O[nt][r] * 0.08838834764831845f); } \
            _Pragma("unroll") for (int m2 = 0; m2 < 2; ++m2) { h16x4 sv; \
                _Pragma("unroll") for (int r = 0; r < 4; ++r) sv[r] = (h16)S[m2][nt][r]; \
                *(h16x4*)(St + (16 * nt + c16) * 136 + 16 * (2 * w + m2) + 4 * gq) = sv; } } \
        lds_barrier(); } while (0)
    SCAN_LOAD(0, 0); SCAN_LOAD(1, 1);
    for (int n = 0; n + 1 < NCH; n += 2) { SCAN_STEP(0, n); SCAN_STEP(1, n + 1); }
    SCAN_STEP(0, NCH - 1);
#undef SCAN_STEP
#undef SCAN_LOAD
}

constexpr int CAP = 704;
__device__ __forceinline__ void dma16_asm(const void* gptr, unsigned lds_addr) {
    unsigned sv; lds_addr = (unsigned)__builtin_amdgcn_readfirstlane((int)lds_addr);
    asm volatile("s_mov_b32 %0, m0\n\ts_mov_b32 m0, %2\n\ts_nop 0\n\tglobal_load_lds_dwordx4 %1, off\n\ts_mov_b32 m0, %0" : "=&s"(sv) : "v"(gptr), "s"(lds_addr) : "memory");
}
__device__ __forceinline__ int dpp_scan_incl(int x) {
    x += __builtin_amdgcn_update_dpp(0, x, 0x111, 0xf, 0xf, false);
    x += __builtin_amdgcn_update_dpp(0, x, 0x112, 0xf, 0xf, false);
    x += __builtin_amdgcn_update_dpp(0, x, 0x114, 0xf, 0xf, false);
    x += __builtin_amdgcn_update_dpp(0, x, 0x118, 0xf, 0xf, false);
    x += __builtin_amdgcn_update_dpp(0, x, 0x142, 0xa, 0xf, false);
    x += __builtin_amdgcn_update_dpp(0, x, 0x143, 0xc, 0xf, false);
    return x;
}

__device__ __forceinline__ int topk_prune(float* sc, unsigned short* ix, unsigned* hist, int c, int lane, int K, int limit, float& theta, float& theta_next) {
    constexpr int NE = (CAP + 63) / 64;
    unsigned key[NE]; unsigned short idx[NE]; float val[NE];
#pragma unroll
    for (int it = 0; it < NE; ++it) { const int i = lane + 64 * it; const bool v = i < c; const float f = v ? sc[i] : 0.f; val[it] = f; idx[it] = v ? ix[i] : (unsigned short)0; key[it] = v ? ordkey(f) : 0u; }
    unsigned prefix = 0; int need = K; int binpop = 0; bool exact = true; int sh = 0;
    const unsigned tb0 = (unsigned)__builtin_amdgcn_readfirstlane((int)(key[0] >> 24));
    bool same = true;
#pragma unroll
    for (int it = 0; it < NE; ++it) same = same && (key[it] == 0u || (key[it] >> 24) == tb0);
    const bool skip0 = __all(same);
    if (skip0) prefix = tb0 << 24;
#pragma unroll
    for (int r = 0; r < 4; ++r) {
        if (r == 0 && skip0) continue;
        const int shift = 24 - 8 * r;
        ((uint4*)hist)[lane] = make_uint4(0u, 0u, 0u, 0u);
        WAVE_FENCE();
#pragma unroll
        for (int it = 0; it < NE; ++it) {
            const bool m = (key[it] != 0u) && (r == 0 || ((key[it] ^ prefix) >> ((shift + 8) & 31)) == 0u);
            if (m) atomicAdd(&hist[(key[it] >> shift) & 255u], 1u);
        }
        WAVE_FENCE();
        const uint4 h4 = ((const uint4*)hist)[63 - lane];
        WAVE_FENCE();
        const int loc = (int)(h4.x + h4.y + h4.z + h4.w);
        const int incl = dpp_scan_incl(loc);
        const int c3 = incl - loc, c2 = c3 + (int)h4.w, c1 = c2 + (int)h4.z, c0 = c1 + (int)h4.y;
        int dsel = -1, cab = 0, hb = 0;
        if (c3 < need && need <= c3 + (int)h4.w) { dsel = 3; cab = c3; hb = (int)h4.w; }
        else if (c2 < need && need <= c2 + (int)h4.z) { dsel = 2; cab = c2; hb = (int)h4.z; }
        else if (c1 < need && need <= c1 + (int)h4.y) { dsel = 1; cab = c1; hb = (int)h4.y; }
        else if (c0 < need && need <= c0 + (int)h4.x) { dsel = 0; cab = c0; hb = (int)h4.x; }
        const u64 fm = __ballot(dsel >= 0);
        const int src = __builtin_amdgcn_readfirstlane(__ffsll((long long)fm) - 1);
        const int digit = __builtin_amdgcn_readlane(4 * (63 - lane) + dsel, src);
        const int cabv = __builtin_amdgcn_readlane(cab, src);
        binpop = __builtin_amdgcn_readlane(hb, src);
        need -= cabv; prefix |= (unsigned)digit << shift; sh = shift;
        if (r < 3 && (K - need) + binpop <= limit) { exact = false; break; }
    }
    (void)sh;
    const unsigned thr = prefix; int out = 0, tb = 0;
#pragma unroll
    for (int it = 0; it < NE; ++it) {
        const bool v = key[it] != 0u; const bool gt = v && key[it] > thr; const bool eq = v && key[it] == thr;
        bool keep;
        if (exact && K == 256) { const u64 meq = __ballot(eq); const int tr = tb + lanes_below(meq); keep = gt || (eq && tr < need); tb += __popcll(meq); }
        else keep = gt || eq;
        const u64 mk = __ballot(keep); const int slot = out + lanes_below(mk);
        if (keep) { sc[slot] = val[it]; ix[slot] = idx[it]; }
        out += __popcll(mk);
    }
    WAVE_FENCE();
    theta = ordinv(thr); theta_next = ordinv(thr + 1u);
    return out;
}

constexpr int WL_SC = 0;
constexpr int WL_IX = 8 * CAP * 4;
constexpr int WL_RING = 0;
constexpr int SLOT_BYTES = 8704;
constexpr int WL_SEL = 34816;
constexpr int WL_NSEL = 38912;
constexpr int WL_BYTES = 38944;
static_assert(WL_IX + 8 * CAP * 2 <= WL_SEL && 4 * SLOT_BYTES <= WL_SEL, "DSA LDS map");

__device__ __forceinline__ void dsa_item(const Params& P, int item, int qlo, int qhi, unsigned char* wl, const float* biasd, int lane) {
    float* sc = (float*)(wl + WL_SC);
    unsigned short* ix = (unsigned short*)(wl + WL_IX);
    unsigned* hist = (unsigned*)(wl + WL_SEL);
    unsigned short* sel = (unsigned short*)(wl + WL_SEL);
    int* nselL = (int*)(wl + WL_NSEL);
    unsigned char* ring = wl + WL_RING;
    const h16* qidx = (const h16*)(P.ws + OFF_QIDX);
    const float* small = (const float*)(P.ws + OFF_SMALL);
    const h16* kvrow = (const h16*)(P.ws + OFF_KVROW);
    const h16* qk = (const h16*)(P.ws + OFF_QK);
    h16* ctxb = (h16*)(P.ws + OFF_CTX);
    const int row0 = item * 8; const int b = row0 >= T_ ? 1 : 0; const int t0 = row0 - b * T_;
    const int half = lane >> 5, kl = lane & 31;
    const unsigned wl_a = (unsigned)(size_t)(LAS unsigned char*)wl;
    unsigned wl_a2 = wl_a; asm volatile("" : "+v"(wl_a2));
    WAVE_FENCE();
    TSEC_BEGIN(3)
    for (int rep_ = 0; rep_ <= (PROBE_TOPK2 | PROBE_SWEEP); ++rep_) {
        const bool dummy_ = PROBE_SWEEP && rep_ == 0;
        h16x8 afr[4];
        { const int qq = kl >> 2, hd = kl & 3; const h16* p = qidx + (size_t)(row0 + qq) * 256 + hd * 64 + 8 * half;
#pragma unroll
          for (int ks = 0; ks < 4; ++ks) afr[ks] = *(const h16x8*)(p + 16 * ks); }
        float wq[4][4]; float thq[8]; int cntq[8];
#pragma unroll
        for (int g = 0; g < 4; ++g) { const float* sp = small + (size_t)(row0 + 2 * g + half) * 16;
#pragma unroll
            for (int hh = 0; hh < 4; ++hh) wq[g][hh] = sp[hh]; }
#pragma unroll
        for (int qq = 0; qq < 8; ++qq) { thq[qq] = (dummy_ || qq < qlo || qq >= qhi) ? INFINITY : -INFINITY; cntq[qq] = 0; }
        const int ntiles = ((t0 + 7) >> 5) + 1;
        bool safe_ = false;
      redo_sweep:
        const h16* kfp = (const h16*)(P.ws + OFF_KFRAG) + (size_t)b * NKT * 2048 + lane * 8;
        h16x8 bt[4][4];
#pragma unroll
        for (int u = 0; u < 4; ++u) { const int tl = u < ntiles ? u : ntiles - 1;
#pragma unroll
            for (int ks = 0; ks < 4; ++ks) bt[u][ks] = *(const h16x8*)(kfp + (size_t)tl * 2048 + ks * 512); }
        const int ngroups = (ntiles + 3) >> 2;
#define SWEEP_GROUP() \
                f32x16 acc[4]; \
                _Pragma("unroll") for (int u = 0; u < 4; ++u) { \
                    _Pragma("unroll") for (int r = 0; r < 16; ++r) acc[u][r] = 0.f; \
                    _Pragma("unroll") for (int ks = 0; ks < 4; ++ks) acc[u] = MFMA32(afr[ks], bt[u][ks], acc[u]); \
                    const int tn = tile0 + u + 4 < ntiles ? tile0 + u + 4 : ntiles - 1;     \
                    _Pragma("unroll") for (int ks = 0; ks < 4; ++ks) bt[u][ks] = *(const h16x8*)(kfp + (size_t)tn * 2048 + ks * 512); } \
                _Pragma("unroll") for (int q = 0; q < 16; ++q) { __builtin_amdgcn_sched_group_barrier(0x8, 1, 0); __builtin_amdgcn_sched_group_barrier(0x20, 1, 0); }     \
                __builtin_amdgcn_sched_barrier(0);
        for (int grp = 0; grp <= ngroups; ++grp) {
            const bool last = grp == ngroups;
            if (!last) {
                const int tile0 = grp * 4;
                f32x16 accs[4];
                { SWEEP_GROUP() _Pragma("unroll") for (int u = 0; u < 4; ++u) accs[u] = acc[u]; }
#define APPEND_CELL(QQ, SV, CAUSAL) do { const float sv_ = (SV); u64 m_; asm("v_cmp_ge_f32 %0, %1, %2" : "=s"(m_) : "v"(sv_), "v"(thq[QQ])); \
                        if (CAUSAL) m_ &= __builtin_amdgcn_ballot_w64(key <= t0 + (QQ)); \
                        const int slot_ = lanes_below_from(m_, cntq[QQ]); \
                        const unsigned a1_ = wl_a + 4u * (unsigned)slot_, a2_ = wl_a2 + 2u * (unsigned)slot_; u64 ex_; \
                        asm volatile("s_and_saveexec_b64 %0, %1\n\tds_write_b32 %2, %3 offset:%6\n\tds_write_b16 %4, %5 offset:%7\n\ts_mov_b64 exec, %0" \
                            : "=&s"(ex_) : "s"(m_), "v"(a1_), "v"(sv_), "v"(a2_), "v"(key), "n"(WL_SC + (QQ) * CAP * 4), "n"(WL_IX + (QQ) * CAP * 2) : "memory"); \
                        cntq[QQ] += __builtin_popcountll(m_); asm("" : "+v"(cntq[QQ])); } while (0)
#define APPEND_PAIR(G, CAUSAL) do { float sa = 0.f, sb = 0.f; \
                        _Pragma("unroll") for (int hh = 0; hh < 4; ++hh) { sa = fmaf(wq[G][hh], relu1(accs[2 * p][4 * (G) + hh]), sa); sb = fmaf(wq[G][hh], relu1(accs[2 * p + 1][4 * (G) + hh]), sb); } \
                        const auto sw = __builtin_amdgcn_permlane32_swap(__float_as_uint(sa), __float_as_uint(sb), false, false);     \
                        APPEND_CELL(2 * (G), __uint_as_float(sw[0]), CAUSAL); APPEND_CELL(2 * (G) + 1, __uint_as_float(sw[1]), CAUSAL); } while (0)
#define APPEND_GROUP(CAUSAL) _Pragma("unroll") for (int p = 0; p < 2; ++p) {     \
                    const int key = (tile0 + 2 * p) * 32 + lane;     \
                    APPEND_PAIR(0, CAUSAL); APPEND_PAIR(1, CAUSAL); APPEND_PAIR(2, CAUSAL); APPEND_PAIR(3, CAUSAL); }
                if (tile0 * 32 + 127 > t0) { APPEND_GROUP(1) } else { APPEND_GROUP(0) }
#undef APPEND_GROUP
#undef APPEND_PAIR
#undef APPEND_CELL
            }
            const int lim = last ? 256 : CAP - 128;
            int cmax = cntq[0];
#pragma unroll
            for (int qq = 1; qq < 8; ++qq) cmax = cntq[qq] > cmax ? cntq[qq] : cmax;
            if (__builtin_amdgcn_readfirstlane(cmax) > lim) {
                WAVE_FENCE();
#pragma unroll 1
                for (int qq = 0; qq < 8; ++qq) {
                    int c = cntq[0];
#pragma unroll
                    for (int j = 1; j < 8; ++j) c = qq == j ? cntq[j] : c;
                    c = __builtin_amdgcn_readfirstlane(c);
                    if (c > lim) {
                        float nth, nthn;
                        const int nall = t0 + qq + 1; int nseen = (grp + 1) * 128; nseen = nseen < nall ? nseen : nall;
                        int K = 256;
                        if (!last && !safe_) { K = (int)(448.f * (float)nseen / (float)nall) + 16; K = K < 48 ? 48 : (K > 256 ? 256 : K); }
                        TSEC_BEGIN(1) TSEC_BEGIN(2)
                        int ncf = c, lm2 = last ? 256 : K + 64; float nv = 0.f;
#pragma unroll 1
                        for (int att = 0; att < 2; ++att) {
                            ncf = topk_prune(sc + qq * CAP, ix + qq * CAP, hist, ncf, lane, K, lm2, nth, nthn);
                            nv = K == 256 ? nthn : nth;
                            if (K == 256 || ncf <= lim) break;
                            K = 256; lm2 = 320;
                        }
                        if (!last) TSEC_END(1); else TSEC_END(2);
#pragma unroll
                        for (int j = 0; j < 8; ++j) if (j == qq) { cntq[j] = ncf; thq[j] = nv; }
                    }
                }
            }
        }
        {
            bool okq = true;
#pragma unroll
            for (int qq = 0; qq < 8; ++qq) okq = okq && (qq < qlo || qq >= qhi || cntq[qq] >= 256 || cntq[qq] >= t0 + qq + 1);
            if (!__builtin_amdgcn_readfirstlane((int)okq) && !safe_ && !dummy_) {
                safe_ = true;
#pragma unroll
                for (int qq = 0; qq < 8; ++qq) { thq[qq] = (qq < qlo || qq >= qhi) ? INFINITY : -INFINITY; cntq[qq] = 0; }
                WAVE_FENCE();
                goto redo_sweep;
            }
        }
#undef SWEEP_GROUP
        WAVE_FENCE();
#pragma unroll 1
        for (int qq = qlo; qq < (dummy_ ? 0 : qhi); ++qq) {
            int c = cntq[0];
#pragma unroll
            for (int j = 1; j < 8; ++j) c = qq == j ? cntq[j] : c;
            c = __builtin_amdgcn_readfirstlane(c);
            if (lane == 0) nselL[qq] = c;
#pragma unroll
            for (int i4 = 0; i4 < 4; ++i4) { const int i = lane + 64 * i4; sel[qq * 256 + i] = i < c ? ix[qq * CAP + i] : (unsigned short)0; }
        }
        WAVE_FENCE();
    }
    TSEC_END(3);
    TSEC_BEGIN(4)
    const int gq = lane >> 4, c16 = lane & 15; const bool hv = c16 < 8;
    const unsigned ring_a = (unsigned)(size_t)(LAS unsigned char*)ring;
    const h16* kvb = kvrow + (size_t)b * T_ * 136;
    int poff[4];
#pragma unroll
    for (int i = 0; i < 4; ++i) poff[i] = (c16 ^ ((4 * i + gq) & 15)) * 8;
    const float b31 = biasd[127 * 8 + (c16 & 7)];
#define DSA_ISSUE(J_) do { const int jj_ = (J_) < 8 * qhi ? (J_) : 8 * qhi - 1; const unsigned short* sp_ = sel + (jj_ >> 3) * 256 + 32 * (jj_ & 7); \
        const h16* a_[8]; \
        _Pragma("unroll") for (int i = 0; i < 8; ++i) a_[i] = kvb + (size_t)sp_[4 * i + gq] * 136 + poff[i & 3]; \
        const h16* ar_ = kvb + (size_t)sp_[lane & 31] * 136 + 128; \
        const unsigned la_ = (unsigned)__builtin_amdgcn_readfirstlane((int)(ring_a + ((J_) & 3) * SLOT_BYTES)); unsigned sv_; unsigned long long ex_; \
        asm volatile("s_mov_b32 %0, m0\n\ts_mov_b32 m0, %2\n\ts_nop 0\n\t" \
            "global_load_lds_dwordx4 %3, off\n\ts_add_u32 m0, m0, 0x400\n\ts_nop 0\n\t" "global_load_lds_dwordx4 %4, off\n\ts_add_u32 m0, m0, 0x400\n\ts_nop 0\n\t" \
            "global_load_lds_dwordx4 %5, off\n\ts_add_u32 m0, m0, 0x400\n\ts_nop 0\n\t" "global_load_lds_dwordx4 %6, off\n\ts_add_u32 m0, m0, 0x400\n\ts_nop 0\n\t" \
            "global_load_lds_dwordx4 %7, off\n\ts_add_u32 m0, m0, 0x400\n\ts_nop 0\n\t" "global_load_lds_dwordx4 %8, off\n\ts_add_u32 m0, m0, 0x400\n\ts_nop 0\n\t" \
            "global_load_lds_dwordx4 %9, off\n\ts_add_u32 m0, m0, 0x400\n\ts_nop 0\n\t" "global_load_lds_dwordx4 %10, off\n\ts_add_u32 m0, m0, 0x400\n\ts_nop 0\n\t" \
            "s_mov_b64 %1, exec\n\ts_mov_b64 exec, 0xffffffff\n\tglobal_load_lds_dwordx4 %11, off\n\ts_mov_b64 exec, %1\n\ts_mov_b32 m0, %0" \
            : "=&s"(sv_), "=&s"(ex_) : "s"(la_), "v"(a_[0]), "v"(a_[1]), "v"(a_[2]), "v"(a_[3]), "v"(a_[4]), "v"(a_[5]), "v"(a_[6]), "v"(a_[7]), "v"(ar_) : "memory"); } while (0)
    for (int rep_ = 0; rep_ <= PROBE_ATT2; ++rep_) {
    asm volatile("s_waitcnt vmcnt(0) lgkmcnt(0)" ::: "memory");
    DSA_ISSUE(8 * qlo); DSA_ISSUE(8 * qlo + 1); DSA_ISSUE(8 * qlo + 2);
#pragma unroll 1
    for (int qq = qlo; qq < qhi; ++qq) {
        const int rowq = row0 + qq, tq = t0 + qq, ns = nselL[qq];
        const unsigned short* selq = sel + qq * 256;
        h16x8 qf[4];
#pragma unroll
        for (int ks = 0; ks < 4; ++ks) {
            if (hv) qf[ks] = *(const h16x8*)(qk + (size_t)rowq * 1024 + c16 * 128 + 32 * ks + 8 * gq);
            else {
#pragma unroll
                for (int e = 0; e < 8; ++e) qf[ks][e] = (h16)0.f;
            }
        }
        float m_run = -INFINITY, l_run = 0.f;
        f32x4 ctx[8];
#pragma unroll
        for (int nt = 0; nt < 8; ++nt) ctx[nt] = (f32x4){0.f, 0.f, 0.f, 0.f};
#pragma unroll 1
        for (int c = 0; c < 8; ++c) {
            const int j = 8 * qq + c;
            DSA_ISSUE(j + 3);
            asm volatile("s_waitcnt vmcnt(27)" ::: "memory");
            const unsigned char* sl = ring + (j & 3) * SLOT_BYTES;
            h16x8 af[2][4];
#pragma unroll
            for (int mt = 0; mt < 2; ++mt)
#pragma unroll
                for (int ks = 0; ks < 4; ++ks) af[mt][ks] = *(const h16x8*)(sl + (16 * mt + c16) * 256 + (((4 * ks + gq) ^ c16) * 16));
            fp16x4 rt[2]; ushort4 sv[2];
#pragma unroll
            for (int mt = 0; mt < 2; ++mt) {
                rt[mt] = __builtin_amdgcn_ds_read_tr16_b64_v4f16((LAS fp16x4*)(sl + 8192 + (16 * mt + 4 * gq + (c16 >> 2)) * 16 + 8 * (c16 & 3)));
                sv[mt] = *(const ushort4*)(selq + 32 * c + 16 * mt + 4 * gq);
            }
            fp16x4 tb[8][2];
            { const int rw0 = 4 * gq + (c16 >> 2), rw1 = 16 + rw0;
#pragma unroll
              for (int nt = 0; nt < 8; ++nt) { const int pc = 2 * nt + ((c16 >> 1) & 1);
                tb[nt][0] = __builtin_amdgcn_ds_read_tr16_b64_v4f16((LAS fp16x4*)(sl + rw0 * 256 + ((pc ^ (rw0 & 15)) * 16) + 8 * (c16 & 1)));
                tb[nt][1] = __builtin_amdgcn_ds_read_tr16_b64_v4f16((LAS fp16x4*)(sl + rw1 * 256 + ((pc ^ (rw1 & 15)) * 16) + 8 * (c16 & 1))); } }
            f32x4 s4[2];
#pragma unroll
            for (int mt = 0; mt < 2; ++mt) { s4[mt] = (f32x4){0.f, 0.f, 0.f, 0.f};
#pragma unroll
                for (int ks = 0; ks < 4; ++ks) s4[mt] = MFMA16(af[mt][ks], qf[ks], s4[mt]); }
            int dist[2][4]; int dmin = 127;
#pragma unroll
            for (int mt = 0; mt < 2; ++mt) { const int sarr[4] = {(int)sv[mt].x, (int)sv[mt].y, (int)sv[mt].z, (int)sv[mt].w};
#pragma unroll
                for (int r = 0; r < 4; ++r) { int d = tq - sarr[r]; d = d < 0 ? 0 : (d > 127 ? 127 : d); dist[mt][r] = d; dmin = d < dmin ? d : dmin; } }
            float bias[2][4];
            if (__all(dmin == 127)) {
#pragma unroll
                for (int mt = 0; mt < 2; ++mt)
#pragma unroll
                    for (int r = 0; r < 4; ++r) bias[mt][r] = b31;
            } else {
#pragma unroll
                for (int mt = 0; mt < 2; ++mt)
#pragma unroll
                    for (int r = 0; r < 4; ++r) bias[mt][r] = biasd[dist[mt][r] * 8 + (c16 & 7)];
            }
            float lg[2][4]; float mx = -INFINITY;
#pragma unroll
            for (int mt = 0; mt < 2; ++mt) { const h16x4 rr = __builtin_bit_cast(h16x4, rt[mt]);
#pragma unroll
                for (int r = 0; r < 4; ++r) {
                    const int kidx = 32 * c + 16 * mt + 4 * gq + r; const bool valid = hv && (kidx < ns);
                    const float v = valid ? s4[mt][r] * (float)rr[r] + bias[mt][r] : -INFINITY;
                    lg[mt][r] = v; mx = fmaxf(mx, v);
                } }
            {
                const unsigned u0 = __float_as_uint(mx);
                const auto p16 = __builtin_amdgcn_permlane16_swap(u0, u0, false, false);
                const float y = fmaxf(__uint_as_float(p16[0]), __uint_as_float(p16[1]));
                const unsigned u1 = __float_as_uint(y);
                const auto p32 = __builtin_amdgcn_permlane32_swap(u1, u1, false, false);
                mx = fmaxf(__uint_as_float(p32[0]), __uint_as_float(p32[1]));
            }
            const float m_new = fmaxf(m_run, mx);
            const float alpha = (hv && m_new > -INFINITY) ? __expf(m_run - m_new) : 1.f;
            float rs = 0.f; float pp[2][4];
#pragma unroll
            for (int mt = 0; mt < 2; ++mt)
#pragma unroll
                for (int r = 0; r < 4; ++r) { const float p = (hv && lg[mt][r] > -INFINITY) ? __expf(lg[mt][r] - m_new) : 0.f; pp[mt][r] = p; rs += p; }
            {
                const unsigned u0 = __float_as_uint(rs);
                const auto p16 = __builtin_amdgcn_permlane16_swap(u0, u0, false, false);
                const float y = __uint_as_float(p16[0]) + __uint_as_float(p16[1]);
                const unsigned u1 = __float_as_uint(y);
                const auto p32 = __builtin_amdgcn_permlane32_swap(u1, u1, false, false);
                rs = __uint_as_float(p32[0]) + __uint_as_float(p32[1]);
            }
            l_run = l_run * alpha + rs; m_run = m_new;
            h16x8 pa;
#pragma unroll
            for (int jx = 0; jx < 8; ++jx) pa[jx] = (h16)pp[jx >> 2][jx & 3];
            if (__any(alpha != 1.f)) {
                float ar[4];
#pragma unroll
                for (int r = 0; r < 4; ++r) ar[r] = __shfl(alpha, 4 * gq + r);
#pragma unroll
                for (int nt = 0; nt < 8; ++nt)
#pragma unroll
                    for (int r = 0; r < 4; ++r) ctx[nt][r] *= ar[r];
            }
#pragma unroll
            for (int nt = 0; nt < 8; ++nt) {
                const h16x4 b0 = __builtin_bit_cast(h16x4, tb[nt][0]), b1 = __builtin_bit_cast(h16x4, tb[nt][1]);
                h16x8 bf; bf[0] = b0[0]; bf[1] = b0[1]; bf[2] = b0[2]; bf[3] = b0[3]; bf[4] = b1[0]; bf[5] = b1[1]; bf[6] = b1[2]; bf[7] = b1[3];
                ctx[nt] = MFMA16(pa, bf, ctx[nt]);
            }
        }
        float li[4];
#pragma unroll
        for (int r = 0; r < 4; ++r) li[r] = 1.f / __shfl(l_run, (4 * gq + r) & 7);
        if (gq < 2) {
#pragma unroll
            for (int nt = 0; nt < 8; ++nt)
#pragma unroll
                for (int r = 0; r < 4; ++r) ctxb[(size_t)rowq * 1024 + (4 * gq + r) * 128 + 16 * nt + c16] = (h16)(ctx[nt][r] * li[r]);
        }
    }
    asm volatile("s_waitcnt vmcnt(0)" ::: "memory");
    }
#undef DSA_ISSUE
    WAVE_FENCE();
    TSEC_END(4);
}

__device__ __forceinline__ void phase3(const Params& P, int l, unsigned char* lds) {
    const int tid = opaque_tid(), lane = tid & 63, w = tid >> 6;
    float* biasd = (float*)(lds + 4 * WL_BYTES);
    __syncthreads();
    for (int i = tid; i < 1024; i += NTHREADS) biasd[i] = P.rel[(int)c_bucket[i >> 3] * 8 + (i & 7)];
    __syncthreads();
    { TSEC_BEGIN(10)
    for (int rep_ = 0; rep_ <= PROBE_SCAN2; ++rep_) for (int sw = blockIdx.x; sw < 8 * (8 / SNT); sw += gridDim.x) gdn_scan(P, sw, lds);
    TSEC_END(10); }
    __syncthreads();
    unsigned* ctr = (unsigned*)(P.ws + OFF_CTL) + 4608 + l * 128;
    unsigned char* wl = lds + w * WL_BYTES;
    const int x0 = (int)xb_xcc_id() & 7; int d = 0;
    for (;;) {
        int item = -1;
        if (lane == 0) {
            while (d < 8) {
                const int xc = (x0 + d) & 7; const int bb = xc >> 2, sub = xc & 3; const int cnt = (1026 - sub + 3) >> 2;
                const int pf = 230;
                const int t = (int)__hip_atomic_fetch_add(ctr + xc * 16, 1u, __ATOMIC_RELAXED, __HIP_MEMORY_SCOPE_AGENT);
                if (t < pf + 2 * (cnt - pf)) {
                    const int p = t < pf ? t : pf + ((t - pf) >> 1);
                    item = (bb * 1026 + 4 * (cnt - 1 - p) + sub) * 4 + (t < pf ? 0 : 1 + ((t - pf) & 1));
                    break;
                }
                ++d;
            }
        }
        d = __builtin_amdgcn_readfirstlane(d);
        item = __builtin_amdgcn_readfirstlane(item);
        if (item < 0) break;
        { const int hsel = item & 3; dsa_item(P, item >> 2, hsel == 2 ? 4 : 0, hsel == 1 ? 4 : 8, wl, biasd, lane); }
    }
}

__device__ __forceinline__ void phase4(const Params& P, int l, unsigned char* lds) {
    const int tid = opaque_tid(), lane = tid & 63, w = tid >> 6;
    (void)lds;
    if (l == 0 && (int)gridDim.x > 160 && (int)blockIdx.x >= 129) { prep_tiles(P, lds, 1, 129, (int)gridDim.x - 129); return; }
    TSEC_BEGIN(11)
    for (int it = blockIdx.x * 4 + w; it < (NT + 31) / 32; it += gridDim.x * 4) p4_item(P, l, it, lane);
    TSEC_END(11);
    if (l == 0 && (int)gridDim.x <= 160) { __syncthreads(); prep_tiles(P, lds, 1, 0, (int)gridDim.x); }
}

__device__ __forceinline__ void phase5(const Params& P, int l, unsigned char* lds) {
    h16* smem = (h16*)lds;
    const h16* W = (const h16*)(P.ws + OFF_WOT) + (size_t)l * 1024 * 1024;
    const h16* A = (const h16*)(P.ws + OFF_OMIX);
    float* sumsq_next = (float*)(P.ws + OFF_SUMSQ) + NTP;
    XcdQueue xq; xq.init((unsigned*)(P.ws + OFF_CTL) + 4352 + l * 128, 32, (int*)(lds + LDS_BYTES - 32));
    int xl, qi;
    while (xq.next(xl, qi)) {
        const int rb = 8 * xl + (qi & 7), tn = qi >> 3;
        EpiResBig ep; ep.layer = l; ep.row0 = rb * 256; ep.n0 = tn * 256; ep.meta = P.meta; ep.x = P.x; ep.metah = (float*)(P.ws + OFF_METAH); ep.out = P.out; ep.h16o = (h16*)(P.ws + OFF_H16); ep.sumsq_next = sumsq_next; ep.ss = 0.f; ep.nseg = 4;
        gemm_big(A + (size_t)rb * 256 * 1024, 1024, W + (size_t)tn * 256 * 1024, 1024, 1024, ep, smem);
    }
    __syncthreads();
    const int tid = opaque_tid();
    for (int it = blockIdx.x; it < 32; it += gridDim.x) {
        EpiResBig ep; ep.layer = l; ep.row0 = 16384; ep.n0 = it * 32; ep.meta = P.meta; ep.x = P.x; ep.metah = (float*)(P.ws + OFF_METAH); ep.out = P.out; ep.h16o = (h16*)(P.ws + OFF_H16); ep.sumsq_next = sumsq_next; ep.ss = 0.f; ep.nseg = 1;
        skinny_tile(A + (size_t)16384 * 1024, 1024, W + (size_t)it * 32 * 1024, 1024, 1024, ep, (float*)lds, tid);
    }
}

__global__ void __launch_bounds__(NTHREADS) hybrid_fwd(Params P) {
    extern __shared__ __attribute__((aligned(16))) unsigned char lds[];
    cg::grid_group grid = cg::this_grid();
    volatile LAS unsigned* bst = (volatile LAS unsigned*)(lds + LDS_BYTES - 16);
    if (threadIdx.x < 4) bst[threadIdx.x] = 0u;
    if (PROBE_TSEC && (threadIdx.x & 63) == 0) *tsec_slot() = 0ull;
    __syncthreads();
    XcdBarrier xbar = xcd_barrier_post((unsigned*)(P.ws + OFF_CTL) + 256, bst);
    if (PROBE_MFMA) {
        f32x16 pa[8]; h16x8 fa, fb;
#pragma unroll
        for (int e = 0; e < 8; ++e) { fa[e] = (h16)(0.001f * (threadIdx.x & 7)); fb[e] = (h16)0.5f; }
#pragma unroll
        for (int i = 0; i < 8; ++i)
#pragma unroll
            for (int r = 0; r < 16; ++r) pa[i][r] = 0.f;
        h16* lp = (h16*)lds + (threadIdx.x & 31) * 72 + 8 * ((threadIdx.x >> 5) & 1) + (threadIdx.x >> 6) * 2304;
#pragma unroll 1
        for (int it = 0; it < 256; ++it) {
            if (PROBE_MFMA == 2) {
                h16x8 t[8];
#pragma unroll
                for (int q = 0; q < 8; ++q) t[q] = *(const h16x8*)(lp + q * 32 * 72 + (it & 3) * 16);
#pragma unroll
                for (int q = 0; q < 4; ++q) *(h16x8*)(lp + 40000 + q * 32 * 72) = fb;
#pragma unroll
                for (int i = 0; i < 16; ++i) pa[i & 7] = MFMA32(t[i & 7], fb, pa[i & 7]);
#pragma unroll
                for (int q = 0; q < 12; ++q) { __builtin_amdgcn_sched_group_barrier(0x8, 1, 0); __builtin_amdgcn_sched_group_barrier(0x300, 1, 0); }
                __builtin_amdgcn_sched_group_barrier(0x8, 4, 0);
                __builtin_amdgcn_sched_barrier(0);
            } else {
#pragma unroll
                for (int i = 0; i < 16; ++i) pa[i & 7] = MFMA32(fa, fb, pa[i & 7]);
            }
        }
        float sacc = 0.f;
#pragma unroll
        for (int i = 0; i < 8; ++i) sacc += pa[i][0];
        if (sacc == 12345.678f) ((float*)(P.ws + OFF_CTL))[40] = sacc;
    }
    for (int ph = P.ph_lo; ph < P.ph_hi; ++ph) {
#ifndef ONLY
#define ONLY -1
#endif
        if (ph == 0) { TSEC_BEGIN(13) if (ONLY < 0 || ((ONLY >> 0) & 1)) for (int rep_ = 0; rep_ <= PROBE_P0X; ++rep_) phase_prep(P, lds); TSEC_END(13); }
        else {
            const int l = (ph - 1) / 5, s = (ph - 1) % 5;
            if (s == 0) { if (ONLY < 0 || ((ONLY >> 1) & 1)) for (int rep_ = 0; rep_ <= PROBE_P1X; ++rep_) phase_inproj(P, l, lds, rep_); }
            else if (s == 1) { if (ONLY < 0 || ((ONLY >> 2) & 1)) phase2(P, l, lds); }
            else if (s == 2) { if (ONLY < 0 || ((ONLY >> 3) & 1)) phase3(P, l, lds); }
            else if (s == 3) { if (ONLY < 0 || ((ONLY >> 4) & 1)) for (int rep_ = 0; rep_ <= PROBE_P4X; ++rep_) phase4(P, l, lds); }
            else { if (ONLY < 0 || ((ONLY >> 5) & 1)) for (int rep_ = 0; rep_ <= (l == 0 ? PROBE_P5L0X : 0); ++rep_) phase5(P, l, lds); }
        }
        if (ph + 1 < P.ph_hi) {
            if (P.ph_hi > 1000) grid.sync();
            { TSEC_BEGIN(20) if (PROBE_TSEC >= 20 && PROBE_TSEC - 20 == ph) t__20 = wall_clock64(); xcd_barrier(xbar); if (PROBE_TSEC >= 20 && PROBE_TSEC - 20 == ph) { const unsigned long long d__ = wall_clock64() - t__20; if ((threadIdx.x & 63) == 0) *tsec_slot() += d__; } }
            if (PROBE_SYNC) xcd_barrier(xbar);
        }
    }
    if (PROBE_TSEC) {
        unsigned long long* acc = (unsigned long long*)((unsigned*)(P.ws + OFF_CTL) + 32);
        __syncthreads();
        if ((threadIdx.x & 63) == 0) atomicAdd(acc, *tsec_slot());
        xcd_barrier(xbar);
        if (blockIdx.x == 0 && threadIdx.x == 0) {
            const unsigned long long tot = __hip_atomic_load(acc, __ATOMIC_RELAXED, __HIP_MEMORY_SCOPE_AGENT);
            const unsigned long long avg = tot / (gridDim.x * 4);
            const unsigned long long t0 = wall_clock64();
            while (wall_clock64() - t0 < avg) __builtin_amdgcn_s_sleep(4);
        }
    }
}

extern "C" void kernel_launch(void* const* d_in, const int* in_sizes, int n_in, void* d_out, int out_size, void* d_ws, size_t ws_size, hipStream_t stream) {
    static int grid_blocks = 0;
    if (grid_blocks == 0) {
        if (n_in != 17 || ws_size < WS_END) { fprintf(stderr, "kernel_launch: unexpected inputs (n_in %d, ws %zu < %zu)\n", n_in, ws_size, (size_t)WS_END); grid_blocks = -1; return; }
        int dev = 0, cus = 0, per_cu = 0;
        hipGetDevice(&dev);
        hipDeviceGetAttribute(&cus, hipDeviceAttributeMultiprocessorCount, dev);
        if (hipFuncSetAttribute((const void*)hybrid_fwd, hipFuncAttributeMaxDynamicSharedMemorySize, LDS_BYTES) != hipSuccess) { fprintf(stderr, "kernel_launch: hipFuncSetAttribute failed\n"); grid_blocks = -1; return; }
        hipOccupancyMaxActiveBlocksPerMultiprocessor(&per_cu, (const void*)hybrid_fwd, NTHREADS, LDS_BYTES);
        if (per_cu < 1) { fprintf(stderr, "kernel_launch: occupancy query says 0 blocks per CU\n"); grid_blocks = -1; return; }
        grid_blocks = cus * per_cu;
    }
    if (grid_blocks < 0) return;
    hipMemsetAsync((char*)d_ws + OFF_CTL, 0, 32768, stream);
    hipMemsetAsync((char*)d_ws + OFF_SUMSQ, 0, (size_t)2 * NTP * 4, stream);
    Params p{};
    p.x = (const float*)d_in[0]; p.meta = (const float*)d_in[1]; p.rel = (const float*)d_in[2]; p.norm_gain = (const float*)d_in[3];
    p.w_in = (const float*)d_in[4]; p.g_cq = (const float*)d_in[5]; p.g_ckv = (const float*)d_in[6]; p.w_uq = (const float*)d_in[7];
    p.w_ukv = (const float*)d_in[8]; p.w_qidx = (const float*)d_in[9]; p.g_qn = (const float*)d_in[10]; p.g_kn = (const float*)d_in[11];
    p.conv_w = (const float*)d_in[12]; p.a_log = (const float*)d_in[13]; p.dt_bias = (const float*)d_in[14]; p.g_out = (const float*)d_in[15];
    p.w_out = (const float*)d_in[16];
    p.out = (float*)d_out; p.ws = (unsigned char*)d_ws;
#if N_LAUNCH_MODE == 1
    p.ph_lo = 0; p.ph_hi = NPHASE;
    void* args[] = {&p};
    hipError_t e = hipLaunchCooperativeKernel((const void*)hybrid_fwd, dim3(grid_blocks), dim3(NTHREADS), args, LDS_BYTES, stream);
    if (e != hipSuccess) fprintf(stderr, "cooperative launch failed: %s (grid %d)\n", hipGetErrorString(e), grid_blocks);
#else
    for (int ph = 0; ph < NPHASE; ++ph) {
        p.ph_lo = ph; p.ph_hi = ph + 1;
        hipLaunchKernelGGL(hybrid_fwd, dim3(grid_blocks), dim3(NTHREADS), LDS_BYTES, stream, p);
    }
#endif
}
```

```cpp
#include <hip/hip_runtime.h>
#include <hip/hip_cooperative_groups.h>
#include <stdio.h>
#include <stdint.h>
namespace cg = cooperative_groups;

#define PROBE_TOPK2 0
#define PROBE_ATT2 0
#define PROBE_P1X 0
#define PROBE_P2X 0
#define PROBE_SCAN2 0
#define PROBE_P4X 0
#define PROBE_P0X 0
#define PROBE_P5L0X 0
#define PROBE_SYNC 0
#define PROBE_SWEEP 0
#define PROBE_P2C 0
#define PROBE_CHAIN 0
#define PROBE_MFMA 0
#define PROBE_TSEC 0
#define PROBE_S1 0
#define PROBE_S3 0
#define PROBE_S5 0
#ifndef N_LAUNCH_MODE
#define N_LAUNCH_MODE 1
#endif

typedef _Float16 h16;
typedef unsigned short u16x8 __attribute__((ext_vector_type(8)));
typedef h16 h16x8 __attribute__((ext_vector_type(8)));
typedef h16 h16x4 __attribute__((ext_vector_type(4)));
typedef float f32x4 __attribute__((ext_vector_type(4)));
typedef float f32x16 __attribute__((ext_vector_type(16)));
typedef unsigned long long u64;
typedef __fp16 fp16x4 __attribute__((__vector_size__(4 * sizeof(__fp16))));

#define MFMA32(a, b, c) __builtin_amdgcn_mfma_f32_32x32x16_f16(a, b, c, 0, 0, 0)
#define MFMA16(a, b, c) __builtin_amdgcn_mfma_f32_16x16x32_f16(a, b, c, 0, 0, 0)
#define WAVE_FENCE() do { __builtin_amdgcn_fence(__ATOMIC_SEQ_CST, "wavefront"); __builtin_amdgcn_wave_barrier(); } while (0)

constexpr int T_ = 8208;
constexpr int NT = 16416;
constexpr int NTP = 16512;
constexpr int NRB = 129;
constexpr int NCH = 129;
constexpr int NGI = 8 * NCH;
constexpr int NKT = 257;
constexpr float EPS = 1e-6f;
constexpr int NTHREADS = 256;
constexpr int LDS_BYTES = 163840;
constexpr int NPHASE = 11;

constexpr size_t OFF_CTL = 0;
constexpr size_t OFF_W1T = 32768;
constexpr size_t OFF_WOT = OFF_W1T + (size_t)2 * 3072 * 1024 * 2;
constexpr size_t OFF_WQ2T = OFF_WOT + (size_t)2 * 1024 * 1024 * 2;
constexpr size_t OFF_WUKT = OFF_WQ2T + (size_t)2 * 768 * 256 * 2;
constexpr size_t OFF_WKABS = OFF_WUKT + (size_t)2 * 512 * 128 * 2;
constexpr size_t OFF_WUVT = OFF_WKABS + (size_t)2 * 8 * 128 * 64 * 2;
constexpr size_t OFF_SMALL = OFF_WUVT + (size_t)2 * 8 * 64 * 128 * 2;
constexpr size_t OFF_SZA = OFF_SMALL + (size_t)NTP * 16 * 4;
constexpr size_t OFF_SZG = OFF_SZA + (size_t)NTP * 512 * 2;
constexpr size_t OFF_PROJG = OFF_SZG + (size_t)NTP * 512 * 2;
constexpr size_t OFF_PROJA = OFF_PROJG + (size_t)NTP * 1536 * 2;
constexpr size_t OFF_QIDX = OFF_PROJA + (size_t)NTP * 512 * 2;
constexpr size_t OFF_QN = OFF_QIDX + (size_t)NTP * 256 * 2;
constexpr size_t OFF_QK = OFF_QN + (size_t)NTP * 512 * 2;
constexpr size_t OFF_KVROW = OFF_QK + (size_t)NTP * 1024 * 2;
constexpr size_t OFF_KFRAG = OFF_KVROW + (size_t)NTP * 136 * 2;
constexpr size_t OFF_U = OFF_KFRAG + (size_t)2 * NKT * 2048 * 2;
constexpr size_t OFF_WM = OFF_U + (size_t)NGI * 8192 * 2;
constexpr size_t OFF_QD = OFF_WM + (size_t)NGI * 8192 * 2;
constexpr size_t OFF_KDT = OFF_QD + (size_t)NGI * 8192 * 2;
constexpr size_t OFF_AQK = OFF_KDT + (size_t)NGI * 8192 * 2;
constexpr size_t OFF_CDEC = OFF_AQK + (size_t)NGI * 4096 * 2;
constexpr size_t OFF_METAH = OFF_CDEC + 8192;
constexpr size_t OFF_SUMSQ = OFF_METAH + (size_t)2 * 16 * 1024 * 4;
constexpr size_t WS_END = OFF_SUMSQ + (size_t)2 * NTP * 4;
constexpr size_t OFF_H16 = OFF_QK;
constexpr size_t OFF_CTX = OFF_PROJG;
constexpr size_t OFF_OMIX = OFF_PROJG + (size_t)NTP * 1024 * 2;

struct Params {
    const float* x; const float* meta; const float* rel; const float* norm_gain; const float* w_in;
    const float* g_cq; const float* g_ckv; const float* w_uq; const float* w_ukv; const float* w_qidx;
    const float* g_qn; const float* g_kn; const float* conv_w; const float* a_log; const float* dt_bias;
    const float* g_out; const float* w_out;
    float* out; unsigned char* ws;
    int ph_lo, ph_hi;
};

__constant__ unsigned char c_bucket[128] = {
    0, 1, 2, 3, 4, 5, 6, 7, 8, 9, 10, 11, 12, 13, 14, 15, 16, 16, 16, 17, 17, 18, 18, 18, 19, 19, 19, 20, 20, 20, 20, 21,
    21, 21, 21, 22, 22, 22, 22, 22, 23, 23, 23, 23, 23, 23, 24, 24, 24, 24, 24, 24, 25, 25, 25, 25, 25, 25, 25, 26, 26, 26, 26, 26,
    26, 26, 26, 27, 27, 27, 27, 27, 27, 27, 27, 27, 27, 28, 28, 28, 28, 28, 28, 28, 28, 28, 28, 29, 29, 29, 29, 29, 29, 29, 29, 29,
    29, 29, 29, 30, 30, 30, 30, 30, 30, 30, 30, 30, 30, 30, 30, 30, 30, 31, 31, 31, 31, 31, 31, 31, 31, 31, 31, 31, 31, 31, 31, 31};

__device__ __forceinline__ unsigned long long* tsec_slot() { extern __shared__ __attribute__((aligned(16))) unsigned char tsec_lds__[]; return (unsigned long long*)(tsec_lds__ + LDS_BYTES - 128) + (threadIdx.x >> 6); }
#define TSEC_BEGIN(id) unsigned long long t__##id = 0; if (PROBE_TSEC == (id)) t__##id = wall_clock64();
#define TSEC_END(id) do { if (PROBE_TSEC == (id)) { const unsigned long long d__ = wall_clock64() - t__##id; if ((threadIdx.x & 63) == 0) *tsec_slot() += d__; } } while (0)
__device__ __forceinline__ float shfl_l(float v, int src_lane) { return __int_as_float(__builtin_amdgcn_ds_bpermute(src_lane << 2, __float_as_int(v))); }
__device__ __forceinline__ float silu_f(float x) { return x * __builtin_amdgcn_rcpf(1.f + __expf(-x)); }
__device__ __forceinline__ int lanes_below(u64 m) { return __builtin_amdgcn_mbcnt_hi((unsigned)(m >> 32), __builtin_amdgcn_mbcnt_lo((unsigned)m, 0)); }
__device__ __forceinline__ int lanes_below_from(u64 m, int base) { return __builtin_amdgcn_mbcnt_hi((unsigned)(m >> 32), __builtin_amdgcn_mbcnt_lo((unsigned)m, base)); }
__device__ __forceinline__ float relu1(float x) { const int i = __float_as_int(x); return __int_as_float(i > 0 ? i : 0); }
__device__ __forceinline__ unsigned ordkey(float f) { const unsigned u = __float_as_uint(f); return u ^ ((unsigned)((int)u >> 31) | 0x80000000u); }
__device__ __forceinline__ float ordinv(unsigned k) { unsigned u = (k & 0x80000000u) ? (k & 0x7fffffffu) : ~k; return __uint_as_float(u); }
__device__ __forceinline__ int opaque_tid() { int t = threadIdx.x; asm volatile("" : "+v"(t)); return t; }
__device__ __forceinline__ void lds_barrier() { asm volatile("s_waitcnt lgkmcnt(0)\n\ts_barrier" ::: "memory"); }

#define XB_TMO      128
#define XB_XCNT(j)  (256  + 64 * (j))
#define XB_XSUB(j)  (1280 + 64 * (j))
#define XB_XGEN(j)  (2304 + 64 * (j))
#define XB_TOP      3328
#define XB_TOPGEN   3392
#define XCD_BAR_WORDS 3456
#define XB_SPIN_CAP (1u << 22)
#define LAS __attribute__((address_space(3)))
__device__ __forceinline__ unsigned xb_ld(unsigned* p)              { return __hip_atomic_load(p, __ATOMIC_RELAXED, __HIP_MEMORY_SCOPE_AGENT); }
__device__ __forceinline__ unsigned xb_add(unsigned* p, unsigned v) { return __hip_atomic_fetch_add(p, v, __ATOMIC_RELAXED, __HIP_MEMORY_SCOPE_AGENT); }
__device__ __forceinline__ unsigned xb_xcc_id() { return (unsigned)__builtin_amdgcn_s_getreg((3 << 11) | 20) & 0xFu; }
#define XB_SPIN(cond, bar) do { unsigned _sp = 0; while (cond) { __builtin_amdgcn_s_sleep(1); \
    if ((++_sp & 255u) == 0u) { if (xb_ld(&(bar)[XB_TMO])) break; if (_sp > XB_SPIN_CAP) { atomicAdd(&(bar)[XB_TMO], 1u); break; } } } } while (0)
struct XcdBarrier { unsigned* bar; unsigned x; volatile LAS unsigned* st; };
__device__ __forceinline__ XcdBarrier xcd_barrier_post(unsigned* bar, volatile LAS unsigned* st) {
    XcdBarrier b; b.bar = bar; b.x = xb_xcc_id(); b.st = st;
    if (threadIdx.x == 0) (void)xb_add(&bar[XB_XCNT(b.x)], 1u);
    return b;
}
__device__ __forceinline__ void xcd_barrier_complete(unsigned* bar, unsigned x, unsigned& nloc, unsigned& nx) {
    const unsigned G = gridDim.x * gridDim.y * gridDim.z;
    unsigned sum, cnt, mine, sp = 0u;
    for (;;) {
        sum = 0u; cnt = 0u; mine = 0u;
#pragma unroll
        for (unsigned j = 0; j < 16; ++j) { const unsigned c = xb_ld(&bar[XB_XCNT(j)]); sum += c; cnt += (c > 0u) ? 1u : 0u; mine = (j == x) ? c : mine; }
        if (sum == G) break;
        __builtin_amdgcn_s_sleep(1);
        if ((++sp & 255u) == 0u) { if (xb_ld(&bar[XB_TMO])) break; if (sp > XB_SPIN_CAP) { atomicAdd(&bar[XB_TMO], 1u); break; } }
    }
    nloc = mine > 0u ? mine : 1u; nx = cnt > 0u ? cnt : 1u;
}
__device__ __forceinline__ void xcd_barrier(const XcdBarrier& b) {
    TSEC_BEGIN(5)
    asm volatile("s_waitcnt vmcnt(0)" ::: "memory");
    __syncthreads();
    if (threadIdx.x == 0) {
        unsigned* bar = b.bar;
        __builtin_amdgcn_s_waitcnt(0);
        unsigned nloc = b.st[0], nx = b.st[1];
        if (nloc == 0u) { xcd_barrier_complete(bar, b.x, nloc, nx); b.st[0] = nloc; b.st[1] = nx; }
        const unsigned old = xb_add(&bar[XB_XSUB(b.x)], 1u);
        const unsigned gen = old / nloc;
        if (old + 1u == (gen + 1u) * nloc) {
            __builtin_amdgcn_fence(__ATOMIC_RELEASE, "agent");
            asm volatile("s_waitcnt vmcnt(0)" ::: "memory");
            const unsigned og = xb_add(&bar[XB_TOP], 1u);
            const unsigned tg = og / nx;
            if (og + 1u == (tg + 1u) * nx) xb_add(&bar[XB_TOPGEN], 1u);
            else XB_SPIN(xb_ld(&bar[XB_TOPGEN]) == tg, bar);
            __builtin_amdgcn_fence(__ATOMIC_ACQUIRE, "agent");
            xb_add(&bar[XB_XGEN(b.x)], 1u);
            asm volatile("s_waitcnt vmcnt(0)" ::: "memory");
        } else {
            XB_SPIN(xb_ld(&bar[XB_XGEN(b.x)]) == gen, bar);
            __builtin_amdgcn_fence(__ATOMIC_ACQUIRE, "agent");
            asm volatile("s_waitcnt vmcnt(0)" ::: "memory");
        }
    }
    __syncthreads();
    TSEC_END(5);
}

struct XcdQueue {
    unsigned* ctr; int n_per; int x0; int d; int* slot;
    int pend;
    __device__ __forceinline__ void init(unsigned* c, int np, int* s) { ctr = c; n_per = np; x0 = (int)xb_xcc_id() & 7; d = 0; slot = s; pend = -1; }
    __device__ __forceinline__ void lookahead() { if (threadIdx.x == 0 && d < 8) pend = (int)__hip_atomic_fetch_add(ctr + ((x0 + d) & 7) * 16, 1u, __ATOMIC_RELAXED, __HIP_MEMORY_SCOPE_AGENT); }
    __device__ __forceinline__ bool next(int& xl, int& q) {
        __syncthreads();
        if (threadIdx.x == 0) {
            int res = -1;
            if (pend >= 0) { if (pend < n_per) res = ((x0 + d) & 7) * 65536 + pend; else ++d; pend = -1; }
            if (res < 0) while (d < 8) {
                const int xc = (x0 + d) & 7;
                const unsigned t = __hip_atomic_fetch_add(ctr + xc * 16, 1u, __ATOMIC_RELAXED, __HIP_MEMORY_SCOPE_AGENT);
                if ((int)t < n_per) { res = xc * 65536 + (int)t; break; }
                ++d;
            }
            *slot = res;
        }
        __syncthreads();
        const int r = *slot;
        if (r < 0) return false;
        xl = r >> 16; q = r & 65535;
        return true;
    }
};

constexpr int GS = 72;

struct AF16 {
    const h16* p; int ld;
    __device__ __forceinline__ void init(int) {}
    __device__ __forceinline__ h16x8 load(int i, int row, int k) { return *(const h16x8*)(p + (size_t)row * ld + k); }
};

struct AH32 {
    const float* meta; const float* xs; int meta_bstride;
    const float* rp[4]; float ss[4];
    __device__ __forceinline__ const float* rowptr(int row) const {
        row = row < NT ? row : NT - 1;
        int b = row >= T_ ? 1 : 0; int t = row - b * T_;
        return t < 16 ? meta + (size_t)b * meta_bstride + (size_t)t * 1024 : xs + ((size_t)b * 8192 + (t - 16)) * 1024;
    }
    __device__ __forceinline__ h16x8 load(int i, int, int k) {
        const float4 v0 = *(const float4*)(rp[i] + k), v1 = *(const float4*)(rp[i] + k + 4);
        ss[i] += v0.x * v0.x + v0.y * v0.y + v0.z * v0.z + v0.w * v0.w + v1.x * v1.x + v1.y * v1.y + v1.z * v1.z + v1.w * v1.w;
        h16x8 r; r[0] = (h16)v0.x; r[1] = (h16)v0.y; r[2] = (h16)v0.z; r[3] = (h16)v0.w; r[4] = (h16)v1.x; r[5] = (h16)v1.y; r[6] = (h16)v1.z; r[7] = (h16)v1.w;
        return r;
    }
};

template <int BN, class AL, class EP>
__device__ __forceinline__ void gemm_tile(AL& al, int arow0, const h16* __restrict__ Bt, int ldb, int K, EP& ep, h16* smem) {
    const int tid = opaque_tid(), lane = tid & 63, w = tid >> 6, wm = w >> 1, wn = w & 1;
    constexpr int NTL = BN / 64;
    constexpr int NBG = BN / 32;
    constexpr int BUF = (128 + BN) * GS;
    f32x16 acc[2][NTL];
#pragma unroll
    for (int i = 0; i < 2; ++i)
#pragma unroll
        for (int j = 0; j < NTL; ++j)
#pragma unroll
            for (int r = 0; r < 16; ++r) acc[i][j][r] = 0.f;
    h16x8 ra[4], rb[NBG];
    const int nk = K >> 6;
#pragma unroll
    for (int i = 0; i < 4; ++i) { int g = tid + 256 * i; ra[i] = al.load(i, arow0 + (g >> 3), (g & 7) * 8); }
#pragma unroll
    for (int i = 0; i < NBG; ++i) { int g = tid + 256 * i; rb[i] = *(const h16x8*)(Bt + (size_t)(g >> 3) * ldb + (g & 7) * 8); }
    __syncthreads();
#pragma unroll
    for (int i = 0; i < 4; ++i) { int g = tid + 256 * i; *(h16x8*)(smem + (g >> 3) * GS + (g & 7) * 8) = ra[i]; }
#pragma unroll
    for (int i = 0; i < NBG; ++i) { int g = tid + 256 * i; *(h16x8*)(smem + 128 * GS + (g >> 3) * GS + (g & 7) * 8) = rb[i]; }
    __syncthreads();
    for (int kt = 0; kt < nk; ++kt) {
        const int cur = kt & 1;
        const h16* sA = smem + cur * BUF;
        const h16* sB = sA + 128 * GS;
        if (kt + 1 < nk) {
            const int k0 = (kt + 1) << 6;
#pragma unroll
            for (int i = 0; i < 4; ++i) { int g = tid + 256 * i; ra[i] = al.load(i, arow0 + (g >> 3), k0 + (g & 7) * 8); }
#pragma unroll
            for (int i = 0; i < NBG; ++i) { int g = tid + 256 * i; rb[i] = *(const h16x8*)(Bt + (size_t)(g >> 3) * ldb + k0 + (g & 7) * 8); }
        }
#pragma unroll
        for (int ks = 0; ks < 4; ++ks) {
            h16x8 af[2], bf[NTL];
#pragma unroll
            for (int mt = 0; mt < 2; ++mt) af[mt] = *(const h16x8*)(sA + (64 * wm + 32 * mt + (lane & 31)) * GS + 16 * ks + 8 * (lane >> 5));
#pragma unroll
            for (int nt = 0; nt < NTL; ++nt) bf[nt] = *(const h16x8*)(sB + ((BN / 2) * wn + 32 * nt + (lane & 31)) * GS + 16 * ks + 8 * (lane >> 5));
#pragma unroll
            for (int mt = 0; mt < 2; ++mt)
#pragma unroll
                for (int nt = 0; nt < NTL; ++nt) acc[mt][nt] = MFMA32(af[mt], bf[nt], acc[mt][nt]);
        }
        if (kt + 1 < nk) {
            h16* dA = smem + (cur ^ 1) * BUF;
            h16* dB = dA + 128 * GS;
#pragma unroll
            for (int i = 0; i < 4; ++i) { int g = tid + 256 * i; *(h16x8*)(dA + (g >> 3) * GS + (g & 7) * 8) = ra[i]; }
#pragma unroll
            for (int i = 0; i < NBG; ++i) { int g = tid + 256 * i; *(h16x8*)(dB + (g >> 3) * GS + (g & 7) * 8) = rb[i]; }
        }
        __syncthreads();
    }
    ep.pre(al);
    float* ft = (float*)smem;
#pragma unroll
    for (int mt = 0; mt < 2; ++mt)
#pragma unroll
        for (int nt = 0; nt < NTL; ++nt)
#pragma unroll
            for (int r = 0; r < 16; ++r) {
                const int rl = 64 * wm + 32 * mt + (r & 3) + 8 * (r >> 2) + 4 * (lane >> 5);
                const int cl = (BN / 2) * wn + 32 * nt + (lane & 31);
                ft[rl * (BN + 1) + cl] = acc[mt][nt][r];
            }
    __syncthreads();
    if (EP::kSweep) {
#pragma unroll 4
        for (int idx = tid; idx < 128 * BN; idx += NTHREADS) {
            const int rl = idx / BN, cl = idx % BN;
            float q = ep(rl, cl, ft[rl * (BN + 1) + cl]);
            if (EP::kRowSum) {
#pragma unroll
                for (int d = 1; d < 64; d <<= 1) q += shfl_l(q, lane ^ d);
                if (lane == 0) ep.rowsum(rl, q);
            }
        }
    }
}

constexpr int GS2 = 72;
template <class EP>
__device__ __forceinline__ void gemm_big(const h16* __restrict__ A, int lda, const h16* __restrict__ Bt, int ldb, int K, EP& ep, h16* smem, XcdQueue& xq) {
    const int tid = opaque_tid(), lane = tid & 63, w = tid >> 6, wm = w >> 1, wn = w & 1;
    constexpr int BUF = 512 * GS2;
    f32x16 acc[4][4];
    float zero_ = 0.f; asm volatile("" : "+v"(zero_));
#pragma unroll
    for (int i = 0; i < 4; ++i)
#pragma unroll
        for (int j = 0; j < 4; ++j)
#pragma unroll
            for (int r = 0; r < 16; ++r) acc[i][j][r] = zero_;
    h16x8 ra[2][8], rb[2][8];
    const int nk = K >> 6;
    const h16* ap = A + (size_t)(tid >> 3) * lda + (tid & 7) * 8;
    const h16* bp = Bt + (size_t)(tid >> 3) * ldb + (tid & 7) * 8;
    const int soff = (tid >> 3) * GS2 + (tid & 7) * 8;
#pragma unroll
    for (int i = 0; i < 8; ++i) { ra[0][i] = *(const h16x8*)(ap + (size_t)(32 * i) * lda); rb[0][i] = *(const h16x8*)(bp + (size_t)(32 * i) * ldb); }
#pragma unroll
    for (int i = 0; i < 8; ++i) { ra[1][i] = *(const h16x8*)(ap + (size_t)(32 * i) * lda + 64); rb[1][i] = *(const h16x8*)(bp + (size_t)(32 * i) * ldb + 64); }
    __syncthreads();
#pragma unroll
    for (int i = 0; i < 8; ++i) { *(h16x8*)(smem + soff + 32 * i * GS2) = ra[0][i]; *(h16x8*)(smem + 256 * GS2 + soff + 32 * i * GS2) = rb[0][i]; }
    __syncthreads();
#define BIG_STEP(CUR, KT) do { \
        const h16* sA = smem + (CUR) * BUF + (128 * wm + (lane & 31)) * GS2 + 8 * (lane >> 5); \
        const h16* sB = smem + (CUR) * BUF + 256 * GS2 + (128 * wn + (lane & 31)) * GS2 + 8 * (lane >> 5); \
        h16* dW = smem + ((CUR) ^ 1) * BUF;     \
        int k0 = ((KT) + 2) << 6; k0 = k0 < K ? k0 : K - 64; \
        h16x8 af[2][4], bf[2][4]; \
        _Pragma("unroll") for (int t = 0; t < 4; ++t) { af[0][t] = *(const h16x8*)(sA + 32 * t * GS2); bf[0][t] = *(const h16x8*)(sB + 32 * t * GS2); } \
        __builtin_amdgcn_sched_barrier(0); \
        _Pragma("unroll") for (int ks = 0; ks < 4; ++ks) { \
            if (ks < 3) { _Pragma("unroll") for (int t = 0; t < 4; ++t) { af[(ks + 1) & 1][t] = *(const h16x8*)(sA + 32 * t * GS2 + 16 * (ks + 1)); bf[(ks + 1) & 1][t] = *(const h16x8*)(sB + 32 * t * GS2 + 16 * (ks + 1)); } } \
            _Pragma("unroll") for (int i = 2 * ks; i < 2 * ks + 2; ++i) { *(h16x8*)(dW + soff + 32 * i * GS2) = ra[(CUR) ^ 1][i]; *(h16x8*)(dW + 256 * GS2 + soff + 32 * i * GS2) = rb[(CUR) ^ 1][i]; } \
            _Pragma("unroll") for (int i = 2 * ks; i < 2 * ks + 2; ++i) { ra[CUR][i] = *(const h16x8*)(ap + (size_t)(32 * i) * lda + k0); rb[CUR][i] = *(const h16x8*)(bp + (size_t)(32 * i) * ldb + k0); } \
            _Pragma("unroll") for (int mt = 0; mt < 4; ++mt) _Pragma("unroll") for (int nt = 0; nt < 4; ++nt) acc[mt][nt] = MFMA32(af[ks & 1][mt], bf[ks & 1][nt], acc[mt][nt]); \
              \
            _Pragma("unroll") for (int q = 0; q < 4; ++q) { \
                __builtin_amdgcn_sched_group_barrier(0x8, 1, 0); __builtin_amdgcn_sched_group_barrier(0x100, 1, 0); \
                __builtin_amdgcn_sched_group_barrier(0x8, 1, 0); __builtin_amdgcn_sched_group_barrier(0x100, 1, 0); \
                __builtin_amdgcn_sched_group_barrier(0x8, 1, 0); __builtin_amdgcn_sched_group_barrier(0x200, 1, 0); \
                __builtin_amdgcn_sched_group_barrier(0x8, 1, 0); __builtin_amdgcn_sched_group_barrier(0x20, 1, 0); } \
            __builtin_amdgcn_sched_barrier(0); } \
        __syncthreads(); } while (0)
    TSEC_BEGIN(8)
    for (int kt = 0; kt < nk; kt += 2) { BIG_STEP(0, kt); BIG_STEP(1, kt + 1); }
    TSEC_END(8);
    TSEC_BEGIN(9)
#undef BIG_STEP
    xq.lookahead();
    float* st = (float*)smem + w * 1152;
    const int prow = lane >> 1, pc0 = (lane & 1) * 8;
    ep.template prefetch<0>(128 * wm + prow, 128 * wn + pc0);
#pragma unroll
    for (int mt = 0; mt < 4; ++mt) {
        if (mt == 0) ep.template prefetch<1>(128 * wm + 32 + prow, 128 * wn + pc0);
        if (mt == 1) ep.template prefetch<0>(128 * wm + 64 + prow, 128 * wn + pc0);
        if (mt == 2) ep.template prefetch<1>(128 * wm + 96 + prow, 128 * wn + pc0);
        ep.row_begin();
#pragma unroll
        for (int nt = 0; nt < 4; ++nt) {
#pragma unroll
            for (int r = 0; r < 16; ++r) st[((r & 3) + 8 * (r >> 2) + 4 * (lane >> 5)) * 36 + (lane & 31)] = acc[mt][nt][r];
            WAVE_FENCE();
            float v[16];
#pragma unroll
            for (int q = 0; q < 4; ++q) { const float4 t4 = *(const float4*)(st + prow * 36 + pc0 + 16 * (q >> 1) + 4 * (q & 1)); v[4 * q] = t4.x; v[4 * q + 1] = t4.y; v[4 * q + 2] = t4.z; v[4 * q + 3] = t4.w; }
            WAVE_FENCE();
            if (mt & 1) ep.template store16<1>(nt, 128 * wm + 32 * mt + prow, 128 * wn + 32 * nt + pc0, v);
            else ep.template store16<0>(nt, 128 * wm + 32 * mt + prow, 128 * wn + 32 * nt + pc0, v);
        }
        ep.row_end(128 * wm + 32 * mt + prow, lane);
    }
    TSEC_END(9);
}

template <class EP>
__device__ __forceinline__ void skinny_tile(const h16* __restrict__ A, int lda, const h16* __restrict__ Bt, int ldb, int K, EP& ep, float* st, int tid) {
    const int lane = tid & 63, w = tid >> 6;
    f32x16 acc;
#pragma unroll
    for (int r = 0; r < 16; ++r) acc[r] = 0.f;
    const int kq = K >> 2;
    const h16* ap = A + (size_t)(lane & 31) * lda + 8 * (lane >> 5) + w * kq;
    const h16* bp = Bt + (size_t)(lane & 31) * ldb + 8 * (lane >> 5) + w * kq;
    if (w == 0) ep.template prefetch<0>(lane >> 1, (lane & 1) * 8);
    for (int k0 = 0; k0 < kq; k0 += 128) {
        h16x8 af[8], bf[8];
#pragma unroll
        for (int u = 0; u < 8; ++u) { af[u] = *(const h16x8*)(ap + k0 + 16 * u); bf[u] = *(const h16x8*)(bp + k0 + 16 * u); }
#pragma unroll
        for (int u = 0; u < 8; ++u) acc = MFMA32(af[u], bf[u], acc);
    }
    __syncthreads();
    float* my = st + w * 1152;
#pragma unroll
    for (int r = 0; r < 16; ++r) my[((r & 3) + 8 * (r >> 2) + 4 * (lane >> 5)) * 36 + (lane & 31)] = acc[r];
    __syncthreads();
    if (w == 0) {
        const int prow = lane >> 1, pc0 = (lane & 1) * 8;
        ep.row_begin();
        float v[16];
#pragma unroll
        for (int q = 0; q < 4; ++q) {
            float4 t4 = *(const float4*)(st + prow * 36 + pc0 + 16 * (q >> 1) + 4 * (q & 1));
#pragma unroll
            for (int ww = 1; ww < 4; ++ww) { const float4 u4 = *(const float4*)(st + ww * 1152 + prow * 36 + pc0 + 16 * (q >> 1) + 4 * (q & 1)); t4.x += u4.x; t4.y += u4.y; t4.z += u4.z; t4.w += u4.w; }
            v[4 * q] = t4.x; v[4 * q + 1] = t4.y; v[4 * q + 2] = t4.z; v[4 * q + 3] = t4.w;
        }
        ep.template store16<0>(0, prow, pc0, v);
        ep.row_end(prow, lane);
    }
}

struct EpiInProj {
    static constexpr bool kSweep = true; static constexpr bool kRowSum = false;
    int row0, n0; const float* rstd; h16* projA; float* small; h16* sza; h16* szg; h16* projG;
    template <class AL_> __device__ __forceinline__ void pre(AL_&) {}
    __device__ __forceinline__ float operator()(int rl, int cl, float v) const {
        const int row = row0 + rl; const float y = v * rstd[rl]; const int c = n0 + cl;
        if (c < 512) { if (c < 448) projA[(size_t)row * 512 + c] = (h16)y; else if (c < 460) small[(size_t)row * 16 + (c - 448)] = y; }
        else if (c < 1024) sza[(size_t)row * 512 + (c - 512)] = (h16)silu_f(y);
        else if (c < 2560) projG[(size_t)row * 1536 + (c - 1024)] = (h16)y;
        else szg[(size_t)row * 512 + (c - 2560)] = (h16)silu_f(y);
        return 0.f;
    }
    __device__ __forceinline__ void rowsum(int, float) const {}
};
struct EpiIn2 : EpiInProj {
    float* rstd_w; int tid; const float* sumsq;
    template <class AL_> __device__ __forceinline__ void pre(AL_&) {
        if (tid < 128) rstd_w[tid] = rsqrtf(sumsq[row0 + tid] * (1.f / 1024.f) + EPS);
        __syncthreads();
    }
};
struct EpiTileF32 {
    static constexpr bool kSweep = false; static constexpr bool kRowSum = false;
    template <class AL_> __device__ __forceinline__ void pre(AL_&) {}
    __device__ __forceinline__ float operator()(int, int, float) const { return 0.f; }
    __device__ __forceinline__ void rowsum(int, float) const {}
};
struct EpiStoreH {
    static constexpr bool kSweep = true; static constexpr bool kRowSum = false;
    h16* dst; int ld; int row0; const float* rs;
    template <class AL_> __device__ __forceinline__ void pre(AL_&) {}
    __device__ __forceinline__ float operator()(int rl, int cl, float v) const { dst[(size_t)(row0 + rl) * ld + cl] = (h16)(rs ? v * rs[rl] : v); return 0.f; }
    __device__ __forceinline__ void rowsum(int, float) const {}
};
struct EpiGate {
    static constexpr bool kSweep = true; static constexpr bool kRowSum = false;
    h16* dst; const h16* gate; int row0; int c0;
    template <class AL_> __device__ __forceinline__ void pre(AL_&) {}
    __device__ __forceinline__ float operator()(int rl, int cl, float v) const {
        const size_t row = row0 + rl;
        dst[row * 1024 + c0 + cl] = (h16)(v * (float)gate[row * 512 + c0 + cl]);
        return 0.f;
    }
    __device__ __forceinline__ void rowsum(int, float) const {}
};
struct EpiResid {
    static constexpr bool kSweep = true; static constexpr bool kRowSum = true;
    int layer; int row0; int n0; const float* meta; const float* x; float* metah; float* out; h16* h16o; float* sumsq_next;
    template <class AL_> __device__ __forceinline__ void pre(AL_&) {}
    __device__ __forceinline__ float operator()(int rl, int cl, float v) const {
        const int row = row0 + rl; if (row >= NT) return 0.f;
        const int b = row >= T_ ? 1 : 0; const int t = row - b * T_; const int c = n0 + cl;
        if (layer == 0) {
            float hn;
            if (t < 16) { hn = meta[(size_t)t * 1024 + c] + v; metah[((size_t)b * 16 + t) * 1024 + c] = hn; }
            else { const size_t o = ((size_t)b * 8192 + (t - 16)) * 1024 + c; hn = x[o] + v; out[o] = hn; }
            h16o[(size_t)row * 1024 + c] = (h16)hn;
            return hn * hn;
        } else {
            if (t >= 16) { const size_t o = ((size_t)b * 8192 + (t - 16)) * 1024 + c; out[o] = out[o] + v; }
            return 0.f;
        }
    }
    __device__ __forceinline__ void rowsum(int rl, float q) const { if (layer == 0 && row0 + rl < NT) atomicAdd(sumsq_next + row0 + rl, q); }
};

__device__ __forceinline__ void store16h(h16* dst, const float* v) {
    h16x8 a, b;
#pragma unroll
    for (int e = 0; e < 8; ++e) { a[e] = (h16)v[e]; b[e] = (h16)v[8 + e]; }
    *(h16x8*)dst = a; *(h16x8*)(dst + 8) = b;
}
__device__ __forceinline__ void store8x2h(h16* dst, const float* v) {
    h16x8 a, b;
#pragma unroll
    for (int e = 0; e < 8; ++e) { a[e] = (h16)v[e]; b[e] = (h16)v[8 + e]; }
    *(h16x8*)dst = a; *(h16x8*)(dst + 16) = b;
}
struct EpiInBig {
    int row0, n0; const float* sumsq; h16* projA; float* small; h16* sza; h16* szg; h16* projG;
    float ssq[2];
    __device__ __forceinline__ void row_begin() {}
    __device__ __forceinline__ void row_end(int, int) {}
    template <int B> __device__ __forceinline__ void prefetch(int rl, int) { ssq[B] = sumsq[row0 + rl]; }
    template <int B> __device__ __forceinline__ void store16(int, int rl, int cl, const float* v) const {
        const int row = row0 + rl; const int c = n0 + cl;
        const float rs = rsqrtf(ssq[B] * (1.f / 1024.f) + EPS);
        float y[16];
#pragma unroll
        for (int e = 0; e < 16; ++e) y[e] = v[e] * rs;
        if (c < 512) {
            if (c < 448) store8x2h(projA + (size_t)row * 512 + c, y);
            else if (c == 448) {
#pragma unroll
                for (int e = 0; e < 8; ++e) small[(size_t)row * 16 + e] = y[e];
            } else if (c == 456) {
#pragma unroll
                for (int e = 0; e < 4; ++e) small[(size_t)row * 16 + 8 + e] = y[e];
            }
        } else if (c < 1024) {
#pragma unroll
            for (int e = 0; e < 16; ++e) y[e] = silu_f(y[e]);
            store8x2h(sza + (size_t)row * 512 + (c - 512), y);
        } else if (c < 2560) store8x2h(projG + (size_t)row * 1536 + (c - 1024), y);
        else {
#pragma unroll
            for (int e = 0; e < 16; ++e) y[e] = silu_f(y[e]);
            store8x2h(szg + (size_t)row * 512 + (c - 2560), y);
        }
    }
};
struct EpiResBig {
    int layer, row0, n0; const float* meta; const float* x; float* metah; float* out; h16* h16o; float* sumsq_next; float ss; int nseg;
    float4 pf[2][4][4];
    __device__ __forceinline__ void row_begin() { ss = 0.f; }
    __device__ __forceinline__ void row_end(int rl, int lane) {
        if (layer == 0) { float q = ss; q += shfl_l(q, lane ^ 1); if ((lane & 1) == 0) atomicAdd(sumsq_next + row0 + rl, q); }
    }
    __device__ __forceinline__ const float* srcp(int row, int c) const {
        const int b = row >= T_ ? 1 : 0; const int t = row - b * T_;
        if (layer == 0) return t < 16 ? meta + (size_t)t * 1024 + c : x + ((size_t)b * 8192 + (t - 16)) * 1024 + c;
        return out + ((size_t)b * 8192 + (t < 16 ? 0 : t - 16)) * 1024 + c;
    }
    template <int B> __device__ __forceinline__ void prefetch(int rl, int cl) {
        const float* src = srcp(row0 + rl, n0 + cl);
#pragma unroll
        for (int nt = 0; nt < 4; ++nt)
            if (nt < nseg) {
#pragma unroll
                for (int q = 0; q < 4; ++q) pf[B][nt][q] = *(const float4*)(src + 32 * nt + 16 * (q >> 1) + 4 * (q & 1));
            }
    }
    template <int B> __device__ __forceinline__ void store16(int nt, int rl, int cl, const float* v) {
        const int row = row0 + rl; const int c = n0 + cl;
        const int b = row >= T_ ? 1 : 0; const int t = row - b * T_;
        float* dst;
        if (layer == 0) dst = t < 16 ? metah + ((size_t)b * 16 + t) * 1024 + c : out + ((size_t)b * 8192 + (t - 16)) * 1024 + c;
        else { if (t < 16) return; dst = out + ((size_t)b * 8192 + (t - 16)) * 1024 + c; }
        float hn[16];
#pragma unroll
        for (int q = 0; q < 4; ++q) {
            const float4 hv = pf[B][nt][q];
            float4 o4; o4.x = hv.x + v[4 * q]; o4.y = hv.y + v[4 * q + 1]; o4.z = hv.z + v[4 * q + 2]; o4.w = hv.w + v[4 * q + 3];
            *(float4*)(dst + 16 * (q >> 1) + 4 * (q & 1)) = o4;
            hn[4 * q] = o4.x; hn[4 * q + 1] = o4.y; hn[4 * q + 2] = o4.z; hn[4 * q + 3] = o4.w;
        }
        if (layer == 0) {
            store8x2h(h16o + (size_t)row * 1024 + c, hn);
#pragma unroll
            for (int e = 0; e < 16; ++e) ss += hn[e] * hn[e];
        }
    }
};

__device__ __forceinline__ int in_src_col(int n) {
    if (n < 452) return n;
    if (n < 456) return 3012 + (n - 452);
    if (n < 460) return 3016 + (n - 456);
    if (n < 512) return -1;
    if (n < 1024) return 452 + (n - 512);
    if (n < 2560) return 964 + (n - 1024);
    return 2500 + (n - 2560);
}
__device__ __forceinline__ float prep_get(const Params& P, int l, int job, int h, int n, int k) {
    switch (job) {
        case 0: { const int s = in_src_col(n); if (s < 0) return 0.f; return P.norm_gain[l * 1024 + k] * P.w_in[((size_t)l * 1024 + k) * 3020 + s]; }
        case 1: return P.w_out[((size_t)l * 1024 + k) * 1024 + n];
        case 2: return P.g_cq[l * 256 + k] * (n < 512 ? P.w_uq[((size_t)l * 256 + k) * 512 + n] : P.w_qidx[((size_t)l * 256 + k) * 256 + (n - 512)]);
        case 3: return P.g_ckv[l * 128 + k] * P.w_ukv[((size_t)l * 128 + k) * 1024 + n];
        case 4: { const int kk = k >> 4, hf = (k >> 3) & 1, j = k & 7; const int d = 16 * kk + 8 * (j >> 2) + 4 * hf + (j & 3);
                  return P.w_ukv[((size_t)l * 128 + n) * 1024 + h * 64 + d] * P.g_kn[l * 64 + d] * P.g_qn[l * 64 + d] * 0.125f; }
        default: return P.w_ukv[((size_t)l * 128 + k) * 1024 + 512 + h * 64 + n];
    }
}
__device__ __forceinline__ void prep_tiles(const Params& P, unsigned char* lds, int l, int first_wg, int nwg);
__device__ __forceinline__ void phase_prep(const Params& P, unsigned char* lds) {
    float* tile = (float*)lds;
    const int tid = opaque_tid();
    {
        h16* h16o = (h16*)(P.ws + OFF_H16); float* sumsq = (float*)(P.ws + OFF_SUMSQ);
        const int lane = tid & 63, w = tid >> 6;
        for (int row = blockIdx.x * 4 + w; row < NT; row += gridDim.x * 4) {
            const int b = row >= T_ ? 1 : 0; const int t = row - b * T_;
            const float* src = t < 16 ? P.meta + (size_t)t * 1024 : P.x + ((size_t)b * 8192 + (t - 16)) * 1024;
            float ss = 0.f;
#pragma unroll
            for (int q = 0; q < 2; ++q) {
                const float4 a = *(const float4*)(src + q * 512 + lane * 8), c4 = *(const float4*)(src + q * 512 + lane * 8 + 4);
                ss += a.x * a.x + a.y * a.y + a.z * a.z + a.w * a.w + c4.x * c4.x + c4.y * c4.y + c4.z * c4.z + c4.w * c4.w;
                h16x8 o; o[0] = (h16)a.x; o[1] = (h16)a.y; o[2] = (h16)a.z; o[3] = (h16)a.w; o[4] = (h16)c4.x; o[5] = (h16)c4.y; o[6] = (h16)c4.z; o[7] = (h16)c4.w;
                *(h16x8*)(h16o + (size_t)row * 1024 + q * 512 + lane * 8) = o;
            }
#pragma unroll
            for (int d = 1; d < 64; d <<= 1) ss += shfl_l(ss, lane ^ d);
            if (lane == 0) sumsq[row] = ss;
        }
    }
    prep_tiles(P, lds, 0, 0, (int)gridDim.x);
}
__device__ __forceinline__ void prep_tiles(const Params& P, unsigned char* lds, int l, int first_wg, int nwg) {
    float* tile = (float*)lds;
    const int tid = opaque_tid();
    for (int it = (int)blockIdx.x - first_wg; it >= 0 && it < 1120; it += nwg) {
        int r = it;
        int job, h = 0, N, K, tn, tk; h16* dst;
        if (r < 768) { job = 0; N = 3072; K = 1024; tn = r / 16; tk = r % 16; dst = (h16*)(P.ws + OFF_W1T) + (size_t)l * 3072 * 1024; }
        else if ((r -= 768) < 256) { job = 1; N = 1024; K = 1024; tn = r / 16; tk = r % 16; dst = (h16*)(P.ws + OFF_WOT) + (size_t)l * 1024 * 1024; }
        else if ((r -= 256) < 48) { job = 2; N = 768; K = 256; tn = r / 4; tk = r % 4; dst = (h16*)(P.ws + OFF_WQ2T) + (size_t)l * 768 * 256; }
        else if ((r -= 48) < 16) { job = 3; N = 512; K = 128; tn = r / 2; tk = r % 2; dst = (h16*)(P.ws + OFF_WUKT) + (size_t)l * 512 * 128; }
        else if ((r -= 16) < 16) { job = 4; N = 128; K = 64; h = r / 2; tn = r % 2; tk = 0; dst = (h16*)(P.ws + OFF_WKABS) + ((size_t)l * 8 + h) * 128 * 64; }
        else { r -= 16; job = 5; N = 64; K = 128; h = r / 2; tn = 0; tk = r % 2; dst = (h16*)(P.ws + OFF_WUVT) + ((size_t)l * 8 + h) * 64 * 128; }
        (void)N;
        const int n0 = tn * 64, k0 = tk * 64;
        __syncthreads();
        {
            float pv[16];
#pragma unroll
            for (int q = 0; q < 16; ++q) pv[q] = prep_get(P, l, job, h, n0 + (tid & 63), k0 + q * 4 + (tid >> 6));
#pragma unroll
            for (int q = 0; q < 16; ++q) tile[(q * 4 + (tid >> 6)) * 65 + (tid & 63)] = pv[q];
        }
        __syncthreads();
#pragma unroll 4
        for (int q = 0; q < 16; ++q) { const int nn = q * 4 + (tid >> 6), kk = tid & 63; dst[(size_t)(n0 + nn) * K + k0 + kk] = (h16)tile[kk * 65 + nn]; }
    }
}

__device__ __forceinline__ void phase_inproj(const Params& P, int l, unsigned char* lds, int rep_p1 = 0) {
    h16* smem = (h16*)lds;
    float* rstd = (float*)(lds + 73728);
    const int tid = opaque_tid();
    const h16* W = (const h16*)(P.ws + OFF_W1T) + (size_t)l * 3072 * 1024;
    const h16* A = (const h16*)(P.ws + OFF_H16);
    const float* sumsq = (const float*)(P.ws + OFF_SUMSQ) + (size_t)l * NTP;
    XcdQueue xq; xq.init((unsigned*)(P.ws + OFF_CTL) + 4096 + l * 128 + 2048 * rep_p1, 96, (int*)(lds + LDS_BYTES - 32));
    int xl, qi;
    while (xq.next(xl, qi)) {
        const int rb = 8 * xl + (qi & 7), tn = 4 * (qi >> 5) + ((qi >> 3) & 3);
        EpiInBig ep{rb * 256, tn * 256, sumsq, (h16*)(P.ws + OFF_PROJA), (float*)(P.ws + OFF_SMALL), (h16*)(P.ws + OFF_SZA), (h16*)(P.ws + OFF_SZG), (h16*)(P.ws + OFF_PROJG), {0.f, 0.f}};
        gemm_big(A + (size_t)rb * 256 * 1024, 1024, W + (size_t)tn * 256 * 1024, 1024, 1024, ep, smem, xq);
    }
    __syncthreads();
    for (int it = blockIdx.x; it < 96; it += gridDim.x) {
        EpiInBig ep{16384, it * 32, sumsq, (h16*)(P.ws + OFF_PROJA), (float*)(P.ws + OFF_SMALL), (h16*)(P.ws + OFF_SZA), (h16*)(P.ws + OFF_SZG), (h16*)(P.ws + OFF_PROJG), {0.f, 0.f}};
        skinny_tile(A + (size_t)16384 * 1024, 1024, W + (size_t)it * 32 * 1024, 1024, 1024, ep, (float*)lds, tid);
    }
    (void)rstd;
}

__device__ __forceinline__ void p2a_item(const Params& P, int l, int rb, int j, unsigned char* lds) {
    h16* smem = (h16*)lds;
    float* ft = (float*)lds;
    float* rstdq = (float*)(lds + 73728);
    const int tid = opaque_tid(); const int row0 = rb * 128;
    const h16* projA = (const h16*)(P.ws + OFF_PROJA);
    __syncthreads();
    {
        const int row = row0 + (tid >> 1), hf = tid & 1; float s = 0.f;
#pragma unroll 4
        for (int q = 0; q < 16; ++q) { const h16x8 v = *(const h16x8*)(projA + (size_t)row * 512 + hf * 128 + q * 8);
#pragma unroll
            for (int e = 0; e < 8; ++e) { const float f = (float)v[e]; s += f * f; } }
        s += shfl_l(s, (tid & 63) ^ 1);
        if (hf == 0) rstdq[tid >> 1] = rsqrtf(s * (1.f / 256.f) + EPS);
    }
    __syncthreads();
    const h16* Wq2 = (const h16*)(P.ws + OFF_WQ2T) + (size_t)l * 768 * 256;
    AF16 al{projA, 512};
    if (j >= 4) {
        EpiStoreH ep{(h16*)(P.ws + OFF_QIDX) + (j - 4) * 128, 256, row0, rstdq};
        gemm_tile<128>(al, row0, Wq2 + (size_t)j * 128 * 256, 256, 256, ep, smem);
        return;
    }
    EpiTileF32 ep;
    gemm_tile<128>(al, row0, Wq2 + (size_t)j * 128 * 256, 256, 256, ep, smem);
    __syncthreads();
    h16* qn = (h16*)(P.ws + OFF_QN);
    {
        const int rl = tid >> 1, hh = tid & 1; float s = 0.f;
        const float rq = rstdq[rl];
        for (int d = 0; d < 64; ++d) { const float f = ft[rl * 129 + hh * 64 + d] * rq; s += f * f; }
        const float rs = rsqrtf(s * (1.f / 64.f) + EPS) * rq;
        h16* dst = qn + (size_t)(row0 + rl) * 512 + (2 * j + hh) * 64;
        const float* gq = P.g_qn + l * 64;
        for (int d = 0; d < 64; d += 8) { h16x8 o;
#pragma unroll
            for (int e = 0; e < 8; ++e) o[e] = (h16)(ft[rl * 129 + hh * 64 + d + e] * rs * gq[d + e]);
            *(h16x8*)(dst + d) = o; }
    }
    __threadfence_block();
    __syncthreads();
    for (int hh = 0; hh < 2; ++hh) {
        const int head = 2 * j + hh;
        AF16 al2{qn + head * 64, 512};
        EpiStoreH ep2{(h16*)(P.ws + OFF_QK) + head * 128, 1024, row0, nullptr};
        gemm_tile<128>(al2, row0, (const h16*)(P.ws + OFF_WKABS) + ((size_t)l * 8 + head) * 128 * 64, 64, 64, ep2, smem);
    }
}

__device__ __forceinline__ void p2b_item(const Params& P, int l, int rb, unsigned char* lds) {
    h16* smem = (h16*)lds;
    float* ft = (float*)lds;
    const int tid = opaque_tid(); const int row0 = rb * 128;
    const h16* projA = (const h16*)(P.ws + OFF_PROJA);
    h16* kvrow = (h16*)(P.ws + OFF_KVROW);
    __syncthreads();
    {
        const int row = row0 + (tid >> 1), hf = tid & 1; float s = 0.f; h16x8 v[8];
#pragma unroll
        for (int q = 0; q < 8; ++q) { v[q] = *(const h16x8*)(projA + (size_t)row * 512 + 256 + hf * 64 + q * 8);
#pragma unroll
            for (int e = 0; e < 8; ++e) { const float f = (float)v[q][e]; s += f * f; } }
        s += shfl_l(s, (tid & 63) ^ 1);
        const float rs = rsqrtf(s * (1.f / 128.f) + EPS);
        const float* g = P.g_ckv + l * 128 + hf * 64;
#pragma unroll
        for (int q = 0; q < 8; ++q) { h16x8 o;
#pragma unroll
            for (int e = 0; e < 8; ++e) o[e] = (h16)((float)v[q][e] * rs * g[q * 8 + e]);
            *(h16x8*)(kvrow + (size_t)row * 136 + hf * 64 + q * 8) = o; }
    }
    {
        h16* kfrag = (h16*)(P.ws + OFF_KFRAG);
#pragma unroll
        for (int q = 0; q < 4; ++q) {
            const int g = tid + 256 * q; const int row = row0 + (g >> 3), g8 = g & 7;
            if (row < NT) {
                const int b = row >= T_ ? 1 : 0; const int t = row - b * T_;
                const h16x8 v = *(const h16x8*)(projA + (size_t)row * 512 + 384 + g8 * 8);
                const int tile = t >> 5, ks = g8 >> 1, hh = g8 & 1;
                *(h16x8*)(kfrag + ((size_t)(b * NKT + tile) * 4 + ks) * 512 + (hh * 32 + (t & 31)) * 8) = v;
            }
        }
    }
    __threadfence_block();
    __syncthreads();
    const h16* Wuk = (const h16*)(P.ws + OFF_WUKT) + (size_t)l * 512 * 128;
    for (int tn = 0; tn < 4; ++tn) {
        AF16 al{kvrow, 136};
        EpiTileF32 ep;
        gemm_tile<128>(al, row0, Wuk + (size_t)tn * 128 * 128, 128, 128, ep, smem);
        __syncthreads();
        const int rl = tid >> 1, hh = tid & 1; float s = 0.f;
        for (int d = 0; d < 64; ++d) { const float f = ft[rl * 129 + hh * 64 + d]; s += f * f; }
        kvrow[(size_t)(row0 + rl) * 136 + 128 + 2 * tn + hh] = (h16)rsqrtf(s * (1.f / 64.f) + EPS);
        __syncthreads();
    }
}

__device__ __forceinline__ void p2c_item(const Params& P, int l, int item, unsigned char* lds) {
    h16* qh = (h16*)lds;
    h16* kh = (h16*)(lds + 17408);
    h16* vh = (h16*)(lds + 34816);
    float* Tm = (float*)(lds + 67584);
    float* TtA = (float*)(lds + 83968);
    float* scl = (float*)(lds + 88576);
    float* Lm = (float*)(lds + 100352);
    float* beta = (float*)(lds + 116736);
    float* dec = beta + 64;
    float* edec = dec + 64;
    const int tid = opaque_tid(), lane = tid & 63, w = tid >> 6;
    const int chain = item / NCH, n = item % NCH, b = chain >> 2, h = chain & 3;
    const h16* projG = (const h16*)(P.ws + OFF_PROJG);
    const float* small = (const float*)(P.ws + OFF_SMALL);
    const float* cw = P.conv_w + (size_t)l * 4 * 1536;
    __syncthreads();
#ifndef P2C
#define P2C 15
#endif
    h16* cwh = (h16*)(lds + 117504);
    {
        float cwv[6];
#pragma unroll
        for (int q = 0; q < 6; ++q) { const int e = tid + q * NTHREADS; const int m = e >> 9, jj = (e >> 7) & 3, c = e & 127; cwv[q] = cw[jj * 1536 + m * 512 + h * 128 + c]; }
#pragma unroll
        for (int q = 0; q < 6; ++q) cwh[tid + q * NTHREADS] = (h16)cwv[q];
        if (tid < 128) cwh[1536 + tid] = (h16)0.f;
    }
    __syncthreads();
    for (int rs1_ = 0; rs1_ <= PROBE_S1; ++rs1_) if (P2C & 1) {
        const int i = tid >> 2, part = tid & 3;
        const int t = 64 * n + i - 48; const bool valid = t >= 0;
        const size_t row = (size_t)b * T_ + (valid ? t : 0);
        h16x8 rv[3][4][4];
#define CONV_LOAD(m_) do { _Pragma("unroll") for (int jj = 0; jj < 4; ++jj) { int tt = t - 3 + jj; tt = tt < 0 ? 0 : tt; \
            const h16* rp = projG + ((size_t)b * T_ + tt) * 1536 + (m_) * 512 + h * 128 + part * 32; \
            _Pragma("unroll") for (int c8 = 0; c8 < 4; ++c8) rv[m_][jj][c8] = *(const h16x8*)(rp + c8 * 8); } } while (0)
        CONV_LOAD(0); CONV_LOAD(1);
        float bl = 0.f, al = 0.f;
        if (part == 0) { bl = small[row * 16 + 4 + h]; al = small[row * 16 + 8 + h]; }
        float vals[32];
#pragma unroll
        for (int m = 0; m < 3; ++m) {
            if (m == 1) { CONV_LOAD(2); }
            __builtin_amdgcn_sched_barrier(0);
            h16x8 av[4];
#pragma unroll
            for (int c8 = 0; c8 < 4; ++c8)
#pragma unroll
                for (int e = 0; e < 8; ++e) av[c8][e] = (h16)0.f;
#pragma unroll
            for (int jj = 0; jj < 4; ++jj) {
                const h16* wp = cwh + ((valid && (t - 3 + jj) >= 0) ? (m * 4 + jj) : 12) * 128 + part * 32;
#pragma unroll
                for (int c8 = 0; c8 < 4; ++c8) { const h16x8 wv = *(const h16x8*)(wp + c8 * 8); av[c8] = wv * rv[m][jj][c8] + av[c8]; }
            }
#pragma unroll
            for (int c8 = 0; c8 < 4; ++c8)
#pragma unroll
                for (int e = 0; e < 8; ++e) vals[c8 * 8 + e] = (float)av[c8][e];
            float ss = 0.f;
#pragma unroll
            for (int c = 0; c < 32; ++c) { vals[c] = silu_f(vals[c]); ss += vals[c] * vals[c]; }
            if (m < 2) {
                ss += shfl_l(ss, lane ^ 1); ss += shfl_l(ss, lane ^ 2);
                const float rs = valid ? rsqrtf(ss + EPS) : 0.f;
                h16* dsth = (m == 0 ? qh : kh) + i * 136 + part * 32;
#pragma unroll
                for (int c8 = 0; c8 < 4; ++c8) { h16x8 o;
#pragma unroll
                    for (int e = 0; e < 8; ++e) o[e] = (h16)(vals[c8 * 8 + e] * rs);
                    *(h16x8*)(dsth + c8 * 8) = o; }
            } else {
                const float vm = valid ? 1.f : 0.f;
#pragma unroll
                for (int c8 = 0; c8 < 4; ++c8) { h16x8 o;
#pragma unroll
                    for (int e = 0; e < 8; ++e) o[e] = (h16)(vals[c8 * 8 + e] * vm);
                    *(h16x8*)(vh + i * 136 + part * 32 + c8 * 8) = o; }
            }
        }
#undef CONV_LOAD
        if (part == 0) {
            float bt = 0.f, g = 0.f;
            if (valid) {
                bt = 1.f / (1.f + __expf(-bl));
                const float xx = al + P.dt_bias[l * 4 + h];
                const float sp = xx > 20.f ? xx : __logf(1.f + __expf(xx));
                g = -__expf(P.a_log[l * 4 + h]) * sp;
            }
            beta[i] = bt; dec[i] = g;
        }
    }
    __syncthreads();
    if (w == 0) {
        float v = dec[lane];
#pragma unroll
        for (int d = 1; d < 64; d <<= 1) { const float o = shfl_l(v, lane >= d ? lane - d : lane); if (lane >= d) v += o; }
        dec[lane] = v; edec[lane] = __expf(v);
    }
    __syncthreads();
    for (int rs3_ = 0; rs3_ <= PROBE_S3; ++rs3_) if (P2C & 2) {
        const int gq = lane >> 4, c16 = lane & 15;
        h16* aqk = (h16*)(P.ws + OFF_AQK) + (size_t)item * 4096;
        h16x8 ak[4], aq[4];
#pragma unroll
        for (int ks = 0; ks < 4; ++ks) { ak[ks] = *(const h16x8*)(kh + (16 * w + c16) * 136 + 32 * ks + 8 * gq); aq[ks] = *(const h16x8*)(qh + (16 * w + c16) * 136 + 32 * ks + 8 * gq); }
#pragma unroll
        for (int nt = 0; nt < 4; ++nt) {
            f32x4 kk = {0.f, 0.f, 0.f, 0.f}, qk = {0.f, 0.f, 0.f, 0.f};
#pragma unroll
            for (int ks = 0; ks < 4; ++ks) { const h16x8 bb = *(const h16x8*)(kh + (16 * nt + c16) * 136 + 32 * ks + 8 * gq); kk = MFMA16(ak[ks], bb, kk); qk = MFMA16(aq[ks], bb, qk); }
            const int jc = 16 * nt + c16; const float dj = dec[jc];
#pragma unroll
            for (int r = 0; r < 4; ++r) {
                const int ir = 16 * w + 4 * gq + r; const float gm = __expf(fminf(dec[ir] - dj, 0.f));
                Lm[ir * 64 + jc] = ir > jc ? beta[ir] * kk[r] * gm : 0.f;
                aqk[ir * 64 + jc] = (h16)(ir >= jc ? qk[r] * gm : 0.f);
            }
        }
    }
    __syncthreads();
    for (int rs5_ = 0; rs5_ <= PROBE_S5; ++rs5_) if (P2C & 8) {
        h16* qd = (h16*)(P.ws + OFF_QD) + (size_t)item * 8192;
        const int i = tid >> 2, part = tid & 3; const float ed = edec[i];
#pragma unroll
        for (int c8 = 0; c8 < 4; ++c8) { const h16x8 v = *(const h16x8*)(qh + i * 136 + part * 32 + c8 * 8); h16x8 o;
#pragma unroll
            for (int e = 0; e < 8; ++e) o[e] = (h16)((float)v[e] * ed);
            *(h16x8*)(qd + i * 128 + part * 32 + c8 * 8) = o; }
        h16* kdt = (h16*)(P.ws + OFF_KDT) + (size_t)item * 8192;
        const int d = tid & 127, ih = tid >> 7; const float dl = dec[63];
#pragma unroll
        for (int i8 = 0; i8 < 4; ++i8) { h16x8 o;
#pragma unroll
            for (int e = 0; e < 8; ++e) { const int ii = ih * 32 + i8 * 8 + e; o[e] = (h16)((float)kh[ii * 136 + d] * __expf(dl - dec[ii])); }
            *(h16x8*)(kdt + d * 64 + ih * 32 + i8 * 8) = o; }
        if (tid == 0) ((float*)(P.ws + OFF_CDEC))[item] = __expf(dl);
        if (tid < 128) { const int ii = tid & 63; scl[tid] = tid < 64 ? beta[ii] : beta[ii] * edec[ii]; }
    }
    __syncthreads();
    if (P2C & 4) {
        const int gq = lane >> 4, c16 = lane & 15;
        if (w == 0) {
            const int hb = lane >> 5, c = lane & 31;
            const float* Lb = Lm + (32 * hb) * 64 + 32 * hb;
            float x[32];
#pragma unroll
            for (int i = 0; i < 32; ++i) {
                float acc = (i == c) ? 1.f : 0.f;
#pragma unroll
                for (int j4 = 0; j4 < (i + 3) / 4; ++j4) {
                    const float4 lv = *(const float4*)(Lb + i * 64 + 4 * j4);
                    const float le[4] = {lv.x, lv.y, lv.z, lv.w};
#pragma unroll
                    for (int e = 0; e < 4; ++e) if (4 * j4 + e < i) acc -= le[e] * x[4 * j4 + e];
                }
                x[i] = acc;
            }
#pragma unroll
            for (int i = 0; i < 32; ++i) Tm[(32 * hb + i) * 64 + 32 * hb + c] = x[i];
            if (hb == 0) {
#pragma unroll
                for (int i4 = 0; i4 < 8; ++i4) *(float4*)(TtA + c * 36 + 4 * i4) = make_float4(x[4 * i4], x[4 * i4 + 1], x[4 * i4 + 2], x[4 * i4 + 3]);
            }
            WAVE_FENCE();
            f32x4 p1[2][2];
#pragma unroll
            for (int mt = 0; mt < 2; ++mt) {
                const float* lr = Lm + (32 + 16 * mt + c16) * 64 + 8 * gq;
                const float4 a0 = *(const float4*)lr, a1 = *(const float4*)(lr + 4);
                h16x8 af; af[0] = (h16)a0.x; af[1] = (h16)a0.y; af[2] = (h16)a0.z; af[3] = (h16)a0.w; af[4] = (h16)a1.x; af[5] = (h16)a1.y; af[6] = (h16)a1.z; af[7] = (h16)a1.w;
#pragma unroll
                for (int nt = 0; nt < 2; ++nt) {
                    const float* tr = TtA + (16 * nt + c16) * 36 + 8 * gq;
                    const float4 b0 = *(const float4*)tr, b1 = *(const float4*)(tr + 4);
                    h16x8 bf; bf[0] = (h16)b0.x; bf[1] = (h16)b0.y; bf[2] = (h16)b0.z; bf[3] = (h16)b0.w; bf[4] = (h16)b1.x; bf[5] = (h16)b1.y; bf[6] = (h16)b1.z; bf[7] = (h16)b1.w;
                    p1[mt][nt] = MFMA16(af, bf, ((f32x4){0.f, 0.f, 0.f, 0.f}));
                }
            }
#pragma unroll
            for (int nt = 0; nt < 2; ++nt) {
                h16x8 bf;
#pragma unroll
                for (int e = 0; e < 4; ++e) { bf[e] = (h16)p1[0][nt][e]; bf[4 + e] = (h16)p1[1][nt][e]; }
#pragma unroll
                for (int mt = 0; mt < 2; ++mt) {
                    const float* tr = Tm + (32 + 16 * mt + c16) * 64 + 32 + 4 * gq;
                    const float4 a0 = *(const float4*)tr, a1 = *(const float4*)(tr + 16);
                    h16x8 af; af[0] = (h16)a0.x; af[1] = (h16)a0.y; af[2] = (h16)a0.z; af[3] = (h16)a0.w; af[4] = (h16)a1.x; af[5] = (h16)a1.y; af[6] = (h16)a1.z; af[7] = (h16)a1.w;
                    const f32x4 tc = MFMA16(af, bf, ((f32x4){0.f, 0.f, 0.f, 0.f}));
#pragma unroll
                    for (int r = 0; r < 4; ++r) Tm[(32 + 16 * mt + 4 * gq + r) * 64 + 16 * nt + c16] = -tc[r];
                }
            }
        }
        __syncthreads();
        {
            const int msel = w >> 1, ch0 = 64 * (w & 1);
            const h16* src = msel ? kh : vh;
            h16* dst = (h16*)(P.ws + (msel ? OFF_WM : OFF_U)) + (size_t)item * 8192;
            f32x4 acc[4][4];
#pragma unroll
            for (int mt = 0; mt < 4; ++mt)
#pragma unroll
                for (int nt = 0; nt < 4; ++nt) acc[mt][nt] = (f32x4){0.f, 0.f, 0.f, 0.f};
#pragma unroll
            for (int ks = 0; ks < 2; ++ks) {
                const float4 s0 = *(const float4*)(scl + 64 * msel + 32 * ks + 4 * gq), s1 = *(const float4*)(scl + 64 * msel + 32 * ks + 16 + 4 * gq);
                const float sj[8] = {s0.x, s0.y, s0.z, s0.w, s1.x, s1.y, s1.z, s1.w};
                fp16x4 tb[4][2];
                { const int rw0 = 32 * ks + 4 * gq + (c16 >> 2), rw1 = 16 + rw0;
#pragma unroll
                  for (int nt = 0; nt < 4; ++nt) { const int colh = ch0 + 16 * nt + 8 * ((c16 >> 1) & 1) + 4 * (c16 & 1);
                    tb[nt][0] = __builtin_amdgcn_ds_read_tr16_b64_v4f16((LAS fp16x4*)(src + rw0 * 136 + colh));
                    tb[nt][1] = __builtin_amdgcn_ds_read_tr16_b64_v4f16((LAS fp16x4*)(src + rw1 * 136 + colh)); } }
#pragma unroll
                for (int mt = 2 * ks; mt < 4; ++mt) {
                    const float* tr = Tm + (16 * mt + c16) * 64 + 32 * ks + 4 * gq;
                    const float4 a0 = *(const float4*)tr, a1 = *(const float4*)(tr + 16);
                    h16x8 af; af[0] = (h16)(a0.x * sj[0]); af[1] = (h16)(a0.y * sj[1]); af[2] = (h16)(a0.z * sj[2]); af[3] = (h16)(a0.w * sj[3]);
                    af[4] = (h16)(a1.x * sj[4]); af[5] = (h16)(a1.y * sj[5]); af[6] = (h16)(a1.z * sj[6]); af[7] = (h16)(a1.w * sj[7]);
#pragma unroll
                    for (int nt = 0; nt < 4; ++nt) {
                        const h16x4 b0 = __builtin_bit_cast(h16x4, tb[nt][0]), b1 = __builtin_bit_cast(h16x4, tb[nt][1]);
                        h16x8 bf; bf[0] = b0[0]; bf[1] = b0[1]; bf[2] = b0[2]; bf[3] = b0[3]; bf[4] = b1[0]; bf[5] = b1[1]; bf[6] = b1[2]; bf[7] = b1[3];
                        acc[mt][nt] = MFMA16(bf, af, acc[mt][nt]);
                    }
                }
            }
#pragma unroll
            for (int mt = 0; mt < 4; ++mt)
#pragma unroll
                for (int nt = 0; nt < 4; ++nt)
                { h16x4 o4; o4[0] = (h16)acc[mt][nt][0]; o4[1] = (h16)acc[mt][nt][1]; o4[2] = (h16)acc[mt][nt][2]; o4[3] = (h16)acc[mt][nt][3];
                  *(h16x4*)(dst + (16 * mt + c16) * 128 + ch0 + 16 * nt + 4 * gq) = o4; }
        }
    }
}

__device__ __forceinline__ float half_sum(float x) {
    const unsigned u = __float_as_uint(x); const auto p = __builtin_amdgcn_permlane32_swap(u, u, false, false);
    return __uint_as_float(p[0]) + __uint_as_float(p[1]);
}
__device__ __forceinline__ void store_tile_T(const f32x16& acc, float scale, float* st, h16* dst_row_lane  , bool ok, int lane) {
#pragma unroll
    for (int r = 0; r < 16; ++r) st[(lane & 31) * 33 + (r & 3) + 8 * (r >> 2) + 4 * (lane >> 5)] = acc[r] * scale;
    WAVE_FENCE();
    float v[16];
#pragma unroll
    for (int q = 0; q < 16; ++q) v[q] = st[(lane >> 1) * 33 + (lane & 1) * 8 + 16 * (q >> 3) + (q & 7)];
    WAVE_FENCE();
    if (ok) store8x2h(dst_row_lane, v);
}

__device__ __forceinline__ void chain_item(const Params& P, int l, int item, float* st, int lane) {
    const int r0 = item * 32; const int tok = lane & 31, hf = lane >> 5;
    const int row = r0 + tok; const int rowc = row < NT ? row : NT - 1;
    const h16* projA = (const h16*)(P.ws + OFF_PROJA);
    const h16* Wq2 = (const h16*)(P.ws + OFF_WQ2T) + (size_t)l * 768 * 256;
    const h16* Wka = (const h16*)(P.ws + OFF_WKABS) + (size_t)l * 8 * 128 * 64;
    const h16* Wuk = (const h16*)(P.ws + OFF_WUKT) + (size_t)l * 512 * 128;
    h16* qidx = (h16*)(P.ws + OFF_QIDX); h16* qk = (h16*)(P.ws + OFF_QK); h16* kvrow = (h16*)(P.ws + OFF_KVROW);
    const int srow = r0 + (lane >> 1); const bool sok = srow < NT; const size_t srowc = sok ? srow : NT - 1;
    h16x8 bq[16]; float ss = 0.f;
#pragma unroll
    for (int ks = 0; ks < 16; ++ks) { bq[ks] = *(const h16x8*)(projA + (size_t)rowc * 512 + 16 * ks + 8 * hf);
#pragma unroll
        for (int e = 0; e < 8; ++e) { const float f = (float)bq[ks][e]; ss += f * f; } }
    ss = half_sum(ss);
    const float rstd_q = rsqrtf(ss * (1.f / 256.f) + EPS);
#pragma unroll 1
    for (int h = 0; h < 8; ++h) {
        f32x16 aq[2];
#pragma unroll
        for (int mt = 0; mt < 2; ++mt)
#pragma unroll
            for (int r = 0; r < 16; ++r) aq[mt][r] = 0.f;
        const h16* wp = Wq2 + (size_t)(64 * h + tok) * 256 + 8 * hf;
#pragma unroll
        for (int ks = 0; ks < 16; ++ks) {
            const h16x8 a0 = *(const h16x8*)(wp + 16 * ks), a1 = *(const h16x8*)(wp + 32 * 256 + 16 * ks);
            aq[0] = MFMA32(a0, bq[ks], aq[0]); aq[1] = MFMA32(a1, bq[ks], aq[1]);
        }
        __builtin_amdgcn_sched_group_barrier(0x20, 8, 0);
#pragma unroll
        for (int q = 0; q < 12; ++q) { __builtin_amdgcn_sched_group_barrier(0x8, 2, 0); __builtin_amdgcn_sched_group_barrier(0x20, 2, 0); }
        __builtin_amdgcn_sched_group_barrier(0x8, 8, 0);
        __builtin_amdgcn_sched_barrier(0);
        float sq = 0.f;
#pragma unroll
        for (int mt = 0; mt < 2; ++mt)
#pragma unroll
            for (int r = 0; r < 16; ++r) sq += aq[mt][r] * aq[mt][r];
        sq = half_sum(sq) * rstd_q * rstd_q;
        const float rsq = rsqrtf(sq * (1.f / 64.f) + EPS) * rstd_q;
        h16x8 qb[4];
#pragma unroll
        for (int kk = 0; kk < 4; ++kk)
#pragma unroll
            for (int j = 0; j < 8; ++j) qb[kk][j] = (h16)(aq[kk >> 1][8 * (kk & 1) + j] * rsq);
        const h16* kp = Wka + (size_t)h * 128 * 64 + (size_t)tok * 64 + 8 * hf;
#pragma unroll
        for (int ct = 0; ct < 4; ++ct) {
            f32x16 ak;
#pragma unroll
            for (int r = 0; r < 16; ++r) ak[r] = 0.f;
#pragma unroll
            for (int kk = 0; kk < 4; ++kk) { const h16x8 a = *(const h16x8*)(kp + (size_t)(32 * ct) * 64 + 16 * kk); ak = MFMA32(a, qb[kk], ak); }
            store_tile_T(ak, 1.f, st, qk + srowc * 1024 + h * 128 + 32 * ct + 8 * (lane & 1), sok, lane);
        }
    }
#pragma unroll 1
    for (int nt = 0; nt < 8; ++nt) {
        f32x16 ai;
#pragma unroll
        for (int r = 0; r < 16; ++r) ai[r] = 0.f;
        const h16* wp = Wq2 + (size_t)(512 + 32 * nt + tok) * 256 + 8 * hf;
#pragma unroll
        for (int ks = 0; ks < 16; ++ks) { const h16x8 a = *(const h16x8*)(wp + 16 * ks); ai = MFMA32(a, bq[ks], ai); }
#pragma unroll
        for (int r = 0; r < 16; ++r) ai[r] *= rstd_q;
        store_tile_T(ai, 1.f, st, qidx + srowc * 256 + 32 * nt + 8 * (lane & 1), sok, lane);
    }
    h16x8 bk[8]; float sk = 0.f;
#pragma unroll
    for (int ks = 0; ks < 8; ++ks) { bk[ks] = *(const h16x8*)(projA + (size_t)rowc * 512 + 256 + 16 * ks + 8 * hf);
#pragma unroll
        for (int e = 0; e < 8; ++e) { const float f = (float)bk[ks][e]; sk += f * f; } }
    sk = half_sum(sk);
    const float rstd_kv = rsqrtf(sk * (1.f / 128.f) + EPS);
    if (row < NT) {
        const float* g = P.g_ckv + l * 128;
#pragma unroll
        for (int ks = 0; ks < 8; ++ks) { h16x8 o;
#pragma unroll
            for (int e = 0; e < 8; ++e) o[e] = (h16)((float)bk[ks][e] * rstd_kv * g[16 * ks + 8 * hf + e]);
            *(h16x8*)(kvrow + (size_t)row * 136 + 16 * ks + 8 * hf) = o; }
    }
#pragma unroll 1
    for (int h = 0; h < 8; ++h) {
        f32x16 ak[2];
#pragma unroll
        for (int mt = 0; mt < 2; ++mt)
#pragma unroll
            for (int r = 0; r < 16; ++r) ak[mt][r] = 0.f;
        const h16* wp = Wuk + (size_t)(64 * h + tok) * 128 + 8 * hf;
#pragma unroll
        for (int ks = 0; ks < 8; ++ks) {
            const h16x8 a0 = *(const h16x8*)(wp + 16 * ks), a1 = *(const h16x8*)(wp + 32 * 128 + 16 * ks);
            ak[0] = MFMA32(a0, bk[ks], ak[0]); ak[1] = MFMA32(a1, bk[ks], ak[1]);
        }
        float sq = 0.f;
#pragma unroll
        for (int mt = 0; mt < 2; ++mt)
#pragma unroll
            for (int r = 0; r < 16; ++r) sq += ak[mt][r] * ak[mt][r];
        sq = half_sum(sq) * rstd_kv * rstd_kv;
        if (row < NT && hf == 0) kvrow[(size_t)row * 136 + 128 + h] = (h16)rsqrtf(sq * (1.f / 64.f) + EPS);
    }
    if (row < NT) {
        h16* kfrag = (h16*)(P.ws + OFF_KFRAG);
        const int b = row >= T_ ? 1 : 0; const int t = row - b * T_; const int tile = t >> 5;
#pragma unroll
        for (int q = 0; q < 4; ++q) {
            const int g8 = 2 * q + hf;
            const h16x8 v = *(const h16x8*)(projA + (size_t)row * 512 + 384 + g8 * 8);
            *(h16x8*)(kfrag + ((size_t)(b * NKT + tile) * 4 + (g8 >> 1)) * 512 + ((g8 & 1) * 32 + (t & 31)) * 8) = v;
        }
    }
}

__device__ __forceinline__ void p4_item(const Params& P, int l, int item, int lane) {
    const int r0 = item * 32; const int tok = lane & 31, hf = lane >> 5;
    const int row = r0 + tok; const bool ok = row < NT; const size_t rowc = ok ? row : NT - 1;
    const h16* ctx = (const h16*)(P.ws + OFF_CTX); const h16* Wuv = (const h16*)(P.ws + OFF_WUVT) + (size_t)l * 8 * 64 * 128;
    const h16* sza = (const h16*)(P.ws + OFF_SZA); const h16* szg = (const h16*)(P.ws + OFF_SZG); const h16* og = (const h16*)(P.ws + OFF_QN);
    h16* omix = (h16*)(P.ws + OFF_OMIX);
#pragma unroll 1
    for (int h = 0; h < 8; ++h) {
        h16x8 bc[8];
#pragma unroll
        for (int ks = 0; ks < 8; ++ks) bc[ks] = *(const h16x8*)(ctx + rowc * 1024 + h * 128 + 16 * ks + 8 * hf);
        f32x16 ao[2];
#pragma unroll
        for (int mt = 0; mt < 2; ++mt)
#pragma unroll
            for (int r = 0; r < 16; ++r) ao[mt][r] = 0.f;
        const h16* wp = Wuv + (size_t)h * 64 * 128 + (size_t)tok * 128 + 8 * hf;
#pragma unroll
        for (int ks = 0; ks < 8; ++ks) {
            const h16x8 a0 = *(const h16x8*)(wp + 16 * ks), a1 = *(const h16x8*)(wp + 32 * 128 + 16 * ks);
            ao[0] = MFMA32(a0, bc[ks], ao[0]); ao[1] = MFMA32(a1, bc[ks], ao[1]);
        }
#pragma unroll
        for (int mt = 0; mt < 2; ++mt)
#pragma unroll
            for (int gp = 0; gp < 2; ++gp) {
                float y[8];
#pragma unroll
                for (int e = 0; e < 4; ++e) {
                    const auto sw = __builtin_amdgcn_permlane32_swap(__float_as_uint(ao[mt][8 * gp + e]), __float_as_uint(ao[mt][8 * gp + 4 + e]), false, false);
                    y[e] = __uint_as_float(sw[0]); y[4 + e] = __uint_as_float(sw[1]);
                }
                if (ok) {
                    const int d0 = h * 64 + 32 * mt + 16 * gp + 8 * hf;
                    const h16x8 z = *(const h16x8*)(sza + (size_t)row * 512 + d0);
                    h16x8 o;
#pragma unroll
                    for (int e = 0; e < 8; ++e) o[e] = (h16)(y[e] * (float)z[e]);
                    *(h16x8*)(omix + (size_t)row * 1024 + d0) = o;
                }
            }
    }
    const float* go = P.g_out + l * 128;
#pragma unroll 1
    for (int h = 0; h < 4; ++h) {
        h16x8 v[8]; float ss = 0.f;
#pragma unroll
        for (int q = 0; q < 8; ++q) { v[q] = *(const h16x8*)(og + rowc * 512 + h * 128 + 16 * q + 8 * hf);
#pragma unroll
            for (int e = 0; e < 8; ++e) { const float f = (float)v[q][e]; ss += f * f; } }
        ss = half_sum(ss);
        const float rs = rsqrtf(ss * (1.f / 128.f) + EPS);
        if (ok) {
#pragma unroll
            for (int q = 0; q < 8; ++q) { const h16x8 z = *(const h16x8*)(szg + (size_t)row * 512 + h * 128 + 16 * q + 8 * hf); h16x8 o;
#pragma unroll
                for (int e = 0; e < 8; ++e) o[e] = (h16)((float)v[q][e] * rs * go[16 * q + 8 * hf + e] * (float)z[e]);
                *(h16x8*)(omix + (size_t)row * 1024 + 512 + h * 128 + 16 * q + 8 * hf) = o; }
        }
    }
}

__device__ __forceinline__ void phase2(const Params& P, int l, unsigned char* lds) {
    const int tid = opaque_tid(), lane = tid & 63, w = tid >> 6;
    unsigned* ctr = (unsigned*)(P.ws + OFF_CTL) + 5000 + l * 128;
    int* slot = (int*)(lds + LDS_BYTES - 32);
    const int x0 = (int)xb_xcc_id() & 7; int d = 0;
    for (;;) {
        __syncthreads();
        if (tid == 0) {
            int res = -1;
            while (d < 8) {
                const int x = (x0 + d) & 7; const int ncx = (129 - x + 7) >> 3;
                const int t = (int)__hip_atomic_fetch_add(ctr + x * 16, 1u, __ATOMIC_RELAXED, __HIP_MEMORY_SCOPE_AGENT);
                if (t < ncx) { res = x + 8 * t; break; }
                if (t < ncx + NCH) { res = 129 + x * NCH + (t - ncx); break; }
                ++d;
            }
            *slot = res;
        }
        __syncthreads();
        const int it = *slot;
        if (it < 0) break;
        if (it >= 129) p2c_item(P, l, it - 129, lds);
        else {
            const int ci = it * 4 + w;
            __syncthreads();
            if (ci < (NT + 31) / 32) chain_item(P, l, ci, (float*)lds + w * 1152, lane);
        }
    }
}

constexpr int SNT = 2;
__device__ __forceinline__ void gdn_scan(const Params& P, int sw, unsigned char* lds) {
    h16* St = (h16*)lds;
    h16* Vt = (h16*)(lds + 16 * SNT * 272);
    const int tid = opaque_tid(), lane = tid & 63, w = tid >> 6, gq = lane >> 4, c16 = lane & 15;
    const int chain = sw / (8 / SNT), e0 = (sw % (8 / SNT)) * 16 * SNT, b = chain >> 2, h = chain & 3;
    const h16* Ub = (const h16*)(P.ws + OFF_U); const h16* Wb = (const h16*)(P.ws + OFF_WM);
    const h16* Qb = (const h16*)(P.ws + OFF_QD); const h16* Kb = (const h16*)(P.ws + OFF_KDT);
    const h16* Ab = (const h16*)(P.ws + OFF_AQK); const float* cdec = (const float*)(P.ws + OFF_CDEC);
    h16* og = (h16*)(P.ws + OFF_QN);
    __syncthreads();
    for (int i = tid; i < 16 * SNT * 136; i += NTHREADS) St[i] = (h16)0.f;
    f32x4 S[2][SNT];
#pragma unroll
    for (int m2 = 0; m2 < 2; ++m2)
#pragma unroll
        for (int nt = 0; nt < SNT; ++nt) S[m2][nt] = (f32x4){0.f, 0.f, 0.f, 0.f};
    __syncthreads();
    h16x8 wf[2][4], qf[2][4], af[2][2], kf_[2][2][2]; h16 uv[2][SNT][4]; float cd[2];
#define SCAN_LOAD(S_, n_) do { const int nn_ = (n_) < NCH ? (n_) : NCH - 1; const size_t itm = (size_t)chain * NCH + nn_; \
        _Pragma("unroll") for (int ks = 0; ks < 4; ++ks) { wf[S_][ks] = *(const h16x8*)(Wb + itm * 8192 + (16 * w + c16) * 128 + 32 * ks + 8 * gq); qf[S_][ks] = *(const h16x8*)(Qb + itm * 8192 + (16 * w + c16) * 128 + 32 * ks + 8 * gq); } \
        _Pragma("unroll") for (int ks = 0; ks < 2; ++ks) { af[S_][ks] = *(const h16x8*)(Ab + itm * 4096 + (16 * w + c16) * 64 + 32 * ks + 8 * gq); \
            _Pragma("unroll") for (int m2 = 0; m2 < 2; ++m2) kf_[S_][m2][ks] = *(const h16x8*)(Kb + itm * 8192 + (16 * (2 * w + m2) + c16) * 64 + 32 * ks + 8 * gq); } \
        _Pragma("unroll") for (int nt = 0; nt < SNT; ++nt) _Pragma("unroll") for (int r = 0; r < 4; ++r) uv[S_][nt][r] = Ub[itm * 8192 + (16 * w + 4 * gq + r) * 128 + e0 + 16 * nt + c16]; \
        cd[S_] = cdec[itm]; } while (0)
#define SCAN_STEP(S_, n_) do { \
        h16x8 cwf[4], cqf[4], caf[2], ckf[2][2]; float cu[SNT][4]; const float ccd = cd[S_]; \
        _Pragma("unroll") for (int ks = 0; ks < 4; ++ks) { cwf[ks] = wf[S_][ks]; cqf[ks] = qf[S_][ks]; } \
        _Pragma("unroll") for (int ks = 0; ks < 2; ++ks) { caf[ks] = af[S_][ks]; ckf[0][ks] = kf_[S_][0][ks]; ckf[1][ks] = kf_[S_][1][ks]; } \
        _Pragma("unroll") for (int nt = 0; nt < SNT; ++nt) _Pragma("unroll") for (int r = 0; r < 4; ++r) cu[nt][r] = (float)uv[S_][nt][r]; \
        SCAN_LOAD(S_, (n_) + 2); \
        f32x4 Pm[SNT], O[SNT]; \
        _Pragma("unroll") for (int nt = 0; nt < SNT; ++nt) { Pm[nt] = (f32x4){0.f, 0.f, 0.f, 0.f}; O[nt] = (f32x4){0.f, 0.f, 0.f, 0.f}; \
            _Pragma("unroll") for (int ks = 0; ks < 4; ++ks) { const h16x8 bs = *(const h16x8*)(St + (16 * nt + c16) * 136 + 32 * ks + 8 * gq); Pm[nt] = MFMA16(cwf[ks], bs, Pm[nt]); O[nt] = MFMA16(cqf[ks], bs, O[nt]); } \
            h16x4 vn; \
            _Pragma("unroll") for (int r = 0; r < 4; ++r) vn[r] = (h16)(cu[nt][r] - Pm[nt][r]); \
            *(h16x4*)(Vt + (16 * nt + c16) * 72 + 16 * w + 4 * gq) = vn; } \
        lds_barrier(); \
        _Pragma("unroll") for (int nt = 0; nt < SNT; ++nt) { \
            _Pragma("unroll") for (int m2 = 0; m2 < 2; ++m2) _Pragma("unroll") for (int r = 0; r < 4; ++r) S[m2][nt][r] *= ccd; \
            _Pragma("unroll") for (int ks = 0; ks < 2; ++ks) { const h16x8 bv = *(const h16x8*)(Vt + (16 * nt + c16) * 72 + 32 * ks + 8 * gq); O[nt] = MFMA16(caf[ks], bv, O[nt]); S[0][nt] = MFMA16(ckf[0][ks], bv, S[0][nt]); S[1][nt] = MFMA16(ckf[1][ks], bv, S[1][nt]); } \
            _Pragma("unroll") for (int r = 0; r < 4; ++r) { const int t = 64 * (n_) + 16 * w + 4 * gq + r - 48; if (t >= 0) og[((size_t)b * T_ + t) * 512 + h * 128 + e0 + 16 * nt + c16] = (h16)(O[nt][r] * 0.08838834764831845f); } \
            _Pragma("unroll") for (int m2 = 0; m2 < 2; ++m2) { h16x4 sv; \
                _Pragma("unroll") for (int r = 0; r < 4; ++r) sv[r] = (h16)S[m2][nt][r]; \
                *(h16x4*)(St + (16 * nt + c16) * 136 + 16 * (2 * w + m2) + 4 * gq) = sv; } } \
        lds_barrier(); } while (0)
    SCAN_LOAD(0, 0); SCAN_LOAD(1, 1);
    for (int n = 0; n + 1 < NCH; n += 2) { SCAN_STEP(0, n); SCAN_STEP(1, n + 1); }
    SCAN_STEP(0, NCH - 1);
#undef SCAN_STEP
#undef SCAN_LOAD
}

constexpr int CAP = 704;
__device__ __forceinline__ void dma16_asm(const void* gptr, unsigned lds_addr) {
    unsigned sv; lds_addr = (unsigned)__builtin_amdgcn_readfirstlane((int)lds_addr);
    asm volatile("s_mov_b32 %0, m0\n\ts_mov_b32 m0, %2\n\ts_nop 0\n\tglobal_load_lds_dwordx4 %1, off\n\ts_mov_b32 m0, %0" : "=&s"(sv) : "v"(gptr), "s"(lds_addr) : "memory");
}
__device__ __forceinline__ int dpp_scan_incl(int x) {
    x += __builtin_amdgcn_update_dpp(0, x, 0x111, 0xf, 0xf, false);
    x += __builtin_amdgcn_update_dpp(0, x, 0x112, 0xf, 0xf, false);
    x += __builtin_amdgcn_update_dpp(0, x, 0x114, 0xf, 0xf, false);
    x += __builtin_amdgcn_update_dpp(0, x, 0x118, 0xf, 0xf, false);
    x += __builtin_amdgcn_update_dpp(0, x, 0x142, 0xa, 0xf, false);
    x += __builtin_amdgcn_update_dpp(0, x, 0x143, 0xc, 0xf, false);
    return x;
}

__device__ __forceinline__ int topk_prune(float* sc, unsigned short* ix, unsigned* hist, int c, int lane, int K, int limit, float& theta, float& theta_next) {
    constexpr int NE = CAP / 64; static_assert(CAP % 64 == 0, "prune reads whole 64-entry rows");
    constexpr unsigned OOB = 0x40000000u;
    unsigned key[NE]; unsigned idx[NE]; float val[NE];
#pragma unroll
    for (int it = 0; it < NE; ++it) { val[it] = sc[lane + 64 * it]; idx[it] = ix[lane + 64 * it]; }
#pragma unroll
    for (int it = 0; it < NE; ++it) key[it] = (lane + 64 * it < c) ? ordkey(val[it]) : 0u;
    unsigned prefix = 0; int need = K; int binpop = 0; bool exact = true;
    const unsigned hist_a = (unsigned)(size_t)(LAS unsigned*)hist;
    const unsigned tb0 = (unsigned)__builtin_amdgcn_readfirstlane((int)(key[0] >> 24));
    unsigned kmax = key[0], kmin1 = key[0] - 1u;
#pragma unroll
    for (int it = 1; it < NE; ++it) { kmax = kmax > key[it] ? kmax : key[it]; const unsigned k1 = key[it] - 1u; kmin1 = kmin1 < k1 ? kmin1 : k1; }
    const bool skip0 = __all((int)(((kmax >> 24) == tb0) & (((kmin1 + 1u) >> 24) == tb0)));
    if (skip0) prefix = tb0 << 24;
#pragma unroll
    for (int r = 0; r < 4; ++r) {
        if (r == 0 && skip0) continue;
        const int shift = 24 - 8 * r;
        ((uint4*)hist)[lane] = make_uint4(0u, 0u, 0u, 0u);
        WAVE_FENCE();
#pragma unroll
        for (int it = 0; it < NE; ++it) {
            const bool m = r == 0 || ((key[it] ^ prefix) >> ((shift + 8) & 31)) == 0u;
            const unsigned ha = m ? hist_a + 4u * ((key[it] >> shift) & 255u) : OOB;
            asm volatile("ds_add_u32 %0, %1" : : "v"(ha), "v"(1u) : "memory");
        }
        WAVE_FENCE();
        const uint4 h4 = ((const uint4*)hist)[63 - lane];
        WAVE_FENCE();
        const int loc = (int)(h4.x + h4.y + h4.z + h4.w);
        const int incl = dpp_scan_incl(loc);
        const int c3 = incl - loc;
        const u64 fm = __builtin_amdgcn_ballot_w64(c3 < need && need <= incl);
        const int src = __builtin_amdgcn_readfirstlane(__ffsll((long long)fm) - 1);
        const int sw_ = __builtin_amdgcn_readlane((int)h4.w, src), sz_ = __builtin_amdgcn_readlane((int)h4.z, src), sy_ = __builtin_amdgcn_readlane((int)h4.y, src), sx_ = __builtin_amdgcn_readlane((int)h4.x, src);
        int cabv = __builtin_amdgcn_readlane(c3, src), dsel = 3; binpop = sw_;
        if (need > cabv + binpop) { cabv += binpop; binpop = sz_; dsel = 2; }
        if (dsel == 2 && need > cabv + binpop) { cabv += binpop; binpop = sy_; dsel = 1; }
        if (dsel == 1 && need > cabv + binpop) { cabv += binpop; binpop = sx_; dsel = 0; }
        const int digit = 4 * (63 - src) + dsel;
        need -= cabv; prefix |= (unsigned)digit << shift;
        if (r < 3 && (K - need) + binpop <= limit) { exact = false; break; }
    }
    const unsigned thr = prefix;
    const unsigned sc_a = (unsigned)(size_t)(LAS float*)sc; unsigned ix_a = (unsigned)(size_t)(LAS unsigned short*)ix; asm volatile("" : "+v"(ix_a));
    int out = 0; asm volatile("" : "+v"(out));
    if (exact && K == 256 && need < binpop) {
        int tb = 0;
#pragma unroll
        for (int it = 0; it < NE; ++it) {
            const bool gt = key[it] > thr; const bool eq = key[it] == thr;
            const u64 meq = __builtin_amdgcn_ballot_w64(eq); const int tr = tb + lanes_below(meq); const bool keep = gt || (eq && tr < need); tb += __builtin_popcountll(meq);
            const u64 mk = __builtin_amdgcn_ballot_w64(keep); int slot = lanes_below_from(mk, out); slot = keep ? slot : (int)(OOB >> 2);
            asm volatile("ds_write_b32 %0, %1\n\tds_write_b16 %2, %3" : : "v"(sc_a + 4u * (unsigned)slot), "v"(val[it]), "v"(ix_a + 2u * (unsigned)slot), "v"(idx[it]) : "memory");
            out += __builtin_popcountll(mk); asm("" : "+v"(out));
        }
    } else {
#pragma unroll
        for (int it = 0; it < NE; ++it) {
            const u64 mk = __builtin_amdgcn_ballot_w64(key[it] >= thr); int slot = lanes_below_from(mk, out); slot = __builtin_amdgcn_inverse_ballot_w64(mk) ? slot : (int)(OOB >> 2);
            asm volatile("ds_write_b32 %0, %1\n\tds_write_b16 %2, %3" : : "v"(sc_a + 4u * (unsigned)slot), "v"(val[it]), "v"(ix_a + 2u * (unsigned)slot), "v"(idx[it]) : "memory");
            out += __builtin_popcountll(mk); asm("" : "+v"(out));
        }
    }
    WAVE_FENCE();
    theta = ordinv(thr); theta_next = ordinv(thr + 1u);
    return __builtin_amdgcn_readfirstlane(out);
}

constexpr int WL_SC = 0;
constexpr int WL_IX = 8 * CAP * 4;
constexpr int WL_RING = 0;
constexpr int SLOT_BYTES = 8704;
constexpr int WL_SEL = 34816;
constexpr int WL_NSEL = 38912;
constexpr int WL_BYTES = 38944;
static_assert(WL_IX + 8 * CAP * 2 <= WL_SEL && 4 * SLOT_BYTES <= WL_SEL, "DSA LDS map");

__device__ __forceinline__ void dsa_item(const Params& P, int item, int qlo, int qhi, unsigned char* wl, const float* biasd, int lane) {
    float* sc = (float*)(wl + WL_SC);
    unsigned short* ix = (unsigned short*)(wl + WL_IX);
    unsigned* hist = (unsigned*)(wl + WL_SEL);
    unsigned short* sel = (unsigned short*)(wl + WL_SEL);
    int* nselL = (int*)(wl + WL_NSEL);
    unsigned char* ring = wl + WL_RING;
    const h16* qidx = (const h16*)(P.ws + OFF_QIDX);
    const float* small = (const float*)(P.ws + OFF_SMALL);
    const h16* kvrow = (const h16*)(P.ws + OFF_KVROW);
    const h16* qk = (const h16*)(P.ws + OFF_QK);
    h16* ctxb = (h16*)(P.ws + OFF_CTX);
    const int row0 = item * 8; const int b = row0 >= T_ ? 1 : 0; const int t0 = row0 - b * T_;
    const int half = lane >> 5, kl = lane & 31;
    const unsigned wl_a = (unsigned)(size_t)(LAS unsigned char*)wl;
    unsigned wl_a2 = wl_a; asm volatile("" : "+v"(wl_a2));
    WAVE_FENCE();
    TSEC_BEGIN(3)
    h16x8 qf[4];
    for (int rep_ = 0; rep_ <= (PROBE_TOPK2 | PROBE_SWEEP); ++rep_) {
        const bool dummy_ = PROBE_SWEEP && rep_ == 0;
        h16x8 afr[4];
        { const int qq = kl >> 2, hd = kl & 3; const h16* p = qidx + (size_t)(row0 + qq) * 256 + hd * 64 + 8 * half;
#pragma unroll
          for (int ks = 0; ks < 4; ++ks) afr[ks] = *(const h16x8*)(p + 16 * ks); }
        float wq[4][4]; float thq[8]; int cntq[8];
#pragma unroll
        for (int g = 0; g < 4; ++g) { const float* sp = small + (size_t)(row0 + 2 * g + half) * 16;
#pragma unroll
            for (int hh = 0; hh < 4; ++hh) wq[g][hh] = sp[hh]; }
#pragma unroll
        for (int qq = 0; qq < 8; ++qq) { thq[qq] = (dummy_ || qq < qlo || qq >= qhi) ? INFINITY : -INFINITY; cntq[qq] = 0; }
        const int ntiles = ((t0 + 7) >> 5) + 1;
        bool safe_ = false;
      redo_sweep:
        const h16* kfp = (const h16*)(P.ws + OFF_KFRAG) + (size_t)b * NKT * 2048 + lane * 8;
        h16x8 bt[4][4];
#pragma unroll
        for (int u = 0; u < 4; ++u) { const int tl = u < ntiles ? u : ntiles - 1;
#pragma unroll
            for (int ks = 0; ks < 4; ++ks) bt[u][ks] = *(const h16x8*)(kfp + (size_t)tl * 2048 + ks * 512); }
        const int ngroups = (ntiles + 3) >> 2;
#define SWEEP_GROUP() \
                f32x16 acc[4]; \
                asm volatile("v_mfma_f32_32x32x16_f16 %0, %4, %5, 0\n\tv_mfma_f32_32x32x16_f16 %1, %4, %6, 0\n\tv_mfma_f32_32x32x16_f16 %2, %4, %7, 0\n\tv_mfma_f32_32x32x16_f16 %3, %4, %8, 0" \
                    : "=&v"(acc[0]), "=&v"(acc[1]), "=&v"(acc[2]), "=&v"(acc[3]) : "v"(afr[0]), "v"(bt[0][0]), "v"(bt[1][0]), "v"(bt[2][0]), "v"(bt[3][0])); \
                _Pragma("unroll") for (int ks = 1; ks < 3; ++ks) \
                    asm volatile("v_mfma_f32_32x32x16_f16 %0, %4, %5, %0\n\tv_mfma_f32_32x32x16_f16 %1, %4, %6, %1\n\tv_mfma_f32_32x32x16_f16 %2, %4, %7, %2\n\tv_mfma_f32_32x32x16_f16 %3, %4, %8, %3" \
                        : "+v"(acc[0]), "+v"(acc[1]), "+v"(acc[2]), "+v"(acc[3]) : "v"(afr[ks]), "v"(bt[0][ks]), "v"(bt[1][ks]), "v"(bt[2][ks]), "v"(bt[3][ks])); \
                asm volatile("v_mfma_f32_32x32x16_f16 %0, %4, %5, %0\n\tv_mfma_f32_32x32x16_f16 %1, %4, %6, %1\n\tv_mfma_f32_32x32x16_f16 %2, %4, %7, %2\n\tv_mfma_f32_32x32x16_f16 %3, %4, %8, %3\n\ts_nop 7\n\ts_nop 7" \
                    : "+v"(acc[0]), "+v"(acc[1]), "+v"(acc[2]), "+v"(acc[3]) : "v"(afr[3]), "v"(bt[0][3]), "v"(bt[1][3]), "v"(bt[2][3]), "v"(bt[3][3])); \
                _Pragma("unroll") for (int u = 0; u < 4; ++u) { \
                    const int tn = tile0 + u + 4 < ntiles ? tile0 + u + 4 : ntiles - 1;     \
                    _Pragma("unroll") for (int ks = 0; ks < 4; ++ks) bt[u][ks] = *(const h16x8*)(kfp + (size_t)tn * 2048 + ks * 512); } \
                __builtin_amdgcn_sched_barrier(0);
        for (int grp = 0; grp <= ngroups; ++grp) {
            const bool last = grp == ngroups;
            if (!last) {
                const int tile0 = grp * 4;
                f32x16 accs[4];
                { SWEEP_GROUP() _Pragma("unroll") for (int u = 0; u < 4; ++u) accs[u] = acc[u]; }
#define APPEND_PAIR(G, CAUSAL) do { float sa = 0.f, sb = 0.f; \
                        _Pragma("unroll") for (int hh = 0; hh < 4; ++hh) { sa = fmaf(wq[G][hh], relu1(accs[2 * p][4 * (G) + hh]), sa); sb = fmaf(wq[G][hh], relu1(accs[2 * p + 1][4 * (G) + hh]), sb); } \
                        const auto sw = __builtin_amdgcn_permlane32_swap(__float_as_uint(sa), __float_as_uint(sb), false, false);     \
                        const float s0_ = __uint_as_float(sw[0]), s1_ = __uint_as_float(sw[1]); u64 m0_, m1_;     \
                        asm("v_cmp_ge_f32 %0, %1, %2" : "=s"(m0_) : "v"(s0_), "v"(thq[2 * (G)])); asm("v_cmp_ge_f32 %0, %1, %2" : "=s"(m1_) : "v"(s1_), "v"(thq[2 * (G) + 1])); \
                        if (CAUSAL) { m0_ &= __builtin_amdgcn_ballot_w64(key <= t0 + 2 * (G)); m1_ &= __builtin_amdgcn_ballot_w64(key <= t0 + 2 * (G) + 1); } \
                        int sl0_ = lanes_below_from(m0_, cntq[2 * (G)]), sl1_ = lanes_below_from(m1_, cntq[2 * (G) + 1]); \
                        sl0_ = __builtin_amdgcn_inverse_ballot_w64(m0_) ? sl0_ : 0x10000000; sl1_ = __builtin_amdgcn_inverse_ballot_w64(m1_) ? sl1_ : 0x10000000;     \
                        const unsigned a10_ = wl_a + 4u * (unsigned)sl0_, a20_ = wl_a2 + 2u * (unsigned)sl0_, a11_ = wl_a + 4u * (unsigned)sl1_, a21_ = wl_a2 + 2u * (unsigned)sl1_; \
                        asm volatile("ds_write_b32 %0, %1 offset:%7\n\tds_write_b16 %2, %6 offset:%8\n\tds_write_b32 %3, %4 offset:%9\n\tds_write_b16 %5, %6 offset:%10" \
                            : : "v"(a10_), "v"(s0_), "v"(a20_), "v"(a11_), "v"(s1_), "v"(a21_), "v"(key), \
                              "n"(WL_SC + 2 * (G) * CAP * 4), "n"(WL_IX + 2 * (G) * CAP * 2), "n"(WL_SC + (2 * (G) + 1) * CAP * 4), "n"(WL_IX + (2 * (G) + 1) * CAP * 2) : "memory"); \
                        cntq[2 * (G)] += __builtin_popcountll(m0_); asm("" : "+v"(cntq[2 * (G)])); cntq[2 * (G) + 1] += __builtin_popcountll(m1_); asm("" : "+v"(cntq[2 * (G) + 1])); } while (0)
#define APPEND_GROUP(CAUSAL) _Pragma("unroll") for (int p = 0; p < 2; ++p) {     \
                    const int key = (tile0 + 2 * p) * 32 + lane;     \
                    APPEND_PAIR(0, CAUSAL); APPEND_PAIR(1, CAUSAL); APPEND_PAIR(2, CAUSAL); APPEND_PAIR(3, CAUSAL); }
                if (tile0 * 32 + 127 > t0) { APPEND_GROUP(1) } else { APPEND_GROUP(0) }
#undef APPEND_GROUP
#undef APPEND_PAIR
            }
            const int lim = last ? 256 : CAP - 128;
            int cmax = cntq[0];
#pragma unroll
            for (int qq = 1; qq < 8; ++qq) cmax = cntq[qq] > cmax ? cntq[qq] : cmax;
            if (__builtin_amdgcn_readfirstlane(cmax) > lim) {
                WAVE_FENCE();
#pragma unroll 1
                for (int qq = 0; qq < 8; ++qq) {
                    int c = cntq[0];
#pragma unroll
                    for (int j = 1; j < 8; ++j) c = qq == j ? cntq[j] : c;
                    c = __builtin_amdgcn_readfirstlane(c);
                    if (c > lim) {
                        float nth, nthn;
                        const int nall = t0 + qq + 1; int nseen = (grp + 1) * 128; nseen = nseen < nall ? nseen : nall;
                        int K = 256;
                        if (!last && !safe_) { K = (int)(336.f * (float)nseen / (float)nall) + 16; K = K < 48 ? 48 : (K > 256 ? 256 : K); }
                        TSEC_BEGIN(1) TSEC_BEGIN(2)
                        int ncf = c, lm2 = last ? 256 : K + 64; float nv = 0.f;
#pragma unroll 1
                        for (int att = 0; att < 2; ++att) {
                            ncf = topk_prune(sc + qq * CAP, ix + qq * CAP, hist, ncf, lane, K, lm2, nth, nthn);
                            nv = K == 256 ? nthn : nth;
                            if (K == 256 || ncf <= lim) break;
                            K = 256; lm2 = 320;
                        }
                        if (!last) TSEC_END(1); else TSEC_END(2);
#pragma unroll
                        for (int j = 0; j < 8; ++j) if (j == qq) { cntq[j] = ncf; thq[j] = nv; }
                    }
                }
            }
        }
        {
            bool okq = true;
#pragma unroll
            for (int qq = 0; qq < 8; ++qq) okq = okq && (qq < qlo || qq >= qhi || cntq[qq] >= 256 || cntq[qq] >= t0 + qq + 1);
            if (!__builtin_amdgcn_readfirstlane((int)okq) && !safe_ && !dummy_) {
                safe_ = true;
#pragma unroll
                for (int qq = 0; qq < 8; ++qq) { const bool done = qq < qlo || qq >= qhi || cntq[qq] >= 256 || cntq[qq] >= t0 + qq + 1;
                    thq[qq] = done ? INFINITY : -INFINITY; cntq[qq] = done ? cntq[qq] : 0; }
                WAVE_FENCE();
                goto redo_sweep;
            }
        }
#undef SWEEP_GROUP
        WAVE_FENCE();
#pragma unroll
        for (int ks = 0; ks < 4; ++ks) qf[ks] = *(const h16x8*)(qk + (size_t)(row0 + qlo) * 1024 + ((lane & 15) & 7) * 128 + 32 * ks + 8 * (lane >> 4));
#pragma unroll 1
        for (int qq = qlo; qq < (dummy_ ? 0 : qhi); ++qq) {
            int c = cntq[0];
#pragma unroll
            for (int j = 1; j < 8; ++j) c = qq == j ? cntq[j] : c;
            c = __builtin_amdgcn_readfirstlane(c);
            if (lane == 0) nselL[qq] = c;
#pragma unroll
            for (int i4 = 0; i4 < 4; ++i4) { const int i = lane + 64 * i4; sel[qq * 256 + (i & ~31) + (i & 3) * 8 + ((i & 31) >> 2)] = i < c ? ix[qq * CAP + i] : (unsigned short)0; }
        }
        WAVE_FENCE();
    }
    TSEC_END(3);
    TSEC_BEGIN(4)
    const int gq = lane >> 4, c16 = lane & 15; const bool hv = c16 < 8;
    const unsigned ring_a = (unsigned)(size_t)(LAS unsigned char*)ring;
    const h16* kvb = kvrow + (size_t)b * T_ * 136;
    const unsigned char* kvb4 = (const unsigned char*)kvb - 4096;
    unsigned poffb[4];
#pragma unroll
    for (int i = 0; i < 4; ++i) poffb[i] = (unsigned)((c16 ^ ((4 * i + gq) & 15)) * 16) + 4096u - 1024u * (unsigned)i;
    const float b31 = biasd[127 * 8 + (c16 & 7)];
    const int rpos = (lane & 3) * 8 + ((lane & 31) >> 2);
#define DSA_ISSUE(J_) do { const int jj_ = (J_) < 8 * qhi ? (J_) : 8 * qhi - 1; const unsigned short* sp_ = sel + (jj_ >> 3) * 256 + 32 * (jj_ & 7); \
        const u16x8 kk_ = *(const u16x8*)(sp_ + 8 * gq); const unsigned kr_ = sp_[rpos]; \
        unsigned o_[8]; \
        _Pragma("unroll") for (int i = 0; i < 8; ++i) o_[i] = (unsigned)kk_[i] * 272u + poffb[i & 3]; \
        const unsigned or_ = kr_ * 272u + 256u + 4096u; \
        const unsigned la_ = (unsigned)__builtin_amdgcn_readfirstlane((int)(ring_a + ((J_) & 3) * SLOT_BYTES)); unsigned sv_; unsigned long long ex_; \
        asm volatile("s_mov_b32 %0, m0\n\ts_mov_b32 m0, %2\n\ts_nop 0\n\t" \
            "global_load_lds_dwordx4 %3, %12\n\t" "global_load_lds_dwordx4 %4, %12 offset:1024\n\t" "global_load_lds_dwordx4 %5, %12 offset:2048\n\t" "global_load_lds_dwordx4 %6, %12 offset:3072\n\t" \
            "s_add_u32 m0, m0, 0x1000\n\ts_nop 0\n\t" \
            "global_load_lds_dwordx4 %7, %12\n\t" "global_load_lds_dwordx4 %8, %12 offset:1024\n\t" "global_load_lds_dwordx4 %9, %12 offset:2048\n\t" "global_load_lds_dwordx4 %10, %12 offset:3072\n\t" \
            "s_add_u32 m0, m0, 0x1000\n\ts_nop 0\n\t" \
            "s_mov_b64 %1, exec\n\ts_mov_b64 exec, 0xffffffff\n\tglobal_load_lds_dwordx4 %11, %12\n\ts_mov_b64 exec, %1\n\ts_mov_b32 m0, %0" \
            : "=&s"(sv_), "=&s"(ex_) : "s"(la_), "v"(o_[0]), "v"(o_[1]), "v"(o_[2]), "v"(o_[3]), "v"(o_[4]), "v"(o_[5]), "v"(o_[6]), "v"(o_[7]), "v"(or_), "s"(kvb4) : "memory"); } while (0)
    for (int rep_ = 0; rep_ <= PROBE_ATT2; ++rep_) {
    asm volatile("s_waitcnt vmcnt(0) lgkmcnt(0)" ::: "memory");
#pragma unroll
    for (int ks = 0; ks < 4; ++ks) { asm volatile("" : "+v"(qf[ks])); qf[ks] *= (h16)1.4426950408889634f; }
    DSA_ISSUE(8 * qlo); DSA_ISSUE(8 * qlo + 1); DSA_ISSUE(8 * qlo + 2);
#pragma unroll 1
    for (int qq = qlo; qq < qhi; ++qq) {
        const int rowq = row0 + qq, tq = t0 + qq, ns = nselL[qq];
        const unsigned short* selq = sel + qq * 256;
        h16x8 qn[4];
        { const int qnx = qq + 1 < 8 ? qq + 1 : 7; const h16* qp = qk + (size_t)(row0 + qnx) * 1024 + (c16 & 7) * 128 + 8 * gq;
#pragma unroll
          for (int ks = 0; ks < 4; ++ks) asm volatile("global_load_dwordx4 %0, %1, off" : "=a"(qn[ks]) : "v"(qp + 32 * ks) : "memory"); }
        float m_run = -INFINITY, l_run = 0.f;
        f32x4 ctx[8];
#pragma unroll
        for (int nt = 0; nt < 8; ++nt) ctx[nt] = (f32x4){0.f, 0.f, 0.f, 0.f};
#pragma unroll 1
        for (int c = 0; c < 8; ++c) {
            const int j = 8 * qq + c;
            DSA_ISSUE(j + 3);
            asm volatile("s_waitcnt vmcnt(27)" ::: "memory");
            const unsigned char* sl = ring + (j & 3) * SLOT_BYTES;
            h16x8 af[2][4];
#pragma unroll
            for (int mt = 0; mt < 2; ++mt)
#pragma unroll
                for (int ks = 0; ks < 4; ++ks) af[mt][ks] = *(const h16x8*)(sl + (16 * mt + c16) * 256 + (((4 * ks + gq) ^ c16) * 16));
            fp16x4 rt[2];
#pragma unroll
            for (int mt = 0; mt < 2; ++mt) rt[mt] = __builtin_amdgcn_ds_read_tr16_b64_v4f16((LAS fp16x4*)(sl + 8192 + (16 * mt + 4 * gq + (c16 >> 2)) * 16 + 8 * (c16 & 3)));
            const int klast = (int)selq[32 * c + 31];
            fp16x4 tb[8][2];
            { const int rw0 = 4 * gq + (c16 >> 2), rw1 = 16 + rw0;
#pragma unroll
              for (int nt = 0; nt < 8; ++nt) { const int pc = 2 * nt + ((c16 >> 1) & 1);
                tb[nt][0] = __builtin_amdgcn_ds_read_tr16_b64_v4f16((LAS fp16x4*)(sl + rw0 * 256 + ((pc ^ (rw0 & 15)) * 16) + 8 * (c16 & 1)));
                tb[nt][1] = __builtin_amdgcn_ds_read_tr16_b64_v4f16((LAS fp16x4*)(sl + rw1 * 256 + ((pc ^ (rw1 & 15)) * 16) + 8 * (c16 & 1))); } }
            f32x4 s4[2];
#pragma unroll
            for (int mt = 0; mt < 2; ++mt) { s4[mt] = (f32x4){0.f, 0.f, 0.f, 0.f};
#pragma unroll
                for (int ks = 0; ks < 4; ++ks) s4[mt] = MFMA16(af[mt][ks], qf[ks], s4[mt]); }
            float bias[2][4];
#pragma unroll
            for (int mt = 0; mt < 2; ++mt)
#pragma unroll
                for (int r = 0; r < 4; ++r) bias[mt][r] = b31;
            if (__builtin_amdgcn_readfirstlane(klast) > tq - 127 || 32 * c + 32 > ns) {
#pragma unroll
                for (int mt = 0; mt < 2; ++mt) { const unsigned short* sq = selq + 32 * c + 4 * mt + gq; const int sarr[4] = {(int)sq[0], (int)sq[8], (int)sq[16], (int)sq[24]};
#pragma unroll
                    for (int r = 0; r < 4; ++r) { int d = tq - sarr[r]; d = d < 0 ? 0 : (d > 127 ? 127 : d);
                        const int kidx = 32 * c + 16 * mt + 4 * gq + r;
                        const float bv = biasd[d * 8 + (c16 & 7)]; bias[mt][r] = kidx < ns ? bv : -INFINITY; } }
            }
            float lg[2][4]; float mx = -INFINITY;
#pragma unroll
            for (int mt = 0; mt < 2; ++mt) { const h16x4 rr = __builtin_bit_cast(h16x4, rt[mt]);
#pragma unroll
                for (int r = 0; r < 4; ++r) { const float v = s4[mt][r] * (float)rr[r] + bias[mt][r]; lg[mt][r] = v; mx = fmaxf(mx, v); } }
            {
                const unsigned u0 = __float_as_uint(mx);
                const auto p16 = __builtin_amdgcn_permlane16_swap(u0, u0, false, false);
                const float y = fmaxf(__uint_as_float(p16[0]), __uint_as_float(p16[1]));
                const unsigned u1 = __float_as_uint(y);
                const auto p32 = __builtin_amdgcn_permlane32_swap(u1, u1, false, false);
                mx = fmaxf(__uint_as_float(p32[0]), __uint_as_float(p32[1]));
            }
            const float m_new = mx > m_run + 11.f ? mx : m_run;
            float rs = 0.f; float pp[2][4];
#pragma unroll
            for (int mt = 0; mt < 2; ++mt)
#pragma unroll
                for (int r = 0; r < 4; ++r) { const float p = __builtin_amdgcn_exp2f(lg[mt][r] - m_new); pp[mt][r] = p; rs += p; }
            {
                const unsigned u0 = __float_as_uint(rs);
                const auto p16 = __builtin_amdgcn_permlane16_swap(u0, u0, false, false);
                const float y = __uint_as_float(p16[0]) + __uint_as_float(p16[1]);
                const unsigned u1 = __float_as_uint(y);
                const auto p32 = __builtin_amdgcn_permlane32_swap(u1, u1, false, false);
                rs = __uint_as_float(p32[0]) + __uint_as_float(p32[1]);
            }
            h16x8 pa;
#pragma unroll
            for (int jx = 0; jx < 8; ++jx) pa[jx] = (h16)pp[jx >> 2][jx & 3];
            if (c > 0 && __any(m_new != m_run)) {
                const float alpha = __builtin_amdgcn_exp2f(m_run - m_new);
#pragma unroll
                for (int nt = 0; nt < 8; ++nt) asm volatile("" : "+a"(ctx[nt]));
                float ar[4];
#pragma unroll
                for (int r = 0; r < 4; ++r) ar[r] = shfl_l(alpha, 4 * gq + r);
#pragma unroll
                for (int nt = 0; nt < 8; ++nt)
#pragma unroll
                    for (int r = 0; r < 4; ++r) ctx[nt][r] *= ar[r];
                l_run *= alpha;
            }
            l_run += rs; m_run = m_new;
#pragma unroll
            for (int nt = 0; nt < 8; ++nt) {
                const h16x4 b0 = __builtin_bit_cast(h16x4, tb[nt][0]), b1 = __builtin_bit_cast(h16x4, tb[nt][1]);
                h16x8 bf; bf[0] = b0[0]; bf[1] = b0[1]; bf[2] = b0[2]; bf[3] = b0[3]; bf[4] = b1[0]; bf[5] = b1[1]; bf[6] = b1[2]; bf[7] = b1[3];
                ctx[nt] = MFMA16(pa, bf, ctx[nt]);
            }
        }
        float li[4];
#pragma unroll
        for (int r = 0; r < 4; ++r) li[r] = 1.f / shfl_l(l_run, (4 * gq + r) & 7);
        if (gq < 2) {
#pragma unroll
            for (int nt = 0; nt < 8; ++nt)
#pragma unroll
                for (int r = 0; r < 4; ++r) ctxb[(size_t)rowq * 1024 + (4 * gq + r) * 128 + 16 * nt + c16] = (h16)(ctx[nt][r] * li[r]);
        }
#pragma unroll
        for (int ks = 0; ks < 4; ++ks) qf[ks] = qn[ks] * (h16)1.4426950408889634f;
    }
    asm volatile("s_waitcnt vmcnt(0)" ::: "memory");
    }
#undef DSA_ISSUE
    WAVE_FENCE();
    TSEC_END(4);
}

__device__ __forceinline__ void phase3(const Params& P, int l, unsigned char* lds) {
    const int tid = opaque_tid(), lane = tid & 63, w = tid >> 6;
    float* biasd = (float*)(lds + 4 * WL_BYTES);
    __syncthreads();
    for (int i = tid; i < 1024; i += NTHREADS) biasd[i] = 1.4426950408889634f * P.rel[(int)c_bucket[i >> 3] * 8 + (i & 7)];
    __syncthreads();
    { TSEC_BEGIN(10)
    for (int rep_ = 0; rep_ <= PROBE_SCAN2; ++rep_) for (int sw = blockIdx.x; sw < 8 * (8 / SNT); sw += gridDim.x) gdn_scan(P, sw, lds);
    TSEC_END(10); }
    __syncthreads();
    unsigned* ctr = (unsigned*)(P.ws + OFF_CTL) + 4608 + l * 128;
    unsigned char* wl = lds + w * WL_BYTES;
    const int x0 = (int)xb_xcc_id() & 7; int d = 0;
    for (;;) {
        int item = -1;
        if (lane == 0) {
            while (d < 8) {
                const int xc = (x0 + d) & 7; const int bb = xc >> 2, sub = xc & 3; const int cnt = (1026 - sub + 3) >> 2;
                const int pf = 210;
                const int t = (int)__hip_atomic_fetch_add(ctr + xc * 16, 1u, __ATOMIC_RELAXED, __HIP_MEMORY_SCOPE_AGENT);
                if (t < pf + 2 * (cnt - pf)) {
                    const int p = t < pf ? t : pf + ((t - pf) >> 1);
                    item = (bb * 1026 + 4 * (cnt - 1 - p) + sub) * 4 + (t < pf ? 0 : 1 + ((t - pf) & 1));
                    break;
                }
                ++d;
            }
        }
        d = __builtin_amdgcn_readfirstlane(d);
        item = __builtin_amdgcn_readfirstlane(item);
        if (item < 0) break;
        { const int hsel = item & 3; dsa_item(P, item >> 2, hsel == 2 ? 4 : 0, hsel == 1 ? 4 : 8, wl, biasd, lane); }
    }
}

__device__ __forceinline__ void phase4(const Params& P, int l, unsigned char* lds) {
    const int tid = opaque_tid(), lane = tid & 63, w = tid >> 6;
    (void)lds;
    if (l == 0 && (int)gridDim.x > 160 && (int)blockIdx.x >= 129) { prep_tiles(P, lds, 1, 129, (int)gridDim.x - 129); return; }
    TSEC_BEGIN(11)
    for (int it = blockIdx.x * 4 + w; it < (NT + 31) / 32; it += gridDim.x * 4) p4_item(P, l, it, lane);
    TSEC_END(11);
    if (l == 0 && (int)gridDim.x <= 160) { __syncthreads(); prep_tiles(P, lds, 1, 0, (int)gridDim.x); }
}

__device__ __forceinline__ void phase5(const Params& P, int l, unsigned char* lds) {
    h16* smem = (h16*)lds;
    const h16* W = (const h16*)(P.ws + OFF_WOT) + (size_t)l * 1024 * 1024;
    const h16* A = (const h16*)(P.ws + OFF_OMIX);
    float* sumsq_next = (float*)(P.ws + OFF_SUMSQ) + NTP;
    XcdQueue xq; xq.init((unsigned*)(P.ws + OFF_CTL) + 4352 + l * 128, 32, (int*)(lds + LDS_BYTES - 32));
    int xl, qi;
    while (xq.next(xl, qi)) {
        const int rb = 8 * xl + (qi & 7), tn = qi >> 3;
        EpiResBig ep; ep.layer = l; ep.row0 = rb * 256; ep.n0 = tn * 256; ep.meta = P.meta; ep.x = P.x; ep.metah = (float*)(P.ws + OFF_METAH); ep.out = P.out; ep.h16o = (h16*)(P.ws + OFF_H16); ep.sumsq_next = sumsq_next; ep.ss = 0.f; ep.nseg = 4;
        gemm_big(A + (size_t)rb * 256 * 1024, 1024, W + (size_t)tn * 256 * 1024, 1024, 1024, ep, smem, xq);
    }
    __syncthreads();
    const int tid = opaque_tid();
    for (int it = blockIdx.x; it < 32; it += gridDim.x) {
        EpiResBig ep; ep.layer = l; ep.row0 = 16384; ep.n0 = it * 32; ep.meta = P.meta; ep.x = P.x; ep.metah = (float*)(P.ws + OFF_METAH); ep.out = P.out; ep.h16o = (h16*)(P.ws + OFF_H16); ep.sumsq_next = sumsq_next; ep.ss = 0.f; ep.nseg = 1;
        skinny_tile(A + (size_t)16384 * 1024, 1024, W + (size_t)it * 32 * 1024, 1024, 1024, ep, (float*)lds, tid);
    }
}

__global__ void __launch_bounds__(NTHREADS) hybrid_fwd(Params P) {
    extern __shared__ __attribute__((aligned(16))) unsigned char lds[];
    cg::grid_group grid = cg::this_grid();
    volatile LAS unsigned* bst = (volatile LAS unsigned*)(lds + LDS_BYTES - 16);
    if (threadIdx.x < 4) bst[threadIdx.x] = 0u;
    if (PROBE_TSEC && (threadIdx.x & 63) == 0) *tsec_slot() = 0ull;
    __syncthreads();
    XcdBarrier xbar = xcd_barrier_post((unsigned*)(P.ws + OFF_CTL) + 256, bst);
    if (PROBE_MFMA) {
        f32x16 pa[8]; h16x8 fa, fb;
#pragma unroll
        for (int e = 0; e < 8; ++e) { fa[e] = (h16)(0.001f * (threadIdx.x & 7)); fb[e] = (h16)0.5f; }
#pragma unroll
        for (int i = 0; i < 8; ++i)
#pragma unroll
            for (int r = 0; r < 16; ++r) pa[i][r] = 0.f;
        h16* lp = (h16*)lds + (threadIdx.x & 31) * 72 + 8 * ((threadIdx.x >> 5) & 1) + (threadIdx.x >> 6) * 2304;
#pragma unroll 1
        for (int it = 0; it < 256; ++it) {
            if (PROBE_MFMA == 2) {
                h16x8 t[8];
#pragma unroll
                for (int q = 0; q < 8; ++q) t[q] = *(const h16x8*)(lp + q * 32 * 72 + (it & 3) * 16);
#pragma unroll
                for (int q = 0; q < 4; ++q) *(h16x8*)(lp + 40000 + q * 32 * 72) = fb;
#pragma unroll
                for (int i = 0; i < 16; ++i) pa[i & 7] = MFMA32(t[i & 7], fb, pa[i & 7]);
#pragma unroll
                for (int q = 0; q < 12; ++q) { __builtin_amdgcn_sched_group_barrier(0x8, 1, 0); __builtin_amdgcn_sched_group_barrier(0x300, 1, 0); }
                __builtin_amdgcn_sched_group_barrier(0x8, 4, 0);
                __builtin_amdgcn_sched_barrier(0);
            } else {
#pragma unroll
                for (int i = 0; i < 16; ++i) pa[i & 7] = MFMA32(fa, fb, pa[i & 7]);
            }
        }
        float sacc = 0.f;
#pragma unroll
        for (int i = 0; i < 8; ++i) sacc += pa[i][0];
        if (sacc == 12345.678f) ((float*)(P.ws + OFF_CTL))[40] = sacc;
    }
    for (int ph0_ = P.ph_lo; ph0_ < P.ph_hi; ++ph0_) {
#ifndef ONLY
#define ONLY -1
#endif
        const int ph = ph0_;
        if (ph == 0) { TSEC_BEGIN(13) if (ONLY < 0 || ((ONLY >> 0) & 1)) for (int rep_ = 0; rep_ <= PROBE_P0X; ++rep_) phase_prep(P, lds); TSEC_END(13); }
        else {
            const int l = (ph - 1) / 5, s = (ph - 1) % 5;
            if (s == 0) { if (ONLY < 0 || ((ONLY >> 1) & 1)) for (int rep_ = 0; rep_ <= PROBE_P1X; ++rep_) phase_inproj(P, l, lds, rep_); }
            else if (s == 1) { if (ONLY < 0 || ((ONLY >> 2) & 1)) phase2(P, l, lds); }
            else if (s == 2) { if (ONLY < 0 || ((ONLY >> 3) & 1)) phase3(P, l, lds); }
            else if (s == 3) { if (ONLY < 0 || ((ONLY >> 4) & 1)) for (int rep_ = 0; rep_ <= PROBE_P4X; ++rep_) phase4(P, l, lds); }
            else { if (ONLY < 0 || ((ONLY >> 5) & 1)) for (int rep_ = 0; rep_ <= (l == 0 ? PROBE_P5L0X : 0); ++rep_) phase5(P, l, lds); }
        }
        if (ph + 1 < P.ph_hi) {
            if (P.ph_hi > 1000) grid.sync();
            { TSEC_BEGIN(20) if (PROBE_TSEC >= 20 && PROBE_TSEC - 20 == ph) t__20 = wall_clock64(); xcd_barrier(xbar); if (PROBE_TSEC >= 20 && PROBE_TSEC - 20 == ph) { const unsigned long long d__ = wall_clock64() - t__20; if ((threadIdx.x & 63) == 0) *tsec_slot() += d__; } }
            if (PROBE_SYNC) xcd_barrier(xbar);
        }
    }
    if (PROBE_TSEC) {
        unsigned long long* acc = (unsigned long long*)((unsigned*)(P.ws + OFF_CTL) + 32);
        __syncthreads();
        if ((threadIdx.x & 63) == 0) atomicAdd(acc, *tsec_slot());
        xcd_barrier(xbar);
        if (blockIdx.x == 0 && threadIdx.x == 0) {
            const unsigned long long tot = __hip_atomic_load(acc, __ATOMIC_RELAXED, __HIP_MEMORY_SCOPE_AGENT);
            const unsigned long long avg = tot / (gridDim.x * 4);
            const unsigned long long t0 = wall_clock64();
            while (wall_clock64() - t0 < avg) __builtin_amdgcn_s_sleep(4);
        }
    }
}

extern "C" void kernel_launch(void* const* d_in, const int* in_sizes, int n_in, void* d_out, int out_size, void* d_ws, size_t ws_size, hipStream_t stream) {
    static int grid_blocks = 0;
    if (grid_blocks == 0) {
        if (n_in != 17 || ws_size < WS_END) { fprintf(stderr, "kernel_launch: unexpected inputs (n_in %d, ws %zu < %zu)\n", n_in, ws_size, (size_t)WS_END); grid_blocks = -1; return; }
        int dev = 0, cus = 0, per_cu = 0;
        hipGetDevice(&dev);
        hipDeviceGetAttribute(&cus, hipDeviceAttributeMultiprocessorCount, dev);
        if (hipFuncSetAttribute((const void*)hybrid_fwd, hipFuncAttributeMaxDynamicSharedMemorySize, LDS_BYTES) != hipSuccess) { fprintf(stderr, "kernel_launch: hipFuncSetAttribute failed\n"); grid_blocks = -1; return; }
        hipOccupancyMaxActiveBlocksPerMultiprocessor(&per_cu, (const void*)hybrid_fwd, NTHREADS, LDS_BYTES);
        if (per_cu < 1) { fprintf(stderr, "kernel_launch: occupancy query says 0 blocks per CU\n"); grid_blocks = -1; return; }
        grid_blocks = cus * per_cu;
    }
    if (grid_blocks < 0) return;
    hipMemsetAsync((char*)d_ws + OFF_CTL, 0, 32768, stream);
    hipMemsetAsync((char*)d_ws + OFF_SUMSQ, 0, (size_t)2 * NTP * 4, stream);
    Params p{};
    p.x = (const float*)d_in[0]; p.meta = (const float*)d_in[1]; p.rel = (const float*)d_in[2]; p.norm_gain = (const float*)d_in[3];
    p.w_in = (const float*)d_in[4]; p.g_cq = (const float*)d_in[5]; p.g_ckv = (const float*)d_in[6]; p.w_uq = (const float*)d_in[7];
    p.w_ukv = (const float*)d_in[8]; p.w_qidx = (const float*)d_in[9]; p.g_qn = (const float*)d_in[10]; p.g_kn = (const float*)d_in[11];
    p.conv_w = (const float*)d_in[12]; p.a_log = (const float*)d_in[13]; p.dt_bias = (const float*)d_in[14]; p.g_out = (const float*)d_in[15];
    p.w_out = (const float*)d_in[16];
    p.out = (float*)d_out; p.ws = (unsigned char*)d_ws;
#if N_LAUNCH_MODE == 1
    p.ph_lo = 0; p.ph_hi = NPHASE;
    void* args[] = {&p};
    hipError_t e = hipLaunchCooperativeKernel((const void*)hybrid_fwd, dim3(grid_blocks), dim3(NTHREADS), args, LDS_BYTES, stream);
    if (e != hipSuccess) fprintf(stderr, "cooperative launch failed: %s (grid %d)\n", hipGetErrorString(e), grid_blocks);
#else
    for (int ph = 0; ph < NPHASE; ++ph) {
        p.ph_lo = ph; p.ph_hi = ph + 1;
        hipLaunchKernelGGL(hybrid_fwd, dim3(grid_blocks), dim3(NTHREADS), LDS_BYTES, stream, p);
    }
#endif
}
```
